# Optimizing an MI355X kernel written in HIP

```python
import math
import jax, jax.numpy as jnp
from jax import lax
import numpy as np

D_MODEL = 1024
BATCH = 8
SEQ = 4096
DEPTH = 2

GRID_W = 64
CTX_LEN = 256
EPS = 1e-6

D_LRU = D_MODEL // 4
LRU_HEADS = 4
LRU_HEAD_DIM = D_LRU // LRU_HEADS
CONV_W = 4
LRU_C = 8.0
MLA_V = 64
MLA_NOPE = 64
MLA_ROPE = 32
MLA_QK = MLA_NOPE + MLA_ROPE
D_MLA = D_MODEL // 2
MLA_HEADS = D_MLA // MLA_V
Q_RANK = 3 * D_MODEL // 8
KV_RANK = D_MODEL // 4
ROPE_FREQS = MLA_ROPE // 4
ROPE_BASE = 10000.0
D_POOL = D_MODEL // 4
POOL_WINDOWS = (2, 4, 8, 16)
POOL_GROUPS = len(POOL_WINDOWS)
POOL_GROUP_DIM = D_POOL // POOL_GROUPS
D_MIX = D_LRU + D_MLA + D_POOL
IN_SPLITS = (D_LRU, 2 * D_LRU, 2 * D_LRU + Q_RANK, 2 * D_LRU + Q_RANK + KV_RANK,
             2 * D_LRU + Q_RANK + KV_RANK + MLA_ROPE)
D_IN = IN_SPLITS[-1] + D_POOL
D_FF = 4 * D_MODEL
Q_BLOCK = 128

kernel_name = "hybrid_rglru_mla_pool_diffusion_block"

F32 = jnp.float32


def _rmsnorm(x, g):
    x32 = x.astype(F32)
    y = x32 * lax.rsqrt(jnp.mean(x32 * x32, axis=-1, keepdims=True) + EPS)
    return (y * g.astype(F32)).astype(x.dtype)


def _modulate(h, shift, scale):
    return h * (1.0 + scale) + shift


def _axial_rope_tables(L):
    rows = L // GRID_W
    row = jnp.repeat(jnp.arange(rows, dtype=F32), GRID_W)
    col = jnp.tile(jnp.arange(GRID_W, dtype=F32), rows)
    freqs = jnp.power(ROPE_BASE, -jnp.arange(ROPE_FREQS, dtype=F32) / ROPE_FREQS)
    ang = jnp.stack([row, col], axis=-1)[:, :, None] * freqs
    return jnp.cos(ang), jnp.sin(ang)


def _apply_axial_rope(x, cos, sin):
    B, L, H, _ = x.shape
    xs = x.astype(F32).reshape(B, L, H, 2, 2, ROPE_FREQS)
    x1, x2 = xs[..., 0, :], xs[..., 1, :]
    c = cos[None, :, None]
    s = sin[None, :, None]
    y = jnp.stack([x1 * c - x2 * s, x2 * c + x1 * s], axis=-2)
    return y.reshape(B, L, H, MLA_ROPE).astype(x.dtype)


def _dwconv(x, w, b):
    L = x.shape[1]
    left = (CONV_W - 1) // 2
    xp = jnp.pad(x, ((0, 0), (left, CONV_W - 1 - left), (0, 0)))
    y = sum(xp[:, k:k + L] * w[k] for k in range(CONV_W))
    return y + b


def _rglru_coeffs(xc, w_a, b_a, w_x, b_x, lam):
    B, L, _ = xc.shape
    xh = xc.reshape(B, L, LRU_HEADS, LRU_HEAD_DIM)
    r = jax.nn.sigmoid((jnp.einsum('blhi,hij->blhj', xh, w_a).reshape(B, L, D_LRU) + b_a).astype(F32))
    i = jax.nn.sigmoid((jnp.einsum('blhi,hij->blhj', xh, w_x).reshape(B, L, D_LRU) + b_x).astype(F32))
    log_a = -LRU_C * r * jax.nn.softplus(-lam.astype(F32))
    a = jnp.exp(log_a)
    b = jnp.sqrt(-jnp.expm1(2.0 * log_a)) * (i * xc.astype(F32))
    return a, b


def _linear_scan(a, b, h0):
    def combine(e1, e2):
        a1, b1 = e1
        a2, b2 = e2
        return a1 * a2, a2 * b1 + b2
    A, H = lax.associative_scan(combine, (a, b), axis=1)
    return H + A * h0[:, None, :]


def _bidir_rglru(xc_lat, xc_ctx, w_a, b_a, w_x, b_x, lam):
    B = xc_lat.shape[0]
    zeros = jnp.zeros((B, D_LRU), F32)
    y_lat = 0.0
    y_ctx = 0.0
    for d in range(2):
        xl = xc_lat if d == 0 else jnp.flip(xc_lat, axis=1)
        xcx = xc_ctx if d == 0 else jnp.flip(xc_ctx, axis=1)
        a_c, b_c = _rglru_coeffs(xcx, w_a[d], b_a[d], w_x[d], b_x[d], lam[d])
        a_l, b_l = _rglru_coeffs(xl, w_a[d], b_a[d], w_x[d], b_x[d], lam[d])
        h_c = _linear_scan(a_c, b_c, zeros)
        h_l = _linear_scan(a_l, b_l, h_c[:, -1])
        if d == 1:
            h_c = jnp.flip(h_c, axis=1)
            h_l = jnp.flip(h_l, axis=1)
        y_lat = y_lat + h_l
        y_ctx = y_ctx + h_c
    return y_lat.astype(xc_lat.dtype), y_ctx.astype(xc_ctx.dtype)


def _mla_q(q_lat, g_q_lat, w_uq, g_qn, rope):
    B, L, _ = q_lat.shape
    q = (_rmsnorm(q_lat, g_q_lat) @ w_uq).reshape(B, L, MLA_HEADS, MLA_QK)
    q = _rmsnorm(q, g_qn)
    if rope is not None:
        q = jnp.concatenate([q[..., :MLA_NOPE], _apply_axial_rope(q[..., MLA_NOPE:], *rope)], axis=-1)
    return q


def _mla_kv(kv_lat, k_rope, g_kv_lat, w_ukv, g_kn, rope):
    B, L, _ = kv_lat.shape
    kv = (_rmsnorm(kv_lat, g_kv_lat) @ w_ukv).reshape(B, L, MLA_HEADS, MLA_NOPE + MLA_V)
    k_nope, v = kv[..., :MLA_NOPE], kv[..., MLA_NOPE:]
    k_r = jnp.broadcast_to(k_rope[:, :, None, :], (B, L, MLA_HEADS, MLA_ROPE))
    k = _rmsnorm(jnp.concatenate([k_nope, k_r], axis=-1), g_kn)
    if rope is not None:
        k = jnp.concatenate([k[..., :MLA_NOPE], _apply_axial_rope(k[..., MLA_NOPE:], *rope)], axis=-1)
    return k, v


def _block_attention(q, k, v):
    B, L, H, Dq = q.shape
    nb = L // Q_BLOCK
    qb = jnp.moveaxis(q.reshape(B, nb, Q_BLOCK, H, Dq), 1, 0)
    scale = 1.0 / math.sqrt(Dq)

    def attend(qi):
        s = jnp.einsum('bqhd,bkhd->bhqk', qi, k).astype(F32) * scale
        p = jax.nn.softmax(s, axis=-1)
        return jnp.einsum('bhqk,bkhd->bqhd', p.astype(v.dtype), v)

    o = lax.map(attend, qb)
    return jnp.moveaxis(o, 0, 1).reshape(B, L, H * v.shape[-1])


def _pool_mixer(u, w_pool, pool_scale):
    B, L, _ = u.shape
    ug = u.astype(F32).reshape(B, L, POOL_GROUPS, POOL_GROUP_DIM)
    csum = jnp.concatenate([jnp.zeros((B, 1, POOL_GROUPS, POOL_GROUP_DIM), F32),
                            jnp.cumsum(ug, axis=1)], axis=1)
    t = jnp.arange(L)
    means = []
    for g, w in enumerate(POOL_WINDOWS):
        lo = jnp.clip(t - w // 2, 0, L)
        hi = jnp.clip(t - w // 2 + w, 0, L)
        cnt = (hi - lo).astype(F32)[None, :, None]
        means.append((csum[:, hi, g] - csum[:, lo, g]) / cnt)
    mixed = jnp.stack(means, axis=2) - ug
    y = jnp.einsum('blgi,gij->blgj', mixed, w_pool.astype(F32)).reshape(B, L, D_POOL)
    return (y * pool_scale.astype(F32)).astype(u.dtype)


def _mixer(h_lat, h_ctx, rope, need_ctx_out, w_in, conv_w, conv_b, lru_w_a, lru_b_a, lru_w_x, lru_b_x,
           lru_lambda, g_q_lat, w_uq, g_kv_lat, w_ukv, g_qn, g_kn, w_pool, pool_scale, w_out):
    z_lat = h_lat @ w_in
    z_ctx = h_ctx @ w_in
    lx_l, lg_l, ql_l, kvl_l, kr_l, pu_l = jnp.split(z_lat, IN_SPLITS, axis=-1)
    lx_c, lg_c, ql_c, kvl_c, kr_c, pu_c = jnp.split(z_ctx, IN_SPLITS, axis=-1)
    r_l, r_c = _bidir_rglru(_dwconv(lx_l, conv_w, conv_b), _dwconv(lx_c, conv_w, conv_b),
                            lru_w_a, lru_b_a, lru_w_x, lru_b_x, lru_lambda)
    a_l = r_l * jax.nn.gelu(lg_l)
    k_c, v_c = _mla_kv(kvl_c, kr_c, g_kv_lat, w_ukv, g_kn, None)
    k_l, v_l = _mla_kv(kvl_l, kr_l[:, :, :], g_kv_lat, w_ukv, g_kn, rope)
    q_l = _mla_q(ql_l, g_q_lat, w_uq, g_qn, rope)
    att_l = _block_attention(q_l, jnp.concatenate([k_c, k_l], axis=1), jnp.concatenate([v_c, v_l], axis=1))
    p_l = _pool_mixer(pu_l, w_pool, pool_scale)
    y_lat = jnp.concatenate([a_l, att_l, p_l], axis=-1) @ w_out
    if not need_ctx_out:
        return y_lat, None
    a_c = r_c * jax.nn.gelu(lg_c)
    q_c = _mla_q(ql_c, g_q_lat, w_uq, g_qn, None)
    att_c = _block_attention(q_c, k_c, v_c)
    p_c = _pool_mixer(pu_c, w_pool, pool_scale)
    y_ctx = jnp.concatenate([a_c, att_c, p_c], axis=-1) @ w_out
    return y_lat, y_ctx


def _mlp(h, w1, w2):
    return jnp.square(jax.nn.relu(h @ w1)) @ w2


def setup_inputs(seed: int = 0) -> dict:
    key = jax.random.key(seed)
    ks = jax.random.split(key, 32)
    nrm = lambda k, shape, s: jax.random.normal(k, shape, F32) * s
    a0 = jax.random.uniform(ks[12], (DEPTH, 2, D_LRU), F32, minval=0.9, maxval=0.999)
    s0 = a0 ** (1.0 / LRU_C)
    return {
        "x": nrm(ks[0], (BATCH, SEQ, D_MODEL), 1.0),
        "c": nrm(ks[1], (BATCH, D_MODEL), 1.0),
        "ctx": nrm(ks[2], (BATCH, CTX_LEN, D_MODEL), 1.0),
        "c_ctx": nrm(ks[3], (D_MODEL,), 1.0),
        "w_mod": nrm(ks[4], (DEPTH, D_MODEL, 6 * D_MODEL), 0.5 * D_MODEL ** -0.5),
        "b_mod": nrm(ks[5], (DEPTH, 6 * D_MODEL), 0.02),
        "g_norm1": 1.0 + nrm(ks[6], (DEPTH, D_MODEL), 0.02),
        "g_norm2": 1.0 + nrm(ks[7], (DEPTH, D_MODEL), 0.02),
        "w_in": nrm(ks[8], (DEPTH, D_MODEL, D_IN), D_MODEL ** -0.5),
        "conv_w": nrm(ks[9], (DEPTH, CONV_W, D_LRU), CONV_W ** -0.5),
        "conv_b": nrm(ks[10], (DEPTH, D_LRU), 0.02),
        "lru_w_a": nrm(ks[11], (DEPTH, 2, LRU_HEADS, LRU_HEAD_DIM, LRU_HEAD_DIM), LRU_HEAD_DIM ** -0.5),
        "lru_b_a": nrm(ks[13], (DEPTH, 2, D_LRU), 0.02),
        "lru_w_x": nrm(ks[14], (DEPTH, 2, LRU_HEADS, LRU_HEAD_DIM, LRU_HEAD_DIM), LRU_HEAD_DIM ** -0.5),
        "lru_b_x": nrm(ks[15], (DEPTH, 2, D_LRU), 0.02),
        "lru_lambda": jnp.log(s0) - jnp.log1p(-s0),
        "g_q_lat": 1.0 + nrm(ks[16], (DEPTH, Q_RANK), 0.02),
        "w_uq": nrm(ks[17], (DEPTH, Q_RANK, MLA_HEADS * MLA_QK), Q_RANK ** -0.5),
        "g_kv_lat": 1.0 + nrm(ks[18], (DEPTH, KV_RANK), 0.02),
        "w_ukv": nrm(ks[19], (DEPTH, KV_RANK, MLA_HEADS * (MLA_NOPE + MLA_V)), KV_RANK ** -0.5),
        "g_qn": 1.0 + nrm(ks[20], (DEPTH, MLA_QK), 0.02),
        "g_kn": 1.0 + nrm(ks[21], (DEPTH, MLA_QK), 0.02),
        "w_pool": nrm(ks[22], (DEPTH, POOL_GROUPS, POOL_GROUP_DIM, POOL_GROUP_DIM), POOL_GROUP_DIM ** -0.5),
        "pool_scale": 1.0 + nrm(ks[23], (DEPTH, D_POOL), 0.1),
        "w_out": nrm(ks[24], (DEPTH, D_MIX, D_MODEL), D_MIX ** -0.5),
        "w_ff1": nrm(ks[25], (DEPTH, D_MODEL, D_FF), D_MODEL ** -0.5),
        "w_ff2": nrm(ks[26], (DEPTH, D_FF, D_MODEL), D_FF ** -0.5),
    }


def reference(x, c, ctx, c_ctx, w_mod, b_mod, g_norm1, g_norm2, w_in, conv_w, conv_b, lru_w_a, lru_b_a,
              lru_w_x, lru_b_x, lru_lambda, g_q_lat, w_uq, g_kv_lat, w_ukv, g_qn, g_kn, w_pool, pool_scale,
              w_out, w_ff1, w_ff2):
    L = x.shape[1]
    rope = _axial_rope_tables(L)
    c_act = jax.nn.silu(c)
    cc_act = jax.nn.silu(c_ctx)
    h = ctx
    for l in range(DEPTH):
        last = l == DEPTH - 1
        mod_l = (c_act @ w_mod[l] + b_mod[l])[:, None, :]
        mod_c = (cc_act @ w_mod[l] + b_mod[l])[None, None, :]
        sh1, sc1, g1, sh2, sc2, g2 = jnp.split(mod_l, 6, axis=-1)
        csh1, csc1, cg1, csh2, csc2, cg2 = jnp.split(mod_c, 6, axis=-1)
        hx = _modulate(_rmsnorm(x, g_norm1[l]), sh1, sc1)
        hc = _modulate(_rmsnorm(h, g_norm1[l]), csh1, csc1)
        y_lat, y_ctx = _mixer(hx, hc, rope, not last, w_in[l], conv_w[l], conv_b[l], lru_w_a[l], lru_b_a[l],
                              lru_w_x[l], lru_b_x[l], lru_lambda[l], g_q_lat[l], w_uq[l], g_kv_lat[l],
                              w_ukv[l], g_qn[l], g_kn[l], w_pool[l], pool_scale[l], w_out[l])
        x = x + g1 * y_lat
        x = x + g2 * _mlp(_modulate(_rmsnorm(x, g_norm2[l]), sh2, sc2), w_ff1[l], w_ff2[l])
        if not last:
            h = h + cg1 * y_ctx
            h = h + cg2 * _mlp(_modulate(_rmsnorm(h, g_norm2[l]), csh2, csc2), w_ff1[l], w_ff2[l])
    return x
```

```cpp
#include <hip/hip_runtime.h>
#include <cstdio>
#include <cstdint>

#define LAS __attribute__((address_space(3)))
#define GAS __attribute__((address_space(1)))
typedef unsigned short bf16_t;
typedef short bf16x8 __attribute__((ext_vector_type(8)));
typedef short s16x4 __attribute__((ext_vector_type(4)));
typedef float f32x4 __attribute__((ext_vector_type(4)));
typedef float f32x2 __attribute__((ext_vector_type(2)));
typedef float f32x16 __attribute__((ext_vector_type(16)));
typedef unsigned u32x4 __attribute__((ext_vector_type(4)));
typedef unsigned u32x2 __attribute__((ext_vector_type(2)));

constexpr int D_MODEL = 1024, BATCH = 8, SEQ = 4096, DEPTH = 2, CTX = 256, D_IN = 1440, D_FF = 4096;
constexpr int TPB = SEQ + CTX;
constexpr int MROWS = BATCH * TPB;
constexpr int PPB = TPB / 256;
constexpr int NPAN = MROWS / 256;
constexpr int ZW = 1536;
constexpr int Z_LX = 0, Z_LG = 256, Z_KVL = 512, Z_PU = 768, Z_QL = 1024, Z_KR = 1408;
constexpr float EPS = 1e-6f;
constexpr float QSCALE = 0.10206207261596575f * 1.4426950408889634f;

typedef __bf16 bf16x2_t __attribute__((ext_vector_type(2)));
__device__ __forceinline__ unsigned cvt_pk_bf16(float lo, float hi) { f32x2 v = {lo, hi}; bf16x2_t b = __builtin_convertvector(v, bf16x2_t); return __builtin_bit_cast(unsigned, b); }
__device__ __forceinline__ float bf2f(unsigned short h) { return __uint_as_float((unsigned)h << 16); }
__device__ __forceinline__ float bflo(unsigned w) { return __uint_as_float(w << 16); }
__device__ __forceinline__ float bfhi(unsigned w) { return __uint_as_float(w & 0xffff0000u); }
__device__ __forceinline__ unsigned short f2bf(float f) { unsigned u = __float_as_uint(f); return (unsigned short)((u + 0x7fffu + ((u >> 16) & 1u)) >> 16); }

namespace pg8 {
constexpr int BM = 256, BK = 64, HALF = 128, HTB = HALF * BK * 2, STAGE_BYTES = 8 * HTB, NXCD = 8, WGM = 8;
__host__ __device__ __forceinline__ int lds_byte(int r, int c) { const int st = (r >> 4) * 2 + (c >> 5), rr = r & 15, cc = c & 31, ob = rr * 64 + cc * 2; return st * 1024 + (ob ^ (((ob >> 9) & 1) << 5)); }
__host__ __device__ __forceinline__ void stage_rc(int b, int& R, int& C) { const int st = b / 1024, sb = b % 1024, swz = sb ^ (((sb >> 9) & 1) << 5); R = (st >> 1) * 16 + swz / 64; C = (st & 1) * 32 + (swz % 64) / 2; }
__host__ __device__ __forceinline__ int perm32(int rho) { const int n = rho >> 4, i = rho & 15; return 8 * (i >> 2) + 4 * n + (i & 3); }

struct Unit { int pm, pn; unsigned koffA, koffB; };
struct Gemm { const bf16_t* A; const bf16_t* Bt; };

struct StaticOrder {
    int nM, nN, nwg, G, c, latonly;
    __device__ void init(int nM_, int nN_, int G_, int c_, int latonly_) { nM = nM_; nN = nN_; nwg = nM * nN; G = G_; c = c_; latonly = latonly_; }
    __device__ bool next(int i, Unit& u) const {
        const long L = (long)i * G + c; if (L >= nwg) return false;
        int wgid = (int)L; { const int q = nwg / NXCD, r = nwg % NXCD, xcd = wgid % NXCD, off = wgid / NXCD; wgid = (xcd < r ? xcd * (q + 1) : r * (q + 1) + (xcd - r) * q) + off; }
        const int nig = WGM * nN, gid = wgid / nig, fm = gid * WGM, gsz = (nM - fm) < WGM ? (nM - fm) : WGM;
        int pm = fm + ((wgid % nig) % gsz); u.pn = (wgid % nig) / gsz;
        if (latonly) pm = pm + pm / 16 + 1;
        u.pm = pm; u.koffA = 0u; u.koffB = 0u; return true;
    }
};
struct CtxSplitOrder {
    int nN, NS, KS, G, c, ablk;
    __device__ bool next(int i, Unit& u) const {
        const int L = i * G + c; if (L >= 8 * nN * NS) return false;
        const int ks = L % NS, t = L / NS; u.pn = t % nN; u.pm = (t / nN) * 17; u.koffB = (unsigned)(ks * KS * 2); u.koffA = ablk ? (unsigned)(ks * (KS / 32) * 16384) : u.koffB; return true;
    }
};

template <int K, int LDA, int LDB, bool ABLK, class Epi, class Sched>
__device__ __forceinline__ void gemm_phase(LAS unsigned char* lds, const Gemm g, const Sched& S, const Epi& E) {
    int tid = threadIdx.x; asm volatile("" : "+v"(tid));
    const int  wid = __builtin_amdgcn_readfirstlane(tid >> 6), lane = tid & 63, wr = wid >> 2, wc = wid & 3, fr = lane & 15, fq = lane >> 4;
    constexpr int nt = K / BK;
    unsigned voffA[2], voffB[2];
#pragma unroll
    for (int i = 0; i < 2; ++i) { int R, C; stage_rc(tid * 16 + i * 8192, R, C); const int Rb = Epi::PERM ? ((R & ~31) + perm32(R & 31)) : R;
        voffA[i] = ABLK ? (unsigned)((C >> 5) * 16384 + (R >> 4) * 1024 + ((R & 15) * 32 + (C & 31)) * 2) : (unsigned)(R * LDA + C) * 2u; voffB[i] = (unsigned)(Rb * LDB + C) * 2u; }
    const size_t kstep = (size_t)(BK * 2);
    const size_t kstepA = ABLK ? (size_t)32768 : kstep;
    const size_t hstepA = ABLK ? (size_t)8192 : (size_t)HALF * LDA * 2, tstepA = ABLK ? (size_t)(LDA / 32) * 16384 : 2 * hstepA;
    const size_t hstepB = (size_t)HALF * LDB * 2, tstepB = 2 * hstepB;
    const unsigned ldsw = (unsigned)wid * 1024u;
    const int aoff = lds_byte(wr * 64 + fr, fq * 8), boff = lds_byte(wc * 32 + fr, fq * 8);
#define PG8_SA(b, h) (((b) * 2 + (h)) * HTB)
#define PG8_SB(b, h) ((4 + (b) * 2 + (h)) * HTB)
#define PG8_STAGE(bufoff, gbase, voff) do { _Pragma("unroll") for (int _i = 0; _i < 2; ++_i) \
        __builtin_amdgcn_global_load_lds((const unsigned*)((const char*)(gbase) + (voff)[_i]), (LAS unsigned*)(lds + (bufoff) + ldsw + _i * 8192), 16, 0, 0); } while (0)
#define PG8_LDA(dst, b, h) do { _Pragma("unroll") for (int m = 0; m < 4; ++m) _Pragma("unroll") for (int k = 0; k < 2; ++k) dst[m][k] = *(const LAS bf16x8*)(lds + PG8_SA(b, h) + aoff + m * 2048 + k * 1024); } while (0)
#define PG8_LDB(dst, b, h) do { _Pragma("unroll") for (int n = 0; n < 2; ++n) _Pragma("unroll") for (int k = 0; k < 2; ++k) dst[n][k] = *(const LAS bf16x8*)(lds + PG8_SB(b, h) + boff + n * 2048 + k * 1024); } while (0)
#define PG8_MMA(ai, bj, At, Bt) do { __builtin_amdgcn_s_setprio(1); _Pragma("unroll") for (int m = 0; m < 4; ++m) _Pragma("unroll") for (int n = 0; n < 2; ++n) _Pragma("unroll") for (int k = 0; k < 2; ++k) \
        acc[ai][bj][m][n] = __builtin_amdgcn_mfma_f32_16x16x32_bf16(Bt[n][k], At[m][k], acc[ai][bj][m][n], 0, 0, 0); __builtin_amdgcn_s_setprio(0); } while (0)
#define PG8_WAIT_V(n) asm volatile("s_waitcnt vmcnt(" #n ")" ::: "memory")
#define PG8_WAIT_L(n) asm volatile("s_waitcnt lgkmcnt(" #n ")" ::: "memory")
#define PG8_BAR __builtin_amdgcn_s_barrier()
#define PG8_SCHED __builtin_amdgcn_sched_barrier(0)
    Unit cur, nxt; int ui = 0;
    if (!S.next(0, cur)) return;
    f32x4 acc[2][2][4][2];
#pragma unroll
    for (int a = 0; a < 2; ++a)
#pragma unroll
        for (int b = 0; b < 2; ++b)
#pragma unroll
            for (int m = 0; m < 4; ++m)
#pragma unroll
                for (int n = 0; n < 2; ++n) acc[a][b][m][n] = (f32x4){0.f, 0.f, 0.f, 0.f};
    bf16x8 At[4][2], B0[2][2], B1[2][2];
    const char* cA = (const char*)g.A + (size_t)cur.pm * tstepA + cur.koffA; const char* cB = (const char*)g.Bt + (size_t)cur.pn * tstepB + cur.koffB;
    PG8_STAGE(PG8_SB(0, 0), cB, voffB); PG8_STAGE(PG8_SB(0, 1), cB + hstepB, voffB); PG8_STAGE(PG8_SA(0, 0), cA, voffA); PG8_STAGE(PG8_SA(0, 1), cA + hstepA, voffA);
    if (wr == 1) PG8_BAR;
    PG8_WAIT_V(2); PG8_BAR;
    PG8_STAGE(PG8_SB(1, 0), cB + kstep, voffB); PG8_STAGE(PG8_SA(1, 0), cA + kstepA, voffA); PG8_STAGE(PG8_SB(1, 1), cB + hstepB + kstep, voffB);
    PG8_WAIT_V(6); PG8_BAR;
    for (;;) {
        const bool has_next = S.next(ui + 1, nxt);
        const char* nA = has_next ? (const char*)g.A + (size_t)nxt.pm * tstepA + nxt.koffA : cA; const char* nB = has_next ? (const char*)g.Bt + (size_t)nxt.pn * tstepB + nxt.koffB : cB;
#pragma unroll 1
        for (int t = 0; t < nt; t += 2) {
            const bool last = (t == nt - 2);
            const char* a1 = cA + (size_t)(t + 1) * kstepA;
            const char* a2 = last ? nA : cA + (size_t)(t + 2) * kstepA; const char* b2 = last ? nB : cB + (size_t)(t + 2) * kstep;
            const char* a3 = a2 + kstepA; const char* b3 = b2 + kstep;
            PG8_LDB(B0, 0, 0); PG8_LDB(B1, 0, 1); PG8_SCHED; PG8_LDA(At, 0, 0); PG8_STAGE(PG8_SA(1, 1), a1 + hstepA, voffA);
            PG8_WAIT_V(8); PG8_WAIT_L(0); PG8_BAR; PG8_MMA(0, 0, At, B0); PG8_MMA(0, 1, At, B1); PG8_BAR; PG8_SCHED;
            PG8_LDA(At, 0, 1); PG8_STAGE(PG8_SB(0, 0), b2, voffB); PG8_STAGE(PG8_SB(0, 1), b2 + hstepB, voffB); PG8_STAGE(PG8_SA(0, 0), a2, voffA);
            PG8_WAIT_V(8); PG8_WAIT_L(0); PG8_BAR; PG8_MMA(1, 0, At, B0); PG8_MMA(1, 1, At, B1); PG8_BAR; PG8_SCHED;
            PG8_LDB(B0, 1, 0); PG8_LDB(B1, 1, 1); PG8_SCHED; PG8_LDA(At, 1, 0); PG8_STAGE(PG8_SA(0, 1), a2 + hstepA, voffA);
            PG8_WAIT_V(8); PG8_WAIT_L(0); PG8_BAR; PG8_MMA(0, 0, At, B0); PG8_MMA(0, 1, At, B1); PG8_BAR; PG8_SCHED;
            PG8_LDA(At, 1, 1); PG8_STAGE(PG8_SB(1, 0), b3, voffB); PG8_STAGE(PG8_SB(1, 1), b3 + hstepB, voffB); PG8_STAGE(PG8_SA(1, 0), a3, voffA);
            PG8_WAIT_V(8); PG8_WAIT_L(0); PG8_BAR; PG8_MMA(1, 0, At, B0); PG8_MMA(1, 1, At, B1); PG8_BAR; PG8_SCHED;
        }
        if (wr == 0) PG8_BAR;
        { int fr2 = fr, fq2 = fq; asm volatile("" : "+v"(fr2), "+v"(fq2));
          E(acc, cur, wr, wc, fr2, fq2); }
        if (!has_next) break;
#pragma unroll
        for (int a = 0; a < 2; ++a)
#pragma unroll
            for (int b = 0; b < 2; ++b)
#pragma unroll
                for (int m = 0; m < 4; ++m)
#pragma unroll
                    for (int n = 0; n < 2; ++n) acc[a][b][m][n] = (f32x4){0.f, 0.f, 0.f, 0.f};
        cur = nxt; cA = nA; cB = nB; ++ui;
        if (wr == 1) PG8_BAR;
    }
    PG8_WAIT_V(0);
    PG8_BAR;
#undef PG8_SA
#undef PG8_SB
#undef PG8_STAGE
#undef PG8_LDA
#undef PG8_LDB
#undef PG8_MMA
#undef PG8_WAIT_V
#undef PG8_WAIT_L
#undef PG8_BAR
#undef PG8_SCHED
}
}
namespace epi {
using pg8::Unit;
typedef f32x4 Acc[2][2][4][2];
__device__ __forceinline__ float sum4(f32x4 v) { return (v[0] + v[1]) + (v[2] + v[3]); }
__device__ __forceinline__ float sq4(f32x4 v) { return (v[0] * v[0] + v[1] * v[1]) + (v[2] * v[2] + v[3] * v[3]); }
__device__ __forceinline__ float red_fq(float s) { s += __shfl_xor(s, 16); s += __shfl_xor(s, 32); return s; }
__device__ __forceinline__ u32x4 pack8(f32x4 a, f32x4 b) { u32x4 w; w.x = cvt_pk_bf16(a[0], a[1]); w.y = cvt_pk_bf16(a[2], a[3]); w.z = cvt_pk_bf16(b[0], b[1]); w.w = cvt_pk_bf16(b[2], b[3]); return w; }
__device__ __forceinline__ void rope4(f32x4& x1, f32x4& x2, const float* rtab, int t, int fq) {
    const int idx = (fq >> 1) ? (t & 63) : (t >> 6);
    const f32x4 c0 = *(const f32x4*)(rtab + (idx * 8 + (fq & 1) * 4) * 2), c1 = *(const f32x4*)(rtab + (idx * 8 + (fq & 1) * 4) * 2 + 4);
    const f32x4 cs = (f32x4){c0[0], c0[2], c1[0], c1[2]}, sn = (f32x4){c0[1], c0[3], c1[1], c1[3]};
    const f32x4 y1 = x1 * cs - x2 * sn, y2 = x2 * cs + x1 * sn; x1 = y1; x2 = y2;
}
__device__ __forceinline__ float row_rstd16(const float* ssq, int row, int fq, float inv_n) {
    const f32x4 p = *(const f32x4*)(ssq + (size_t)row * 16 + 4 * fq); return rsqrtf(red_fq(sum4(p)) * inv_n + EPS);
}

struct EpiIn {
    static constexpr bool PERM = true;
    bf16_t* z; const float* ssqx; const float* bias; float* ssqkv; const float* gkn; const float* rtab;
    __device__ __forceinline__ void operator()(const Acc& acc, const Unit& u, int wr, int wc, int fr, int fq) const {
        const int pm = u.pm, pn = u.pn, b = pm / PPB, pp = pm - b * PPB, bidx = pp == 0 ? 8 : b;
        const float* bia = bias + bidx * ZW + pn * 256 + wc * 32 + 8 * fq;
        f32x4 bv[2][2];
#pragma unroll
        for (int bj = 0; bj < 2; ++bj)
#pragma unroll
            for (int n = 0; n < 2; ++n) bv[bj][n] = *(const f32x4*)(bia + bj * 128 + 4 * n);
        const int ax = fq >> 1, f0 = (fq & 1) * 4;
        const f32x4 gk1 = *(const f32x4*)(gkn + 64 + ax * 16 + f0), gk2 = *(const f32x4*)(gkn + 64 + ax * 16 + 8 + f0);
#pragma unroll
        for (int ai = 0; ai < 2; ++ai)
#pragma unroll
            for (int m = 0; m < 4; ++m) {
                const int rl = ai * 128 + wr * 64 + m * 16 + fr, row = pm * 256 + rl;
                const float rs = row_rstd16(ssqx, row, fq, 1.0f / 1024.0f);
                f32x4 v[2][2];
#pragma unroll
                for (int bj = 0; bj < 2; ++bj)
#pragma unroll
                    for (int n = 0; n < 2; ++n) v[bj][n] = acc[ai][bj][m][n] * rs + bv[bj][n];
                if (pn == 2 || pn == 4) {
                    const float s = red_fq((sq4(v[0][0]) + sq4(v[0][1])) + (sq4(v[1][0]) + sq4(v[1][1])));
                    if (fq == 0) ssqkv[(size_t)row * 16 + (pn == 2 ? wc : 4 + wc)] = s;
                }
                if (pn == 5) {
                    const float s = red_fq(sq4(v[0][0]) + sq4(v[0][1]));
                    if (fq == 0) ssqkv[(size_t)row * 16 + 8 + wc] = s;
                    if (wc == 0) {
                        const float s1 = red_fq(sq4(v[1][0]) + sq4(v[1][1]));
                        if (fq == 0) ssqkv[(size_t)row * 16 + 12] = s1;
                        v[1][0] = v[1][0] * gk1; v[1][1] = v[1][1] * gk2;
                        if (pp != 0) rope4(v[1][0], v[1][1], rtab, (pp - 1) * 256 + rl, fq);
                    }
                }
                bf16_t* zp = z + (size_t)row * ZW + pn * 256 + wc * 32 + 8 * fq;
#pragma unroll
                for (int bj = 0; bj < 2; ++bj) *(u32x4*)(zp + bj * 128) = pack8(v[bj][0], v[bj][1]);
                asm volatile("" ::: "memory");
            }
    }
};

struct EpiQ {
    static constexpr bool PERM = true;
    bf16_t* Q; float* ssqq; const float* gqn; const float* rtab;
    __device__ __forceinline__ void operator()(const Acc& acc, const Unit& u, int wr, int wc, int fr, int fq) const {
        const int pm = u.pm, pn = u.pn, b = pm / PPB, pp = pm - b * PPB;
        const int ax = fq >> 1, f0 = (fq & 1) * 4;
        f32x4 g0[2], g1[2]; int part[2], grp[2];
#pragma unroll
        for (int bj = 0; bj < 2; ++bj) {
            grp[bj] = pn * 8 + bj * 4 + wc; part[bj] = grp[bj] % 3;
            if (part[bj] < 2) { g0[bj] = *(const f32x4*)(gqn + 32 * part[bj] + 8 * fq); g1[bj] = *(const f32x4*)(gqn + 32 * part[bj] + 8 * fq + 4); }
            else { g0[bj] = *(const f32x4*)(gqn + 64 + ax * 16 + f0); g1[bj] = *(const f32x4*)(gqn + 64 + ax * 16 + 8 + f0); }
        }
#pragma unroll
        for (int ai = 0; ai < 2; ++ai)
#pragma unroll
            for (int m = 0; m < 4; ++m) {
                const int rl = ai * 128 + wr * 64 + m * 16 + fr, row = pm * 256 + rl;
                bf16_t* qp = Q + (size_t)row * 768 + pn * 256 + wc * 32 + 8 * fq;
#pragma unroll
                for (int bj = 0; bj < 2; ++bj) {
                    const f32x4 a0 = acc[ai][bj][m][0], a1 = acc[ai][bj][m][1];
                    const float s = red_fq(sq4(a0) + sq4(a1));
                    if (fq == 0) ssqq[(size_t)row * 24 + grp[bj]] = s;
                    f32x4 v0 = a0 * g0[bj], v1 = a1 * g1[bj];
                    if (part[bj] == 2 && pp != 0) rope4(v0, v1, rtab, (pp - 1) * 256 + rl, fq);
                    *(u32x4*)(qp + bj * 128) = pack8(v0, v1);
                }
                asm volatile("" ::: "memory");
            }
    }
};

struct EpiKV {
    static constexpr bool PERM = true;
    bf16_t* Kb; bf16_t* Vb; const bf16_t* z; const float* ssqkv; const float* gkn;
    __device__ __forceinline__ void operator()(const Acc& acc, const Unit& u, int wr, int wc, int fr, int fq) const {
        const int pm = u.pm, pn = u.pn;
        f32x4 gk[2][2];
#pragma unroll
        for (int bj = 0; bj < 2; ++bj)
#pragma unroll
            for (int n = 0; n < 2; ++n) gk[bj][n] = *(const f32x4*)(gkn + 32 * bj + 8 * fq + 4 * n);
#pragma unroll
        for (int ai = 0; ai < 2; ++ai)
#pragma unroll
            for (int m = 0; m < 4; ++m) {
                const int rl = ai * 128 + wr * 64 + m * 16 + fr, row = pm * 256 + rl;
                const f32x4 st = *(const f32x4*)(ssqkv + (size_t)row * 16);
                const float s = rsqrtf(sum4(st) * (1.0f / 256.0f) + EPS);
                if (pn < 2) {
                    const int head = 4 * pn + wc;
                    const float ss = red_fq((sq4(acc[ai][0][m][0]) + sq4(acc[ai][0][m][1])) + (sq4(acc[ai][1][m][0]) + sq4(acc[ai][1][m][1])));
                    const float sskr = ssqkv[(size_t)row * 16 + 12];
                    const float rk = rsqrtf((s * s * ss + sskr) * (1.0f / 96.0f) + EPS);
                    const float sk = s * rk;
                    bf16_t* kp = Kb + (size_t)row * 768 + head * 96;
#pragma unroll
                    for (int bj = 0; bj < 2; ++bj) *(u32x4*)(kp + 32 * bj + 8 * fq) = pack8(acc[ai][bj][m][0] * gk[bj][0] * sk, acc[ai][bj][m][1] * gk[bj][1] * sk);
                    const u32x4 kr = *(const u32x4*)(z + (size_t)row * ZW + Z_KR + 8 * fq);
                    u32x4 o;
                    o.x = cvt_pk_bf16(bflo(kr.x) * rk, bfhi(kr.x) * rk); o.y = cvt_pk_bf16(bflo(kr.y) * rk, bfhi(kr.y) * rk);
                    o.z = cvt_pk_bf16(bflo(kr.z) * rk, bfhi(kr.z) * rk); o.w = cvt_pk_bf16(bflo(kr.w) * rk, bfhi(kr.w) * rk);
                    *(u32x4*)(kp + 64 + 8 * fq) = o;
                } else {
                    const int head = 4 * (pn - 2) + wc;
                    bf16_t* vp = Vb + (size_t)row * 512 + head * 64;
#pragma unroll
                    for (int bj = 0; bj < 2; ++bj) *(u32x4*)(vp + 32 * bj + 8 * fq) = pack8(acc[ai][bj][m][0] * s, acc[ai][bj][m][1] * s);
                }
                asm volatile("" ::: "memory");
            }
    }
};

template <bool IN_F32, bool OUT_F32>
struct EpiRes {
    static constexpr bool PERM = true;
    const float* xin_lat; const float* xin_ctx; float* xout; bf16_t* xg; float* ssqx; const float* gate; const float* rgm_prev; const float* gm;
    __device__ __forceinline__ void operator()(const Acc& acc, const Unit& u, int wr, int wc, int fr, int fq) const {
        const int pm = u.pm, pn = u.pn, b = pm / PPB, pp = pm - b * PPB, bidx = pp == 0 ? 8 : b;
        const size_t rbase = pp == 0 ? (size_t)b * 256 : (size_t)b * SEQ + (size_t)(pp - 1) * 256;
        const float* xi = IN_F32 ? (pp == 0 ? xin_ctx : xin_lat) + rbase * D_MODEL : nullptr;
        float* xo = OUT_F32 ? xout + rbase * D_MODEL : nullptr;
        const int col0 = pn * 256 + wc * 32 + 8 * fq;
        f32x4 gv[2][2], mv[2][2], rv[2][2];
#pragma unroll
        for (int bj = 0; bj < 2; ++bj)
#pragma unroll
            for (int n = 0; n < 2; ++n) { gv[bj][n] = *(const f32x4*)(gate + bidx * 6144 + col0 + bj * 128 + n * 4);
                mv[bj][n] = OUT_F32 ? (f32x4){0.f, 0.f, 0.f, 0.f} : *(const f32x4*)(gm + bidx * 6144 + col0 + bj * 128 + n * 4);
                rv[bj][n] = IN_F32 ? (f32x4){0.f, 0.f, 0.f, 0.f} : *(const f32x4*)(rgm_prev + bidx * 2048 + col0 + bj * 128 + n * 4); }
#pragma unroll
        for (int ai = 0; ai < 2; ++ai)
#pragma unroll
            for (int m = 0; m < 4; ++m) {
                const int rl = ai * 128 + wr * 64 + m * 16 + fr; const size_t urow = (size_t)pm * 256 + rl, off = urow * D_MODEL + col0;
                float ss = 0.f;
#pragma unroll
                for (int bj = 0; bj < 2; ++bj) {
                    f32x4 x0, x1;
                    if (IN_F32) { x0 = *(const f32x4*)(xi + (size_t)rl * D_MODEL + col0 + bj * 128); x1 = *(const f32x4*)(xi + (size_t)rl * D_MODEL + col0 + bj * 128 + 4); }
                    else { const u32x4 w = *(const u32x4*)(xg + off + bj * 128); x0 = (f32x4){bflo(w.x), bfhi(w.x), bflo(w.y), bfhi(w.y)} * rv[bj][0]; x1 = (f32x4){bflo(w.z), bfhi(w.z), bflo(w.w), bfhi(w.w)} * rv[bj][1]; }
                    x0 += gv[bj][0] * acc[ai][bj][m][0]; x1 += gv[bj][1] * acc[ai][bj][m][1];
                    if (OUT_F32) { *(f32x4*)(xo + (size_t)rl * D_MODEL + col0 + bj * 128) = x0; *(f32x4*)(xo + (size_t)rl * D_MODEL + col0 + bj * 128 + 4) = x1; }
                    else { ss += sq4(x0) + sq4(x1); *(u32x4*)(xg + off + bj * 128) = pack8(x0 * mv[bj][0], x1 * mv[bj][1]); }
                }
                if (!OUT_F32) { ss = red_fq(ss); if (fq == 0) ssqx[urow * 16 + pn * 4 + wc] = ss; }
                asm volatile("" ::: "memory");
            }
    }
};

struct EpiSlab {
    static constexpr bool PERM = true;
    float* slab; int KS;
    __device__ __forceinline__ void operator()(const Acc& acc, const Unit& u, int wr, int wc, int fr, int fq) const {
        const int cp = u.pm / PPB, ks = (int)(u.koffB / (unsigned)(2 * KS));
        float* sp = slab + ((size_t)(ks * (BATCH * CTX) + cp * 256)) * D_MODEL + u.pn * 256 + wc * 32 + 8 * fq;
#pragma unroll
        for (int ai = 0; ai < 2; ++ai)
#pragma unroll
            for (int m = 0; m < 4; ++m) { float* rp = sp + (size_t)(ai * 128 + wr * 64 + m * 16 + fr) * D_MODEL;
#pragma unroll
                for (int bj = 0; bj < 2; ++bj) { *(f32x4*)(rp + bj * 128) = acc[ai][bj][m][0]; *(f32x4*)(rp + bj * 128 + 4) = acc[ai][bj][m][1]; } }
    }
};

struct EpiFF1 {
    static constexpr bool PERM = true;
    bf16_t* U; const float* ssqx; const float* bias;
    __device__ __forceinline__ void operator()(const Acc& acc, const Unit& u, int wr, int wc, int fr, int fq) const {
        const int pm = u.pm, pn = u.pn, b = pm / PPB, pp = pm - b * PPB, bidx = pp == 0 ? 8 : b;
        const float* bia = bias + bidx * D_FF + pn * 256 + wc * 32 + 8 * fq;
        f32x4 bv[2][2];
#pragma unroll
        for (int bj = 0; bj < 2; ++bj)
#pragma unroll
            for (int n = 0; n < 2; ++n) bv[bj][n] = *(const f32x4*)(bia + bj * 128 + 4 * n);
#pragma unroll
        for (int ai = 0; ai < 2; ++ai)
#pragma unroll
            for (int m = 0; m < 4; ++m) {
                const int row = pm * 256 + ai * 128 + wr * 64 + m * 16 + fr;
                const float rs = row_rstd16(ssqx, row, fq, 1.0f / 1024.0f);
                bf16_t* up = U + (((size_t)pm * 128 + pn * 8 + wc) * 16 + (ai * 8 + wr * 4 + m)) * 512 + fr * 32 + 8 * fq;
#pragma unroll
                for (int bj = 0; bj < 2; ++bj) {
                    f32x4 v0 = acc[ai][bj][m][0] * rs + bv[bj][0], v1 = acc[ai][bj][m][1] * rs + bv[bj][1];
#pragma unroll
                    for (int e = 0; e < 4; ++e) { const float a = fmaxf(v0[e], 0.f), c = fmaxf(v1[e], 0.f); v0[e] = a * a; v1[e] = c * c; }
#ifndef U_NT
#define U_NT 1
#endif
#if U_NT
                    __builtin_nontemporal_store(pack8(v0, v1), (u32x4*)(up + (size_t)bj * 4 * 16 * 512));
#else
                    *(u32x4*)(up + (size_t)bj * 4 * 16 * 512) = pack8(v0, v1);
#endif
                }
                asm volatile("" ::: "memory");
            }
    }
};
}
namespace att {
constexpr int NW = 8, QBLK = 32, KVBLK = 64, DQK = 96, DV = 64;
constexpr int KROWB = 208;
constexpr int SHM_K = KVBLK * KROWB, SHM_V = KVBLK * DV * 2;
constexpr int NSLOT = 3;
constexpr int LDS_V = 0, LDS_K = NSLOT * SHM_V, LDS_WS = LDS_K + NSLOT * SHM_K, LDS_OST = LDS_WS + NW * 64 * 4, LDS_BYTES = LDS_OST + NW * 4096;
#define SBAR() __builtin_amdgcn_sched_barrier(0)
__device__ __forceinline__ int crow(int r, int hi) { return (r & 3) + 8 * (r >> 2) + 4 * hi; }

template <int VAR> __device__ __forceinline__ void partialSM(f32x16& p0, float shift) {
  if (VAR == 1) return;
  if (VAR == 9) {
#pragma unroll
    for (int r = 0; r < 16; ++r) p0[r] -= shift; }
#pragma unroll
  for (int r = 0; r < 16; ++r) p0[r] = __builtin_amdgcn_exp2f(p0[r]);
}
template <int VAR> __device__ __forceinline__ void finishSM(f32x16& p0, f32x16& p1, float shift, float& l_reg, bf16x8& pa0, bf16x8& pa1, bf16x8& pa2, bf16x8& pa3) {
  if (VAR == 9) {
#pragma unroll
    for (int r = 0; r < 16; ++r) p1[r] -= shift; }
  if (VAR != 1) {
#pragma unroll
  for (int r = 0; r < 16; ++r) p1[r] = __builtin_amdgcn_exp2f(p1[r]); }
  float ps = 0;
#pragma unroll
  for (int r = 0; r < 16; ++r) ps += p0[r];
#pragma unroll
  for (int r = 0; r < 16; ++r) ps += p1[r];
  l_reg += ps;
#define PK4(P, BASE, OUT) do { u32x4 w = {cvt_pk_bf16(P[BASE + 0], P[BASE + 1]), cvt_pk_bf16(P[BASE + 2], P[BASE + 3]), cvt_pk_bf16(P[BASE + 4], P[BASE + 5]), cvt_pk_bf16(P[BASE + 6], P[BASE + 7])}; \
    OUT = *reinterpret_cast<bf16x8*>(&w); } while (0)
  PK4(p0, 0, pa0); PK4(p0, 8, pa1); PK4(p1, 0, pa2); PK4(p1, 8, pa3);
#undef PK4
}
#define KFR(KS, d0, half) (*reinterpret_cast<const bf16x8*>((KS) + (r32 + 32 * (half)) * KROWB + ((d0) * 16 + hi * 8) * 2))
__device__ __forceinline__ void kread4(bf16x8* kf, const char* Ks, int r32, int hi) { kf[0] = KFR(Ks, 0, 0); kf[1] = KFR(Ks, 0, 1); kf[2] = KFR(Ks, 1, 0); kf[3] = KFR(Ks, 1, 1); }
#define MF(A_, B_, C_) __builtin_amdgcn_mfma_f32_32x32x16_bf16(A_, B_, C_, 0, 0, 0)
template <bool FIN, int VAR>
__device__ __forceinline__ void qkt_fin(f32x16& p0, f32x16& p1, const char* Ks, const bf16x8* qr, int r32, int hi,
                                        f32x16& f0, f32x16& f1, float shift, float& l_reg, bf16x8& pa0, bf16x8& pa1, bf16x8& pa2, bf16x8& pa3) {
  bf16x8 kf[4]; kf[0] = VAR == 8 ? qr[0] : KFR(Ks, 0, 0); kf[1] = VAR == 8 ? qr[0] : KFR(Ks, 0, 1); kf[2] = VAR == 8 ? qr[1] : KFR(Ks, 1, 0); kf[3] = VAR == 8 ? qr[1] : KFR(Ks, 1, 1);
  SBAR();
  const bf16x8 b0 = VAR == 8 ? qr[2] : KFR(Ks, 2, 0), b1 = VAR == 8 ? qr[2] : KFR(Ks, 2, 1), b2 = VAR == 8 ? qr[3] : KFR(Ks, 3, 0), b3 = VAR == 8 ? qr[3] : KFR(Ks, 3, 1);
  p0 = MF(kf[0], qr[0], f32x16{}); p1 = MF(kf[1], qr[0], f32x16{});
  p0 = MF(kf[2], qr[1], p0); p1 = MF(kf[3], qr[1], p1);
  if (FIN) {
    if (VAR == 9) {
#pragma unroll
      for (int r = 0; r < 16; ++r) f1[r] -= shift; }
    if (VAR != 1) {
#pragma unroll
      for (int r = 0; r < 16; ++r) f1[r] = __builtin_amdgcn_exp2f(f1[r]); }
  }
  SBAR();
  const bf16x8 c0 = VAR == 8 ? qr[4] : KFR(Ks, 4, 0), c1 = VAR == 8 ? qr[4] : KFR(Ks, 4, 1), c2 = VAR == 8 ? qr[5] : KFR(Ks, 5, 0), c3 = VAR == 8 ? qr[5] : KFR(Ks, 5, 1);
  p0 = MF(b0, qr[2], p0); p1 = MF(b1, qr[2], p1);
  p0 = MF(b2, qr[3], p0); p1 = MF(b3, qr[3], p1);
  if (FIN) {
    float ps = 0;
#pragma unroll
    for (int r = 0; r < 16; ++r) ps += f0[r];
#pragma unroll
    for (int r = 0; r < 16; ++r) ps += f1[r];
    l_reg += ps;
  }
  SBAR();
  p0 = MF(c0, qr[4], p0); p1 = MF(c1, qr[4], p1);
  p0 = MF(c2, qr[5], p0); p1 = MF(c3, qr[5], p1);
  if (FIN) {
#define PK4(P, BASE, OUT) do { u32x4 w = {cvt_pk_bf16(P[BASE + 0], P[BASE + 1]), cvt_pk_bf16(P[BASE + 2], P[BASE + 3]), cvt_pk_bf16(P[BASE + 4], P[BASE + 5]), cvt_pk_bf16(P[BASE + 6], P[BASE + 7])}; \
    OUT = *reinterpret_cast<bf16x8*>(&w); } while (0)
    PK4(f0, 0, pa0); PK4(f0, 8, pa1); PK4(f1, 0, pa2); PK4(f1, 8, pa3);
#undef PK4
  }
}
#undef MF
__device__ __forceinline__ int v_st(int k, int c) { return ((k >> 3) * 2 + (c >> 5)) * 512 + ((k & 7) * 32 + (c & 31)) * 2; }
__device__ __forceinline__ int v_rd_base(int lane) { return ((lane & 3) << 3) | (((lane >> 2) & 3) << 6) | (((lane >> 4) & 1) << 5) | (((lane >> 5) & 1) << 8); }
constexpr int v_rd_off(int d0, int ks, int half) { return d0 * 512 + ks * 2048 + half * 1024; }
template <int OFF> __device__ __forceinline__ s16x4 tr_read(int vb) {
  s16x4 r; asm volatile("ds_read_b64_tr_b16 %0, %1 offset:%2" : "=&v"(r) : "v"(vb), "i"(OFF) : "memory"); return r;
}
template <int D0> __device__ __forceinline__ void pv_one(f32x16& od, int vb, bf16x8 pa0, bf16x8 pa1, bf16x8 pa2, bf16x8 pa3) {
  const s16x4 l0 = tr_read<v_rd_off(D0, 0, 0)>(vb), h0 = tr_read<v_rd_off(D0, 0, 1)>(vb), l1 = tr_read<v_rd_off(D0, 1, 0)>(vb), h1 = tr_read<v_rd_off(D0, 1, 1)>(vb);
  const s16x4 l2 = tr_read<v_rd_off(D0, 2, 0)>(vb), h2 = tr_read<v_rd_off(D0, 2, 1)>(vb), l3 = tr_read<v_rd_off(D0, 3, 0)>(vb), h3 = tr_read<v_rd_off(D0, 3, 1)>(vb);
  asm volatile("s_waitcnt lgkmcnt(0)" ::: "memory"); SBAR();
#define PK(L, H) (bf16x8){L[0], L[1], L[2], L[3], H[0], H[1], H[2], H[3]}
  od = __builtin_amdgcn_mfma_f32_32x32x16_bf16(PK(l0, h0), pa0, od, 0, 0, 0);
  od = __builtin_amdgcn_mfma_f32_32x32x16_bf16(PK(l1, h1), pa1, od, 0, 0, 0);
  od = __builtin_amdgcn_mfma_f32_32x32x16_bf16(PK(l2, h2), pa2, od, 0, 0, 0);
  od = __builtin_amdgcn_mfma_f32_32x32x16_bf16(PK(l3, h3), pa3, od, 0, 0, 0);
#undef PK
}
__device__ __forceinline__ void pv_d0(f32x16* o, int vb, bf16x8 pa0, bf16x8 pa1, bf16x8 pa2, bf16x8 pa3) {
  pv_one<0>(o[0], vb, pa0, pa1, pa2, pa3); pv_one<1>(o[1], vb, pa0, pa1, pa2, pa3);
}

template <int VAR>
__device__ __forceinline__ void attn_unit(const bf16_t* __restrict__ Qraw, const bf16_t* __restrict__ Kb, const bf16_t* __restrict__ Vb, bf16_t* mix,
                                          const float* ssqkv, const float* ssqq, float negB2, int qrow0, int krow0, int nkeys, int h, char* lds) {
  if (VAR == 10) return;
  int tid = threadIdx.x; asm volatile("" : "+v"(tid));
    const int  wid = __builtin_amdgcn_readfirstlane(tid >> 6), lane = tid & 63, r32 = lane & 31, hi = lane >> 5;
  char* V_lds = lds + LDS_V; char* K_lds = lds + LDS_K;
  float l_reg = 0; f32x16 o[2] = {}; bf16x8 qr[6];
  const float shift = -negB2;
  {
    const int row = qrow0 + wid * QBLK + r32;
    const f32x4 pa = *(const f32x4*)(ssqkv + (size_t)row * 16 + 4), pb = *(const f32x4*)(ssqkv + (size_t)row * 16 + 8);
    const float sql = rsqrtf(((pa[0] + pa[1]) + (pa[2] + pa[3]) + (pb[0] + pb[1]) + (pb[2] + pb[3])) * (1.0f / 384.0f) + EPS);
    const float ssh = ssqq[(size_t)row * 24 + 3 * h] + ssqq[(size_t)row * 24 + 3 * h + 1] + ssqq[(size_t)row * 24 + 3 * h + 2];
    const float sc = sql * rsqrtf(sql * sql * ssh * (1.0f / 96.0f) + EPS) * QSCALE;
    const bf16_t* Qw = Qraw + (size_t)row * 768 + h * 96 + hi * 8;
#pragma unroll
    for (int d0 = 0; d0 < 6; ++d0) { const u32x4 w = *(const u32x4*)(Qw + d0 * 16); u32x4 o4;
      o4.x = cvt_pk_bf16(bflo(w.x) * sc, bfhi(w.x) * sc); o4.y = cvt_pk_bf16(bflo(w.y) * sc, bfhi(w.y) * sc);
      o4.z = cvt_pk_bf16(bflo(w.z) * sc, bfhi(w.z) * sc); o4.w = cvt_pk_bf16(bflo(w.w) * sc, bfhi(w.w) * sc);
      qr[d0] = *reinterpret_cast<bf16x8*>(&o4); }
  }
  const int kk0 = tid / 12, kc0 = tid - kk0 * 12, kk1 = (tid + 512) / 12, kc1 = (tid + 512) - kk1 * 12, vk = tid >> 3, vc = tid & 7;
  const bf16_t* Kh = Kb + (size_t)krow0 * 768 + h * 96; const bf16_t* Vh = Vb + (size_t)krow0 * 512 + h * 64;
  const unsigned kof0 = (unsigned)(kk0 * 768 + kc0 * 8) * 2u, kof1 = (unsigned)(kk1 * 768 + kc1 * 8) * 2u, vof = (unsigned)(vk * 512 + vc * 8) * 2u;
  const int kst0 = kk0 * KROWB + kc0 * 16, kst1 = kk1 * KROWB + kc1 * 16, vst = v_st(vk, vc * 8);
  const __amdgpu_buffer_rsrc_t krs = __builtin_amdgcn_make_buffer_rsrc((void*)Kh, 0, nkeys * 768 * 2, 0x00020000);
  const __amdgpu_buffer_rsrc_t vrs = __builtin_amdgcn_make_buffer_rsrc((void*)Vh, 0, nkeys * 512 * 2, 0x00020000);
  const bool two = wid < 4;
  const int vb0 = (int)(uintptr_t)V_lds + v_rd_base(lane);
  bf16x8 sk0, sk1, sv;
#define LOADK(t) do { if (VAR == 4) break; const int so_ = (t) * (KVBLK * 768 * 2); sk0 = __builtin_bit_cast(bf16x8, __builtin_amdgcn_raw_buffer_load_b128(krs, kof0, so_, 0)); if (two) sk1 = __builtin_bit_cast(bf16x8, __builtin_amdgcn_raw_buffer_load_b128(krs, kof1, so_, 0)); } while (0)
#define LOADV(t) do { if (VAR == 4) break; sv = __builtin_bit_cast(bf16x8, __builtin_amdgcn_raw_buffer_load_b128(vrs, vof, (t) * (KVBLK * 512 * 2), 0)); } while (0)
#define WRITEK(slot) do { if (VAR == 4) break; *(bf16x8*)(K_lds + (slot) * SHM_K + kst0) = sk0; if (two) *(bf16x8*)(K_lds + (slot) * SHM_K + kst1) = sk1; } while (0)
#define WRITEV(slot) do { if (VAR == 4) break; *(bf16x8*)(V_lds + (slot) * SHM_V + vst) = sv; } while (0)
#define PV(slot) do { if (VAR != 2) pv_d0(o, vb0 + (slot) * SHM_V, pa0, pa1, pa2, pa3); else { asm volatile("" :: "v"(pa0), "v"(pa1), "v"(pa2), "v"(pa3)); } } while (0)
#define QFS(FIN, P0, P1, F0, F1, KQ) qkt_fin<FIN, VAR>(P0, P1, K_lds + (KQ) * SHM_K, qr, r32, hi, F0, F1, shift, l_reg, pa0, pa1, pa2, pa3)
#define QF(FIN, P0, P1, F0, F1) QFS(FIN, P0, P1, F0, F1, kq)
  f32x16 pA0, pA1, pB0, pB1; bf16x8 pa0, pa1, pa2, pa3; const int NT = nkeys / KVBLK;
  LOADK(0); LOADV(0); WRITEK(0); WRITEV(0); LOADK(1); WRITEK(1); LOADK(2); LOADV(1);
  __syncthreads();
  int sa = 2, sb = 1, kq = 0;
#define ROT() do { sa = (sa == 2) ? 0 : sa + 1; sb = (sb == 2) ? 0 : sb + 1; kq = (kq == 2) ? 0 : kq + 1; } while (0)
  SBAR(); QF(false, pA0, pA1, pA0, pA1); SBAR(); partialSM<VAR>(pA0, shift); WRITEK(sa); WRITEV(sb); LOADK(3); LOADV(2); __syncthreads();
  ROT();
#define STEP_U(PC0, PC1, PP0, PP1, s_, KQ, SA, SB) do { SBAR(); QFS(true, PC0, PC1, PP0, PP1, KQ); SBAR(); PV(SA); SBAR(); partialSM<VAR>(PC0, shift); \
    WRITEK(SA); WRITEV(SB); LOADK((s_) + 3); LOADV((s_) + 2); __syncthreads(); } while (0)
  int j = 1;
#ifdef ATT_UNROLL6
  for (; j + 8 < NT; j += 6) {
    STEP_U(pB0, pB1, pA0, pA1, j,     1, 0, 2);
    STEP_U(pA0, pA1, pB0, pB1, j + 1, 2, 1, 0);
    STEP_U(pB0, pB1, pA0, pA1, j + 2, 0, 2, 1);
    STEP_U(pA0, pA1, pB0, pB1, j + 3, 1, 0, 2);
    STEP_U(pB0, pB1, pA0, pA1, j + 4, 2, 1, 0);
    STEP_U(pA0, pA1, pB0, pB1, j + 5, 0, 2, 1);
  }
#endif
  for (; j + 1 < NT; j += 2) {
    SBAR(); QF(true, pB0, pB1, pA0, pA1); SBAR(); PV(sa); SBAR(); partialSM<VAR>(pB0, shift);
    WRITEK(sa); WRITEV(sb); if (j + 3 < NT) LOADK(j + 3); LOADV(j + 2); __syncthreads();
    ROT();
    const bool t3 = (j + 3 < NT);
    SBAR(); QF(true, pA0, pA1, pB0, pB1); SBAR(); PV(sa); SBAR(); partialSM<VAR>(pA0, shift);
    if (t3) WRITEK(sa); WRITEV(sb); if (j + 4 < NT) LOADK(j + 4); if (t3) LOADV(j + 3); __syncthreads();
    ROT();
  }
  SBAR(); QF(true, pB0, pB1, pA0, pA1); SBAR(); PV(sa); partialSM<VAR>(pB0, shift);
  finishSM<VAR>(pB0, pB1, shift, l_reg, pa0, pa1, pa2, pa3); SBAR();
  ROT();
  PV(sa);
  { auto rr = __builtin_amdgcn_permlane32_swap(__float_as_uint(l_reg), __float_as_uint(l_reg), false, false); l_reg = __uint_as_float(rr[0]) + __uint_as_float(rr[1]); }
  const float rl = __builtin_amdgcn_rcpf(l_reg);
  { bf16_t* stg = (bf16_t*)(lds + LDS_OST) + wid * 2048;
#pragma unroll
    for (int d0 = 0; d0 < 2; ++d0)
#pragma unroll
      for (int g = 0; g < 4; ++g) { u32x2 w; w.x = cvt_pk_bf16(o[d0][4 * g] * rl, o[d0][4 * g + 1] * rl); w.y = cvt_pk_bf16(o[d0][4 * g + 2] * rl, o[d0][4 * g + 3] * rl);
        *(u32x2*)(stg + r32 * 64 + d0 * 32 + 8 * g + 4 * hi) = w; }
    asm volatile("s_waitcnt lgkmcnt(0)" ::: "memory");
    bf16_t* Ow = mix + (size_t)(qrow0 + wid * QBLK) * D_MODEL + 256 + h * 64;
#pragma unroll
    for (int i = 0; i < 4; ++i) { const int row = i * 8 + (lane >> 3), ch = lane & 7; const u32x4 v = *(const u32x4*)(stg + row * 64 + ch * 8); *(u32x4*)(Ow + (size_t)row * D_MODEL + ch * 8) = v; } }
  __syncthreads();
#undef LOADK
#undef LOADV
#undef WRITEK
#undef WRITEV
#undef ROT
#undef QF
#undef QFS
#undef STEP_U
#undef PV
}
#undef SBAR
}
namespace thin {
__device__ __forceinline__ float fexp(float x) { return __builtin_amdgcn_exp2f(x * 1.4426950408889634f); }
__device__ __forceinline__ float sigmoidf_(float x) { return __builtin_amdgcn_rcpf(1.0f + fexp(-x)); }
__device__ __forceinline__ float gelu_tanh(float x) { return x * __builtin_amdgcn_rcpf(1.0f + __builtin_amdgcn_exp2f(x * fmaf(x * x, -0.10294323f, -2.3022082f))); }
__device__ __forceinline__ float fexpm1_neg(float x) { const float p = x * (1.0f + x * (0.5f + x * (0.16666667f + x * (0.041666668f + x * 0.0083333338f)))); const float e = fexp(x) - 1.0f; return x > -0.25f ? p : e; }
__device__ __forceinline__ int rope_logical(int p) { const int q = p >> 3, i = p & 7; return (q >> 1) * 16 + (i >> 2) * 8 + (q & 1) * 4 + (i & 3); }

constexpr int XC_ROWB = 144;
constexpr int LRU_XC = 0, LRU_Y = 256 * XC_ROWB;
constexpr int NPOS = 34;

struct LruP { const bf16_t* z; const float* convw; const float* convb; const bf16_t* gw; const float* ba; const float* bx; const float* lam; float* agg; bf16_t* mix; };

template <int PASS>
__device__ __forceinline__ void lru_item(const LruP& P, int pm, int hd, char* lds) {
    int tid = threadIdx.x; asm volatile("" : "+v"(tid));
    const int  wid = __builtin_amdgcn_readfirstlane(tid >> 6), lane = tid & 63, r32 = lane & 31, hi = lane >> 5;
    const int b = pm / PPB, pp = pm - b * PPB;
    const int L = pp == 0 ? CTX : SEQ, seqbase = b * TPB + (pp == 0 ? 0 : CTX), t0 = pp == 0 ? 0 : (pp - 1) * 256;
    char* XC = lds + LRU_XC; float* Y = (float*)(lds + LRU_Y);
    {
        const int c8 = tid & 7, ch = hd * 64 + c8 * 8;
        f32x4 w[4][2];
#pragma unroll
        for (int k = 0; k < 4; ++k) { w[k][0] = *(const f32x4*)(P.convw + k * 256 + ch); w[k][1] = *(const f32x4*)(P.convw + k * 256 + ch + 4); }
        const f32x4 cb0 = *(const f32x4*)(P.convb + ch), cb1 = *(const f32x4*)(P.convb + ch + 4);
#pragma unroll
        for (int i = 0; i < 4; ++i) {
            const int tk = (tid >> 3) + 64 * i, ts = t0 + tk;
            f32x4 a0 = cb0, a1 = cb1;
#pragma unroll
            for (int k = 0; k < 4; ++k) { const int tsrc = ts + k - 1;
                if (tsrc >= 0 && tsrc < L) { const u32x4 v = *(const u32x4*)(P.z + (size_t)(seqbase + tsrc) * ZW + Z_LX + ch);
                    a0 += w[k][0] * (f32x4){bflo(v.x), bfhi(v.x), bflo(v.y), bfhi(v.y)}; a1 += w[k][1] * (f32x4){bflo(v.z), bfhi(v.z), bflo(v.w), bfhi(v.w)}; } }
            *(u32x4*)(XC + tk * XC_ROWB + c8 * 16) = epi::pack8(a0, a1);
        }
    }
    __syncthreads();
    const int dir = wid & 1, cb = (wid >> 1) & 1, half = wid >> 2;
    const int chl = cb * 32 + r32, ch = hd * 64 + chl;
    bf16x8 Ba[4], Bx[4];
#pragma unroll
    for (int ks = 0; ks < 4; ++ks) {
        Ba[ks] = *(const bf16x8*)(P.gw + ((size_t)((dir * 2 + 0) * 4 + hd) * 64 + chl) * 64 + ks * 16 + hi * 8);
        Bx[ks] = *(const bf16x8*)(P.gw + ((size_t)((dir * 2 + 1) * 4 + hd) * 64 + chl) * 64 + ks * 16 + hi * 8);
    }
    const float bav = P.ba[dir * 256 + ch], bxv = P.bx[dir * 256 + ch];
    const float sp8 = 8.0f * log1pf(expf(-P.lam[dir * 256 + ch]));
    const float nsp8 = -sp8, ba2 = bav * -1.4426950408889634f, bx2 = bxv * -1.4426950408889634f;
    const bool small_la = __all(sp8 <= 0.125f);
    const int chunk = pp == 0 ? half : 2 * pp + half;
    const int pos = dir == 0 ? chunk : (chunk == 1 ? 0 : (chunk == 0 ? 1 : 35 - chunk));
    float Hrun = 0.f, Arun = 1.f;
    if (PASS == 2) {
        const float* ag = P.agg + ((size_t)(b * 2 + dir) * NPOS) * 512 + ch * 2;
#pragma unroll 1
        for (int p0 = 0; p0 < pos; p0 += 11) {
            f32x2 e[11];
#pragma unroll
            for (int q = 0; q < 11; ++q) e[q] = (p0 + q) < pos ? *(const f32x2*)(ag + (size_t)(p0 + q) * 512) : (f32x2){1.0f, 0.0f};
#pragma unroll
            for (int q = 0; q < 11; ++q) Hrun = e[q].x * Hrun + e[q].y;
        }
    }
    float yv[4][16];
    const int tau = ((r32 >> 2) & 1) * 16 + (r32 >> 3) * 4 + (r32 & 3);
    const int firsthi = dir;
#pragma unroll
    for (int ii = 0; ii < 4; ++ii) {
        const int tile = dir == 0 ? ii : 3 - ii, tb = half * 128 + tile * 32;
        f32x16 ra = {}, ix = {};
#pragma unroll
        for (int ks = 0; ks < 4; ++ks) {
            const bf16x8 af = *(const bf16x8*)(XC + (tb + tau) * XC_ROWB + (ks * 16 + hi * 8) * 2);
            ra = __builtin_amdgcn_mfma_f32_32x32x16_bf16(af, Ba[ks], ra, 0, 0, 0);
            ix = __builtin_amdgcn_mfma_f32_32x32x16_bf16(af, Bx[ks], ix, 0, 0, 0);
        }
        float av[16], bv[16];
        if (small_la) { asm volatile("; lru: series expm1" ::: "memory");
#pragma unroll
            for (int r = 0; r < 16; ++r) {
                const float xcv = bf2f(*(const bf16_t*)(XC + (tb + hi * 16 + r) * XC_ROWB + chl * 2));
                const float rr = __builtin_amdgcn_rcpf(1.0f + __builtin_amdgcn_exp2f(fmaf(ra[r], -1.4426950408889634f, ba2)));
                const float iv = __builtin_amdgcn_rcpf(1.0f + __builtin_amdgcn_exp2f(fmaf(ix[r], -1.4426950408889634f, bx2)));
                const float la = nsp8 * rr;
                const float em = la * fmaf(la, fmaf(la, fmaf(la, 0.041666668f, 0.16666667f), 0.5f), 1.0f);
                av[r] = 1.0f + em; bv[r] = __builtin_amdgcn_sqrtf(-fmaf(em, em, em + em)) * (iv * xcv);
            }
        } else {
#pragma unroll
            for (int r = 0; r < 16; ++r) {
                const float xcv = bf2f(*(const bf16_t*)(XC + (tb + hi * 16 + r) * XC_ROWB + chl * 2));
                const float rr = __builtin_amdgcn_rcpf(1.0f + __builtin_amdgcn_exp2f(fmaf(ra[r], -1.4426950408889634f, ba2)));
                const float iv = __builtin_amdgcn_rcpf(1.0f + __builtin_amdgcn_exp2f(fmaf(ix[r], -1.4426950408889634f, bx2)));
                const float em = fexpm1_neg(nsp8 * rr);
                av[r] = 1.0f + em; bv[r] = __builtin_amdgcn_sqrtf(-fmaf(em, em, em + em)) * (iv * xcv);
            }
        }
        float hl[16], cl[16]; float h = 0.f, c = 1.f;
        if (dir == 0) {
#pragma unroll
            for (int r = 0; r < 16; ++r) { h = av[r] * h + bv[r]; c *= av[r]; hl[r] = h; cl[r] = c; }
        } else {
#pragma unroll
            for (int r = 15; r >= 0; --r) { h = av[r] * h + bv[r]; c *= av[r]; hl[r] = h; cl[r] = c; }
        }
        const float H1 = __shfl(h, r32 + 32 * firsthi), A1 = __shfl(c, r32 + 32 * firsthi);
        const float H2 = __shfl(h, r32 + 32 * (1 - firsthi)), A2 = __shfl(c, r32 + 32 * (1 - firsthi));
        const float Hin1 = Hrun, Hin2 = A1 * Hrun + H1;
        const float Hmine = (hi == firsthi) ? Hin1 : Hin2;
        Hrun = A2 * Hin2 + H2; Arun = Arun * A1 * A2;
        if (PASS == 2) {
#pragma unroll
            for (int r = 0; r < 16; ++r) yv[ii][r] = hl[r] + cl[r] * Hmine;
        }
    }
    if (PASS == 1) {
        if (hi == 0) *(f32x2*)(P.agg + ((size_t)(b * 2 + dir) * NPOS + pos) * 512 + ch * 2) = (f32x2){Arun, Hrun};
        __syncthreads();
    } else {
        if (dir == 0) {
#pragma unroll
            for (int ii = 0; ii < 4; ++ii)
#pragma unroll
                for (int r = 0; r < 16; ++r) Y[(half * 128 + ii * 32 + hi * 16 + r) * 64 + chl] = yv[ii][r];
        }
        __syncthreads();
        if (dir == 1) {
#pragma unroll
            for (int ii = 0; ii < 4; ++ii)
#pragma unroll
                for (int r = 0; r < 16; ++r) Y[(half * 128 + (3 - ii) * 32 + hi * 16 + r) * 64 + chl] += yv[ii][r];
        }
        __syncthreads();
        const int c8 = tid & 7;
#pragma unroll
        for (int i = 0; i < 4; ++i) {
            const int tk = (tid >> 3) + 64 * i; const size_t row = (size_t)pm * 256 + tk;
            const f32x4 y0 = *(const f32x4*)(Y + tk * 64 + c8 * 8), y1 = *(const f32x4*)(Y + tk * 64 + c8 * 8 + 4);
            const u32x4 g = *(const u32x4*)(P.z + row * ZW + Z_LG + hd * 64 + c8 * 8);
            const f32x4 o0 = y0 * (f32x4){gelu_tanh(bflo(g.x)), gelu_tanh(bfhi(g.x)), gelu_tanh(bflo(g.y)), gelu_tanh(bfhi(g.y))};
            const f32x4 o1 = y1 * (f32x4){gelu_tanh(bflo(g.z)), gelu_tanh(bfhi(g.z)), gelu_tanh(bflo(g.w)), gelu_tanh(bfhi(g.w))};
            *(u32x4*)(P.mix + row * D_MODEL + hd * 64 + c8 * 8) = epi::pack8(o0, o1);
        }
        __syncthreads();
    }
}

constexpr int PL_PU = 0, PL_MX = 272 * 128;
__device__ __forceinline__ void pool_item(const bf16_t* z, const bf16_t* pw, bf16_t* mix, int pm, int g, char* lds) {
    int tid = threadIdx.x; asm volatile("" : "+v"(tid));
    const int  wid = __builtin_amdgcn_readfirstlane(tid >> 6), lane = tid & 63, r32 = lane & 31, hi = lane >> 5;
    const int b = pm / PPB, pp = pm - b * PPB;
    const int L = pp == 0 ? CTX : SEQ, seqbase = b * TPB + (pp == 0 ? 0 : CTX), t0 = pp == 0 ? 0 : (pp - 1) * 256;
    char* PU = lds + PL_PU; char* MX = lds + PL_MX;
    const int c8 = tid & 7;
#pragma unroll
    for (int i = 0; i < 5; ++i) { const int hr = (tid >> 3) + 64 * i, ts = t0 - 8 + hr;
        if (hr < 272 && ts >= 0 && ts < L) *(u32x4*)(PU + hr * 128 + c8 * 16) = *(const u32x4*)(z + (size_t)(seqbase + ts) * ZW + Z_PU + g * 64 + c8 * 8); }
    __syncthreads();
    const int w = 2 << g;
#pragma unroll
    for (int i = 0; i < 4; ++i) {
        const int tk = (tid >> 3) + 64 * i, ts = t0 + tk;
        const int lo = max(ts - w / 2, 0), hi_ = min(ts - w / 2 + w, L);
        f32x4 s0 = {0.f, 0.f, 0.f, 0.f}, s1 = {0.f, 0.f, 0.f, 0.f};
        for (int tt = lo; tt < hi_; ++tt) { const u32x4 v = *(const u32x4*)(PU + (tt - t0 + 8) * 128 + c8 * 16);
            s0 += (f32x4){bflo(v.x), bfhi(v.x), bflo(v.y), bfhi(v.y)}; s1 += (f32x4){bflo(v.z), bfhi(v.z), bflo(v.w), bfhi(v.w)}; }
        const float inv = 1.0f / (float)(hi_ - lo);
        const u32x4 v = *(const u32x4*)(PU + (tk + 8) * 128 + c8 * 16);
        s0 = s0 * inv - (f32x4){bflo(v.x), bfhi(v.x), bflo(v.y), bfhi(v.y)}; s1 = s1 * inv - (f32x4){bflo(v.z), bfhi(v.z), bflo(v.w), bfhi(v.w)};
        *(u32x4*)(MX + tk * XC_ROWB + c8 * 16) = epi::pack8(s0, s1);
    }
    __syncthreads();
    f32x16 c0 = {}, c1 = {};
#pragma unroll
    for (int ks = 0; ks < 4; ++ks) {
        const bf16x8 bf = *(const bf16x8*)(MX + (wid * 32 + r32) * XC_ROWB + (ks * 16 + hi * 8) * 2);
        const bf16x8 a0 = *(const bf16x8*)(pw + ((size_t)g * 64 + r32) * 64 + ks * 16 + hi * 8);
        const bf16x8 a1 = *(const bf16x8*)(pw + ((size_t)g * 64 + 32 + r32) * 64 + ks * 16 + hi * 8);
        c0 = __builtin_amdgcn_mfma_f32_32x32x16_bf16(a0, bf, c0, 0, 0, 0);
        c1 = __builtin_amdgcn_mfma_f32_32x32x16_bf16(a1, bf, c1, 0, 0, 0);
    }
    bf16_t* op = mix + ((size_t)pm * 256 + wid * 32 + r32) * D_MODEL + 768 + g * 64 + 4 * hi;
#pragma unroll
    for (int q = 0; q < 4; ++q) {
        u32x2 w0, w1; w0.x = cvt_pk_bf16(c0[4 * q], c0[4 * q + 1]); w0.y = cvt_pk_bf16(c0[4 * q + 2], c0[4 * q + 3]);
        w1.x = cvt_pk_bf16(c1[4 * q], c1[4 * q + 1]); w1.y = cvt_pk_bf16(c1[4 * q + 2], c1[4 * q + 3]);
        *(u32x2*)(op + 8 * q) = w0; *(u32x2*)(op + 32 + 8 * q) = w1;
    }
    __syncthreads();
}

__device__ __forceinline__ void transpose_tile(const float* W, int N, bf16_t* WT, int Kp, int k0, int nphys, int srcbase, bool rperm, const float* kscale, const float* nscale, bool zero, LAS float* scr, int lane) {
    const int nl = lane & 31, sc = srcbase + (rperm ? rope_logical(nl) : nl);
    const float nsv = nscale ? nscale[nl] : 1.0f;
#pragma unroll 8
    for (int i = 0; i < 32; ++i) { const int kk = 2 * i + (lane >> 5);
        float v = zero ? 0.f : W[(size_t)(k0 + kk) * N + sc] * nsv; if (kscale) v *= kscale[k0 + kk];
        scr[kk * 33 + nl] = v; }
    asm volatile("s_waitcnt lgkmcnt(0)" ::: "memory");
    const int c = lane & 7;
#pragma unroll
    for (int j = 0; j < 4; ++j) { const int n = (lane >> 3) + 8 * j; const LAS float* s = scr + (8 * c) * 33 + n;
        u32x4 o; o.x = cvt_pk_bf16(s[0 * 33], s[1 * 33]); o.y = cvt_pk_bf16(s[2 * 33], s[3 * 33]); o.z = cvt_pk_bf16(s[4 * 33], s[5 * 33]); o.w = cvt_pk_bf16(s[6 * 33], s[7 * 33]);
        *(u32x4*)(WT + (size_t)(nphys + n) * Kp + k0 + 8 * c) = o; }
    asm volatile("s_waitcnt lgkmcnt(0)" ::: "memory");
}
__device__ __forceinline__ float wave_sum(float v) {
#pragma unroll
    for (int o = 1; o < 64; o <<= 1) v += __shfl_xor(v, o);
    return v;
}
}
constexpr int NWAVES = 8;
constexpr size_t MiB = 1u << 20;
constexpr size_t WS_CTL = 0, CTL_ZERO_BYTES = 64 * 1024;
constexpr size_t WS_MODPART = 1 * MiB;
constexpr size_t WS_VEC = 5 * MiB;
constexpr size_t WS_BIASIN = WS_VEC + 512 * 1024;
constexpr size_t WS_BIASFF = WS_BIASIN + 128 * 1024;
constexpr size_t WS_RTAB = WS_BIASFF + 320 * 1024;
constexpr size_t WS_RVEC = 17 * MiB + 512 * 1024;
constexpr size_t WS_AGG = 6 * MiB;
constexpr size_t WS_SSQX = 8 * MiB;
constexpr size_t WS_SSQKV = 11 * MiB;
constexpr size_t WS_SSQQ = 14 * MiB;
constexpr size_t WS_WT = 18 * MiB, WT_LAYER = 23 * MiB;
constexpr size_t WT_IN = 0, WT_UQ = 3 * MiB, WT_UKV = WT_UQ + 640 * 1024, WT_OUT = WT_UKV + 512 * 1024, WT_FF1 = WT_OUT + 2 * MiB, WT_FF2 = WT_FF1 + 8 * MiB, WT_GATE = WT_FF2 + 8 * MiB, WT_POOL = WT_GATE + 128 * 1024;
static_assert(WT_POOL + 32 * 1024 <= WT_LAYER, "weights per layer");
constexpr size_t WS_XG = 72 * MiB;
constexpr size_t WS_U = 208 * MiB;
constexpr size_t WS_Z = WS_U, WS_Q = WS_Z + 102 * MiB, WS_K = WS_Q + 51 * MiB, WS_V = WS_K + 51 * MiB;
constexpr size_t WS_END = WS_U + 272 * MiB;
static_assert(WS_V + 34 * MiB <= WS_END && WS_END <= 512 * MiB, "d_ws map");
enum { VEC_GM1 = 0, VEC_G1 = 1, VEC_GM2 = 2, VEC_G2 = 3, VEC_SH1 = 4, VEC_SH2 = 5 };

constexpr int LDS_BYTES = 147456;
constexpr int LDSCTL_OFF = 131072, MISC_OFF = LDSCTL_OFF + 320;

typedef GAS unsigned gu32;
#define RLX_AGENT __ATOMIC_RELAXED, __HIP_MEMORY_SCOPE_AGENT
#define XB_TMO      128
#define XB_XCNT(j)  (256  + 64 * (j))
#define XB_XSUB(j)  (1280 + 64 * (j))
#define XB_XGEN(j)  (2304 + 64 * (j))
#define XB_TOP      3328
#define XB_TOPGEN   3392
#define XCD_BAR_WORDS 3456
#define XB_SPIN_CAP (1u << 20)
__device__ __forceinline__ unsigned xb_ld(unsigned* p)              { return __hip_atomic_load(p, __ATOMIC_RELAXED, __HIP_MEMORY_SCOPE_AGENT); }
__device__ __forceinline__ unsigned xb_add(unsigned* p, unsigned v) { return __hip_atomic_fetch_add(p, v, __ATOMIC_RELAXED, __HIP_MEMORY_SCOPE_AGENT); }
__device__ __forceinline__ unsigned xb_xcc_id() { return (unsigned)__builtin_amdgcn_s_getreg((3 << 11) | 20) & 0xFu; }
#define XB_SPIN(cond, bar) do { unsigned _sp = 0; while (cond) { __builtin_amdgcn_s_sleep(1); \
    if ((++_sp & 255u) == 0u) { if (xb_ld(&(bar)[XB_TMO])) break; if (_sp > XB_SPIN_CAP) { atomicAdd(&(bar)[XB_TMO], 1u); break; } } } } while (0)
struct XcdBarrier { unsigned* bar; unsigned x; volatile LAS unsigned* st; };
__device__ __forceinline__ XcdBarrier xcd_barrier_post(unsigned* bar, volatile LAS unsigned* st) {
    XcdBarrier b; b.bar = bar; b.x = xb_xcc_id(); b.st = st;
    if (threadIdx.x == 0) (void)xb_add(&bar[XB_XCNT(b.x)], 1u);
    return b;
}
__device__ __forceinline__ void xcd_barrier_complete(unsigned* bar, unsigned x, unsigned& nloc, unsigned& nx) {
    const unsigned G = gridDim.x * gridDim.y * gridDim.z;
    unsigned sum, cnt, mine, sp = 0u;
    for (;;) {
        sum = 0u; cnt = 0u; mine = 0u;
#pragma unroll
        for (unsigned j = 0; j < 16; ++j) { const unsigned c = xb_ld(&bar[XB_XCNT(j)]); sum += c; cnt += (c > 0u) ? 1u : 0u; mine = (j == x) ? c : mine; }
        if (sum == G) break;
        __builtin_amdgcn_s_sleep(1);
        if ((++sp & 255u) == 0u) { if (xb_ld(&bar[XB_TMO])) break; if (sp > XB_SPIN_CAP) { atomicAdd(&bar[XB_TMO], 1u); break; } }
    }
    nloc = mine > 0u ? mine : 1u; nx = cnt > 0u ? cnt : 1u;
}
__device__ __forceinline__ void xcd_barrier(const XcdBarrier& b) {
    asm volatile("s_waitcnt vmcnt(0)" ::: "memory");
    __syncthreads();
    if (threadIdx.x == 0) {
        unsigned* bar = b.bar;
        __builtin_amdgcn_s_waitcnt(0);
        unsigned nloc = b.st[0], nx = b.st[1];
        if (nloc == 0u) { xcd_barrier_complete(bar, b.x, nloc, nx); b.st[0] = nloc; b.st[1] = nx; }
        const unsigned old = xb_add(&bar[XB_XSUB(b.x)], 1u);
        const unsigned gen = old / nloc;
        if (old + 1u == (gen + 1u) * nloc) {
            __builtin_amdgcn_fence(__ATOMIC_RELEASE, "agent");
            asm volatile("s_waitcnt vmcnt(0)" ::: "memory");
            const unsigned og = xb_add(&bar[XB_TOP], 1u);
            const unsigned tg = og / nx;
            if (og + 1u == (tg + 1u) * nx) xb_add(&bar[XB_TOPGEN], 1u);
            else XB_SPIN(xb_ld(&bar[XB_TOPGEN]) == tg, bar);
            __builtin_amdgcn_fence(__ATOMIC_ACQUIRE, "agent");
            xb_add(&bar[XB_XGEN(b.x)], 1u);
            asm volatile("s_waitcnt vmcnt(0)" ::: "memory");
        } else {
            XB_SPIN(xb_ld(&bar[XB_XGEN(b.x)]) == gen, bar);
            __builtin_amdgcn_fence(__ATOMIC_ACQUIRE, "agent");
            asm volatile("s_waitcnt vmcnt(0)" ::: "memory");
        }
    }
    __syncthreads();
}


__device__ __forceinline__ void ctx_combine(unsigned char* ws, float* out, const float* rgmv, const float* gatev, const float* gmv, int gw, int NGW, int lane_in) {
    int lane = lane_in; asm volatile("" : "+v"(lane));
    const float* slab = out + (size_t)18 * 1024 * 1024;
    bf16_t* xg_ = (bf16_t*)(ws + WS_XG); float* ssq_ = (float*)(ws + WS_SSQX);
    for (int cr = gw; cr < BATCH * CTX; cr += NGW) {
        const size_t urow = (size_t)(cr >> 8) * TPB + (cr & 255); float ss = 0.f;
#pragma unroll
        for (int j = 0; j < 4; ++j) { const int col = 256 * j + 4 * lane;
            f32x4 a = *(const f32x4*)(slab + (size_t)cr * D_MODEL + col);
#pragma unroll
            for (int ks = 1; ks < 4; ++ks) a += *(const f32x4*)(slab + ((size_t)ks * (BATCH * CTX) + cr) * D_MODEL + col);
            const u32x2 w = *(const u32x2*)(xg_ + urow * D_MODEL + col);
            const f32x4 x = (f32x4){bflo(w.x), bfhi(w.x), bflo(w.y), bfhi(w.y)} * *(const f32x4*)(rgmv + col) + *(const f32x4*)(gatev + col) * a;
            ss += epi::sq4(x);
            const f32x4 t = x * *(const f32x4*)(gmv + col); u32x2 o; o.x = cvt_pk_bf16(t[0], t[1]); o.y = cvt_pk_bf16(t[2], t[3]); *(u32x2*)(xg_ + urow * D_MODEL + col) = o; }
        ss = thin::wave_sum(ss);
        if (lane < 16) ssq_[urow * 16 + lane] = lane == 0 ? ss : 0.f;
    }
}

struct Args { const float* in[27]; float* out; unsigned char* ws; int ph_lo, ph_hi; };
constexpr int NPHASE = 15;

__global__ void __launch_bounds__(NWAVES * 64, 2) fwd_kernel(Args args) {
    extern __shared__ __attribute__((aligned(16))) unsigned char lds_raw[];
    LAS unsigned char* lds = (LAS unsigned char*)lds_raw;
    char* ldsg = (char*)lds_raw;
    const int tid = threadIdx.x, lane = tid & 63, wave = __builtin_amdgcn_readfirstlane(tid >> 6);
    const int G = gridDim.x; const int bx = blockIdx.x; const int vcu = (G % 8 == 0) ? (bx % 8) * (G / 8) + bx / 8 : bx;
    unsigned char* ws = args.ws;
    typedef __attribute__((address_space(4))) const Args* KArgs;
#define KA(i) (((KArgs)__builtin_amdgcn_kernarg_segment_ptr())->in[i])
#define x_in KA(0)
#define c_in KA(1)
#define ctx_in KA(2)
#define cctx_in KA(3)
#define w_mod KA(4)
#define b_mod KA(5)
#define g_norm1 KA(6)
#define g_norm2 KA(7)
#define w_in KA(8)
#define conv_w KA(9)
#define conv_b KA(10)
#define lru_w_a KA(11)
#define lru_b_a KA(12)
#define lru_w_x KA(13)
#define lru_b_x KA(14)
#define lru_lambda KA(15)
#define g_q_lat KA(16)
#define w_uq KA(17)
#define g_kv_lat KA(18)
#define w_ukv KA(19)
#define g_qn KA(20)
#define g_kn KA(21)
#define w_pool KA(22)
#define pool_scale KA(23)
#define w_out KA(24)
#define w_ff1 KA(25)
#define w_ff2 KA(26)
    float* out = args.out;
#define modpart ((float*)(ws + WS_MODPART))
#define vec ((float*)(ws + WS_VEC))
#define bias_in ((float*)(ws + WS_BIASIN))
#define bias_ff ((float*)(ws + WS_BIASFF))
#define rtab ((float*)(ws + WS_RTAB))
#define agg ((float*)(ws + WS_AGG))
#define ssqx ((float*)(ws + WS_SSQX))
#define ssqkv ((float*)(ws + WS_SSQKV))
#define ssqq ((float*)(ws + WS_SSQQ))
#define rvec ((float*)(ws + WS_RVEC))
#define xg ((bf16_t*)(ws + WS_XG))
#define mix ((bf16_t*)out)
#define U ((bf16_t*)(ws + WS_U))
#define zb ((bf16_t*)(ws + WS_Z))
#define Qb ((bf16_t*)(ws + WS_Q))
#define Kb ((bf16_t*)(ws + WS_K))
#define Vb ((bf16_t*)(ws + WS_V))

    for (int u = tid; u < (LDS_BYTES - LDSCTL_OFF) / 4; u += NWAVES * 64) ((LAS unsigned*)(lds + LDSCTL_OFF))[u] = 0u;
    __syncthreads();
    const bool single = (args.ph_hi - args.ph_lo) > 1;
    XcdBarrier bar; bar.bar = (unsigned*)(ws + WS_CTL); bar.x = 0; bar.st = nullptr;
    if (single) bar = xcd_barrier_post((unsigned*)(ws + WS_CTL), (volatile LAS unsigned*)(lds + MISC_OFF) + 8);
    const int lo = args.ph_lo, hi = args.ph_hi;
#ifndef PHASE_MASK
#define PHASE_MASK 0x7FF
#endif
#define IN(k) (lo <= (k) && (k) < hi)
#define EN(j) ((PHASE_MASK >> (j)) & 1)
#ifndef DUP_PHASE
#define DUP_PHASE (-1)
#endif
#define NREP(k) (((k) == DUP_PHASE) ? 2 : 1)
#define SEAM(k) do { if (IN(k) && IN((k) + 1)) xcd_barrier(bar); } while (0)
    const int gw = vcu * NWAVES + wave, NGW = G * NWAVES;

    for (int rep_ = 0; rep_ < NREP(0); ++rep_) { if (rep_) xcd_barrier(bar);
    if (EN(0) && IN(0)) {
        float* sl = (float*)ldsg;
        for (int i = tid; i < 9 * 1024; i += NWAVES * 64) { const float v = i < 8192 ? c_in[i] : cctx_in[i - 8192]; sl[i] = v / (1.0f + expf(-v)); }
        __syncthreads();
        for (int it = gw; it < 2 * 96 * 8; it += NGW) {
            const int l = it / 768, r = it - l * 768, cg = r >> 3, ks = r & 7;
            float acc[9];
#pragma unroll
            for (int b = 0; b < 9; ++b) acc[b] = 0.f;
            const float* wp = w_mod + ((size_t)l * 1024 + ks * 128) * 6144 + cg * 64 + lane;
#pragma unroll 8
            for (int kk = 0; kk < 128; ++kk) { const float w = wp[(size_t)kk * 6144];
#pragma unroll
                for (int b = 0; b < 9; ++b) acc[b] += sl[b * 1024 + ks * 128 + kk] * w; }
#pragma unroll
            for (int b = 0; b < 9; ++b) modpart[((size_t)(ks * 2 + l) * 9 + b) * 6144 + cg * 64 + lane] = acc[b];
        }
        __syncthreads();
        if (bx == 0) for (int i = tid; i < 512; i += NWAVES * 64) { const int pos = i >> 3, f = i & 7; const float fr = powf(10000.0f, -(float)f / 8.0f), ang = (float)pos * fr; rtab[i * 2] = cosf(ang); rtab[i * 2 + 1] = sinf(ang); }
        LAS float* scr = (LAS float*)(lds + wave * 16384);
        constexpr int I_IN = 768, I_UQ = 144, I_UKV = 128, I_OUT = 512, I_FF1 = 2048, I_FF2 = 2048, I_G = 32, I_P = 8, I_L = I_IN + I_UQ + I_UKV + I_OUT + I_FF1 + I_FF2 + I_G + I_P;
        for (int it = gw; it < 2 * I_L; it += NGW) {
            const int l = it / I_L; int r = it - l * I_L; bf16_t* wt = (bf16_t*)(ws + WS_WT + (size_t)l * WT_LAYER);
            if (r < I_IN) { const int pg = r >> 4, kb = r & 15; int src = 0; bool z0 = false, rp = false;
                if (pg < 16) src = 32 * pg; else if (pg < 24) src = 896 + 32 * (pg - 16); else if (pg < 32) src = 1184 + 32 * (pg - 24); else if (pg < 44) src = 512 + 32 * (pg - 32); else if (pg == 44) { src = 1152; rp = true; } else z0 = true;
                thin::transpose_tile(w_in + (size_t)l * 1024 * D_IN, D_IN, wt + WT_IN / 2, 1024, kb * 64, pg * 32, src, rp, nullptr, nullptr, z0, scr, lane); continue; } r -= I_IN;
            if (r < I_UQ) { const int pg = r / 6, kb = r - pg * 6;
                thin::transpose_tile(w_uq + (size_t)l * 384 * 768, 768, wt + WT_UQ / 2, 384, kb * 64, pg * 32, pg * 32, (pg % 3) == 2, g_q_lat + l * 384, nullptr, false, scr, lane); continue; } r -= I_UQ;
            if (r < I_UKV) { const int pg = r >> 2, kb = r & 3, pn = pg >> 3, bj = (pg >> 2) & 1, wc = pg & 3;
                const int src = pn < 2 ? (4 * pn + wc) * 128 + 32 * bj : (4 * (pn - 2) + wc) * 128 + 64 + 32 * bj;
                thin::transpose_tile(w_ukv + (size_t)l * 256 * 1024, 1024, wt + WT_UKV / 2, 256, kb * 64, pg * 32, src, false, g_kv_lat + l * 256, nullptr, false, scr, lane); continue; } r -= I_UKV;
            if (r < I_OUT) { const int pg = r >> 4, kb = r & 15;
                thin::transpose_tile(w_out + (size_t)l * 1024 * 1024, 1024, wt + WT_OUT / 2, 1024, kb * 64, pg * 32, pg * 32, false, nullptr, nullptr, false, scr, lane); continue; } r -= I_OUT;
            if (r < I_FF1) { const int pg = r >> 4, kb = r & 15;
                thin::transpose_tile(w_ff1 + (size_t)l * 1024 * 4096, 4096, wt + WT_FF1 / 2, 1024, kb * 64, pg * 32, pg * 32, false, nullptr, nullptr, false, scr, lane); continue; } r -= I_FF1;
            if (r < I_FF2) { const int pg = r >> 6, kb = r & 63;
                thin::transpose_tile(w_ff2 + (size_t)l * 4096 * 1024, 1024, wt + WT_FF2 / 2, 4096, kb * 64, pg * 32, pg * 32, false, nullptr, nullptr, false, scr, lane); continue; } r -= I_FF2;
            if (r < I_G) { const int mat = r >> 1, pg = r & 1, dir = mat >> 3, gate = (mat >> 2) & 1, hd = mat & 3;
                const float* src = (gate ? lru_w_x : lru_w_a) + ((size_t)((l * 2 + dir) * 4 + hd)) * 4096;
                thin::transpose_tile(src, 64, wt + WT_GATE / 2 + (size_t)mat * 4096, 64, 0, pg * 32, pg * 32, false, nullptr, nullptr, false, scr, lane); continue; } r -= I_G;
            { const int g = r >> 1, pg = r & 1;
                thin::transpose_tile(w_pool + (size_t)(l * 4 + g) * 4096, 64, wt + WT_POOL / 2 + (size_t)g * 4096, 64, 0, pg * 32, pg * 32, false, nullptr, pool_scale + l * 256 + g * 64 + pg * 32, false, scr, lane); }
        }
        __syncthreads();
    }
    } SEAM(0);
    for (int rep_ = 0; rep_ < NREP(1); ++rep_) { if (rep_) xcd_barrier(bar);
    if (EN(0) && IN(1)) {
        const int gt = vcu * (NWAVES * 64) + tid;
        if (gt < 2 * 9 * 1024) {
            const int l = gt / 9216, r = gt - l * 9216, b = r >> 10, j = r & 1023;
            float m[6];
#pragma unroll
            for (int s = 0; s < 6; ++s) { float a = b_mod[l * 6144 + s * 1024 + j];
#pragma unroll
                for (int ks = 0; ks < 8; ++ks) a += modpart[((size_t)(ks * 2 + l) * 9 + b) * 6144 + s * 1024 + j];
                m[s] = a; }
            float* v = vec + (size_t)(l * 9 + b) * 6144 + j;
            float gm1 = g_norm1[l * 1024 + j] * (1.0f + m[1]), gm2 = g_norm2[l * 1024 + j] * (1.0f + m[4]);
            gm1 = fabsf(gm1) < 1e-20f ? 1e-20f : gm1; gm2 = fabsf(gm2) < 1e-20f ? 1e-20f : gm2;
            v[VEC_GM1 * 1024] = gm1; v[VEC_G1 * 1024] = m[2];
            v[VEC_GM2 * 1024] = gm2; v[VEC_G2 * 1024] = m[5];
            rvec[(size_t)(l * 9 + b) * 2048 + j] = 1.0f / gm1; rvec[(size_t)(l * 9 + b) * 2048 + 1024 + j] = 1.0f / gm2;
            v[VEC_SH1 * 1024] = m[0]; v[VEC_SH2 * 1024] = m[3];
        }
    }
    } SEAM(1);
    for (int rep_ = 0; rep_ < NREP(2); ++rep_) { if (rep_) xcd_barrier(bar);
    if (EN(0) && IN(2)) {
        float* sl = (float*)ldsg;
        for (int combo = 0; combo < 4; ++combo) {
            const int l = combo >> 1, mat = combo & 1, N = mat ? D_FF : ZW;
            __syncthreads();
            for (int i = tid; i < 9 * 1024; i += NWAVES * 64) sl[i] = vec[(size_t)(l * 9 + (i >> 10)) * 6144 + (mat ? VEC_SH2 : VEC_SH1) * 1024 + (i & 1023)];
            __syncthreads();
            const bf16_t* wt = (const bf16_t*)(ws + WS_WT + (size_t)l * WT_LAYER + (mat ? WT_FF1 : WT_IN));
            float* bo = (mat ? bias_ff : bias_in) + (size_t)l * 9 * N;
            for (int n = gw; n < N; n += NGW) {
                const u32x4 w0 = *(const u32x4*)(wt + (size_t)n * 1024 + 8 * lane), w1 = *(const u32x4*)(wt + (size_t)n * 1024 + 512 + 8 * lane);
                float wv[16] = {bflo(w0.x), bfhi(w0.x), bflo(w0.y), bfhi(w0.y), bflo(w0.z), bfhi(w0.z), bflo(w0.w), bfhi(w0.w), bflo(w1.x), bfhi(w1.x), bflo(w1.y), bfhi(w1.y), bflo(w1.z), bfhi(w1.z), bflo(w1.w), bfhi(w1.w)};
#pragma unroll
                for (int b = 0; b < 9; ++b) { float s = 0.f;
#pragma unroll
                    for (int i = 0; i < 8; ++i) s += wv[i] * sl[b * 1024 + 8 * lane + i] + wv[8 + i] * sl[b * 1024 + 512 + 8 * lane + i];
                    s = thin::wave_sum(s); if (lane == 0) bo[b * N + n] = s; }
            }
        }
        for (int r0 = gw * 2; r0 < MROWS; r0 += NGW * 2) {
            f32x4 v[2][4]; const float* gmv[2];
#pragma unroll
            for (int q = 0; q < 2; ++q) { const int r = r0 + q, b = r / TPB, tt = r - b * TPB, bidx = tt < CTX ? 8 : b;
                const float* src = tt < CTX ? ctx_in + ((size_t)b * CTX + tt) * D_MODEL : x_in + ((size_t)b * SEQ + (tt - CTX)) * D_MODEL;
                gmv[q] = vec + (size_t)(0 * 9 + bidx) * 6144 + VEC_GM1 * 1024;
#pragma unroll
                for (int j = 0; j < 4; ++j) v[q][j] = *(const f32x4*)(src + 256 * j + 4 * lane); }
#pragma unroll
            for (int q = 0; q < 2; ++q) { const int r = r0 + q; float ss = 0.f;
#pragma unroll
                for (int j = 0; j < 4; ++j) { const f32x4 g4 = *(const f32x4*)(gmv[q] + 256 * j + 4 * lane); ss += epi::sq4(v[q][j]);
                    const f32x4 t = v[q][j] * g4; u32x2 w; w.x = cvt_pk_bf16(t[0], t[1]); w.y = cvt_pk_bf16(t[2], t[3]); *(u32x2*)(xg + (size_t)r * D_MODEL + 256 * j + 4 * lane) = w; }
                ss = thin::wave_sum(ss);
                if (lane < 16) ssqx[(size_t)r * 16 + lane] = lane == 0 ? ss : 0.f; }
        }
    }
    } SEAM(2);
    for (int l = 0; l < DEPTH; ++l) {
        const int p0 = 3 + 6 * l; const bool lastl = (l == DEPTH - 1);
        const unsigned char* wtl = ws + WS_WT + (size_t)l * WT_LAYER;
        const float* vl = vec + (size_t)l * 9 * 6144;
    for (int rep_ = 0; rep_ < NREP(p0); ++rep_) { if (rep_) xcd_barrier(bar);
        if (EN(1) && IN(p0)) {
            pg8::Gemm g{xg, (const bf16_t*)(wtl + WT_IN)}; pg8::StaticOrder S; S.init(NPAN, ZW / 256, G, bx, 0);
            epi::EpiIn E{zb, ssqx, bias_in + (size_t)l * 9 * ZW, ssqkv, g_kn + l * 96, rtab};
            pg8::gemm_phase<1024, 1024, 1024, false>(lds, g, S, E);
        }
        } SEAM(p0);
    for (int rep_ = 0; rep_ < NREP(p0 + 1); ++rep_) { if (rep_) xcd_barrier(bar);
        if (IN(p0 + 1)) {
            if (EN(2)) { pg8::Gemm g{zb + Z_QL, (const bf16_t*)(wtl + WT_UQ)}; pg8::StaticOrder S; S.init(lastl ? 128 : NPAN, 3, G, bx, lastl ? 1 : 0);
              epi::EpiQ E{Qb, ssqq, g_qn + l * 96, rtab}; pg8::gemm_phase<384, ZW, 384, false>(lds, g, S, E); }
            if (EN(3)) { pg8::Gemm g{zb + Z_KVL, (const bf16_t*)(wtl + WT_UKV)}; pg8::StaticOrder S; S.init(NPAN, 4, G, (bx + 96) % G, 0);
              epi::EpiKV E{Kb, Vb, zb, ssqkv, g_kn + l * 96}; pg8::gemm_phase<256, ZW, 256, false>(lds, g, S, E); }
            thin::LruP P{zb, conv_w + l * 1024, conv_b + l * 256, (const bf16_t*)(wtl + WT_GATE), lru_b_a + l * 512, lru_b_x + l * 512, lru_lambda + l * 512, agg, mix};
            if (EN(4)) for (int it = G - 1 - vcu; it < NPAN * 4; it += G) thin::lru_item<1>(P, it >> 2, it & 3, ldsg);
            if (!EN(5)) {} else if (lastl) { for (int it = vcu; it < 128 * 4; it += G) { const int pl = it >> 2; thin::pool_item(zb, (const bf16_t*)(wtl + WT_POOL), mix, pl + pl / 16 + 1, it & 3, ldsg); } }
            else { for (int it = vcu; it < NPAN * 4; it += G) thin::pool_item(zb, (const bf16_t*)(wtl + WT_POOL), mix, it >> 2, it & 3, ldsg); }
        }
        } SEAM(p0 + 1);
    for (int rep_ = 0; rep_ < NREP(p0 + 2); ++rep_) { if (rep_) xcd_barrier(bar);
        if (IN(p0 + 2)) {
#ifndef SHIFT_THRESH
#define SHIFT_THRESH 64.0f
#endif
            float negB2; bool shifted;
            {
                const float* gq = g_qn + l * 96; const float* gk = g_kn + l * 96;
                float mq = fmaxf(fabsf(gq[lane]), lane < 32 ? fabsf(gq[64 + lane]) : 0.f), mk = fmaxf(fabsf(gk[lane]), lane < 32 ? fabsf(gk[64 + lane]) : 0.f);
#pragma unroll
                for (int o = 1; o < 64; o <<= 1) { mq = fmaxf(mq, __shfl_xor(mq, o)); mk = fmaxf(mk, __shfl_xor(mk, o)); }
                negB2 = -(96.0f * 1.02f * QSCALE) * mq * mk;
                shifted = __builtin_amdgcn_readfirstlane(negB2 < -SHIFT_THRESH ? 1 : 0) != 0;
                if (!shifted) negB2 = 0.f;
            }
            thin::LruP P{zb, conv_w + l * 1024, conv_b + l * 256, (const bf16_t*)(wtl + WT_GATE), lru_b_a + l * 512, lru_b_x + l * 512, lru_lambda + l * 512, agg, mix};
            if (!EN(6)) {} else if (lastl) { for (int it = vcu; it < 128 * 4; it += G) { const int pl = it >> 2; thin::lru_item<2>(P, pl + pl / 16 + 1, it & 3, ldsg); } }
            else { for (int it = vcu; it < NPAN * 4; it += G) thin::lru_item<2>(P, it >> 2, it & 3, ldsg); }
            if (EN(7)) for (int it = vcu; it < 1024; it += G) {
                const int bh = it >> 4, qp = it & 15, b = bh >> 3, h = bh & 7;
                #ifdef ATT_VAR
                if (rep_ == 0 && NREP(p0 + 2) == 2) att::attn_unit<ATT_VAR>(Qb, Kb, Vb, mix, ssqkv, ssqq, negB2, b * TPB + CTX + qp * 256, b * TPB, TPB, h, ldsg); else
#endif
                if (shifted) att::attn_unit<9>(Qb, Kb, Vb, mix, ssqkv, ssqq, negB2, b * TPB + CTX + qp * 256, b * TPB, TPB, h, ldsg);
                else att::attn_unit<0>(Qb, Kb, Vb, mix, ssqkv, ssqq, negB2, b * TPB + CTX + qp * 256, b * TPB, TPB, h, ldsg);
            }
            if (EN(7) && !lastl) for (int it = G - 1 - vcu; it < 64; it += G) { const int b = it >> 3, h = it & 7;
                if (shifted) att::attn_unit<9>(Qb, Kb, Vb, mix, ssqkv, ssqq, negB2, b * TPB, b * TPB, CTX, h, ldsg); else att::attn_unit<0>(Qb, Kb, Vb, mix, ssqkv, ssqq, negB2, b * TPB, b * TPB, CTX, h, ldsg); }
        }
        } SEAM(p0 + 2);
    for (int rep_ = 0; rep_ < NREP(p0 + 3); ++rep_) { if (rep_) xcd_barrier(bar);
        if (EN(8) && IN(p0 + 3)) {
            pg8::Gemm g{mix, (const bf16_t*)(wtl + WT_OUT)}; pg8::StaticOrder S; S.init(lastl ? 128 : NPAN, 4, G, bx, lastl ? 1 : 0);
            if (l == 0) { epi::EpiRes<true, false> E{x_in, ctx_in, nullptr, xg, ssqx, vl + VEC_G1 * 1024, nullptr, vl + VEC_GM2 * 1024}; pg8::gemm_phase<1024, 1024, 1024, false>(lds, g, S, E); }
            else { epi::EpiRes<false, false> E{nullptr, nullptr, nullptr, xg, ssqx, vl + VEC_G1 * 1024, rvec + (size_t)l * 9 * 2048, vl + VEC_GM2 * 1024}; pg8::gemm_phase<1024, 1024, 1024, false>(lds, g, S, E); }
        }
        } SEAM(p0 + 3);
    for (int rep_ = 0; rep_ < NREP(p0 + 4); ++rep_) { if (rep_) xcd_barrier(bar);
        if (EN(9) && IN(p0 + 4)) {
            pg8::Gemm g{xg, (const bf16_t*)(wtl + WT_FF1)}; pg8::StaticOrder S; S.init(lastl ? 128 : NPAN, 16, G, bx, lastl ? 1 : 0);
            epi::EpiFF1 E{U, ssqx, bias_ff + (size_t)l * 9 * D_FF};
            pg8::gemm_phase<1024, 1024, 1024, false>(lds, g, S, E);
        }
        } SEAM(p0 + 4);
    for (int rep_ = 0; rep_ < NREP(p0 + 5); ++rep_) { if (rep_) xcd_barrier(bar);
        if (EN(10) && IN(p0 + 5)) {
            pg8::Gemm g{U, (const bf16_t*)(wtl + WT_FF2)}; pg8::StaticOrder S; S.init(lastl ? 128 : NPAN, 4, G, bx, lastl ? 1 : 0);
            if (lastl) { epi::EpiRes<false, true> E{nullptr, nullptr, out, xg, nullptr, vl + VEC_G2 * 1024, rvec + (size_t)l * 9 * 2048 + 1024, nullptr}; pg8::gemm_phase<4096, 4096, 4096, true>(lds, g, S, E); }
            else {
                { pg8::StaticOrder SL; SL.init(128, 4, G, bx, 1);
                  epi::EpiRes<false, false> E{nullptr, nullptr, nullptr, xg, ssqx, vl + VEC_G2 * 1024, rvec + (size_t)l * 9 * 2048 + 1024, vec + (size_t)(l + 1) * 9 * 6144 + VEC_GM1 * 1024}; pg8::gemm_phase<4096, 4096, 4096, true>(lds, g, SL, E); }
                float* slab = out + (size_t)18 * 1024 * 1024;
                { pg8::CtxSplitOrder SC{4, 4, 1024, G, bx, 1}; epi::EpiSlab E{slab, 1024}; pg8::gemm_phase<1024, 4096, 4096, true>(lds, g, SC, E); }
                xcd_barrier(bar);
                ctx_combine(ws, out, rvec + (size_t)(l * 9 + 8) * 2048 + 1024, vl + 8 * 6144 + VEC_G2 * 1024, vec + (size_t)(l + 1) * 9 * 6144 + 8 * 6144 + VEC_GM1 * 1024, gw, NGW, lane);
            }
        }
        } if (!lastl) SEAM(p0 + 5);
    }
#undef IN
#undef SEAM
}


#ifdef DBG_DUMP
__global__ void dbg_dump(const bf16_t* buf, int pitch, int coloff, int ncols, float* out) {
    for (size_t i = blockIdx.x * (size_t)blockDim.x + threadIdx.x; i < (size_t)BATCH * SEQ * D_MODEL; i += (size_t)gridDim.x * blockDim.x) {
        const int c = (int)(i & 1023); const size_t rt = i >> 10; const int b = (int)(rt / SEQ), t = (int)(rt - (size_t)b * SEQ);
        out[i] = c < ncols ? bf2f(buf[((size_t)b * TPB + CTX + t) * pitch + coloff + c]) : 0.f;
    }
}
#endif
#ifndef N_LAUNCH_MODE
#define N_LAUNCH_MODE 1
#endif
extern "C" void kernel_launch(void* const* d_in, const int* in_sizes, int n_in, void* d_out, int out_size, void* d_ws, size_t ws_size, hipStream_t stream) {
    static int grid = 0;
    if (grid == 0) {
        if (n_in != 27 || in_sizes[0] != BATCH * SEQ * D_MODEL || out_size != BATCH * SEQ * D_MODEL || ws_size < WS_END) { fprintf(stderr, "kernel_launch: unexpected shapes (n_in %d, in0 %d, out %d, ws %zu < %zu)\n", n_in, n_in > 0 ? in_sizes[0] : -1, out_size, ws_size, (size_t)WS_END); grid = -1; return; }
        int dev = 0, cus = 0, per_cu = 0;
        if (hipGetDevice(&dev) != hipSuccess || hipDeviceGetAttribute(&cus, hipDeviceAttributeMultiprocessorCount, dev) != hipSuccess) { grid = -1; return; }
        if (hipFuncSetAttribute((const void*)fwd_kernel, hipFuncAttributeMaxDynamicSharedMemorySize, LDS_BYTES) != hipSuccess) { fprintf(stderr, "kernel_launch: hipFuncSetAttribute failed\n"); grid = -1; return; }
        if (hipOccupancyMaxActiveBlocksPerMultiprocessor(&per_cu, (const void*)fwd_kernel, NWAVES * 64, LDS_BYTES) != hipSuccess || per_cu < 1) { fprintf(stderr, "kernel_launch: occupancy query says %d blocks per CU\n", per_cu); (void)hipGetLastError(); grid = -1; return; }
        grid = cus;
    }
    if (grid < 0) return;
    (void)hipMemsetAsync((char*)d_ws + WS_CTL, 0, CTL_ZERO_BYTES, stream);
    Args a{};
    for (int i = 0; i < 27; ++i) a.in[i] = (const float*)d_in[i];
    a.out = (float*)d_out; a.ws = (unsigned char*)d_ws;
#if N_LAUNCH_MODE
    a.ph_lo = 0; a.ph_hi = NPHASE;
    void* kargs[] = {&a};
    hipError_t e = hipLaunchCooperativeKernel((const void*)fwd_kernel, dim3(grid), dim3(NWAVES * 64), kargs, LDS_BYTES, stream);
    if (e != hipSuccess) fprintf(stderr, "kernel_launch: cooperative launch failed: %s\n", hipGetErrorString(e));
#else
#ifndef DBG_STOP_PHASE
#define DBG_STOP_PHASE NPHASE
#endif
    for (int p = 0; p < DBG_STOP_PHASE; ++p) { a.ph_lo = p; a.ph_hi = p + 1; hipLaunchKernelGGL(fwd_kernel, dim3(grid), dim3(NWAVES * 64), LDS_BYTES, stream, a); }
#ifdef DBG_DUMP
    hipLaunchKernelGGL(dbg_dump, dim3(2048), dim3(256), 0, stream, (const bf16_t*)((unsigned char*)d_ws + DBG_DUMP_OFF), DBG_DUMP_PITCH, DBG_DUMP_COL, DBG_DUMP_NCOLS, (float*)d_out);
#endif
#endif
}
```

```cpp
#include <hip/hip_runtime.h>
#include <cstdio>
#include <cstdint>

#define LAS __attribute__((address_space(3)))
#define GAS __attribute__((address_space(1)))
typedef unsigned short bf16_t;
typedef short bf16x8 __attribute__((ext_vector_type(8)));
typedef short s16x4 __attribute__((ext_vector_type(4)));
typedef float f32x4 __attribute__((ext_vector_type(4)));
typedef float f32x2 __attribute__((ext_vector_type(2)));
typedef float f32x16 __attribute__((ext_vector_type(16)));
typedef unsigned u32x4 __attribute__((ext_vector_type(4)));
typedef unsigned u32x2 __attribute__((ext_vector_type(2)));

constexpr int D_MODEL = 1024, BATCH = 8, SEQ = 4096, DEPTH = 2, CTX = 256, D_IN = 1440, D_FF = 4096;
constexpr int TPB = SEQ + CTX;
constexpr int MROWS = BATCH * TPB;
constexpr int PPB = TPB / 256;
constexpr int NPAN = MROWS / 256;
constexpr int ZW = 1536;
constexpr int Z_LX = 0, Z_LG = 256, Z_KVL = 512, Z_PU = 768, Z_QL = 1024, Z_KR = 1408;
constexpr float EPS = 1e-6f;
constexpr float QSCALE = 0.10206207261596575f * 1.4426950408889634f;

typedef __bf16 bf16x2_t __attribute__((ext_vector_type(2)));
__device__ __forceinline__ unsigned cvt_pk_bf16(float lo, float hi) { f32x2 v = {lo, hi}; bf16x2_t b = __builtin_convertvector(v, bf16x2_t); return __builtin_bit_cast(unsigned, b); }
__device__ __forceinline__ float bf2f(unsigned short h) { return __uint_as_float((unsigned)h << 16); }
__device__ __forceinline__ float bflo(unsigned w) { return __uint_as_float(w << 16); }
__device__ __forceinline__ float bfhi(unsigned w) { return __uint_as_float(w & 0xffff0000u); }
__device__ __forceinline__ unsigned short f2bf(float f) { unsigned u = __float_as_uint(f); return (unsigned short)((u + 0x7fffu + ((u >> 16) & 1u)) >> 16); }

namespace pg8 {
constexpr int BM = 256, BK = 64, HALF = 128, HTB = HALF * BK * 2, STAGE_BYTES = 8 * HTB, NXCD = 8, WGM = 8;
__host__ __device__ __forceinline__ int lds_byte(int r, int c) { const int st = (r >> 4) * 2 + (c >> 5), rr = r & 15, cc = c & 31, ob = rr * 64 + cc * 2; return st * 1024 + (ob ^ (((ob >> 9) & 1) << 5)); }
__host__ __device__ __forceinline__ void stage_rc(int b, int& R, int& C) { const int st = b / 1024, sb = b % 1024, swz = sb ^ (((sb >> 9) & 1) << 5); R = (st >> 1) * 16 + swz / 64; C = (st & 1) * 32 + (swz % 64) / 2; }
__host__ __device__ __forceinline__ int perm32(int rho) { const int n = rho >> 4, i = rho & 15; return 8 * (i >> 2) + 4 * n + (i & 3); }

struct Unit { int pm, pn; unsigned koffA, koffB; };
struct Gemm { const bf16_t* A; const bf16_t* Bt; };

struct StaticOrder {
    int nM, nN, nwg, G, c, latonly;
    __device__ void init(int nM_, int nN_, int G_, int c_, int latonly_) { nM = nM_; nN = nN_; nwg = nM * nN; G = G_; c = c_; latonly = latonly_; }
    __device__ bool next(int i, Unit& u) const {
        const long L = (long)i * G + c; if (L >= nwg) return false;
        int wgid = (int)L; { const int q = nwg / NXCD, r = nwg % NXCD, xcd = wgid % NXCD, off = wgid / NXCD; wgid = (xcd < r ? xcd * (q + 1) : r * (q + 1) + (xcd - r) * q) + off; }
        const int nig = WGM * nN, gid = wgid / nig, fm = gid * WGM, gsz = (nM - fm) < WGM ? (nM - fm) : WGM;
        int pm = fm + ((wgid % nig) % gsz); u.pn = (wgid % nig) / gsz;
        if (latonly) pm = pm + pm / 16 + 1;
        u.pm = pm; u.koffA = 0u; u.koffB = 0u; return true;
    }
};
struct CtxSplitOrder {
    int nN, NS, KS, G, c, ablk;
    __device__ bool next(int i, Unit& u) const {
        const int L = i * G + c; if (L >= 8 * nN * NS) return false;
        const int ks = L % NS, t = L / NS; u.pn = t % nN; u.pm = (t / nN) * 17; u.koffB = (unsigned)(ks * KS * 2); u.koffA = ablk ? (unsigned)(ks * (KS / 32) * 16384) : u.koffB; return true;
    }
};

template <int K, int LDA, int LDB, bool ABLK, class Epi, class Sched>
__device__ __forceinline__ void gemm_phase(LAS unsigned char* lds, const Gemm g, const Sched& S, const Epi& E) {
    int tid = threadIdx.x; asm volatile("" : "+v"(tid));
    const int  wid = __builtin_amdgcn_readfirstlane(tid >> 6), lane = tid & 63, wr = wid >> 2, wc = wid & 3, fr = lane & 15, fq = lane >> 4;
    constexpr int nt = K / BK;
    unsigned voffA[2], voffB[2];
#pragma unroll
    for (int i = 0; i < 2; ++i) { int R, C; stage_rc(tid * 16 + i * 8192, R, C); const int Rb = Epi::PERM ? ((R & ~31) + perm32(R & 31)) : R;
        voffA[i] = ABLK ? (unsigned)((C >> 5) * 16384 + (R >> 4) * 1024 + ((R & 15) * 32 + (C & 31)) * 2) : (unsigned)(R * LDA + C) * 2u; voffB[i] = (unsigned)(Rb * LDB + C) * 2u; }
    const size_t kstep = (size_t)(BK * 2);
    const size_t kstepA = ABLK ? (size_t)32768 : kstep;
    const size_t hstepA = ABLK ? (size_t)8192 : (size_t)HALF * LDA * 2, tstepA = ABLK ? (size_t)(LDA / 32) * 16384 : 2 * hstepA;
    const size_t hstepB = (size_t)HALF * LDB * 2, tstepB = 2 * hstepB;
    const unsigned ldsw = (unsigned)wid * 1024u;
    const int aoff = lds_byte(wr * 64 + fr, fq * 8), boff = lds_byte(wc * 32 + fr, fq * 8);
#define PG8_SA(b, h) (((b) * 2 + (h)) * HTB)
#define PG8_SB(b, h) ((4 + (b) * 2 + (h)) * HTB)
#define PG8_STAGE(bufoff, gbase, voff) do { _Pragma("unroll") for (int _i = 0; _i < 2; ++_i) \
        __builtin_amdgcn_global_load_lds((const unsigned*)((const char*)(gbase) + (voff)[_i]), (LAS unsigned*)(lds + (bufoff) + ldsw + _i * 8192), 16, 0, 0); } while (0)
#define PG8_LDA(dst, b, h) do { _Pragma("unroll") for (int m = 0; m < 4; ++m) _Pragma("unroll") for (int k = 0; k < 2; ++k) dst[m][k] = *(const LAS bf16x8*)(lds + PG8_SA(b, h) + aoff + m * 2048 + k * 1024); } while (0)
#define PG8_LDB(dst, b, h) do { _Pragma("unroll") for (int n = 0; n < 2; ++n) _Pragma("unroll") for (int k = 0; k < 2; ++k) dst[n][k] = *(const LAS bf16x8*)(lds + PG8_SB(b, h) + boff + n * 2048 + k * 1024); } while (0)
#define PG8_MMA(ai, bj, At, Bt) do { __builtin_amdgcn_s_setprio(1); _Pragma("unroll") for (int m = 0; m < 4; ++m) _Pragma("unroll") for (int n = 0; n < 2; ++n) _Pragma("unroll") for (int k = 0; k < 2; ++k) \
        acc[ai][bj][m][n] = __builtin_amdgcn_mfma_f32_16x16x32_bf16(Bt[n][k], At[m][k], acc[ai][bj][m][n], 0, 0, 0); __builtin_amdgcn_s_setprio(0); } while (0)
#define PG8_WAIT_V(n) asm volatile("s_waitcnt vmcnt(" #n ")" ::: "memory")
#define PG8_WAIT_L(n) asm volatile("s_waitcnt lgkmcnt(" #n ")" ::: "memory")
#define PG8_BAR __builtin_amdgcn_s_barrier()
#define PG8_SCHED __builtin_amdgcn_sched_barrier(0)
    Unit cur, nxt; int ui = 0;
    if (!S.next(0, cur)) return;
    f32x4 acc[2][2][4][2];
#pragma unroll
    for (int a = 0; a < 2; ++a)
#pragma unroll
        for (int b = 0; b < 2; ++b)
#pragma unroll
            for (int m = 0; m < 4; ++m)
#pragma unroll
                for (int n = 0; n < 2; ++n) acc[a][b][m][n] = (f32x4){0.f, 0.f, 0.f, 0.f};
    bf16x8 At[4][2], B0[2][2], B1[2][2];
    const char* cA = (const char*)g.A + (size_t)cur.pm * tstepA + cur.koffA; const char* cB = (const char*)g.Bt + (size_t)cur.pn * tstepB + cur.koffB;
    PG8_STAGE(PG8_SB(0, 0), cB, voffB); PG8_STAGE(PG8_SB(0, 1), cB + hstepB, voffB); PG8_STAGE(PG8_SA(0, 0), cA, voffA); PG8_STAGE(PG8_SA(0, 1), cA + hstepA, voffA);
    if (wr == 1) PG8_BAR;
    PG8_WAIT_V(2); PG8_BAR;
    PG8_STAGE(PG8_SB(1, 0), cB + kstep, voffB); PG8_STAGE(PG8_SA(1, 0), cA + kstepA, voffA); PG8_STAGE(PG8_SB(1, 1), cB + hstepB + kstep, voffB);
    PG8_WAIT_V(6); PG8_BAR;
    for (;;) {
        const bool has_next = S.next(ui + 1, nxt);
        const char* nA = has_next ? (const char*)g.A + (size_t)nxt.pm * tstepA + nxt.koffA : cA; const char* nB = has_next ? (const char*)g.Bt + (size_t)nxt.pn * tstepB + nxt.koffB : cB;
#pragma unroll 1
        for (int t = 0; t < nt; t += 2) {
            const bool last = (t == nt - 2);
            const char* a1 = cA + (size_t)(t + 1) * kstepA;
            const char* a2 = last ? nA : cA + (size_t)(t + 2) * kstepA; const char* b2 = last ? nB : cB + (size_t)(t + 2) * kstep;
            const char* a3 = a2 + kstepA; const char* b3 = b2 + kstep;
            PG8_LDB(B0, 0, 0); PG8_LDB(B1, 0, 1); PG8_SCHED; PG8_LDA(At, 0, 0); PG8_STAGE(PG8_SA(1, 1), a1 + hstepA, voffA);
            PG8_WAIT_V(8); PG8_WAIT_L(0); PG8_BAR; PG8_MMA(0, 0, At, B0); PG8_MMA(0, 1, At, B1); PG8_BAR; PG8_SCHED;
            PG8_LDA(At, 0, 1); PG8_STAGE(PG8_SB(0, 0), b2, voffB); PG8_STAGE(PG8_SB(0, 1), b2 + hstepB, voffB); PG8_STAGE(PG8_SA(0, 0), a2, voffA);
            PG8_WAIT_V(8); PG8_WAIT_L(0); PG8_BAR; PG8_MMA(1, 0, At, B0); PG8_MMA(1, 1, At, B1); PG8_BAR; PG8_SCHED;
            PG8_LDB(B0, 1, 0); PG8_LDB(B1, 1, 1); PG8_SCHED; PG8_LDA(At, 1, 0); PG8_STAGE(PG8_SA(0, 1), a2 + hstepA, voffA);
            PG8_WAIT_V(8); PG8_WAIT_L(0); PG8_BAR; PG8_MMA(0, 0, At, B0); PG8_MMA(0, 1, At, B1); PG8_BAR; PG8_SCHED;
            PG8_LDA(At, 1, 1); PG8_STAGE(PG8_SB(1, 0), b3, voffB); PG8_STAGE(PG8_SB(1, 1), b3 + hstepB, voffB); PG8_STAGE(PG8_SA(1, 0), a3, voffA);
            PG8_WAIT_V(8); PG8_WAIT_L(0); PG8_BAR; PG8_MMA(1, 0, At, B0); PG8_MMA(1, 1, At, B1); PG8_BAR; PG8_SCHED;
        }
        if (wr == 0) PG8_BAR;
        { int fr2 = fr, fq2 = fq; asm volatile("" : "+v"(fr2), "+v"(fq2));
          E(acc, cur, wr, wc, fr2, fq2); }
        if (!has_next) break;
#pragma unroll
        for (int a = 0; a < 2; ++a)
#pragma unroll
            for (int b = 0; b < 2; ++b)
#pragma unroll
                for (int m = 0; m < 4; ++m)
#pragma unroll
                    for (int n = 0; n < 2; ++n) acc[a][b][m][n] = (f32x4){0.f, 0.f, 0.f, 0.f};
        cur = nxt; cA = nA; cB = nB; ++ui;
        if (wr == 1) PG8_BAR;
    }
    PG8_WAIT_V(0);
    PG8_BAR;
#undef PG8_SA
#undef PG8_SB
#undef PG8_STAGE
#undef PG8_LDA
#undef PG8_LDB
#undef PG8_MMA
#undef PG8_WAIT_V
#undef PG8_WAIT_L
#undef PG8_BAR
#undef PG8_SCHED
}
}
namespace epi {
using pg8::Unit;
typedef f32x4 Acc[2][2][4][2];
__device__ __forceinline__ float sum4(f32x4 v) { return (v[0] + v[1]) + (v[2] + v[3]); }
__device__ __forceinline__ float sq4(f32x4 v) { return (v[0] * v[0] + v[1] * v[1]) + (v[2] * v[2] + v[3] * v[3]); }
__device__ __forceinline__ float red_fq(float s) { s += __shfl_xor(s, 16); s += __shfl_xor(s, 32); return s; }
__device__ __forceinline__ u32x4 pack8(f32x4 a, f32x4 b) { u32x4 w; w.x = cvt_pk_bf16(a[0], a[1]); w.y = cvt_pk_bf16(a[2], a[3]); w.z = cvt_pk_bf16(b[0], b[1]); w.w = cvt_pk_bf16(b[2], b[3]); return w; }
__device__ __forceinline__ void rope4(f32x4& x1, f32x4& x2, const float* rtab, int t, int fq) {
    const int idx = (fq >> 1) ? (t & 63) : (t >> 6);
    const f32x4 c0 = *(const f32x4*)(rtab + (idx * 8 + (fq & 1) * 4) * 2), c1 = *(const f32x4*)(rtab + (idx * 8 + (fq & 1) * 4) * 2 + 4);
    const f32x4 cs = (f32x4){c0[0], c0[2], c1[0], c1[2]}, sn = (f32x4){c0[1], c0[3], c1[1], c1[3]};
    const f32x4 y1 = x1 * cs - x2 * sn, y2 = x2 * cs + x1 * sn; x1 = y1; x2 = y2;
}
__device__ __forceinline__ float row_rstd16(const float* ssq, int row, int fq, float inv_n) {
    const f32x4 p = *(const f32x4*)(ssq + (size_t)row * 16 + 4 * fq); return rsqrtf(red_fq(sum4(p)) * inv_n + EPS);
}

struct EpiIn {
    static constexpr bool PERM = true;
    bf16_t* z; const float* ssqx; const float* bias; float* ssqkv; const float* gkn; const float* rtab;
    __device__ __forceinline__ void operator()(const Acc& acc, const Unit& u, int wr, int wc, int fr, int fq) const {
        const int pm = u.pm, pn = u.pn, b = pm / PPB, pp = pm - b * PPB, bidx = pp == 0 ? 8 : b;
        const float* bia = bias + bidx * ZW + pn * 256 + wc * 32 + 8 * fq;
        f32x4 bv[2][2];
#pragma unroll
        for (int bj = 0; bj < 2; ++bj)
#pragma unroll
            for (int n = 0; n < 2; ++n) bv[bj][n] = *(const f32x4*)(bia + bj * 128 + 4 * n);
        const int ax = fq >> 1, f0 = (fq & 1) * 4;
        const f32x4 gk1 = *(const f32x4*)(gkn + 64 + ax * 16 + f0), gk2 = *(const f32x4*)(gkn + 64 + ax * 16 + 8 + f0);
#pragma unroll
        for (int ai = 0; ai < 2; ++ai)
#pragma unroll
            for (int m = 0; m < 4; ++m) {
                const int rl = ai * 128 + wr * 64 + m * 16 + fr, row = pm * 256 + rl;
                const float rs = row_rstd16(ssqx, row, fq, 1.0f / 1024.0f);
                f32x4 v[2][2];
#pragma unroll
                for (int bj = 0; bj < 2; ++bj)
#pragma unroll
                    for (int n = 0; n < 2; ++n) v[bj][n] = acc[ai][bj][m][n] * rs + bv[bj][n];
                if (pn == 2 || pn == 4) {
                    const float s = red_fq((sq4(v[0][0]) + sq4(v[0][1])) + (sq4(v[1][0]) + sq4(v[1][1])));
                    if (fq == 0) ssqkv[(size_t)row * 16 + (pn == 2 ? wc : 4 + wc)] = s;
                }
                if (pn == 5) {
                    const float s = red_fq(sq4(v[0][0]) + sq4(v[0][1]));
                    if (fq == 0) ssqkv[(size_t)row * 16 + 8 + wc] = s;
                    if (wc == 0) {
                        const float s1 = red_fq(sq4(v[1][0]) + sq4(v[1][1]));
                        if (fq == 0) ssqkv[(size_t)row * 16 + 12] = s1;
                        v[1][0] = v[1][0] * gk1; v[1][1] = v[1][1] * gk2;
                        if (pp != 0) rope4(v[1][0], v[1][1], rtab, (pp - 1) * 256 + rl, fq);
                    }
                }
                bf16_t* zp = z + (size_t)row * ZW + pn * 256 + wc * 32 + 8 * fq;
#pragma unroll
                for (int bj = 0; bj < 2; ++bj) *(u32x4*)(zp + bj * 128) = pack8(v[bj][0], v[bj][1]);
                asm volatile("" ::: "memory");
            }
    }
};

struct EpiQ {
    static constexpr bool PERM = true;
    bf16_t* Q; float* ssqq; const float* gqn; const float* rtab;
    __device__ __forceinline__ void operator()(const Acc& acc, const Unit& u, int wr, int wc, int fr, int fq) const {
        const int pm = u.pm, pn = u.pn, b = pm / PPB, pp = pm - b * PPB;
        const int ax = fq >> 1, f0 = (fq & 1) * 4;
        f32x4 g0[2], g1[2]; int part[2], grp[2];
#pragma unroll
        for (int bj = 0; bj < 2; ++bj) {
            grp[bj] = pn * 8 + bj * 4 + wc; part[bj] = grp[bj] % 3;
            if (part[bj] < 2) { g0[bj] = *(const f32x4*)(gqn + 32 * part[bj] + 8 * fq); g1[bj] = *(const f32x4*)(gqn + 32 * part[bj] + 8 * fq + 4); }
            else { g0[bj] = *(const f32x4*)(gqn + 64 + ax * 16 + f0); g1[bj] = *(const f32x4*)(gqn + 64 + ax * 16 + 8 + f0); }
        }
#pragma unroll
        for (int ai = 0; ai < 2; ++ai)
#pragma unroll
            for (int m = 0; m < 4; ++m) {
                const int rl = ai * 128 + wr * 64 + m * 16 + fr, row = pm * 256 + rl;
                bf16_t* qp = Q + (size_t)row * 768 + pn * 256 + wc * 32 + 8 * fq;
#pragma unroll
                for (int bj = 0; bj < 2; ++bj) {
                    const f32x4 a0 = acc[ai][bj][m][0], a1 = acc[ai][bj][m][1];
                    const float s = red_fq(sq4(a0) + sq4(a1));
                    if (fq == 0) ssqq[(size_t)row * 24 + grp[bj]] = s;
                    f32x4 v0 = a0 * g0[bj], v1 = a1 * g1[bj];
                    if (part[bj] == 2 && pp != 0) rope4(v0, v1, rtab, (pp - 1) * 256 + rl, fq);
                    *(u32x4*)(qp + bj * 128) = pack8(v0, v1);
                }
                asm volatile("" ::: "memory");
            }
    }
};

struct EpiKV {
    static constexpr bool PERM = true;
    bf16_t* Kb; bf16_t* Vb; const bf16_t* z; const float* ssqkv; const float* gkn;
    __device__ __forceinline__ void operator()(const Acc& acc, const Unit& u, int wr, int wc, int fr, int fq) const {
        const int pm = u.pm, pn = u.pn;
        f32x4 gk[2][2];
#pragma unroll
        for (int bj = 0; bj < 2; ++bj)
#pragma unroll
            for (int n = 0; n < 2; ++n) gk[bj][n] = *(const f32x4*)(gkn + 32 * bj + 8 * fq + 4 * n);
#pragma unroll
        for (int ai = 0; ai < 2; ++ai)
#pragma unroll
            for (int m = 0; m < 4; ++m) {
                const int rl = ai * 128 + wr * 64 + m * 16 + fr, row = pm * 256 + rl;
                const f32x4 st = *(const f32x4*)(ssqkv + (size_t)row * 16);
                const float s = rsqrtf(sum4(st) * (1.0f / 256.0f) + EPS);
                if (pn < 2) {
                    const int head = 4 * pn + wc;
                    const float ss = red_fq((sq4(acc[ai][0][m][0]) + sq4(acc[ai][0][m][1])) + (sq4(acc[ai][1][m][0]) + sq4(acc[ai][1][m][1])));
                    const float sskr = ssqkv[(size_t)row * 16 + 12];
                    const float rk = rsqrtf((s * s * ss + sskr) * (1.0f / 96.0f) + EPS);
                    const float sk = s * rk;
                    bf16_t* kp = Kb + (size_t)row * 768 + head * 96;
#pragma unroll
                    for (int bj = 0; bj < 2; ++bj) *(u32x4*)(kp + 32 * bj + 8 * fq) = pack8(acc[ai][bj][m][0] * gk[bj][0] * sk, acc[ai][bj][m][1] * gk[bj][1] * sk);
                    const u32x4 kr = *(const u32x4*)(z + (size_t)row * ZW + Z_KR + 8 * fq);
                    u32x4 o;
                    o.x = cvt_pk_bf16(bflo(kr.x) * rk, bfhi(kr.x) * rk); o.y = cvt_pk_bf16(bflo(kr.y) * rk, bfhi(kr.y) * rk);
                    o.z = cvt_pk_bf16(bflo(kr.z) * rk, bfhi(kr.z) * rk); o.w = cvt_pk_bf16(bflo(kr.w) * rk, bfhi(kr.w) * rk);
                    *(u32x4*)(kp + 64 + 8 * fq) = o;
                } else {
                    const int head = 4 * (pn - 2) + wc;
                    bf16_t* vp = Vb + (size_t)row * 512 + head * 64;
#pragma unroll
                    for (int bj = 0; bj < 2; ++bj) *(u32x4*)(vp + 32 * bj + 8 * fq) = pack8(acc[ai][bj][m][0] * s, acc[ai][bj][m][1] * s);
                }
                if (m & 1) asm volatile("" ::: "memory");
            }
    }
};

template <bool IN_F32, bool OUT_F32>
struct EpiRes {
    static constexpr bool PERM = true;
    const float* xin_lat; const float* xin_ctx; float* xout; bf16_t* xg; float* ssqx; const float* gate; const float* rgm_prev; const float* gm;
    __device__ __forceinline__ void operator()(const Acc& acc, const Unit& u, int wr, int wc, int fr, int fq) const {
        const int pm = u.pm, pn = u.pn, b = pm / PPB, pp = pm - b * PPB, bidx = pp == 0 ? 8 : b;
        const size_t rbase = pp == 0 ? (size_t)b * 256 : (size_t)b * SEQ + (size_t)(pp - 1) * 256;
        const float* xi = IN_F32 ? (pp == 0 ? xin_ctx : xin_lat) + rbase * D_MODEL : nullptr;
        float* xo = OUT_F32 ? xout + rbase * D_MODEL : nullptr;
        const int col0 = pn * 256 + wc * 32 + 8 * fq;
        f32x4 gv[2][2], mv[2][2], rv[2][2];
#pragma unroll
        for (int bj = 0; bj < 2; ++bj)
#pragma unroll
            for (int n = 0; n < 2; ++n) { gv[bj][n] = *(const f32x4*)(gate + bidx * 6144 + col0 + bj * 128 + n * 4);
                mv[bj][n] = OUT_F32 ? (f32x4){0.f, 0.f, 0.f, 0.f} : *(const f32x4*)(gm + bidx * 6144 + col0 + bj * 128 + n * 4);
                rv[bj][n] = IN_F32 ? (f32x4){0.f, 0.f, 0.f, 0.f} : *(const f32x4*)(rgm_prev + bidx * 2048 + col0 + bj * 128 + n * 4); }
#pragma unroll
        for (int ai = 0; ai < 2; ++ai)
#pragma unroll
            for (int m = 0; m < 4; ++m) {
                const int rl = ai * 128 + wr * 64 + m * 16 + fr; const size_t urow = (size_t)pm * 256 + rl, off = urow * D_MODEL + col0;
                float ss = 0.f;
#pragma unroll
                for (int bj = 0; bj < 2; ++bj) {
                    f32x4 x0, x1;
                    if (IN_F32) { x0 = *(const f32x4*)(xi + (size_t)rl * D_MODEL + col0 + bj * 128); x1 = *(const f32x4*)(xi + (size_t)rl * D_MODEL + col0 + bj * 128 + 4); }
                    else { const u32x4 w = *(const u32x4*)(xg + off + bj * 128); x0 = (f32x4){bflo(w.x), bfhi(w.x), bflo(w.y), bfhi(w.y)} * rv[bj][0]; x1 = (f32x4){bflo(w.z), bfhi(w.z), bflo(w.w), bfhi(w.w)} * rv[bj][1]; }
                    x0 += gv[bj][0] * acc[ai][bj][m][0]; x1 += gv[bj][1] * acc[ai][bj][m][1];
                    if (OUT_F32) { *(f32x4*)(xo + (size_t)rl * D_MODEL + col0 + bj * 128) = x0; *(f32x4*)(xo + (size_t)rl * D_MODEL + col0 + bj * 128 + 4) = x1; }
                    else { ss += sq4(x0) + sq4(x1); *(u32x4*)(xg + off + bj * 128) = pack8(x0 * mv[bj][0], x1 * mv[bj][1]); }
                }
                if (!OUT_F32) { ss = red_fq(ss); if (fq == 0) ssqx[urow * 16 + pn * 4 + wc] = ss; }
                asm volatile("" ::: "memory");
            }
    }
};

struct EpiSlab {
    static constexpr bool PERM = true;
    float* slab; int KS;
    __device__ __forceinline__ void operator()(const Acc& acc, const Unit& u, int wr, int wc, int fr, int fq) const {
        const int cp = u.pm / PPB, ks = (int)(u.koffB / (unsigned)(2 * KS));
        float* sp = slab + ((size_t)(ks * (BATCH * CTX) + cp * 256)) * D_MODEL + u.pn * 256 + wc * 32 + 8 * fq;
#pragma unroll
        for (int ai = 0; ai < 2; ++ai)
#pragma unroll
            for (int m = 0; m < 4; ++m) { float* rp = sp + (size_t)(ai * 128 + wr * 64 + m * 16 + fr) * D_MODEL;
#pragma unroll
                for (int bj = 0; bj < 2; ++bj) { *(f32x4*)(rp + bj * 128) = acc[ai][bj][m][0]; *(f32x4*)(rp + bj * 128 + 4) = acc[ai][bj][m][1]; } }
    }
};

struct EpiFF1 {
    static constexpr bool PERM = true;
    bf16_t* U; const float* ssqx; const float* bias;
    __device__ __forceinline__ void operator()(const Acc& acc, const Unit& u, int wr, int wc, int fr, int fq) const {
        const int pm = u.pm, pn = u.pn, b = pm / PPB, pp = pm - b * PPB, bidx = pp == 0 ? 8 : b;
        const float* bia = bias + bidx * D_FF + pn * 256 + wc * 32 + 8 * fq;
        f32x4 bv[2][2];
#pragma unroll
        for (int bj = 0; bj < 2; ++bj)
#pragma unroll
            for (int n = 0; n < 2; ++n) bv[bj][n] = *(const f32x4*)(bia + bj * 128 + 4 * n);
#pragma unroll
        for (int ai = 0; ai < 2; ++ai)
#pragma unroll
            for (int m = 0; m < 4; ++m) {
                const int row = pm * 256 + ai * 128 + wr * 64 + m * 16 + fr;
                const float rs = row_rstd16(ssqx, row, fq, 1.0f / 1024.0f);
                bf16_t* up = U + (((size_t)pm * 128 + pn * 8 + wc) * 16 + (ai * 8 + wr * 4 + m)) * 512 + fr * 32 + 8 * fq;
#pragma unroll
                for (int bj = 0; bj < 2; ++bj) {
                    f32x4 v0 = acc[ai][bj][m][0] * rs + bv[bj][0], v1 = acc[ai][bj][m][1] * rs + bv[bj][1];
#pragma unroll
                    for (int e = 0; e < 4; ++e) { const float a = fmaxf(v0[e], 0.f), c = fmaxf(v1[e], 0.f); v0[e] = a * a; v1[e] = c * c; }
#ifndef U_NT
#define U_NT 1
#endif
#if U_NT
                    __builtin_nontemporal_store(pack8(v0, v1), (u32x4*)(up + (size_t)bj * 4 * 16 * 512));
#else
                    *(u32x4*)(up + (size_t)bj * 4 * 16 * 512) = pack8(v0, v1);
#endif
                }
                asm volatile("" ::: "memory");
            }
    }
};
}
namespace att {
constexpr int NW = 8, QBLK = 32, KVBLK = 64, DQK = 96, DV = 64;
constexpr int KROWB = 208;
constexpr int SHM_K = KVBLK * KROWB, SHM_V = KVBLK * DV * 2;
constexpr int NSLOT = 3;
constexpr int LDS_V = 0, LDS_K = NSLOT * SHM_V, LDS_WS = LDS_K + NSLOT * SHM_K, LDS_OST = LDS_WS + NW * 64 * 4, LDS_BYTES = LDS_OST + NW * 4096;
#define SBAR() __builtin_amdgcn_sched_barrier(0)
__device__ __forceinline__ int crow(int r, int hi) { return (r & 3) + 8 * (r >> 2) + 4 * hi; }

template <int VAR> __device__ __forceinline__ void partialSM(f32x16& p0, float shift) {
  if (VAR == 1) return;
  if (VAR == 9) {
#pragma unroll
    for (int r = 0; r < 16; ++r) p0[r] -= shift; }
#pragma unroll
  for (int r = 0; r < 16; ++r) p0[r] = __builtin_amdgcn_exp2f(p0[r]);
}
template <int VAR> __device__ __forceinline__ void finishSM(f32x16& p0, f32x16& p1, float shift, float& l_reg, bf16x8& pa0, bf16x8& pa1, bf16x8& pa2, bf16x8& pa3) {
  if (VAR == 9) {
#pragma unroll
    for (int r = 0; r < 16; ++r) p1[r] -= shift; }
  if (VAR != 1) {
#pragma unroll
  for (int r = 0; r < 16; ++r) p1[r] = __builtin_amdgcn_exp2f(p1[r]); }
  float ps = 0;
#pragma unroll
  for (int r = 0; r < 16; ++r) ps += p0[r];
#pragma unroll
  for (int r = 0; r < 16; ++r) ps += p1[r];
  l_reg += ps;
#define PK4(P, BASE, OUT) do { u32x4 w = {cvt_pk_bf16(P[BASE + 0], P[BASE + 1]), cvt_pk_bf16(P[BASE + 2], P[BASE + 3]), cvt_pk_bf16(P[BASE + 4], P[BASE + 5]), cvt_pk_bf16(P[BASE + 6], P[BASE + 7])}; \
    OUT = *reinterpret_cast<bf16x8*>(&w); } while (0)
  PK4(p0, 0, pa0); PK4(p0, 8, pa1); PK4(p1, 0, pa2); PK4(p1, 8, pa3);
#undef PK4
}
#define KFR(KS, d0, half) (*reinterpret_cast<const bf16x8*>((KS) + (r32 + 32 * (half)) * KROWB + ((d0) * 16 + hi * 8) * 2))
__device__ __forceinline__ void kread4(bf16x8* kf, const char* Ks, int r32, int hi) { kf[0] = KFR(Ks, 0, 0); kf[1] = KFR(Ks, 0, 1); kf[2] = KFR(Ks, 1, 0); kf[3] = KFR(Ks, 1, 1); }
#define MF(A_, B_, C_) __builtin_amdgcn_mfma_f32_32x32x16_bf16(A_, B_, C_, 0, 0, 0)
template <bool FIN, int VAR>
__device__ __forceinline__ void qkt_fin(f32x16& p0, f32x16& p1, const char* Ks, const bf16x8* qr, int r32, int hi,
                                        f32x16& f0, f32x16& f1, float shift, float& l_reg, bf16x8& pa0, bf16x8& pa1, bf16x8& pa2, bf16x8& pa3) {
  bf16x8 kf[4]; kf[0] = VAR == 8 ? qr[0] : KFR(Ks, 0, 0); kf[1] = VAR == 8 ? qr[0] : KFR(Ks, 0, 1); kf[2] = VAR == 8 ? qr[1] : KFR(Ks, 1, 0); kf[3] = VAR == 8 ? qr[1] : KFR(Ks, 1, 1);
  SBAR();
  const bf16x8 b0 = VAR == 8 ? qr[2] : KFR(Ks, 2, 0), b1 = VAR == 8 ? qr[2] : KFR(Ks, 2, 1), b2 = VAR == 8 ? qr[3] : KFR(Ks, 3, 0), b3 = VAR == 8 ? qr[3] : KFR(Ks, 3, 1);
  p0 = MF(kf[0], qr[0], f32x16{}); p1 = MF(kf[1], qr[0], f32x16{});
  p0 = MF(kf[2], qr[1], p0); p1 = MF(kf[3], qr[1], p1);
  if (FIN) {
    if (VAR == 9) {
#pragma unroll
      for (int r = 0; r < 16; ++r) f1[r] -= shift; }
    if (VAR != 1) {
#pragma unroll
      for (int r = 0; r < 16; ++r) f1[r] = __builtin_amdgcn_exp2f(f1[r]); }
  }
  SBAR();
  const bf16x8 c0 = VAR == 8 ? qr[4] : KFR(Ks, 4, 0), c1 = VAR == 8 ? qr[4] : KFR(Ks, 4, 1), c2 = VAR == 8 ? qr[5] : KFR(Ks, 5, 0), c3 = VAR == 8 ? qr[5] : KFR(Ks, 5, 1);
  p0 = MF(b0, qr[2], p0); p1 = MF(b1, qr[2], p1);
  p0 = MF(b2, qr[3], p0); p1 = MF(b3, qr[3], p1);
  if (FIN) {
    float ps = 0;
#pragma unroll
    for (int r = 0; r < 16; ++r) ps += f0[r];
#pragma unroll
    for (int r = 0; r < 16; ++r) ps += f1[r];
    l_reg += ps;
  }
  SBAR();
  p0 = MF(c0, qr[4], p0); p1 = MF(c1, qr[4], p1);
  p0 = MF(c2, qr[5], p0); p1 = MF(c3, qr[5], p1);
  if (FIN) {
#define PK4(P, BASE, OUT) do { u32x4 w = {cvt_pk_bf16(P[BASE + 0], P[BASE + 1]), cvt_pk_bf16(P[BASE + 2], P[BASE + 3]), cvt_pk_bf16(P[BASE + 4], P[BASE + 5]), cvt_pk_bf16(P[BASE + 6], P[BASE + 7])}; \
    OUT = *reinterpret_cast<bf16x8*>(&w); } while (0)
    PK4(f0, 0, pa0); PK4(f0, 8, pa1); PK4(f1, 0, pa2); PK4(f1, 8, pa3);
#undef PK4
  }
}
#undef MF
__device__ __forceinline__ int v_st(int k, int c) { return ((k >> 3) * 2 + (c >> 5)) * 512 + ((k & 7) * 32 + (c & 31)) * 2; }
__device__ __forceinline__ int v_rd_base(int lane) { return ((lane & 3) << 3) | (((lane >> 2) & 3) << 6) | (((lane >> 4) & 1) << 5) | (((lane >> 5) & 1) << 8); }
constexpr int v_rd_off(int d0, int ks, int half) { return d0 * 512 + ks * 2048 + half * 1024; }
template <int OFF> __device__ __forceinline__ s16x4 tr_read(int vb) {
  s16x4 r; asm volatile("ds_read_b64_tr_b16 %0, %1 offset:%2" : "=&v"(r) : "v"(vb), "i"(OFF) : "memory"); return r;
}
template <int D0> __device__ __forceinline__ void pv_one(f32x16& od, int vb, bf16x8 pa0, bf16x8 pa1, bf16x8 pa2, bf16x8 pa3) {
  const s16x4 l0 = tr_read<v_rd_off(D0, 0, 0)>(vb), h0 = tr_read<v_rd_off(D0, 0, 1)>(vb), l1 = tr_read<v_rd_off(D0, 1, 0)>(vb), h1 = tr_read<v_rd_off(D0, 1, 1)>(vb);
  const s16x4 l2 = tr_read<v_rd_off(D0, 2, 0)>(vb), h2 = tr_read<v_rd_off(D0, 2, 1)>(vb), l3 = tr_read<v_rd_off(D0, 3, 0)>(vb), h3 = tr_read<v_rd_off(D0, 3, 1)>(vb);
  asm volatile("s_waitcnt lgkmcnt(0)" ::: "memory"); SBAR();
#define PK(L, H) (bf16x8){L[0], L[1], L[2], L[3], H[0], H[1], H[2], H[3]}
  od = __builtin_amdgcn_mfma_f32_32x32x16_bf16(PK(l0, h0), pa0, od, 0, 0, 0);
  od = __builtin_amdgcn_mfma_f32_32x32x16_bf16(PK(l1, h1), pa1, od, 0, 0, 0);
  od = __builtin_amdgcn_mfma_f32_32x32x16_bf16(PK(l2, h2), pa2, od, 0, 0, 0);
  od = __builtin_amdgcn_mfma_f32_32x32x16_bf16(PK(l3, h3), pa3, od, 0, 0, 0);
#undef PK
}
__device__ __forceinline__ void pv_d0(f32x16* o, int vb, bf16x8 pa0, bf16x8 pa1, bf16x8 pa2, bf16x8 pa3) {
  pv_one<0>(o[0], vb, pa0, pa1, pa2, pa3); pv_one<1>(o[1], vb, pa0, pa1, pa2, pa3);
}

template <int VAR>
__device__ __forceinline__ void attn_unit(const bf16_t* __restrict__ Qraw, const bf16_t* __restrict__ Kb, const bf16_t* __restrict__ Vb, bf16_t* mix,
                                          const float* ssqkv, const float* ssqq, float negB2, int qrow0, int krow0, int nkeys, int h, char* lds) {
  if (VAR == 10) return;
  int tid = threadIdx.x; asm volatile("" : "+v"(tid));
    const int  wid = __builtin_amdgcn_readfirstlane(tid >> 6), lane = tid & 63, r32 = lane & 31, hi = lane >> 5;
  char* V_lds = lds + LDS_V; char* K_lds = lds + LDS_K;
  float l_reg = 0; f32x16 o[2] = {}; bf16x8 qr[6];
  const float shift = -negB2;
  {
    const int row = qrow0 + wid * QBLK + r32;
    const f32x4 pa = *(const f32x4*)(ssqkv + (size_t)row * 16 + 4), pb = *(const f32x4*)(ssqkv + (size_t)row * 16 + 8);
    const float sql = rsqrtf(((pa[0] + pa[1]) + (pa[2] + pa[3]) + (pb[0] + pb[1]) + (pb[2] + pb[3])) * (1.0f / 384.0f) + EPS);
    const float ssh = ssqq[(size_t)row * 24 + 3 * h] + ssqq[(size_t)row * 24 + 3 * h + 1] + ssqq[(size_t)row * 24 + 3 * h + 2];
    const float sc = sql * rsqrtf(sql * sql * ssh * (1.0f / 96.0f) + EPS) * QSCALE;
    const bf16_t* Qw = Qraw + (size_t)row * 768 + h * 96 + hi * 8;
#pragma unroll
    for (int d0 = 0; d0 < 6; ++d0) { const u32x4 w = *(const u32x4*)(Qw + d0 * 16); u32x4 o4;
      o4.x = cvt_pk_bf16(bflo(w.x) * sc, bfhi(w.x) * sc); o4.y = cvt_pk_bf16(bflo(w.y) * sc, bfhi(w.y) * sc);
      o4.z = cvt_pk_bf16(bflo(w.z) * sc, bfhi(w.z) * sc); o4.w = cvt_pk_bf16(bflo(w.w) * sc, bfhi(w.w) * sc);
      qr[d0] = *reinterpret_cast<bf16x8*>(&o4); }
  }
  const int kk0 = tid / 12, kc0 = tid - kk0 * 12, kk1 = (tid + 512) / 12, kc1 = (tid + 512) - kk1 * 12, vk = tid >> 3, vc = tid & 7;
  const bf16_t* Kh = Kb + (size_t)krow0 * 768 + h * 96; const bf16_t* Vh = Vb + (size_t)krow0 * 512 + h * 64;
  const unsigned kof0 = (unsigned)(kk0 * 768 + kc0 * 8) * 2u, kof1 = (unsigned)(kk1 * 768 + kc1 * 8) * 2u, vof = (unsigned)(vk * 512 + vc * 8) * 2u;
  const int kst0 = kk0 * KROWB + kc0 * 16, kst1 = kk1 * KROWB + kc1 * 16, vst = v_st(vk, vc * 8);
  const __amdgpu_buffer_rsrc_t krs = __builtin_amdgcn_make_buffer_rsrc((void*)Kh, 0, nkeys * 768 * 2, 0x00020000);
  const __amdgpu_buffer_rsrc_t vrs = __builtin_amdgcn_make_buffer_rsrc((void*)Vh, 0, nkeys * 512 * 2, 0x00020000);
  const bool two = wid < 4;
  const int vb0 = (int)(uintptr_t)V_lds + v_rd_base(lane);
  bf16x8 sk0, sk1, sv;
#define LOADK(t) do { if (VAR == 4) break; const int so_ = (t) * (KVBLK * 768 * 2); sk0 = __builtin_bit_cast(bf16x8, __builtin_amdgcn_raw_buffer_load_b128(krs, kof0, so_, 0)); if (two) sk1 = __builtin_bit_cast(bf16x8, __builtin_amdgcn_raw_buffer_load_b128(krs, kof1, so_, 0)); } while (0)
#define LOADV(t) do { if (VAR == 4) break; sv = __builtin_bit_cast(bf16x8, __builtin_amdgcn_raw_buffer_load_b128(vrs, vof, (t) * (KVBLK * 512 * 2), 0)); } while (0)
#define WRITEK(slot) do { if (VAR == 4) break; *(bf16x8*)(K_lds + (slot) * SHM_K + kst0) = sk0; if (two) *(bf16x8*)(K_lds + (slot) * SHM_K + kst1) = sk1; } while (0)
#define WRITEV(slot) do { if (VAR == 4) break; *(bf16x8*)(V_lds + (slot) * SHM_V + vst) = sv; } while (0)
#define PV(slot) do { if (VAR != 2) pv_d0(o, vb0 + (slot) * SHM_V, pa0, pa1, pa2, pa3); else { asm volatile("" :: "v"(pa0), "v"(pa1), "v"(pa2), "v"(pa3)); } } while (0)
#define QFS(FIN, P0, P1, F0, F1, KQ) qkt_fin<FIN, VAR>(P0, P1, K_lds + (KQ) * SHM_K, qr, r32, hi, F0, F1, shift, l_reg, pa0, pa1, pa2, pa3)
#define QF(FIN, P0, P1, F0, F1) QFS(FIN, P0, P1, F0, F1, kq)
  f32x16 pA0, pA1, pB0, pB1; bf16x8 pa0, pa1, pa2, pa3; const int NT = nkeys / KVBLK;
  LOADK(0); LOADV(0); WRITEK(0); WRITEV(0); LOADK(1); WRITEK(1); LOADK(2); LOADV(1);
  __syncthreads();
  int sa = 2, sb = 1, kq = 0;
#define ROT() do { sa = (sa == 2) ? 0 : sa + 1; sb = (sb == 2) ? 0 : sb + 1; kq = (kq == 2) ? 0 : kq + 1; } while (0)
  SBAR(); QF(false, pA0, pA1, pA0, pA1); SBAR(); partialSM<VAR>(pA0, shift); WRITEK(sa); WRITEV(sb); LOADK(3); LOADV(2); __syncthreads();
  ROT();
#define STEP_U(PC0, PC1, PP0, PP1, s_, KQ, SA, SB) do { SBAR(); QFS(true, PC0, PC1, PP0, PP1, KQ); SBAR(); PV(SA); SBAR(); partialSM<VAR>(PC0, shift); \
    WRITEK(SA); WRITEV(SB); LOADK((s_) + 3); LOADV((s_) + 2); __syncthreads(); } while (0)
  int j = 1;
#ifdef ATT_UNROLL6
  for (; j + 8 < NT; j += 6) {
    STEP_U(pB0, pB1, pA0, pA1, j,     1, 0, 2);
    STEP_U(pA0, pA1, pB0, pB1, j + 1, 2, 1, 0);
    STEP_U(pB0, pB1, pA0, pA1, j + 2, 0, 2, 1);
    STEP_U(pA0, pA1, pB0, pB1, j + 3, 1, 0, 2);
    STEP_U(pB0, pB1, pA0, pA1, j + 4, 2, 1, 0);
    STEP_U(pA0, pA1, pB0, pB1, j + 5, 0, 2, 1);
  }
#endif
  for (; j + 1 < NT; j += 2) {
    SBAR(); QF(true, pB0, pB1, pA0, pA1); SBAR(); PV(sa); SBAR(); partialSM<VAR>(pB0, shift);
    WRITEK(sa); WRITEV(sb); if (j + 3 < NT) LOADK(j + 3); LOADV(j + 2); __syncthreads();
    ROT();
    const bool t3 = (j + 3 < NT);
    SBAR(); QF(true, pA0, pA1, pB0, pB1); SBAR(); PV(sa); SBAR(); partialSM<VAR>(pA0, shift);
    if (t3) WRITEK(sa); WRITEV(sb); if (j + 4 < NT) LOADK(j + 4); if (t3) LOADV(j + 3); __syncthreads();
    ROT();
  }
  SBAR(); QF(true, pB0, pB1, pA0, pA1); SBAR(); PV(sa); partialSM<VAR>(pB0, shift);
  finishSM<VAR>(pB0, pB1, shift, l_reg, pa0, pa1, pa2, pa3); SBAR();
  ROT();
  PV(sa);
  { auto rr = __builtin_amdgcn_permlane32_swap(__float_as_uint(l_reg), __float_as_uint(l_reg), false, false); l_reg = __uint_as_float(rr[0]) + __uint_as_float(rr[1]); }
  const float rl = __builtin_amdgcn_rcpf(l_reg);
  { bf16_t* stg = (bf16_t*)(lds + LDS_OST) + wid * 2048;
#pragma unroll
    for (int d0 = 0; d0 < 2; ++d0)
#pragma unroll
      for (int g = 0; g < 4; ++g) { u32x2 w; w.x = cvt_pk_bf16(o[d0][4 * g] * rl, o[d0][4 * g + 1] * rl); w.y = cvt_pk_bf16(o[d0][4 * g + 2] * rl, o[d0][4 * g + 3] * rl);
        *(u32x2*)(stg + r32 * 64 + d0 * 32 + 8 * g + 4 * hi) = w; }
    asm volatile("s_waitcnt lgkmcnt(0)" ::: "memory");
    bf16_t* Ow = mix + (size_t)(qrow0 + wid * QBLK) * D_MODEL + 256 + h * 64;
#pragma unroll
    for (int i = 0; i < 4; ++i) { const int row = i * 8 + (lane >> 3), ch = lane & 7; const u32x4 v = *(const u32x4*)(stg + row * 64 + ch * 8); *(u32x4*)(Ow + (size_t)row * D_MODEL + ch * 8) = v; } }
  __syncthreads();
#undef LOADK
#undef LOADV
#undef WRITEK
#undef WRITEV
#undef ROT
#undef QF
#undef QFS
#undef STEP_U
#undef PV
}
#undef SBAR
}
namespace thin {
__device__ __forceinline__ float fexp(float x) { return __builtin_amdgcn_exp2f(x * 1.4426950408889634f); }
__device__ __forceinline__ float sigmoidf_(float x) { return __builtin_amdgcn_rcpf(1.0f + fexp(-x)); }
__device__ __forceinline__ float gelu_tanh(float x) { return x * __builtin_amdgcn_rcpf(1.0f + __builtin_amdgcn_exp2f(x * fmaf(x * x, -0.10294323f, -2.3022082f))); }
__device__ __forceinline__ float fexpm1_neg(float x) { const float p = x * (1.0f + x * (0.5f + x * (0.16666667f + x * (0.041666668f + x * 0.0083333338f)))); const float e = fexp(x) - 1.0f; return x > -0.25f ? p : e; }
__device__ __forceinline__ int rope_logical(int p) { const int q = p >> 3, i = p & 7; return (q >> 1) * 16 + (i >> 2) * 8 + (q & 1) * 4 + (i & 3); }

constexpr int XC_ROWB = 144;
constexpr int LRU_XC = 0, LRU_Y = 256 * XC_ROWB;
constexpr int NPOS = 34;

struct LruP { const bf16_t* z; const float* convw; const float* convb; const bf16_t* gw; const float* ba; const float* bx; const float* lam; float* agg; bf16_t* mix; };

template <int PASS>
__device__ __forceinline__ void lru_item(const LruP& P, int pm, int hd, char* lds) {
    int tid = threadIdx.x; asm volatile("" : "+v"(tid));
    const int  wid = __builtin_amdgcn_readfirstlane(tid >> 6), lane = tid & 63, r32 = lane & 31, hi = lane >> 5;
    const int b = pm / PPB, pp = pm - b * PPB;
    const int L = pp == 0 ? CTX : SEQ, seqbase = b * TPB + (pp == 0 ? 0 : CTX), t0 = pp == 0 ? 0 : (pp - 1) * 256;
    char* XC = lds + LRU_XC; float* Y = (float*)(lds + LRU_Y);
    {
        const int c8 = tid & 7, ch = hd * 64 + c8 * 8;
        f32x4 w[4][2];
#pragma unroll
        for (int k = 0; k < 4; ++k) { w[k][0] = *(const f32x4*)(P.convw + k * 256 + ch); w[k][1] = *(const f32x4*)(P.convw + k * 256 + ch + 4); }
        const f32x4 cb0 = *(const f32x4*)(P.convb + ch), cb1 = *(const f32x4*)(P.convb + ch + 4);
#pragma unroll
        for (int i = 0; i < 4; ++i) {
            const int tk = (tid >> 3) + 64 * i, ts = t0 + tk;
            f32x4 a0 = cb0, a1 = cb1;
#pragma unroll
            for (int k = 0; k < 4; ++k) { const int tsrc = ts + k - 1;
                if (tsrc >= 0 && tsrc < L) { const u32x4 v = *(const u32x4*)(P.z + (size_t)(seqbase + tsrc) * ZW + Z_LX + ch);
                    a0 += w[k][0] * (f32x4){bflo(v.x), bfhi(v.x), bflo(v.y), bfhi(v.y)}; a1 += w[k][1] * (f32x4){bflo(v.z), bfhi(v.z), bflo(v.w), bfhi(v.w)}; } }
            *(u32x4*)(XC + tk * XC_ROWB + c8 * 16) = epi::pack8(a0, a1);
        }
    }
    __syncthreads();
    const int dir = wid & 1, cb = (wid >> 1) & 1, half = wid >> 2;
    const int chl = cb * 32 + r32, ch = hd * 64 + chl;
    bf16x8 Ba[4], Bx[4];
#pragma unroll
    for (int ks = 0; ks < 4; ++ks) {
        Ba[ks] = *(const bf16x8*)(P.gw + ((size_t)((dir * 2 + 0) * 4 + hd) * 64 + chl) * 64 + ks * 16 + hi * 8);
        Bx[ks] = *(const bf16x8*)(P.gw + ((size_t)((dir * 2 + 1) * 4 + hd) * 64 + chl) * 64 + ks * 16 + hi * 8);
    }
    const float bav = P.ba[dir * 256 + ch], bxv = P.bx[dir * 256 + ch];
    const float sp8 = 8.0f * log1pf(expf(-P.lam[dir * 256 + ch]));
    const float nsp8 = -sp8, ba2 = bav * -1.4426950408889634f, bx2 = bxv * -1.4426950408889634f;
    const bool small_la = __all(sp8 <= 0.125f);
    const int chunk = pp == 0 ? half : 2 * pp + half;
    const int pos = dir == 0 ? chunk : (chunk == 1 ? 0 : (chunk == 0 ? 1 : 35 - chunk));
    float Hrun = 0.f, Arun = 1.f;
    if (PASS == 2) {
        const float* ag = P.agg + ((size_t)(b * 2 + dir) * NPOS) * 512 + ch * 2;
#pragma unroll 1
        for (int p0 = 0; p0 < pos; p0 += 11) {
            f32x2 e[11];
#pragma unroll
            for (int q = 0; q < 11; ++q) e[q] = (p0 + q) < pos ? *(const f32x2*)(ag + (size_t)(p0 + q) * 512) : (f32x2){1.0f, 0.0f};
#pragma unroll
            for (int q = 0; q < 11; ++q) Hrun = e[q].x * Hrun + e[q].y;
        }
    }
    float yv[4][16];
    const int tau = ((r32 >> 2) & 1) * 16 + (r32 >> 3) * 4 + (r32 & 3);
    const int firsthi = dir;
#pragma unroll
    for (int ii = 0; ii < 4; ++ii) {
        const int tile = dir == 0 ? ii : 3 - ii, tb = half * 128 + tile * 32;
        f32x16 ra = {}, ix = {};
#pragma unroll
        for (int ks = 0; ks < 4; ++ks) {
            const bf16x8 af = *(const bf16x8*)(XC + (tb + tau) * XC_ROWB + (ks * 16 + hi * 8) * 2);
            ra = __builtin_amdgcn_mfma_f32_32x32x16_bf16(af, Ba[ks], ra, 0, 0, 0);
            ix = __builtin_amdgcn_mfma_f32_32x32x16_bf16(af, Bx[ks], ix, 0, 0, 0);
        }
        float av[16], bv[16];
        if (small_la) { asm volatile("; lru: series expm1" ::: "memory");
#pragma unroll
            for (int r = 0; r < 16; ++r) {
                const float xcv = bf2f(*(const bf16_t*)(XC + (tb + hi * 16 + r) * XC_ROWB + chl * 2));
                const float rr = __builtin_amdgcn_rcpf(1.0f + __builtin_amdgcn_exp2f(fmaf(ra[r], -1.4426950408889634f, ba2)));
                const float iv = __builtin_amdgcn_rcpf(1.0f + __builtin_amdgcn_exp2f(fmaf(ix[r], -1.4426950408889634f, bx2)));
                const float la = nsp8 * rr;
                const float em = la * fmaf(la, fmaf(la, fmaf(la, 0.041666668f, 0.16666667f), 0.5f), 1.0f);
                av[r] = 1.0f + em; bv[r] = __builtin_amdgcn_sqrtf(-fmaf(em, em, em + em)) * (iv * xcv);
            }
        } else {
#pragma unroll
            for (int r = 0; r < 16; ++r) {
                const float xcv = bf2f(*(const bf16_t*)(XC + (tb + hi * 16 + r) * XC_ROWB + chl * 2));
                const float rr = __builtin_amdgcn_rcpf(1.0f + __builtin_amdgcn_exp2f(fmaf(ra[r], -1.4426950408889634f, ba2)));
                const float iv = __builtin_amdgcn_rcpf(1.0f + __builtin_amdgcn_exp2f(fmaf(ix[r], -1.4426950408889634f, bx2)));
                const float em = fexpm1_neg(nsp8 * rr);
                av[r] = 1.0f + em; bv[r] = __builtin_amdgcn_sqrtf(-fmaf(em, em, em + em)) * (iv * xcv);
            }
        }
        float hl[16], cl[16]; float h = 0.f, c = 1.f;
        if (dir == 0) {
#pragma unroll
            for (int r = 0; r < 16; ++r) { h = av[r] * h + bv[r]; c *= av[r]; hl[r] = h; cl[r] = c; }
        } else {
#pragma unroll
            for (int r = 15; r >= 0; --r) { h = av[r] * h + bv[r]; c *= av[r]; hl[r] = h; cl[r] = c; }
        }
        const float H1 = __shfl(h, r32 + 32 * firsthi), A1 = __shfl(c, r32 + 32 * firsthi);
        const float H2 = __shfl(h, r32 + 32 * (1 - firsthi)), A2 = __shfl(c, r32 + 32 * (1 - firsthi));
        const float Hin1 = Hrun, Hin2 = A1 * Hrun + H1;
        const float Hmine = (hi == firsthi) ? Hin1 : Hin2;
        Hrun = A2 * Hin2 + H2; Arun = Arun * A1 * A2;
        if (PASS == 2) {
#pragma unroll
            for (int r = 0; r < 16; ++r) yv[ii][r] = hl[r] + cl[r] * Hmine;
        }
    }
    if (PASS == 1) {
        if (hi == 0) *(f32x2*)(P.agg + ((size_t)(b * 2 + dir) * NPOS + pos) * 512 + ch * 2) = (f32x2){Arun, Hrun};
        __syncthreads();
    } else {
        if (dir == 0) {
#pragma unroll
            for (int ii = 0; ii < 4; ++ii)
#pragma unroll
                for (int r = 0; r < 16; ++r) Y[(half * 128 + ii * 32 + hi * 16 + r) * 64 + chl] = yv[ii][r];
        }
        __syncthreads();
        if (dir == 1) {
#pragma unroll
            for (int ii = 0; ii < 4; ++ii)
#pragma unroll
                for (int r = 0; r < 16; ++r) Y[(half * 128 + (3 - ii) * 32 + hi * 16 + r) * 64 + chl] += yv[ii][r];
        }
        __syncthreads();
        const int c8 = tid & 7;
#pragma unroll
        for (int i = 0; i < 4; ++i) {
            const int tk = (tid >> 3) + 64 * i; const size_t row = (size_t)pm * 256 + tk;
            const f32x4 y0 = *(const f32x4*)(Y + tk * 64 + c8 * 8), y1 = *(const f32x4*)(Y + tk * 64 + c8 * 8 + 4);
            const u32x4 g = *(const u32x4*)(P.z + row * ZW + Z_LG + hd * 64 + c8 * 8);
            const f32x4 o0 = y0 * (f32x4){gelu_tanh(bflo(g.x)), gelu_tanh(bfhi(g.x)), gelu_tanh(bflo(g.y)), gelu_tanh(bfhi(g.y))};
            const f32x4 o1 = y1 * (f32x4){gelu_tanh(bflo(g.z)), gelu_tanh(bfhi(g.z)), gelu_tanh(bflo(g.w)), gelu_tanh(bfhi(g.w))};
            *(u32x4*)(P.mix + row * D_MODEL + hd * 64 + c8 * 8) = epi::pack8(o0, o1);
        }
        __syncthreads();
    }
}

constexpr int PL_PU = 0, PL_MX = 272 * 128;
template <int GI>
__device__ __forceinline__ void pool_item_g(const bf16_t* z, const bf16_t* pw, bf16_t* mix, int pm, char* lds) {
    constexpr int g = GI, W = 2 << GI;
    int tid = threadIdx.x; asm volatile("" : "+v"(tid));
    const int  wid = __builtin_amdgcn_readfirstlane(tid >> 6), lane = tid & 63, r32 = lane & 31, hi = lane >> 5;
    const int b = pm / PPB, pp = pm - b * PPB;
    const int L = pp == 0 ? CTX : SEQ, seqbase = b * TPB + (pp == 0 ? 0 : CTX), t0 = pp == 0 ? 0 : (pp - 1) * 256;
    char* PU = lds + PL_PU; char* MX = lds + PL_MX;
    const int c8 = tid & 7;
#pragma unroll
    for (int i = 0; i < 5; ++i) { const int hr = (tid >> 3) + 64 * i, ts = t0 - 8 + hr;
        if (hr < 272 && ts >= 0 && ts < L) *(u32x4*)(PU + hr * 128 + c8 * 16) = *(const u32x4*)(z + (size_t)(seqbase + ts) * ZW + Z_PU + g * 64 + c8 * 8); }
    __syncthreads();
#pragma unroll
    for (int i = 0; i < 4; ++i) {
        const int tk = (tid >> 3) + 64 * i, ts = t0 + tk;
        f32x4 s0 = {0.f, 0.f, 0.f, 0.f}, s1 = {0.f, 0.f, 0.f, 0.f}; int cnt = 0;
#pragma unroll
        for (int k = 0; k < W; ++k) {
            const int tt = ts - W / 2 + k;
            if (tt >= 0 && tt < L) { const u32x4 v = *(const u32x4*)(PU + (tk + 8 - W / 2 + k) * 128 + c8 * 16); ++cnt;
                s0 += (f32x4){bflo(v.x), bfhi(v.x), bflo(v.y), bfhi(v.y)}; s1 += (f32x4){bflo(v.z), bfhi(v.z), bflo(v.w), bfhi(v.w)}; } }
        const float inv = __builtin_amdgcn_rcpf((float)cnt);
        const u32x4 v = *(const u32x4*)(PU + (tk + 8) * 128 + c8 * 16);
        s0 = s0 * inv - (f32x4){bflo(v.x), bfhi(v.x), bflo(v.y), bfhi(v.y)}; s1 = s1 * inv - (f32x4){bflo(v.z), bfhi(v.z), bflo(v.w), bfhi(v.w)};
        *(u32x4*)(MX + tk * XC_ROWB + c8 * 16) = epi::pack8(s0, s1);
    }
    __syncthreads();
    f32x16 c0 = {}, c1 = {};
#pragma unroll
    for (int ks = 0; ks < 4; ++ks) {
        const bf16x8 bf = *(const bf16x8*)(MX + (wid * 32 + r32) * XC_ROWB + (ks * 16 + hi * 8) * 2);
        const bf16x8 a0 = *(const bf16x8*)(pw + ((size_t)g * 64 + r32) * 64 + ks * 16 + hi * 8);
        const bf16x8 a1 = *(const bf16x8*)(pw + ((size_t)g * 64 + 32 + r32) * 64 + ks * 16 + hi * 8);
        c0 = __builtin_amdgcn_mfma_f32_32x32x16_bf16(a0, bf, c0, 0, 0, 0);
        c1 = __builtin_amdgcn_mfma_f32_32x32x16_bf16(a1, bf, c1, 0, 0, 0);
    }
    bf16_t* OT = (bf16_t*)PU;
#pragma unroll
    for (int q = 0; q < 4; ++q) {
        u32x2 w0, w1; w0.x = cvt_pk_bf16(c0[4 * q], c0[4 * q + 1]); w0.y = cvt_pk_bf16(c0[4 * q + 2], c0[4 * q + 3]);
        w1.x = cvt_pk_bf16(c1[4 * q], c1[4 * q + 1]); w1.y = cvt_pk_bf16(c1[4 * q + 2], c1[4 * q + 3]);
        *(u32x2*)(OT + (wid * 32 + r32) * 64 + 4 * hi + 8 * q) = w0; *(u32x2*)(OT + (wid * 32 + r32) * 64 + 32 + 4 * hi + 8 * q) = w1;
    }
    __syncthreads();
#pragma unroll
    for (int i = 0; i < 4; ++i) { const int tk = (tid >> 3) + 64 * i;
        *(u32x4*)(mix + ((size_t)pm * 256 + tk) * D_MODEL + 768 + g * 64 + c8 * 8) = *(const u32x4*)(OT + tk * 64 + c8 * 8); }
    __syncthreads();
}
__device__ __forceinline__ void pool_item(const bf16_t* z, const bf16_t* pw, bf16_t* mix, int pm, int g, char* lds) {
    if (g == 0) pool_item_g<0>(z, pw, mix, pm, lds); else if (g == 1) pool_item_g<1>(z, pw, mix, pm, lds); else if (g == 2) pool_item_g<2>(z, pw, mix, pm, lds); else pool_item_g<3>(z, pw, mix, pm, lds);
}

__device__ __forceinline__ void transpose_tile(const float* W, int N, bf16_t* WT, int Kp, int k0, int nphys, int srcbase, bool rperm, const float* kscale, const float* nscale, bool zero, LAS float* scr, int lane) {
    const int nl = lane & 31, sc = srcbase + (rperm ? rope_logical(nl) : nl);
    const float nsv = nscale ? nscale[nl] : 1.0f;
#pragma unroll 8
    for (int i = 0; i < 32; ++i) { const int kk = 2 * i + (lane >> 5);
        float v = zero ? 0.f : W[(size_t)(k0 + kk) * N + sc] * nsv; if (kscale) v *= kscale[k0 + kk];
        scr[kk * 33 + nl] = v; }
    asm volatile("s_waitcnt lgkmcnt(0)" ::: "memory");
    const int c = lane & 7;
#pragma unroll
    for (int j = 0; j < 4; ++j) { const int n = (lane >> 3) + 8 * j; const LAS float* s = scr + (8 * c) * 33 + n;
        u32x4 o; o.x = cvt_pk_bf16(s[0 * 33], s[1 * 33]); o.y = cvt_pk_bf16(s[2 * 33], s[3 * 33]); o.z = cvt_pk_bf16(s[4 * 33], s[5 * 33]); o.w = cvt_pk_bf16(s[6 * 33], s[7 * 33]);
        *(u32x4*)(WT + (size_t)(nphys + n) * Kp + k0 + 8 * c) = o; }
    asm volatile("s_waitcnt lgkmcnt(0)" ::: "memory");
}
__device__ __forceinline__ float wave_sum(float v) {
#pragma unroll
    for (int o = 1; o < 64; o <<= 1) v += __shfl_xor(v, o);
    return v;
}
}
constexpr int NWAVES = 8;
constexpr size_t MiB = 1u << 20;
constexpr size_t WS_CTL = 0, CTL_ZERO_BYTES = 64 * 1024;
constexpr size_t WS_MODPART = 1 * MiB;
constexpr size_t WS_VEC = 5 * MiB;
constexpr size_t WS_BIASIN = WS_VEC + 512 * 1024;
constexpr size_t WS_BIASFF = WS_BIASIN + 128 * 1024;
constexpr size_t WS_RTAB = WS_BIASFF + 320 * 1024;
constexpr size_t WS_RVEC = 17 * MiB + 512 * 1024;
constexpr size_t WS_AGG = 6 * MiB;
constexpr size_t WS_SSQX = 8 * MiB;
constexpr size_t WS_SSQKV = 11 * MiB;
constexpr size_t WS_SSQQ = 14 * MiB;
constexpr size_t WS_WT = 18 * MiB, WT_LAYER = 23 * MiB;
constexpr size_t WT_IN = 0, WT_UQ = 3 * MiB, WT_UKV = WT_UQ + 640 * 1024, WT_OUT = WT_UKV + 512 * 1024, WT_FF1 = WT_OUT + 2 * MiB, WT_FF2 = WT_FF1 + 8 * MiB, WT_GATE = WT_FF2 + 8 * MiB, WT_POOL = WT_GATE + 128 * 1024;
static_assert(WT_POOL + 32 * 1024 <= WT_LAYER, "weights per layer");
constexpr size_t WS_XG = 72 * MiB;
constexpr size_t WS_U = 208 * MiB;
constexpr size_t WS_Z = WS_U, WS_Q = WS_Z + 102 * MiB, WS_K = WS_Q + 51 * MiB, WS_V = WS_K + 51 * MiB;
constexpr size_t WS_END = WS_U + 272 * MiB;
static_assert(WS_V + 34 * MiB <= WS_END && WS_END <= 512 * MiB, "d_ws map");
enum { VEC_GM1 = 0, VEC_G1 = 1, VEC_GM2 = 2, VEC_G2 = 3, VEC_SH1 = 4, VEC_SH2 = 5 };

constexpr int LDS_BYTES = 147456;
constexpr int LDSCTL_OFF = 131072, MISC_OFF = LDSCTL_OFF + 320;

typedef GAS unsigned gu32;
#define RLX_AGENT __ATOMIC_RELAXED, __HIP_MEMORY_SCOPE_AGENT
#define XB_TMO      128
#define XB_XCNT(j)  (256  + 64 * (j))
#define XB_XSUB(j)  (1280 + 64 * (j))
#define XB_XGEN(j)  (2304 + 64 * (j))
#define XB_TOP      3328
#define XB_TOPGEN   3392
#define XCD_BAR_WORDS 3456
#define XB_SPIN_CAP (1u << 20)
__device__ __forceinline__ unsigned xb_ld(unsigned* p)              { return __hip_atomic_load(p, __ATOMIC_RELAXED, __HIP_MEMORY_SCOPE_AGENT); }
__device__ __forceinline__ unsigned xb_add(unsigned* p, unsigned v) { return __hip_atomic_fetch_add(p, v, __ATOMIC_RELAXED, __HIP_MEMORY_SCOPE_AGENT); }
__device__ __forceinline__ unsigned xb_xcc_id() { return (unsigned)__builtin_amdgcn_s_getreg((3 << 11) | 20) & 0xFu; }
#define XB_SPIN(cond, bar) do { unsigned _sp = 0; while (cond) { __builtin_amdgcn_s_sleep(1); \
    if ((++_sp & 255u) == 0u) { if (xb_ld(&(bar)[XB_TMO])) break; if (_sp > XB_SPIN_CAP) { atomicAdd(&(bar)[XB_TMO], 1u); break; } } } } while (0)
struct XcdBarrier { unsigned* bar; unsigned x; volatile LAS unsigned* st; };
__device__ __forceinline__ XcdBarrier xcd_barrier_post(unsigned* bar, volatile LAS unsigned* st) {
    XcdBarrier b; b.bar = bar; b.x = xb_xcc_id(); b.st = st;
    if (threadIdx.x == 0) (void)xb_add(&bar[XB_XCNT(b.x)], 1u);
    return b;
}
__device__ __forceinline__ void xcd_barrier_complete(unsigned* bar, unsigned x, unsigned& nloc, unsigned& nx) {
    const unsigned G = gridDim.x * gridDim.y * gridDim.z;
    unsigned sum, cnt, mine, sp = 0u;
    for (;;) {
        sum = 0u; cnt = 0u; mine = 0u;
#pragma unroll
        for (unsigned j = 0; j < 16; ++j) { const unsigned c = xb_ld(&bar[XB_XCNT(j)]); sum += c; cnt += (c > 0u) ? 1u : 0u; mine = (j == x) ? c : mine; }
        if (sum == G) break;
        __builtin_amdgcn_s_sleep(1);
        if ((++sp & 255u) == 0u) { if (xb_ld(&bar[XB_TMO])) break; if (sp > XB_SPIN_CAP) { atomicAdd(&bar[XB_TMO], 1u); break; } }
    }
    nloc = mine > 0u ? mine : 1u; nx = cnt > 0u ? cnt : 1u;
}
__device__ __forceinline__ void xcd_barrier(const XcdBarrier& b) {
    asm volatile("s_waitcnt vmcnt(0)" ::: "memory");
    __syncthreads();
    if (threadIdx.x == 0) {
        unsigned* bar = b.bar;
        __builtin_amdgcn_s_waitcnt(0);
        unsigned nloc = b.st[0], nx = b.st[1];
        if (nloc == 0u) { xcd_barrier_complete(bar, b.x, nloc, nx); b.st[0] = nloc; b.st[1] = nx; }
        const unsigned old = xb_add(&bar[XB_XSUB(b.x)], 1u);
        const unsigned gen = old / nloc;
        if (old + 1u == (gen + 1u) * nloc) {
            __builtin_amdgcn_fence(__ATOMIC_RELEASE, "agent");
            asm volatile("s_waitcnt vmcnt(0)" ::: "memory");
            const unsigned og = xb_add(&bar[XB_TOP], 1u);
            const unsigned tg = og / nx;
            if (og + 1u == (tg + 1u) * nx) xb_add(&bar[XB_TOPGEN], 1u);
            else XB_SPIN(xb_ld(&bar[XB_TOPGEN]) == tg, bar);
            __builtin_amdgcn_fence(__ATOMIC_ACQUIRE, "agent");
            xb_add(&bar[XB_XGEN(b.x)], 1u);
            asm volatile("s_waitcnt vmcnt(0)" ::: "memory");
        } else {
            XB_SPIN(xb_ld(&bar[XB_XGEN(b.x)]) == gen, bar);
            __builtin_amdgcn_fence(__ATOMIC_ACQUIRE, "agent");
            asm volatile("s_waitcnt vmcnt(0)" ::: "memory");
        }
    }
    __syncthreads();
}


__device__ __forceinline__ void ctx_combine(unsigned char* ws, float* out, const float* rgmv, const float* gatev, const float* gmv, int gw, int NGW, int lane_in) {
    int lane = lane_in; asm volatile("" : "+v"(lane));
    const float* slab = out + (size_t)18 * 1024 * 1024;
    bf16_t* xg_ = (bf16_t*)(ws + WS_XG); float* ssq_ = (float*)(ws + WS_SSQX);
    for (int cr = gw; cr < BATCH * CTX; cr += NGW) {
        const size_t urow = (size_t)(cr >> 8) * TPB + (cr & 255); float ss = 0.f;
#pragma unroll
        for (int j = 0; j < 4; ++j) { const int col = 256 * j + 4 * lane;
            f32x4 a = *(const f32x4*)(slab + (size_t)cr * D_MODEL + col);
#pragma unroll
            for (int ks = 1; ks < 4; ++ks) a += *(const f32x4*)(slab + ((size_t)ks * (BATCH * CTX) + cr) * D_MODEL + col);
            const u32x2 w = *(const u32x2*)(xg_ + urow * D_MODEL + col);
            const f32x4 x = (f32x4){bflo(w.x), bfhi(w.x), bflo(w.y), bfhi(w.y)} * *(const f32x4*)(rgmv + col) + *(const f32x4*)(gatev + col) * a;
            ss += epi::sq4(x);
            const f32x4 t = x * *(const f32x4*)(gmv + col); u32x2 o; o.x = cvt_pk_bf16(t[0], t[1]); o.y = cvt_pk_bf16(t[2], t[3]); *(u32x2*)(xg_ + urow * D_MODEL + col) = o; }
        ss = thin::wave_sum(ss);
        if (lane < 16) ssq_[urow * 16 + lane] = lane == 0 ? ss : 0.f;
    }
}

struct Args { const float* in[27]; float* out; unsigned char* ws; int ph_lo, ph_hi; };
constexpr int NPHASE = 15;

__global__ void __launch_bounds__(NWAVES * 64, 2) fwd_kernel(Args args) {
    extern __shared__ __attribute__((aligned(16))) unsigned char lds_raw[];
    LAS unsigned char* lds = (LAS unsigned char*)lds_raw;
    char* ldsg = (char*)lds_raw;
    const int tid = threadIdx.x, lane = tid & 63, wave = __builtin_amdgcn_readfirstlane(tid >> 6);
    const int G = gridDim.x; const int bx = blockIdx.x; const int vcu = (G % 8 == 0) ? (bx % 8) * (G / 8) + bx / 8 : bx;
    unsigned char* ws = args.ws;
    typedef __attribute__((address_space(4))) const Args* KArgs;
#define KA(i) (((KArgs)__builtin_amdgcn_kernarg_segment_ptr())->in[i])
#define x_in KA(0)
#define c_in KA(1)
#define ctx_in KA(2)
#define cctx_in KA(3)
#define w_mod KA(4)
#define b_mod KA(5)
#define g_norm1 KA(6)
#define g_norm2 KA(7)
#define w_in KA(8)
#define conv_w KA(9)
#define conv_b KA(10)
#define lru_w_a KA(11)
#define lru_b_a KA(12)
#define lru_w_x KA(13)
#define lru_b_x KA(14)
#define lru_lambda KA(15)
#define g_q_lat KA(16)
#define w_uq KA(17)
#define g_kv_lat KA(18)
#define w_ukv KA(19)
#define g_qn KA(20)
#define g_kn KA(21)
#define w_pool KA(22)
#define pool_scale KA(23)
#define w_out KA(24)
#define w_ff1 KA(25)
#define w_ff2 KA(26)
    float* out = args.out;
#define modpart ((float*)(ws + WS_MODPART))
#define vec ((float*)(ws + WS_VEC))
#define bias_in ((float*)(ws + WS_BIASIN))
#define bias_ff ((float*)(ws + WS_BIASFF))
#define rtab ((float*)(ws + WS_RTAB))
#define agg ((float*)(ws + WS_AGG))
#define ssqx ((float*)(ws + WS_SSQX))
#define ssqkv ((float*)(ws + WS_SSQKV))
#define ssqq ((float*)(ws + WS_SSQQ))
#define rvec ((float*)(ws + WS_RVEC))
#define xg ((bf16_t*)(ws + WS_XG))
#define mix ((bf16_t*)out)
#define U ((bf16_t*)(ws + WS_U))
#define zb ((bf16_t*)(ws + WS_Z))
#define Qb ((bf16_t*)(ws + WS_Q))
#define Kb ((bf16_t*)(ws + WS_K))
#define Vb ((bf16_t*)(ws + WS_V))

    for (int u = tid; u < (LDS_BYTES - LDSCTL_OFF) / 4; u += NWAVES * 64) ((LAS unsigned*)(lds + LDSCTL_OFF))[u] = 0u;
    __syncthreads();
    const bool single = (args.ph_hi - args.ph_lo) > 1;
    XcdBarrier bar; bar.bar = (unsigned*)(ws + WS_CTL); bar.x = 0; bar.st = nullptr;
    if (single) bar = xcd_barrier_post((unsigned*)(ws + WS_CTL), (volatile LAS unsigned*)(lds + MISC_OFF) + 8);
    const int lo = args.ph_lo, hi = args.ph_hi;
#ifndef PHASE_MASK
#define PHASE_MASK 0x7FF
#endif
#define IN(k) (lo <= (k) && (k) < hi)
#ifndef DUP_MASK
#define DUP_MASK 0x7FF
#endif
#define EN(j) (((PHASE_MASK >> (j)) & 1) && (rep_ > 0 || NREP_CUR == 1 || ((DUP_MASK >> (j)) & 1)))
#ifndef DUP_PHASE
#define DUP_PHASE (-1)
#endif
#define NREP(k) (((k) == DUP_PHASE) ? 2 : 1)
#define SEAM(k) do { if (IN(k) && IN((k) + 1)) xcd_barrier(bar); } while (0)
    const int gw = vcu * NWAVES + wave, NGW = G * NWAVES;

    for (int rep_ = 0, NREP_CUR = NREP(0); rep_ < NREP_CUR; ++rep_) { if (rep_) xcd_barrier(bar);
    if (EN(0) && IN(0)) {
        float* sl = (float*)ldsg;
        for (int i = tid; i < 9 * 1024; i += NWAVES * 64) { const float v = i < 8192 ? c_in[i] : cctx_in[i - 8192]; sl[i] = v / (1.0f + expf(-v)); }
        __syncthreads();
        for (int it = gw; it < 2 * 96 * 8; it += NGW) {
            const int l = it / 768, r = it - l * 768, cg = r >> 3, ks = r & 7;
            float acc[9];
#pragma unroll
            for (int b = 0; b < 9; ++b) acc[b] = 0.f;
            const float* wp = w_mod + ((size_t)l * 1024 + ks * 128) * 6144 + cg * 64 + lane;
#pragma unroll 8
            for (int kk = 0; kk < 128; ++kk) { const float w = wp[(size_t)kk * 6144];
#pragma unroll
                for (int b = 0; b < 9; ++b) acc[b] += sl[b * 1024 + ks * 128 + kk] * w; }
#pragma unroll
            for (int b = 0; b < 9; ++b) modpart[((size_t)(ks * 2 + l) * 9 + b) * 6144 + cg * 64 + lane] = acc[b];
        }
        __syncthreads();
        if (bx == 0) for (int i = tid; i < 512; i += NWAVES * 64) { const int pos = i >> 3, f = i & 7; const float fr = powf(10000.0f, -(float)f / 8.0f), ang = (float)pos * fr; rtab[i * 2] = cosf(ang); rtab[i * 2 + 1] = sinf(ang); }
        LAS float* scr = (LAS float*)(lds + wave * 16384);
        constexpr int I_IN = 768, I_UQ = 144, I_UKV = 128, I_OUT = 512, I_FF1 = 2048, I_FF2 = 2048, I_G = 32, I_P = 8, I_L = I_IN + I_UQ + I_UKV + I_OUT + I_FF1 + I_FF2 + I_G + I_P;
        for (int it = gw; it < 2 * I_L; it += NGW) {
            const int l = it / I_L; int r = it - l * I_L; bf16_t* wt = (bf16_t*)(ws + WS_WT + (size_t)l * WT_LAYER);
            if (r < I_IN) { const int pg = r >> 4, kb = r & 15; int src = 0; bool z0 = false, rp = false;
                if (pg < 16) src = 32 * pg; else if (pg < 24) src = 896 + 32 * (pg - 16); else if (pg < 32) src = 1184 + 32 * (pg - 24); else if (pg < 44) src = 512 + 32 * (pg - 32); else if (pg == 44) { src = 1152; rp = true; } else z0 = true;
                thin::transpose_tile(w_in + (size_t)l * 1024 * D_IN, D_IN, wt + WT_IN / 2, 1024, kb * 64, pg * 32, src, rp, nullptr, nullptr, z0, scr, lane); continue; } r -= I_IN;
            if (r < I_UQ) { const int pg = r / 6, kb = r - pg * 6;
                thin::transpose_tile(w_uq + (size_t)l * 384 * 768, 768, wt + WT_UQ / 2, 384, kb * 64, pg * 32, pg * 32, (pg % 3) == 2, g_q_lat + l * 384, nullptr, false, scr, lane); continue; } r -= I_UQ;
            if (r < I_UKV) { const int pg = r >> 2, kb = r & 3, pn = pg >> 3, bj = (pg >> 2) & 1, wc = pg & 3;
                const int src = pn < 2 ? (4 * pn + wc) * 128 + 32 * bj : (4 * (pn - 2) + wc) * 128 + 64 + 32 * bj;
                thin::transpose_tile(w_ukv + (size_t)l * 256 * 1024, 1024, wt + WT_UKV / 2, 256, kb * 64, pg * 32, src, false, g_kv_lat + l * 256, nullptr, false, scr, lane); continue; } r -= I_UKV;
            if (r < I_OUT) { const int pg = r >> 4, kb = r & 15;
                thin::transpose_tile(w_out + (size_t)l * 1024 * 1024, 1024, wt + WT_OUT / 2, 1024, kb * 64, pg * 32, pg * 32, false, nullptr, nullptr, false, scr, lane); continue; } r -= I_OUT;
            if (r < I_FF1) { const int pg = r >> 4, kb = r & 15;
                thin::transpose_tile(w_ff1 + (size_t)l * 1024 * 4096, 4096, wt + WT_FF1 / 2, 1024, kb * 64, pg * 32, pg * 32, false, nullptr, nullptr, false, scr, lane); continue; } r -= I_FF1;
            if (r < I_FF2) { const int pg = r >> 6, kb = r & 63;
                thin::transpose_tile(w_ff2 + (size_t)l * 4096 * 1024, 1024, wt + WT_FF2 / 2, 4096, kb * 64, pg * 32, pg * 32, false, nullptr, nullptr, false, scr, lane); continue; } r -= I_FF2;
            if (r < I_G) { const int mat = r >> 1, pg = r & 1, dir = mat >> 3, gate = (mat >> 2) & 1, hd = mat & 3;
                const float* src = (gate ? lru_w_x : lru_w_a) + ((size_t)((l * 2 + dir) * 4 + hd)) * 4096;
                thin::transpose_tile(src, 64, wt + WT_GATE / 2 + (size_t)mat * 4096, 64, 0, pg * 32, pg * 32, false, nullptr, nullptr, false, scr, lane); continue; } r -= I_G;
            { const int g = r >> 1, pg = r & 1;
                thin::transpose_tile(w_pool + (size_t)(l * 4 + g) * 4096, 64, wt + WT_POOL / 2 + (size_t)g * 4096, 64, 0, pg * 32, pg * 32, false, nullptr, pool_scale + l * 256 + g * 64 + pg * 32, false, scr, lane); }
        }
        __syncthreads();
    }
    } SEAM(0);
    for (int rep_ = 0, NREP_CUR = NREP(1); rep_ < NREP_CUR; ++rep_) { if (rep_) xcd_barrier(bar);
    if (EN(0) && IN(1)) {
        const int gt = vcu * (NWAVES * 64) + tid;
        if (gt < 2 * 9 * 1024) {
            const int l = gt / 9216, r = gt - l * 9216, b = r >> 10, j = r & 1023;
            float m[6];
#pragma unroll
            for (int s = 0; s < 6; ++s) { float a = b_mod[l * 6144 + s * 1024 + j];
#pragma unroll
                for (int ks = 0; ks < 8; ++ks) a += modpart[((size_t)(ks * 2 + l) * 9 + b) * 6144 + s * 1024 + j];
                m[s] = a; }
            float* v = vec + (size_t)(l * 9 + b) * 6144 + j;
            float gm1 = g_norm1[l * 1024 + j] * (1.0f + m[1]), gm2 = g_norm2[l * 1024 + j] * (1.0f + m[4]);
            gm1 = fabsf(gm1) < 1e-20f ? 1e-20f : gm1; gm2 = fabsf(gm2) < 1e-20f ? 1e-20f : gm2;
            v[VEC_GM1 * 1024] = gm1; v[VEC_G1 * 1024] = m[2];
            v[VEC_GM2 * 1024] = gm2; v[VEC_G2 * 1024] = m[5];
            rvec[(size_t)(l * 9 + b) * 2048 + j] = 1.0f / gm1; rvec[(size_t)(l * 9 + b) * 2048 + 1024 + j] = 1.0f / gm2;
            v[VEC_SH1 * 1024] = m[0]; v[VEC_SH2 * 1024] = m[3];
        }
    }
    } SEAM(1);
    for (int rep_ = 0, NREP_CUR = NREP(2); rep_ < NREP_CUR; ++rep_) { if (rep_) xcd_barrier(bar);
    if (EN(0) && IN(2)) {
        float* sl = (float*)ldsg;
        for (int combo = 0; combo < 4; ++combo) {
            const int l = combo >> 1, mat = combo & 1, N = mat ? D_FF : ZW;
            __syncthreads();
            for (int i = tid; i < 9 * 1024; i += NWAVES * 64) sl[i] = vec[(size_t)(l * 9 + (i >> 10)) * 6144 + (mat ? VEC_SH2 : VEC_SH1) * 1024 + (i & 1023)];
            __syncthreads();
            const bf16_t* wt = (const bf16_t*)(ws + WS_WT + (size_t)l * WT_LAYER + (mat ? WT_FF1 : WT_IN));
            float* bo = (mat ? bias_ff : bias_in) + (size_t)l * 9 * N;
            for (int n = gw; n < N; n += NGW) {
                const u32x4 w0 = *(const u32x4*)(wt + (size_t)n * 1024 + 8 * lane), w1 = *(const u32x4*)(wt + (size_t)n * 1024 + 512 + 8 * lane);
                float wv[16] = {bflo(w0.x), bfhi(w0.x), bflo(w0.y), bfhi(w0.y), bflo(w0.z), bfhi(w0.z), bflo(w0.w), bfhi(w0.w), bflo(w1.x), bfhi(w1.x), bflo(w1.y), bfhi(w1.y), bflo(w1.z), bfhi(w1.z), bflo(w1.w), bfhi(w1.w)};
#pragma unroll
                for (int b = 0; b < 9; ++b) { float s = 0.f;
#pragma unroll
                    for (int i = 0; i < 8; ++i) s += wv[i] * sl[b * 1024 + 8 * lane + i] + wv[8 + i] * sl[b * 1024 + 512 + 8 * lane + i];
                    s = thin::wave_sum(s); if (lane == 0) bo[b * N + n] = s; }
            }
        }
        for (int r0 = gw * 2; r0 < MROWS; r0 += NGW * 2) {
            f32x4 v[2][4]; const float* gmv[2];
#pragma unroll
            for (int q = 0; q < 2; ++q) { const int r = r0 + q, b = r / TPB, tt = r - b * TPB, bidx = tt < CTX ? 8 : b;
                const float* src = tt < CTX ? ctx_in + ((size_t)b * CTX + tt) * D_MODEL : x_in + ((size_t)b * SEQ + (tt - CTX)) * D_MODEL;
                gmv[q] = vec + (size_t)(0 * 9 + bidx) * 6144 + VEC_GM1 * 1024;
#pragma unroll
                for (int j = 0; j < 4; ++j) v[q][j] = *(const f32x4*)(src + 256 * j + 4 * lane); }
#pragma unroll
            for (int q = 0; q < 2; ++q) { const int r = r0 + q; float ss = 0.f;
#pragma unroll
                for (int j = 0; j < 4; ++j) { const f32x4 g4 = *(const f32x4*)(gmv[q] + 256 * j + 4 * lane); ss += epi::sq4(v[q][j]);
                    const f32x4 t = v[q][j] * g4; u32x2 w; w.x = cvt_pk_bf16(t[0], t[1]); w.y = cvt_pk_bf16(t[2], t[3]); *(u32x2*)(xg + (size_t)r * D_MODEL + 256 * j + 4 * lane) = w; }
                ss = thin::wave_sum(ss);
                if (lane < 16) ssqx[(size_t)r * 16 + lane] = lane == 0 ? ss : 0.f; }
        }
    }
    } SEAM(2);
    for (int l = 0; l < DEPTH; ++l) {
        const int p0 = 3 + 6 * l; const bool lastl = (l == DEPTH - 1);
        const unsigned char* wtl = ws + WS_WT + (size_t)l * WT_LAYER;
        const float* vl = vec + (size_t)l * 9 * 6144;
    for (int rep_ = 0, NREP_CUR = NREP(p0); rep_ < NREP_CUR; ++rep_) { if (rep_) xcd_barrier(bar);
        if (EN(1) && IN(p0)) {
            pg8::Gemm g{xg, (const bf16_t*)(wtl + WT_IN)}; pg8::StaticOrder S; S.init(NPAN, ZW / 256, G, bx, 0);
            epi::EpiIn E{zb, ssqx, bias_in + (size_t)l * 9 * ZW, ssqkv, g_kn + l * 96, rtab};
            pg8::gemm_phase<1024, 1024, 1024, false>(lds, g, S, E);
        }
        } SEAM(p0);
    for (int rep_ = 0, NREP_CUR = NREP(p0 + 1); rep_ < NREP_CUR; ++rep_) { if (rep_) xcd_barrier(bar);
        if (IN(p0 + 1)) {
            if (EN(2)) { pg8::Gemm g{zb + Z_QL, (const bf16_t*)(wtl + WT_UQ)}; pg8::StaticOrder S; S.init(lastl ? 128 : NPAN, 3, G, bx, lastl ? 1 : 0);
              epi::EpiQ E{Qb, ssqq, g_qn + l * 96, rtab}; pg8::gemm_phase<384, ZW, 384, false>(lds, g, S, E); }
            if (EN(3)) { pg8::Gemm g{zb + Z_KVL, (const bf16_t*)(wtl + WT_UKV)}; pg8::StaticOrder S; S.init(NPAN, 4, G, (bx + 96) % G, 0);
              epi::EpiKV E{Kb, Vb, zb, ssqkv, g_kn + l * 96}; pg8::gemm_phase<256, ZW, 256, false>(lds, g, S, E); }
            thin::LruP P{zb, conv_w + l * 1024, conv_b + l * 256, (const bf16_t*)(wtl + WT_GATE), lru_b_a + l * 512, lru_b_x + l * 512, lru_lambda + l * 512, agg, mix};
            if (EN(4)) for (int it = G - 1 - vcu; it < NPAN * 4; it += G) thin::lru_item<1>(P, it >> 2, it & 3, ldsg);
            if (!EN(5)) {} else if (lastl) { for (int it = vcu; it < 128 * 4; it += G) { const int pl = it >> 2; thin::pool_item(zb, (const bf16_t*)(wtl + WT_POOL), mix, pl + pl / 16 + 1, it & 3, ldsg); } }
            else { for (int it = vcu; it < NPAN * 4; it += G) thin::pool_item(zb, (const bf16_t*)(wtl + WT_POOL), mix, it >> 2, it & 3, ldsg); }
        }
        } SEAM(p0 + 1);
    for (int rep_ = 0, NREP_CUR = NREP(p0 + 2); rep_ < NREP_CUR; ++rep_) { if (rep_) xcd_barrier(bar);
        if (IN(p0 + 2)) {
#ifndef SHIFT_THRESH
#define SHIFT_THRESH 64.0f
#endif
            float negB2; bool shifted;
            {
                const float* gq = g_qn + l * 96; const float* gk = g_kn + l * 96;
                float mq = fmaxf(fabsf(gq[lane]), lane < 32 ? fabsf(gq[64 + lane]) : 0.f), mk = fmaxf(fabsf(gk[lane]), lane < 32 ? fabsf(gk[64 + lane]) : 0.f);
#pragma unroll
                for (int o = 1; o < 64; o <<= 1) { mq = fmaxf(mq, __shfl_xor(mq, o)); mk = fmaxf(mk, __shfl_xor(mk, o)); }
                negB2 = -(96.0f * 1.02f * QSCALE) * mq * mk;
                shifted = __builtin_amdgcn_readfirstlane(negB2 < -SHIFT_THRESH ? 1 : 0) != 0;
                if (!shifted) negB2 = 0.f;
            }
            thin::LruP P{zb, conv_w + l * 1024, conv_b + l * 256, (const bf16_t*)(wtl + WT_GATE), lru_b_a + l * 512, lru_b_x + l * 512, lru_lambda + l * 512, agg, mix};
            if (!EN(6)) {} else if (lastl) { for (int it = vcu; it < 128 * 4; it += G) { const int pl = it >> 2; thin::lru_item<2>(P, pl + pl / 16 + 1, it & 3, ldsg); } }
            else { for (int it = vcu; it < NPAN * 4; it += G) thin::lru_item<2>(P, it >> 2, it & 3, ldsg); }
            if (EN(7)) for (int it = vcu; it < 1024; it += G) {
                const int bh = it >> 4, qp = it & 15, b = bh >> 3, h = bh & 7;
                #ifdef ATT_VAR
                if (rep_ == 0 && NREP(p0 + 2) == 2) att::attn_unit<ATT_VAR>(Qb, Kb, Vb, mix, ssqkv, ssqq, negB2, b * TPB + CTX + qp * 256, b * TPB, TPB, h, ldsg); else
#endif
                if (shifted) att::attn_unit<9>(Qb, Kb, Vb, mix, ssqkv, ssqq, negB2, b * TPB + CTX + qp * 256, b * TPB, TPB, h, ldsg);
                else att::attn_unit<0>(Qb, Kb, Vb, mix, ssqkv, ssqq, negB2, b * TPB + CTX + qp * 256, b * TPB, TPB, h, ldsg);
            }
            if (EN(7) && !lastl) for (int it = G - 1 - vcu; it < 64; it += G) { const int b = it >> 3, h = it & 7;
                if (shifted) att::attn_unit<9>(Qb, Kb, Vb, mix, ssqkv, ssqq, negB2, b * TPB, b * TPB, CTX, h, ldsg); else att::attn_unit<0>(Qb, Kb, Vb, mix, ssqkv, ssqq, negB2, b * TPB, b * TPB, CTX, h, ldsg); }
        }
        } SEAM(p0 + 2);
    for (int rep_ = 0, NREP_CUR = NREP(p0 + 3); rep_ < NREP_CUR; ++rep_) { if (rep_) xcd_barrier(bar);
        if (EN(8) && IN(p0 + 3)) {
            pg8::Gemm g{mix, (const bf16_t*)(wtl + WT_OUT)}; pg8::StaticOrder S; S.init(lastl ? 128 : NPAN, 4, G, bx, lastl ? 1 : 0);
            if (l == 0) { epi::EpiRes<true, false> E{x_in, ctx_in, nullptr, xg, ssqx, vl + VEC_G1 * 1024, nullptr, vl + VEC_GM2 * 1024}; pg8::gemm_phase<1024, 1024, 1024, false>(lds, g, S, E); }
            else { epi::EpiRes<false, false> E{nullptr, nullptr, nullptr, xg, ssqx, vl + VEC_G1 * 1024, rvec + (size_t)l * 9 * 2048, vl + VEC_GM2 * 1024}; pg8::gemm_phase<1024, 1024, 1024, false>(lds, g, S, E); }
        }
        } SEAM(p0 + 3);
    for (int rep_ = 0, NREP_CUR = NREP(p0 + 4); rep_ < NREP_CUR; ++rep_) { if (rep_) xcd_barrier(bar);
        if (EN(9) && IN(p0 + 4)) {
            pg8::Gemm g{xg, (const bf16_t*)(wtl + WT_FF1)}; pg8::StaticOrder S; S.init(lastl ? 128 : NPAN, 16, G, bx, lastl ? 1 : 0);
            epi::EpiFF1 E{U, ssqx, bias_ff + (size_t)l * 9 * D_FF};
            pg8::gemm_phase<1024, 1024, 1024, false>(lds, g, S, E);
        }
        } SEAM(p0 + 4);
    for (int rep_ = 0, NREP_CUR = NREP(p0 + 5); rep_ < NREP_CUR; ++rep_) { if (rep_) xcd_barrier(bar);
        if (EN(10) && IN(p0 + 5)) {
            pg8::Gemm g{U, (const bf16_t*)(wtl + WT_FF2)}; pg8::StaticOrder S; S.init(lastl ? 128 : NPAN, 4, G, bx, lastl ? 1 : 0);
            if (lastl) { epi::EpiRes<false, true> E{nullptr, nullptr, out, xg, nullptr, vl + VEC_G2 * 1024, rvec + (size_t)l * 9 * 2048 + 1024, nullptr}; pg8::gemm_phase<4096, 4096, 4096, true>(lds, g, S, E); }
            else {
                { pg8::StaticOrder SL; SL.init(128, 4, G, bx, 1);
                  epi::EpiRes<false, false> E{nullptr, nullptr, nullptr, xg, ssqx, vl + VEC_G2 * 1024, rvec + (size_t)l * 9 * 2048 + 1024, vec + (size_t)(l + 1) * 9 * 6144 + VEC_GM1 * 1024}; pg8::gemm_phase<4096, 4096, 4096, true>(lds, g, SL, E); }
                float* slab = out + (size_t)18 * 1024 * 1024;
                { pg8::CtxSplitOrder SC{4, 4, 1024, G, bx, 1}; epi::EpiSlab E{slab, 1024}; pg8::gemm_phase<1024, 4096, 4096, true>(lds, g, SC, E); }
                xcd_barrier(bar);
                ctx_combine(ws, out, rvec + (size_t)(l * 9 + 8) * 2048 + 1024, vl + 8 * 6144 + VEC_G2 * 1024, vec + (size_t)(l + 1) * 9 * 6144 + 8 * 6144 + VEC_GM1 * 1024, gw, NGW, lane);
            }
        }
        } if (!lastl) SEAM(p0 + 5);
    }
#undef IN
#undef SEAM
}


#ifdef DBG_DUMP
__global__ void dbg_dump(const bf16_t* buf, int pitch, int coloff, int ncols, float* out) {
    for (size_t i = blockIdx.x * (size_t)blockDim.x + threadIdx.x; i < (size_t)BATCH * SEQ * D_MODEL; i += (size_t)gridDim.x * blockDim.x) {
        const int c = (int)(i & 1023); const size_t rt = i >> 10; const int b = (int)(rt / SEQ), t = (int)(rt - (size_t)b * SEQ);
        out[i] = c < ncols ? bf2f(buf[((size_t)b * TPB + CTX + t) * pitch + coloff + c]) : 0.f;
    }
}
#endif
#ifndef N_LAUNCH_MODE
#define N_LAUNCH_MODE 1
#endif
extern "C" void kernel_launch(void* const* d_in, const int* in_sizes, int n_in, void* d_out, int out_size, void* d_ws, size_t ws_size, hipStream_t stream) {
    static int grid = 0;
    if (grid == 0) {
        if (n_in != 27 || in_sizes[0] != BATCH * SEQ * D_MODEL || out_size != BATCH * SEQ * D_MODEL || ws_size < WS_END) { fprintf(stderr, "kernel_launch: unexpected shapes (n_in %d, in0 %d, out %d, ws %zu < %zu)\n", n_in, n_in > 0 ? in_sizes[0] : -1, out_size, ws_size, (size_t)WS_END); grid = -1; return; }
        int dev = 0, cus = 0, per_cu = 0;
        if (hipGetDevice(&dev) != hipSuccess || hipDeviceGetAttribute(&cus, hipDeviceAttributeMultiprocessorCount, dev) != hipSuccess) { grid = -1; return; }
        if (hipFuncSetAttribute((const void*)fwd_kernel, hipFuncAttributeMaxDynamicSharedMemorySize, LDS_BYTES) != hipSuccess) { fprintf(stderr, "kernel_launch: hipFuncSetAttribute failed\n"); grid = -1; return; }
        if (hipOccupancyMaxActiveBlocksPerMultiprocessor(&per_cu, (const void*)fwd_kernel, NWAVES * 64, LDS_BYTES) != hipSuccess || per_cu < 1) { fprintf(stderr, "kernel_launch: occupancy query says %d blocks per CU\n", per_cu); (void)hipGetLastError(); grid = -1; return; }
        grid = cus;
    }
    if (grid < 0) return;
    (void)hipMemsetAsync((char*)d_ws + WS_CTL, 0, CTL_ZERO_BYTES, stream);
    Args a{};
    for (int i = 0; i < 27; ++i) a.in[i] = (const float*)d_in[i];
    a.out = (float*)d_out; a.ws = (unsigned char*)d_ws;
#if N_LAUNCH_MODE
    a.ph_lo = 0; a.ph_hi = NPHASE;
    void* kargs[] = {&a};
    hipError_t e = hipLaunchCooperativeKernel((const void*)fwd_kernel, dim3(grid), dim3(NWAVES * 64), kargs, LDS_BYTES, stream);
    if (e != hipSuccess) fprintf(stderr, "kernel_launch: cooperative launch failed: %s\n", hipGetErrorString(e));
#else
#ifndef DBG_STOP_PHASE
#define DBG_STOP_PHASE NPHASE
#endif
    for (int p = 0; p < DBG_STOP_PHASE; ++p) { a.ph_lo = p; a.ph_hi = p + 1; hipLaunchKernelGGL(fwd_kernel, dim3(grid), dim3(NWAVES * 64), LDS_BYTES, stream, a); }
#ifdef DBG_DUMP
    hipLaunchKernelGGL(dbg_dump, dim3(2048), dim3(256), 0, stream, (const bf16_t*)((unsigned char*)d_ws + DBG_DUMP_OFF), DBG_DUMP_PITCH, DBG_DUMP_COL, DBG_DUMP_NCOLS, (float*)d_out);
#endif
#endif
}
```

```cpp
#include <hip/hip_runtime.h>
#include <cstdio>
#include <cstdint>

#define LAS __attribute__((address_space(3)))
#define GAS __attribute__((address_space(1)))
typedef unsigned short bf16_t;
typedef short bf16x8 __attribute__((ext_vector_type(8)));
typedef short s16x4 __attribute__((ext_vector_type(4)));
typedef float f32x4 __attribute__((ext_vector_type(4)));
typedef float f32x2 __attribute__((ext_vector_type(2)));
typedef float f32x16 __attribute__((ext_vector_type(16)));
typedef unsigned u32x4 __attribute__((ext_vector_type(4)));
typedef unsigned u32x2 __attribute__((ext_vector_type(2)));

constexpr int D_MODEL = 1024, BATCH = 8, SEQ = 4096, DEPTH = 2, CTX = 256, D_IN = 1440, D_FF = 4096;
constexpr int TPB = SEQ + CTX;
constexpr int MROWS = BATCH * TPB;
constexpr int PPB = TPB / 256;
constexpr int NPAN = MROWS / 256;
constexpr int ZW = 1536;
constexpr int Z_LX = 0, Z_LG = 256, Z_KVL = 512, Z_PU = 768, Z_QL = 1024, Z_KR = 1408;
constexpr float EPS = 1e-6f;
constexpr float QSCALE = 0.10206207261596575f * 1.4426950408889634f;

typedef __bf16 bf16x2_t __attribute__((ext_vector_type(2)));
__device__ __forceinline__ unsigned cvt_pk_bf16(float lo, float hi) { f32x2 v = {lo, hi}; bf16x2_t b = __builtin_convertvector(v, bf16x2_t); return __builtin_bit_cast(unsigned, b); }
__device__ __forceinline__ float bf2f(unsigned short h) { return __uint_as_float((unsigned)h << 16); }
__device__ __forceinline__ float bflo(unsigned w) { return __uint_as_float(w << 16); }
__device__ __forceinline__ float bfhi(unsigned w) { return __uint_as_float(w & 0xffff0000u); }
__device__ __forceinline__ unsigned short f2bf(float f) { unsigned u = __float_as_uint(f); return (unsigned short)((u + 0x7fffu + ((u >> 16) & 1u)) >> 16); }

namespace pg8 {
constexpr int BM = 256, BK = 64, HALF = 128, HTB = HALF * BK * 2, STAGE_BYTES = 8 * HTB, NXCD = 8, WGM = 8;
__host__ __device__ __forceinline__ int lds_byte(int r, int c) { const int st = (r >> 4) * 2 + (c >> 5), rr = r & 15, cc = c & 31, ob = rr * 64 + cc * 2; return st * 1024 + (ob ^ (((ob >> 9) & 1) << 5)); }
__host__ __device__ __forceinline__ void stage_rc(int b, int& R, int& C) { const int st = b / 1024, sb = b % 1024, swz = sb ^ (((sb >> 9) & 1) << 5); R = (st >> 1) * 16 + swz / 64; C = (st & 1) * 32 + (swz % 64) / 2; }
__host__ __device__ __forceinline__ int perm32(int rho) { const int n = rho >> 4, i = rho & 15; return 8 * (i >> 2) + 4 * n + (i & 3); }

struct Unit { int pm, pn; unsigned koffA, koffB; };
struct Gemm { const bf16_t* A; const bf16_t* Bt; };

struct StaticOrder {
    int nM, nN, nwg, G, c, latonly;
    __device__ void init(int nM_, int nN_, int G_, int c_, int latonly_) { nM = nM_; nN = nN_; nwg = nM * nN; G = G_; c = c_; latonly = latonly_; }
    __device__ bool next(int i, Unit& u) const {
        const long L = (long)i * G + c; if (L >= nwg) return false;
        int wgid = (int)L; { const int q = nwg / NXCD, r = nwg % NXCD, xcd = wgid % NXCD, off = wgid / NXCD; wgid = (xcd < r ? xcd * (q + 1) : r * (q + 1) + (xcd - r) * q) + off; }
        const int nig = WGM * nN, gid = wgid / nig, fm = gid * WGM, gsz = (nM - fm) < WGM ? (nM - fm) : WGM;
        int pm = fm + ((wgid % nig) % gsz); u.pn = (wgid % nig) / gsz;
        if (latonly) pm = pm + pm / 16 + 1;
        u.pm = pm; u.koffA = 0u; u.koffB = 0u; return true;
    }
    __device__ __forceinline__ void a_ready(const Unit&) const {}
    __device__ __forceinline__ void done(const Unit&) const {}
};
struct CtxSplitOrder {
    int nN, NS, KS, G, c, ablk;
    __device__ bool next(int i, Unit& u) const {
        const int L = i * G + c; if (L >= 8 * nN * NS) return false;
        const int ks = L % NS, t = L / NS; u.pn = t % nN; u.pm = (t / nN) * 17; u.koffB = (unsigned)(ks * KS * 2); u.koffA = ablk ? (unsigned)(ks * (KS / 32) * 16384) : u.koffB; return true;
    }
    __device__ __forceinline__ void a_ready(const Unit&) const {}
    __device__ __forceinline__ void done(const Unit&) const {}
};
struct CtxProdOrder {
    int unit, nsel, pn0, pstep; unsigned* ready;
    __device__ void init(int c, int c0, int cstride, int nsel_, int pn0_, int pstep_, unsigned* ready_) { const int d = c - c0; unit = (d >= 0 && d % cstride == 0 && d / cstride < 8 * nsel_) ? d / cstride : -1; nsel = nsel_; pn0 = pn0_; pstep = pstep_; ready = ready_; }
    __device__ bool next(int i, Unit& u) const { if (i != 0 || unit < 0) return false; u.pm = 17 * (unit / nsel); u.pn = pn0 + pstep * (unit % nsel); u.koffA = 0u; u.koffB = 0u; return true; }
    __device__ __forceinline__ void a_ready(const Unit&) const {}
    __device__ __forceinline__ void done(const Unit& u) const {
        asm volatile("s_waitcnt vmcnt(0)" ::: "memory");
        __builtin_amdgcn_fence(__ATOMIC_RELEASE, "agent");
        asm volatile("s_waitcnt vmcnt(0)" ::: "memory");
        if ((threadIdx.x & 63) == 0) (void)__hip_atomic_fetch_add(ready + 64 * (u.pm / 17), 1u, __ATOMIC_RELAXED, __HIP_MEMORY_SCOPE_AGENT);
    }
};
struct GatedOrder {
    int nN, nwg, G, c; const unsigned* ready; unsigned need; unsigned* tmo;
    __device__ void init(int nN_, int G_, int c_, const unsigned* ready_, unsigned need_, unsigned* tmo_) { nN = nN_; nwg = 136 * nN_; G = G_; c = c_; ready = ready_; need = need_; tmo = tmo_; }
    __device__ bool next(int i, Unit& u) const {
        const long L = (long)i * G + c; if (L >= nwg) return false;
        int wgid = (int)L; { const int q = nwg / NXCD, r = nwg % NXCD, xcd = wgid % NXCD, off = wgid / NXCD; wgid = (xcd < r ? xcd * (q + 1) : r * (q + 1) + (xcd - r) * q) + off; }
        const int nig = WGM * nN, gid = wgid / nig, fm = gid * WGM;
        const int q = fm + ((wgid % nig) % WGM); u.pn = (wgid % nig) / WGM;
        u.pm = q < 128 ? q + q / 16 + 1 : (q - 128) * 17; u.koffA = 0u; u.koffB = 0u; return true;
    }
    __device__ __forceinline__ void a_ready(const Unit& u) const {
        if (u.pm % 17 != 0) return;
        if (threadIdx.x < 64) {
            const unsigned* w = ready + 64 * (u.pm / 17); unsigned sp = 0u;
            while ((unsigned)__builtin_amdgcn_readfirstlane(__hip_atomic_load(w, __ATOMIC_RELAXED, __HIP_MEMORY_SCOPE_AGENT)) < need) {
                __builtin_amdgcn_s_sleep(2);
                if ((++sp & 255u) == 0u) { if (__hip_atomic_load(tmo, __ATOMIC_RELAXED, __HIP_MEMORY_SCOPE_AGENT)) break; if (sp > (1u << 20)) { if (threadIdx.x == 0) atomicAdd(tmo, 1u); break; } } }
            __builtin_amdgcn_fence(__ATOMIC_ACQUIRE, "agent");
            asm volatile("s_waitcnt vmcnt(0)" ::: "memory");
        }
        asm volatile("" ::: "memory"); __builtin_amdgcn_s_barrier(); asm volatile("" ::: "memory");
    }
    __device__ __forceinline__ void done(const Unit&) const {}
};

template <int K, int LDA, int LDB, bool ABLK, class Epi, class Sched>
__device__ __forceinline__ void gemm_phase(LAS unsigned char* lds, const Gemm g, const Sched& S, const Epi& E) {
    int tid = threadIdx.x; asm volatile("" : "+v"(tid));
    const int  wid = __builtin_amdgcn_readfirstlane(tid >> 6), lane = tid & 63, wr = wid >> 2, wc = wid & 3, fr = lane & 15, fq = lane >> 4;
    constexpr int nt = K / BK;
    unsigned voffA[2], voffB[2];
#pragma unroll
    for (int i = 0; i < 2; ++i) { int R, C; stage_rc(tid * 16 + i * 8192, R, C); const int Rb = Epi::PERM ? ((R & ~31) + perm32(R & 31)) : R;
        voffA[i] = ABLK ? (unsigned)((C >> 5) * 16384 + (R >> 4) * 1024 + ((R & 15) * 32 + (C & 31)) * 2) : (unsigned)(R * LDA + C) * 2u; voffB[i] = (unsigned)(Rb * LDB + C) * 2u; }
    const size_t kstep = (size_t)(BK * 2);
    const size_t kstepA = ABLK ? (size_t)32768 : kstep;
    const size_t hstepA = ABLK ? (size_t)8192 : (size_t)HALF * LDA * 2, tstepA = ABLK ? (size_t)(LDA / 32) * 16384 : 2 * hstepA;
    const size_t hstepB = (size_t)HALF * LDB * 2, tstepB = 2 * hstepB;
    const unsigned ldsw = (unsigned)wid * 1024u;
    const int aoff = lds_byte(wr * 64 + fr, fq * 8), boff = lds_byte(wc * 32 + fr, fq * 8);
#define PG8_SA(b, h) (((b) * 2 + (h)) * HTB)
#define PG8_SB(b, h) ((4 + (b) * 2 + (h)) * HTB)
#define PG8_STAGE(bufoff, gbase, voff) do { _Pragma("unroll") for (int _i = 0; _i < 2; ++_i) \
        __builtin_amdgcn_global_load_lds((const unsigned*)((const char*)(gbase) + (voff)[_i]), (LAS unsigned*)(lds + (bufoff) + ldsw + _i * 8192), 16, 0, 0); } while (0)
#define PG8_LDA(dst, b, h) do { _Pragma("unroll") for (int m = 0; m < 4; ++m) _Pragma("unroll") for (int k = 0; k < 2; ++k) dst[m][k] = *(const LAS bf16x8*)(lds + PG8_SA(b, h) + aoff + m * 2048 + k * 1024); } while (0)
#define PG8_LDB(dst, b, h) do { _Pragma("unroll") for (int n = 0; n < 2; ++n) _Pragma("unroll") for (int k = 0; k < 2; ++k) dst[n][k] = *(const LAS bf16x8*)(lds + PG8_SB(b, h) + boff + n * 2048 + k * 1024); } while (0)
#define PG8_MMA(ai, bj, At, Bt) do { __builtin_amdgcn_s_setprio(1); _Pragma("unroll") for (int m = 0; m < 4; ++m) _Pragma("unroll") for (int n = 0; n < 2; ++n) _Pragma("unroll") for (int k = 0; k < 2; ++k) \
        acc[ai][bj][m][n] = __builtin_amdgcn_mfma_f32_16x16x32_bf16(Bt[n][k], At[m][k], acc[ai][bj][m][n], 0, 0, 0); __builtin_amdgcn_s_setprio(0); } while (0)
#define PG8_WAIT_V(n) asm volatile("s_waitcnt vmcnt(" #n ")" ::: "memory")
#define PG8_WAIT_L(n) asm volatile("s_waitcnt lgkmcnt(" #n ")" ::: "memory")
#define PG8_BAR __builtin_amdgcn_s_barrier()
#define PG8_SCHED __builtin_amdgcn_sched_barrier(0)
    Unit cur, nxt; int ui = 0;
    if (!S.next(0, cur)) return;
    f32x4 acc[2][2][4][2];
#pragma unroll
    for (int a = 0; a < 2; ++a)
#pragma unroll
        for (int b = 0; b < 2; ++b)
#pragma unroll
            for (int m = 0; m < 4; ++m)
#pragma unroll
                for (int n = 0; n < 2; ++n) acc[a][b][m][n] = (f32x4){0.f, 0.f, 0.f, 0.f};
    bf16x8 At[4][2], B0[2][2], B1[2][2];
    const char* cA = (const char*)g.A + (size_t)cur.pm * tstepA + cur.koffA; const char* cB = (const char*)g.Bt + (size_t)cur.pn * tstepB + cur.koffB;
    S.a_ready(cur);
    PG8_STAGE(PG8_SB(0, 0), cB, voffB); PG8_STAGE(PG8_SB(0, 1), cB + hstepB, voffB); PG8_STAGE(PG8_SA(0, 0), cA, voffA); PG8_STAGE(PG8_SA(0, 1), cA + hstepA, voffA);
    if (wr == 1) PG8_BAR;
    PG8_WAIT_V(2); PG8_BAR;
    PG8_STAGE(PG8_SB(1, 0), cB + kstep, voffB); PG8_STAGE(PG8_SA(1, 0), cA + kstepA, voffA); PG8_STAGE(PG8_SB(1, 1), cB + hstepB + kstep, voffB);
    PG8_WAIT_V(6); PG8_BAR;
    for (;;) {
        const bool has_next = S.next(ui + 1, nxt);
        const char* nA = has_next ? (const char*)g.A + (size_t)nxt.pm * tstepA + nxt.koffA : cA; const char* nB = has_next ? (const char*)g.Bt + (size_t)nxt.pn * tstepB + nxt.koffB : cB;
#pragma unroll 1
        for (int t = 0; t < nt; t += 2) {
            const bool last = (t == nt - 2);
            const char* a1 = cA + (size_t)(t + 1) * kstepA;
            const char* a2 = last ? nA : cA + (size_t)(t + 2) * kstepA; const char* b2 = last ? nB : cB + (size_t)(t + 2) * kstep;
            const char* a3 = a2 + kstepA; const char* b3 = b2 + kstep;
            if (last && has_next) S.a_ready(nxt);
            PG8_LDB(B0, 0, 0); PG8_LDB(B1, 0, 1); PG8_SCHED; PG8_LDA(At, 0, 0); PG8_STAGE(PG8_SA(1, 1), a1 + hstepA, voffA);
            PG8_WAIT_V(8); PG8_WAIT_L(0); PG8_BAR; PG8_MMA(0, 0, At, B0); PG8_MMA(0, 1, At, B1); PG8_BAR; PG8_SCHED;
            PG8_LDA(At, 0, 1); PG8_STAGE(PG8_SB(0, 0), b2, voffB); PG8_STAGE(PG8_SB(0, 1), b2 + hstepB, voffB); PG8_STAGE(PG8_SA(0, 0), a2, voffA);
            PG8_WAIT_V(8); PG8_WAIT_L(0); PG8_BAR; PG8_MMA(1, 0, At, B0); PG8_MMA(1, 1, At, B1); PG8_BAR; PG8_SCHED;
            PG8_LDB(B0, 1, 0); PG8_LDB(B1, 1, 1); PG8_SCHED; PG8_LDA(At, 1, 0); PG8_STAGE(PG8_SA(0, 1), a2 + hstepA, voffA);
            PG8_WAIT_V(8); PG8_WAIT_L(0); PG8_BAR; PG8_MMA(0, 0, At, B0); PG8_MMA(0, 1, At, B1); PG8_BAR; PG8_SCHED;
            PG8_LDA(At, 1, 1); PG8_STAGE(PG8_SB(1, 0), b3, voffB); PG8_STAGE(PG8_SB(1, 1), b3 + hstepB, voffB); PG8_STAGE(PG8_SA(1, 0), a3, voffA);
            PG8_WAIT_V(8); PG8_WAIT_L(0); PG8_BAR; PG8_MMA(1, 0, At, B0); PG8_MMA(1, 1, At, B1); PG8_BAR; PG8_SCHED;
        }
        if (wr == 0) PG8_BAR;
        { int fr2 = fr, fq2 = fq; asm volatile("" : "+v"(fr2), "+v"(fq2));
          E(acc, cur, wr, wc, fr2, fq2); }
        S.done(cur);
        if (!has_next) break;
#pragma unroll
        for (int a = 0; a < 2; ++a)
#pragma unroll
            for (int b = 0; b < 2; ++b)
#pragma unroll
                for (int m = 0; m < 4; ++m)
#pragma unroll
                    for (int n = 0; n < 2; ++n) acc[a][b][m][n] = (f32x4){0.f, 0.f, 0.f, 0.f};
        cur = nxt; cA = nA; cB = nB; ++ui;
        if (wr == 1) PG8_BAR;
    }
    PG8_WAIT_V(0);
    PG8_BAR;
#undef PG8_SA
#undef PG8_SB
#undef PG8_STAGE
#undef PG8_LDA
#undef PG8_LDB
#undef PG8_MMA
#undef PG8_WAIT_V
#undef PG8_WAIT_L
#undef PG8_BAR
#undef PG8_SCHED
}
}
namespace epi {
using pg8::Unit;
typedef f32x4 Acc[2][2][4][2];
__device__ __forceinline__ float sum4(f32x4 v) { return (v[0] + v[1]) + (v[2] + v[3]); }
__device__ __forceinline__ float sq4(f32x4 v) { return (v[0] * v[0] + v[1] * v[1]) + (v[2] * v[2] + v[3] * v[3]); }
__device__ __forceinline__ float red_fq(float s) { s += __shfl_xor(s, 16); s += __shfl_xor(s, 32); return s; }
__device__ __forceinline__ u32x4 pack8(f32x4 a, f32x4 b) { u32x4 w; w.x = cvt_pk_bf16(a[0], a[1]); w.y = cvt_pk_bf16(a[2], a[3]); w.z = cvt_pk_bf16(b[0], b[1]); w.w = cvt_pk_bf16(b[2], b[3]); return w; }
__device__ __forceinline__ void rope4(f32x4& x1, f32x4& x2, const float* rtab, int t, int fq) {
    const int idx = (fq >> 1) ? (t & 63) : (t >> 6);
    const f32x4 c0 = *(const f32x4*)(rtab + (idx * 8 + (fq & 1) * 4) * 2), c1 = *(const f32x4*)(rtab + (idx * 8 + (fq & 1) * 4) * 2 + 4);
    const f32x4 cs = (f32x4){c0[0], c0[2], c1[0], c1[2]}, sn = (f32x4){c0[1], c0[3], c1[1], c1[3]};
    const f32x4 y1 = x1 * cs - x2 * sn, y2 = x2 * cs + x1 * sn; x1 = y1; x2 = y2;
}
__device__ __forceinline__ float row_rstd16(const float* ssq, int row, int fq, float inv_n) {
    const f32x4 p = *(const f32x4*)(ssq + (size_t)row * 16 + 4 * fq); return rsqrtf(red_fq(sum4(p)) * inv_n + EPS);
}

struct EpiIn {
    static constexpr bool PERM = true;
    bf16_t* z; const float* ssqx; const float* bias; float* ssqkv; const float* gkn; const float* rtab;
    __device__ __forceinline__ void operator()(const Acc& acc, const Unit& u, int wr, int wc, int fr, int fq) const {
        const int pm = u.pm, pn = u.pn, b = pm / PPB, pp = pm - b * PPB, bidx = pp == 0 ? 8 : b;
        const float* bia = bias + bidx * ZW + pn * 256 + wc * 32 + 8 * fq;
        f32x4 bv[2][2];
#pragma unroll
        for (int bj = 0; bj < 2; ++bj)
#pragma unroll
            for (int n = 0; n < 2; ++n) bv[bj][n] = *(const f32x4*)(bia + bj * 128 + 4 * n);
        const int ax = fq >> 1, f0 = (fq & 1) * 4;
        const f32x4 gk1 = *(const f32x4*)(gkn + 64 + ax * 16 + f0), gk2 = *(const f32x4*)(gkn + 64 + ax * 16 + 8 + f0);
#pragma unroll
        for (int ai = 0; ai < 2; ++ai)
#pragma unroll
            for (int m = 0; m < 4; ++m) {
                const int rl = ai * 128 + wr * 64 + m * 16 + fr, row = pm * 256 + rl;
                const float rs = row_rstd16(ssqx, row, fq, 1.0f / 1024.0f);
                f32x4 v[2][2];
#pragma unroll
                for (int bj = 0; bj < 2; ++bj)
#pragma unroll
                    for (int n = 0; n < 2; ++n) v[bj][n] = acc[ai][bj][m][n] * rs + bv[bj][n];
                if (pn == 2 || pn == 4) {
                    const float s = red_fq((sq4(v[0][0]) + sq4(v[0][1])) + (sq4(v[1][0]) + sq4(v[1][1])));
                    if (fq == 0) ssqkv[(size_t)row * 16 + (pn == 2 ? wc : 4 + wc)] = s;
                }
                if (pn == 5) {
                    const float s = red_fq(sq4(v[0][0]) + sq4(v[0][1]));
                    if (fq == 0) ssqkv[(size_t)row * 16 + 8 + wc] = s;
                    if (wc == 0) {
                        const float s1 = red_fq(sq4(v[1][0]) + sq4(v[1][1]));
                        if (fq == 0) ssqkv[(size_t)row * 16 + 12] = s1;
                        v[1][0] = v[1][0] * gk1; v[1][1] = v[1][1] * gk2;
                        if (pp != 0) rope4(v[1][0], v[1][1], rtab, (pp - 1) * 256 + rl, fq);
                    }
                }
                bf16_t* zp = z + (size_t)row * ZW + pn * 256 + wc * 32 + 8 * fq;
#pragma unroll
                for (int bj = 0; bj < 2; ++bj) *(u32x4*)(zp + bj * 128) = pack8(v[bj][0], v[bj][1]);
                asm volatile("" ::: "memory");
            }
    }
};

struct EpiQ {
    static constexpr bool PERM = true;
    bf16_t* Q; float* ssqq; const float* gqn; const float* rtab;
    __device__ __forceinline__ void operator()(const Acc& acc, const Unit& u, int wr, int wc, int fr, int fq) const {
        const int pm = u.pm, pn = u.pn, b = pm / PPB, pp = pm - b * PPB;
        const int ax = fq >> 1, f0 = (fq & 1) * 4;
        f32x4 g0[2], g1[2]; int part[2], grp[2];
#pragma unroll
        for (int bj = 0; bj < 2; ++bj) {
            grp[bj] = pn * 8 + bj * 4 + wc; part[bj] = grp[bj] % 3;
            if (part[bj] < 2) { g0[bj] = *(const f32x4*)(gqn + 32 * part[bj] + 8 * fq); g1[bj] = *(const f32x4*)(gqn + 32 * part[bj] + 8 * fq + 4); }
            else { g0[bj] = *(const f32x4*)(gqn + 64 + ax * 16 + f0); g1[bj] = *(const f32x4*)(gqn + 64 + ax * 16 + 8 + f0); }
        }
#pragma unroll
        for (int ai = 0; ai < 2; ++ai)
#pragma unroll
            for (int m = 0; m < 4; ++m) {
                const int rl = ai * 128 + wr * 64 + m * 16 + fr, row = pm * 256 + rl;
                bf16_t* qp = Q + (size_t)row * 768 + pn * 256 + wc * 32 + 8 * fq;
#pragma unroll
                for (int bj = 0; bj < 2; ++bj) {
                    const f32x4 a0 = acc[ai][bj][m][0], a1 = acc[ai][bj][m][1];
                    const float s = red_fq(sq4(a0) + sq4(a1));
                    if (fq == 0) ssqq[(size_t)row * 24 + grp[bj]] = s;
                    f32x4 v0 = a0 * g0[bj], v1 = a1 * g1[bj];
                    if (part[bj] == 2 && pp != 0) rope4(v0, v1, rtab, (pp - 1) * 256 + rl, fq);
                    *(u32x4*)(qp + bj * 128) = pack8(v0, v1);
                }
                asm volatile("" ::: "memory");
            }
    }
};

struct EpiKV {
    static constexpr bool PERM = true;
    bf16_t* Kb; bf16_t* Vb; const bf16_t* z; const float* ssqkv; const float* gkn;
    __device__ __forceinline__ void operator()(const Acc& acc, const Unit& u, int wr, int wc, int fr, int fq) const {
        const int pm = u.pm, pn = u.pn;
        f32x4 gk[2][2];
#pragma unroll
        for (int bj = 0; bj < 2; ++bj)
#pragma unroll
            for (int n = 0; n < 2; ++n) gk[bj][n] = *(const f32x4*)(gkn + 32 * bj + 8 * fq + 4 * n);
#pragma unroll
        for (int ai = 0; ai < 2; ++ai)
#pragma unroll
            for (int m = 0; m < 4; ++m) {
                const int rl = ai * 128 + wr * 64 + m * 16 + fr, row = pm * 256 + rl;
                const f32x4 st = *(const f32x4*)(ssqkv + (size_t)row * 16);
                const float s = rsqrtf(sum4(st) * (1.0f / 256.0f) + EPS);
                if (pn < 2) {
                    const int head = 4 * pn + wc;
                    const float ss = red_fq((sq4(acc[ai][0][m][0]) + sq4(acc[ai][0][m][1])) + (sq4(acc[ai][1][m][0]) + sq4(acc[ai][1][m][1])));
                    const float sskr = ssqkv[(size_t)row * 16 + 12];
                    const float rk = rsqrtf((s * s * ss + sskr) * (1.0f / 96.0f) + EPS);
                    const float sk = s * rk;
                    bf16_t* kp = Kb + (size_t)row * 768 + head * 96;
#pragma unroll
                    for (int bj = 0; bj < 2; ++bj) *(u32x4*)(kp + 32 * bj + 8 * fq) = pack8(acc[ai][bj][m][0] * gk[bj][0] * sk, acc[ai][bj][m][1] * gk[bj][1] * sk);
                    const u32x4 kr = *(const u32x4*)(z + (size_t)row * ZW + Z_KR + 8 * fq);
                    u32x4 o;
                    o.x = cvt_pk_bf16(bflo(kr.x) * rk, bfhi(kr.x) * rk); o.y = cvt_pk_bf16(bflo(kr.y) * rk, bfhi(kr.y) * rk);
                    o.z = cvt_pk_bf16(bflo(kr.z) * rk, bfhi(kr.z) * rk); o.w = cvt_pk_bf16(bflo(kr.w) * rk, bfhi(kr.w) * rk);
                    *(u32x4*)(kp + 64 + 8 * fq) = o;
                } else {
                    const int head = 4 * (pn - 2) + wc;
                    bf16_t* vp = Vb + (size_t)row * 512 + head * 64;
#pragma unroll
                    for (int bj = 0; bj < 2; ++bj) *(u32x4*)(vp + 32 * bj + 8 * fq) = pack8(acc[ai][bj][m][0] * s, acc[ai][bj][m][1] * s);
                }
                if (m & 1) asm volatile("" ::: "memory");
            }
    }
};

template <bool IN_F32, bool OUT_F32>
struct EpiRes {
    static constexpr bool PERM = true;
    const float* xin_lat; const float* xin_ctx; float* xout; bf16_t* xg; float* ssqx; const float* gate; const float* rgm_prev; const float* gm;
    __device__ __forceinline__ void operator()(const Acc& acc, const Unit& u, int wr, int wc, int fr, int fq) const {
        const int pm = u.pm, pn = u.pn, b = pm / PPB, pp = pm - b * PPB, bidx = pp == 0 ? 8 : b;
        const size_t rbase = pp == 0 ? (size_t)b * 256 : (size_t)b * SEQ + (size_t)(pp - 1) * 256;
        const float* xi = IN_F32 ? (pp == 0 ? xin_ctx : xin_lat) + rbase * D_MODEL : nullptr;
        float* xo = OUT_F32 ? xout + rbase * D_MODEL : nullptr;
        const int col0 = pn * 256 + wc * 32 + 8 * fq;
        f32x4 gv[2][2], mv[2][2], rv[2][2];
#pragma unroll
        for (int bj = 0; bj < 2; ++bj)
#pragma unroll
            for (int n = 0; n < 2; ++n) { gv[bj][n] = *(const f32x4*)(gate + bidx * 6144 + col0 + bj * 128 + n * 4);
                mv[bj][n] = OUT_F32 ? (f32x4){0.f, 0.f, 0.f, 0.f} : *(const f32x4*)(gm + bidx * 6144 + col0 + bj * 128 + n * 4);
                rv[bj][n] = IN_F32 ? (f32x4){0.f, 0.f, 0.f, 0.f} : *(const f32x4*)(rgm_prev + bidx * 2048 + col0 + bj * 128 + n * 4); }
#pragma unroll
        for (int ai = 0; ai < 2; ++ai)
#pragma unroll
            for (int m = 0; m < 4; ++m) {
                const int rl = ai * 128 + wr * 64 + m * 16 + fr; const size_t urow = (size_t)pm * 256 + rl, off = urow * D_MODEL + col0;
                float ss = 0.f;
#pragma unroll
                for (int bj = 0; bj < 2; ++bj) {
                    f32x4 x0, x1;
                    if (IN_F32) { x0 = *(const f32x4*)(xi + (size_t)rl * D_MODEL + col0 + bj * 128); x1 = *(const f32x4*)(xi + (size_t)rl * D_MODEL + col0 + bj * 128 + 4); }
                    else { const u32x4 w = *(const u32x4*)(xg + off + bj * 128); x0 = (f32x4){bflo(w.x), bfhi(w.x), bflo(w.y), bfhi(w.y)} * rv[bj][0]; x1 = (f32x4){bflo(w.z), bfhi(w.z), bflo(w.w), bfhi(w.w)} * rv[bj][1]; }
                    x0 += gv[bj][0] * acc[ai][bj][m][0]; x1 += gv[bj][1] * acc[ai][bj][m][1];
                    if (OUT_F32) { *(f32x4*)(xo + (size_t)rl * D_MODEL + col0 + bj * 128) = x0; *(f32x4*)(xo + (size_t)rl * D_MODEL + col0 + bj * 128 + 4) = x1; }
                    else { ss += sq4(x0) + sq4(x1); *(u32x4*)(xg + off + bj * 128) = pack8(x0 * mv[bj][0], x1 * mv[bj][1]); }
                }
                if (!OUT_F32) { ss = red_fq(ss); if (fq == 0) ssqx[urow * 16 + pn * 4 + wc] = ss; }
                asm volatile("" ::: "memory");
            }
    }
};

struct EpiSlab {
    static constexpr bool PERM = true;
    float* slab; int KS;
    __device__ __forceinline__ void operator()(const Acc& acc, const Unit& u, int wr, int wc, int fr, int fq) const {
        const int cp = u.pm / PPB, ks = (int)(u.koffB / (unsigned)(2 * KS));
        float* sp = slab + ((size_t)(ks * (BATCH * CTX) + cp * 256)) * D_MODEL + u.pn * 256 + wc * 32 + 8 * fq;
#pragma unroll
        for (int ai = 0; ai < 2; ++ai)
#pragma unroll
            for (int m = 0; m < 4; ++m) { float* rp = sp + (size_t)(ai * 128 + wr * 64 + m * 16 + fr) * D_MODEL;
#pragma unroll
                for (int bj = 0; bj < 2; ++bj) { *(f32x4*)(rp + bj * 128) = acc[ai][bj][m][0]; *(f32x4*)(rp + bj * 128 + 4) = acc[ai][bj][m][1]; } }
    }
};

struct EpiFF1 {
    static constexpr bool PERM = true;
    bf16_t* U; const float* ssqx; const float* bias;
    __device__ __forceinline__ void operator()(const Acc& acc, const Unit& u, int wr, int wc, int fr, int fq) const {
        const int pm = u.pm, pn = u.pn, b = pm / PPB, pp = pm - b * PPB, bidx = pp == 0 ? 8 : b;
        const float* bia = bias + bidx * D_FF + pn * 256 + wc * 32 + 8 * fq;
        f32x4 bv[2][2];
#pragma unroll
        for (int bj = 0; bj < 2; ++bj)
#pragma unroll
            for (int n = 0; n < 2; ++n) bv[bj][n] = *(const f32x4*)(bia + bj * 128 + 4 * n);
#pragma unroll
        for (int ai = 0; ai < 2; ++ai)
#pragma unroll
            for (int m = 0; m < 4; ++m) {
                const int row = pm * 256 + ai * 128 + wr * 64 + m * 16 + fr;
                const float rs = row_rstd16(ssqx, row, fq, 1.0f / 1024.0f);
                bf16_t* up = U + (((size_t)pm * 128 + pn * 8 + wc) * 16 + (ai * 8 + wr * 4 + m)) * 512 + fr * 32 + 8 * fq;
#pragma unroll
                for (int bj = 0; bj < 2; ++bj) {
                    f32x4 v0 = acc[ai][bj][m][0] * rs + bv[bj][0], v1 = acc[ai][bj][m][1] * rs + bv[bj][1];
#pragma unroll
                    for (int e = 0; e < 4; ++e) { const float a = fmaxf(v0[e], 0.f), c = fmaxf(v1[e], 0.f); v0[e] = a * a; v1[e] = c * c; }
#ifndef U_NT
#define U_NT 1
#endif
#if U_NT
                    __builtin_nontemporal_store(pack8(v0, v1), (u32x4*)(up + (size_t)bj * 4 * 16 * 512));
#else
                    *(u32x4*)(up + (size_t)bj * 4 * 16 * 512) = pack8(v0, v1);
#endif
                }
                asm volatile("" ::: "memory");
            }
    }
};
struct EpiSink {
    static constexpr bool PERM = true;
    float* dummy;
    __device__ __forceinline__ void operator()(const Acc& acc, const Unit& u, int wr, int wc, int fr, int fq) const {
        f32x4 s = {0.f, 0.f, 0.f, 0.f};
#pragma unroll
        for (int ai = 0; ai < 2; ++ai)
#pragma unroll
            for (int bj = 0; bj < 2; ++bj)
#pragma unroll
                for (int m = 0; m < 4; ++m) s += acc[ai][bj][m][0] + acc[ai][bj][m][1];
        const float t = s[0] + s[1] + s[2] + s[3];
        if (t == 1.2345678e33f) dummy[u.pm] = t;
    }
};
}
namespace att {
constexpr int NW = 8, QBLK = 32, KVBLK = 64, DQK = 96, DV = 64;
constexpr int KROWB = 208;
constexpr int SHM_K = KVBLK * KROWB, SHM_V = KVBLK * DV * 2;
constexpr int NSLOT = 3;
constexpr int LDS_V = 0, LDS_K = NSLOT * SHM_V, LDS_WS = LDS_K + NSLOT * SHM_K, LDS_OST = LDS_WS + NW * 64 * 4, LDS_BYTES = LDS_OST + NW * 4096;
#define SBAR() __builtin_amdgcn_sched_barrier(0)
__device__ __forceinline__ int crow(int r, int hi) { return (r & 3) + 8 * (r >> 2) + 4 * hi; }

template <int VAR> __device__ __forceinline__ void partialSM(f32x16& p0, float shift) {
  if (VAR == 1) return;
  if (VAR == 9) {
#pragma unroll
    for (int r = 0; r < 16; ++r) p0[r] -= shift; }
#pragma unroll
  for (int r = 0; r < 16; ++r) p0[r] = __builtin_amdgcn_exp2f(p0[r]);
}
template <int VAR> __device__ __forceinline__ void finishSM(f32x16& p0, f32x16& p1, float shift, float& l_reg, bf16x8& pa0, bf16x8& pa1, bf16x8& pa2, bf16x8& pa3) {
  if (VAR == 9) {
#pragma unroll
    for (int r = 0; r < 16; ++r) p1[r] -= shift; }
  if (VAR != 1) {
#pragma unroll
  for (int r = 0; r < 16; ++r) p1[r] = __builtin_amdgcn_exp2f(p1[r]); }
  float ps = 0;
#pragma unroll
  for (int r = 0; r < 16; ++r) ps += p0[r];
#pragma unroll
  for (int r = 0; r < 16; ++r) ps += p1[r];
  l_reg += ps;
#define PK4(P, BASE, OUT) do { u32x4 w = {cvt_pk_bf16(P[BASE + 0], P[BASE + 1]), cvt_pk_bf16(P[BASE + 2], P[BASE + 3]), cvt_pk_bf16(P[BASE + 4], P[BASE + 5]), cvt_pk_bf16(P[BASE + 6], P[BASE + 7])}; \
    OUT = *reinterpret_cast<bf16x8*>(&w); } while (0)
  PK4(p0, 0, pa0); PK4(p0, 8, pa1); PK4(p1, 0, pa2); PK4(p1, 8, pa3);
#undef PK4
}
#define KFR(KS, d0, half) (*reinterpret_cast<const bf16x8*>((KS) + (r32 + 32 * (half)) * KROWB + ((d0) * 16 + hi * 8) * 2))
__device__ __forceinline__ void kread4(bf16x8* kf, const char* Ks, int r32, int hi) { kf[0] = KFR(Ks, 0, 0); kf[1] = KFR(Ks, 0, 1); kf[2] = KFR(Ks, 1, 0); kf[3] = KFR(Ks, 1, 1); }
#define MF(A_, B_, C_) __builtin_amdgcn_mfma_f32_32x32x16_bf16(A_, B_, C_, 0, 0, 0)
template <bool FIN, int VAR>
__device__ __forceinline__ void qkt_fin(f32x16& p0, f32x16& p1, const char* Ks, const bf16x8* qr, int r32, int hi,
                                        f32x16& f0, f32x16& f1, float shift, float& l_reg, bf16x8& pa0, bf16x8& pa1, bf16x8& pa2, bf16x8& pa3) {
  bf16x8 kf[4]; kf[0] = VAR == 8 ? qr[0] : KFR(Ks, 0, 0); kf[1] = VAR == 8 ? qr[0] : KFR(Ks, 0, 1); kf[2] = VAR == 8 ? qr[1] : KFR(Ks, 1, 0); kf[3] = VAR == 8 ? qr[1] : KFR(Ks, 1, 1);
  SBAR();
  const bf16x8 b0 = VAR == 8 ? qr[2] : KFR(Ks, 2, 0), b1 = VAR == 8 ? qr[2] : KFR(Ks, 2, 1), b2 = VAR == 8 ? qr[3] : KFR(Ks, 3, 0), b3 = VAR == 8 ? qr[3] : KFR(Ks, 3, 1);
  p0 = MF(kf[0], qr[0], f32x16{}); p1 = MF(kf[1], qr[0], f32x16{});
  p0 = MF(kf[2], qr[1], p0); p1 = MF(kf[3], qr[1], p1);
  if (FIN) {
    if (VAR == 9) {
#pragma unroll
      for (int r = 0; r < 16; ++r) f1[r] -= shift; }
    if (VAR != 1) {
#pragma unroll
      for (int r = 0; r < 16; ++r) f1[r] = __builtin_amdgcn_exp2f(f1[r]); }
  }
  SBAR();
  const bf16x8 c0 = VAR == 8 ? qr[4] : KFR(Ks, 4, 0), c1 = VAR == 8 ? qr[4] : KFR(Ks, 4, 1), c2 = VAR == 8 ? qr[5] : KFR(Ks, 5, 0), c3 = VAR == 8 ? qr[5] : KFR(Ks, 5, 1);
  p0 = MF(b0, qr[2], p0); p1 = MF(b1, qr[2], p1);
  p0 = MF(b2, qr[3], p0); p1 = MF(b3, qr[3], p1);
  if (FIN) {
    float ps = 0;
#pragma unroll
    for (int r = 0; r < 16; ++r) ps += f0[r];
#pragma unroll
    for (int r = 0; r < 16; ++r) ps += f1[r];
    l_reg += ps;
  }
  SBAR();
  p0 = MF(c0, qr[4], p0); p1 = MF(c1, qr[4], p1);
  p0 = MF(c2, qr[5], p0); p1 = MF(c3, qr[5], p1);
  if (FIN) {
#define PK4(P, BASE, OUT) do { u32x4 w = {cvt_pk_bf16(P[BASE + 0], P[BASE + 1]), cvt_pk_bf16(P[BASE + 2], P[BASE + 3]), cvt_pk_bf16(P[BASE + 4], P[BASE + 5]), cvt_pk_bf16(P[BASE + 6], P[BASE + 7])}; \
    OUT = *reinterpret_cast<bf16x8*>(&w); } while (0)
    PK4(f0, 0, pa0); PK4(f0, 8, pa1); PK4(f1, 0, pa2); PK4(f1, 8, pa3);
#undef PK4
  }
}
#undef MF
__device__ __forceinline__ int v_st(int k, int c) { return ((k >> 3) * 2 + (c >> 5)) * 512 + ((k & 7) * 32 + (c & 31)) * 2; }
__device__ __forceinline__ int v_rd_base(int lane) { return ((lane & 3) << 3) | (((lane >> 2) & 3) << 6) | (((lane >> 4) & 1) << 5) | (((lane >> 5) & 1) << 8); }
constexpr int v_rd_off(int d0, int ks, int half) { return d0 * 512 + ks * 2048 + half * 1024; }
template <int OFF> __device__ __forceinline__ s16x4 tr_read(int vb) {
  s16x4 r; asm volatile("ds_read_b64_tr_b16 %0, %1 offset:%2" : "=&v"(r) : "v"(vb), "i"(OFF) : "memory"); return r;
}
template <int D0> __device__ __forceinline__ void pv_one(f32x16& od, int vb, bf16x8 pa0, bf16x8 pa1, bf16x8 pa2, bf16x8 pa3) {
  const s16x4 l0 = tr_read<v_rd_off(D0, 0, 0)>(vb), h0 = tr_read<v_rd_off(D0, 0, 1)>(vb), l1 = tr_read<v_rd_off(D0, 1, 0)>(vb), h1 = tr_read<v_rd_off(D0, 1, 1)>(vb);
  const s16x4 l2 = tr_read<v_rd_off(D0, 2, 0)>(vb), h2 = tr_read<v_rd_off(D0, 2, 1)>(vb), l3 = tr_read<v_rd_off(D0, 3, 0)>(vb), h3 = tr_read<v_rd_off(D0, 3, 1)>(vb);
  asm volatile("s_waitcnt lgkmcnt(0)" ::: "memory"); SBAR();
#define PK(L, H) (bf16x8){L[0], L[1], L[2], L[3], H[0], H[1], H[2], H[3]}
  od = __builtin_amdgcn_mfma_f32_32x32x16_bf16(PK(l0, h0), pa0, od, 0, 0, 0);
  od = __builtin_amdgcn_mfma_f32_32x32x16_bf16(PK(l1, h1), pa1, od, 0, 0, 0);
  od = __builtin_amdgcn_mfma_f32_32x32x16_bf16(PK(l2, h2), pa2, od, 0, 0, 0);
  od = __builtin_amdgcn_mfma_f32_32x32x16_bf16(PK(l3, h3), pa3, od, 0, 0, 0);
#undef PK
}
__device__ __forceinline__ void pv_d0(f32x16* o, int vb, bf16x8 pa0, bf16x8 pa1, bf16x8 pa2, bf16x8 pa3) {
  pv_one<0>(o[0], vb, pa0, pa1, pa2, pa3); pv_one<1>(o[1], vb, pa0, pa1, pa2, pa3);
}

template <int VAR>
__device__ __forceinline__ void attn_unit(const bf16_t* __restrict__ Qraw, const bf16_t* __restrict__ Kb, const bf16_t* __restrict__ Vb, bf16_t* mix,
                                          const float* ssqkv, const float* ssqq, float negB2, int qrow0, int krow0, int nkeys, int h, char* lds) {
  if (VAR == 10) return;
  int tid = threadIdx.x; asm volatile("" : "+v"(tid));
    const int  wid = __builtin_amdgcn_readfirstlane(tid >> 6), lane = tid & 63, r32 = lane & 31, hi = lane >> 5;
  char* V_lds = lds + LDS_V; char* K_lds = lds + LDS_K;
  float l_reg = 0; f32x16 o[2] = {}; bf16x8 qr[6];
  const float shift = -negB2;
  {
    const int row = qrow0 + wid * QBLK + r32;
    const f32x4 pa = *(const f32x4*)(ssqkv + (size_t)row * 16 + 4), pb = *(const f32x4*)(ssqkv + (size_t)row * 16 + 8);
    const float sql = rsqrtf(((pa[0] + pa[1]) + (pa[2] + pa[3]) + (pb[0] + pb[1]) + (pb[2] + pb[3])) * (1.0f / 384.0f) + EPS);
    const float ssh = ssqq[(size_t)row * 24 + 3 * h] + ssqq[(size_t)row * 24 + 3 * h + 1] + ssqq[(size_t)row * 24 + 3 * h + 2];
    const float sc = sql * rsqrtf(sql * sql * ssh * (1.0f / 96.0f) + EPS) * QSCALE;
    const bf16_t* Qw = Qraw + (size_t)row * 768 + h * 96 + hi * 8;
#pragma unroll
    for (int d0 = 0; d0 < 6; ++d0) { const u32x4 w = *(const u32x4*)(Qw + d0 * 16); u32x4 o4;
      o4.x = cvt_pk_bf16(bflo(w.x) * sc, bfhi(w.x) * sc); o4.y = cvt_pk_bf16(bflo(w.y) * sc, bfhi(w.y) * sc);
      o4.z = cvt_pk_bf16(bflo(w.z) * sc, bfhi(w.z) * sc); o4.w = cvt_pk_bf16(bflo(w.w) * sc, bfhi(w.w) * sc);
      qr[d0] = *reinterpret_cast<bf16x8*>(&o4); }
  }
  const int kk0 = tid / 12, kc0 = tid - kk0 * 12, kk1 = (tid + 512) / 12, kc1 = (tid + 512) - kk1 * 12, vk = tid >> 3, vc = tid & 7;
  const bf16_t* Kh = Kb + (size_t)krow0 * 768 + h * 96; const bf16_t* Vh = Vb + (size_t)krow0 * 512 + h * 64;
  const unsigned kof0 = (unsigned)(kk0 * 768 + kc0 * 8) * 2u, kof1 = (unsigned)(kk1 * 768 + kc1 * 8) * 2u, vof = (unsigned)(vk * 512 + vc * 8) * 2u;
  const int kst0 = kk0 * KROWB + kc0 * 16, kst1 = kk1 * KROWB + kc1 * 16, vst = v_st(vk, vc * 8);
  const __amdgpu_buffer_rsrc_t krs = __builtin_amdgcn_make_buffer_rsrc((void*)Kh, 0, nkeys * 768 * 2, 0x00020000);
  const __amdgpu_buffer_rsrc_t vrs = __builtin_amdgcn_make_buffer_rsrc((void*)Vh, 0, nkeys * 512 * 2, 0x00020000);
  const bool two = wid < 4;
  const int vb0 = (int)(uintptr_t)V_lds + v_rd_base(lane);
  bf16x8 sk0, sk1, sv;
#define LOADK(t) do { if (VAR == 4) break; const int so_ = (t) * (KVBLK * 768 * 2); sk0 = __builtin_bit_cast(bf16x8, __builtin_amdgcn_raw_buffer_load_b128(krs, kof0, so_, 0)); if (two) sk1 = __builtin_bit_cast(bf16x8, __builtin_amdgcn_raw_buffer_load_b128(krs, kof1, so_, 0)); } while (0)
#define LOADV(t) do { if (VAR == 4) break; sv = __builtin_bit_cast(bf16x8, __builtin_amdgcn_raw_buffer_load_b128(vrs, vof, (t) * (KVBLK * 512 * 2), 0)); } while (0)
#define WRITEK(slot) do { if (VAR == 4) break; *(bf16x8*)(K_lds + (slot) * SHM_K + kst0) = sk0; if (two) *(bf16x8*)(K_lds + (slot) * SHM_K + kst1) = sk1; } while (0)
#define WRITEV(slot) do { if (VAR == 4) break; *(bf16x8*)(V_lds + (slot) * SHM_V + vst) = sv; } while (0)
#define PV(slot) do { if (VAR != 2) pv_d0(o, vb0 + (slot) * SHM_V, pa0, pa1, pa2, pa3); else { asm volatile("" :: "v"(pa0), "v"(pa1), "v"(pa2), "v"(pa3)); } } while (0)
#define QFS(FIN, P0, P1, F0, F1, KQ) qkt_fin<FIN, VAR>(P0, P1, K_lds + (KQ) * SHM_K, qr, r32, hi, F0, F1, shift, l_reg, pa0, pa1, pa2, pa3)
#define QF(FIN, P0, P1, F0, F1) QFS(FIN, P0, P1, F0, F1, kq)
  f32x16 pA0, pA1, pB0, pB1; bf16x8 pa0, pa1, pa2, pa3; const int NT = nkeys / KVBLK;
  LOADK(0); LOADV(0); WRITEK(0); WRITEV(0); LOADK(1); WRITEK(1); LOADK(2); LOADV(1);
  __syncthreads();
  int sa = 2, sb = 1, kq = 0;
#define ROT() do { sa = (sa == 2) ? 0 : sa + 1; sb = (sb == 2) ? 0 : sb + 1; kq = (kq == 2) ? 0 : kq + 1; } while (0)
  SBAR(); QF(false, pA0, pA1, pA0, pA1); SBAR(); partialSM<VAR>(pA0, shift); WRITEK(sa); WRITEV(sb); LOADK(3); LOADV(2); __syncthreads();
  ROT();
#define STEP_U(PC0, PC1, PP0, PP1, s_, KQ, SA, SB) do { SBAR(); QFS(true, PC0, PC1, PP0, PP1, KQ); SBAR(); PV(SA); SBAR(); partialSM<VAR>(PC0, shift); \
    WRITEK(SA); WRITEV(SB); LOADK((s_) + 3); LOADV((s_) + 2); __syncthreads(); } while (0)
  int j = 1;
#ifdef ATT_UNROLL6
  for (; j + 8 < NT; j += 6) {
    STEP_U(pB0, pB1, pA0, pA1, j,     1, 0, 2);
    STEP_U(pA0, pA1, pB0, pB1, j + 1, 2, 1, 0);
    STEP_U(pB0, pB1, pA0, pA1, j + 2, 0, 2, 1);
    STEP_U(pA0, pA1, pB0, pB1, j + 3, 1, 0, 2);
    STEP_U(pB0, pB1, pA0, pA1, j + 4, 2, 1, 0);
    STEP_U(pA0, pA1, pB0, pB1, j + 5, 0, 2, 1);
  }
#endif
  for (; j + 1 < NT; j += 2) {
    SBAR(); QF(true, pB0, pB1, pA0, pA1); SBAR(); PV(sa); SBAR(); partialSM<VAR>(pB0, shift);
    WRITEK(sa); WRITEV(sb); if (j + 3 < NT) LOADK(j + 3); LOADV(j + 2); __syncthreads();
    ROT();
    const bool t3 = (j + 3 < NT);
    SBAR(); QF(true, pA0, pA1, pB0, pB1); SBAR(); PV(sa); SBAR(); partialSM<VAR>(pA0, shift);
    if (t3) WRITEK(sa); WRITEV(sb); if (j + 4 < NT) LOADK(j + 4); if (t3) LOADV(j + 3); __syncthreads();
    ROT();
  }
  SBAR(); QF(true, pB0, pB1, pA0, pA1); SBAR(); PV(sa); partialSM<VAR>(pB0, shift);
  finishSM<VAR>(pB0, pB1, shift, l_reg, pa0, pa1, pa2, pa3); SBAR();
  ROT();
  PV(sa);
  { auto rr = __builtin_amdgcn_permlane32_swap(__float_as_uint(l_reg), __float_as_uint(l_reg), false, false); l_reg = __uint_as_float(rr[0]) + __uint_as_float(rr[1]); }
  const float rl = __builtin_amdgcn_rcpf(l_reg);
  { bf16_t* stg = (bf16_t*)(lds + LDS_OST) + wid * 2048;
#pragma unroll
    for (int d0 = 0; d0 < 2; ++d0)
#pragma unroll
      for (int g = 0; g < 4; ++g) { u32x2 w; w.x = cvt_pk_bf16(o[d0][4 * g] * rl, o[d0][4 * g + 1] * rl); w.y = cvt_pk_bf16(o[d0][4 * g + 2] * rl, o[d0][4 * g + 3] * rl);
        *(u32x2*)(stg + r32 * 64 + d0 * 32 + 8 * g + 4 * hi) = w; }
    asm volatile("s_waitcnt lgkmcnt(0)" ::: "memory");
    bf16_t* Ow = mix + (size_t)(qrow0 + wid * QBLK) * D_MODEL + 256 + h * 64;
#pragma unroll
    for (int i = 0; i < 4; ++i) { const int row = i * 8 + (lane >> 3), ch = lane & 7; const u32x4 v = *(const u32x4*)(stg + row * 64 + ch * 8); *(u32x4*)(Ow + (size_t)row * D_MODEL + ch * 8) = v; } }
  __syncthreads();
#undef LOADK
#undef LOADV
#undef WRITEK
#undef WRITEV
#undef ROT
#undef QF
#undef QFS
#undef STEP_U
#undef PV
}
#undef SBAR
}
namespace thin {
__device__ __forceinline__ float fexp(float x) { return __builtin_amdgcn_exp2f(x * 1.4426950408889634f); }
__device__ __forceinline__ float sigmoidf_(float x) { return __builtin_amdgcn_rcpf(1.0f + fexp(-x)); }
__device__ __forceinline__ float gelu_tanh(float x) { return x * __builtin_amdgcn_rcpf(1.0f + __builtin_amdgcn_exp2f(x * fmaf(x * x, -0.10294323f, -2.3022082f))); }
__device__ __forceinline__ float fexpm1_neg(float x) { const float p = x * (1.0f + x * (0.5f + x * (0.16666667f + x * (0.041666668f + x * 0.0083333338f)))); const float e = fexp(x) - 1.0f; return x > -0.25f ? p : e; }
__device__ __forceinline__ int rope_logical(int p) { const int q = p >> 3, i = p & 7; return (q >> 1) * 16 + (i >> 2) * 8 + (q & 1) * 4 + (i & 3); }

constexpr int XC_ROWB = 144;
constexpr int LRU_XC = 0, LRU_Y = 256 * XC_ROWB;
constexpr int NPOS = 34;

struct LruP { const bf16_t* z; const float* convw; const float* convb; const bf16_t* gw; const float* ba; const float* bx; const float* lam; float* agg; bf16_t* mix; };

template <int PASS>
__device__ __forceinline__ void lru_item(const LruP& P, int pm, int hd, char* lds) {
    int tid = threadIdx.x; asm volatile("" : "+v"(tid));
    const int  wid = __builtin_amdgcn_readfirstlane(tid >> 6), lane = tid & 63, r32 = lane & 31, hi = lane >> 5;
    const int b = pm / PPB, pp = pm - b * PPB;
    const int L = pp == 0 ? CTX : SEQ, seqbase = b * TPB + (pp == 0 ? 0 : CTX), t0 = pp == 0 ? 0 : (pp - 1) * 256;
    char* XC = lds + LRU_XC; float* Y = (float*)(lds + LRU_Y);
    {
        const int c8 = tid & 7, ch = hd * 64 + c8 * 8;
        f32x4 w[4][2];
#pragma unroll
        for (int k = 0; k < 4; ++k) { w[k][0] = *(const f32x4*)(P.convw + k * 256 + ch); w[k][1] = *(const f32x4*)(P.convw + k * 256 + ch + 4); }
        const f32x4 cb0 = *(const f32x4*)(P.convb + ch), cb1 = *(const f32x4*)(P.convb + ch + 4);
#pragma unroll
        for (int i = 0; i < 4; ++i) {
            const int tk = (tid >> 3) + 64 * i, ts = t0 + tk;
            f32x4 a0 = cb0, a1 = cb1;
#pragma unroll
            for (int k = 0; k < 4; ++k) { const int tsrc = ts + k - 1;
                if (tsrc >= 0 && tsrc < L) { const u32x4 v = *(const u32x4*)(P.z + (size_t)(seqbase + tsrc) * ZW + Z_LX + ch);
                    a0 += w[k][0] * (f32x4){bflo(v.x), bfhi(v.x), bflo(v.y), bfhi(v.y)}; a1 += w[k][1] * (f32x4){bflo(v.z), bfhi(v.z), bflo(v.w), bfhi(v.w)}; } }
            *(u32x4*)(XC + tk * XC_ROWB + c8 * 16) = epi::pack8(a0, a1);
        }
    }
    __syncthreads();
    const int dir = wid & 1, cb = (wid >> 1) & 1, half = wid >> 2;
    const int chl = cb * 32 + r32, ch = hd * 64 + chl;
    bf16x8 Ba[4], Bx[4];
#pragma unroll
    for (int ks = 0; ks < 4; ++ks) {
        Ba[ks] = *(const bf16x8*)(P.gw + ((size_t)((dir * 2 + 0) * 4 + hd) * 64 + chl) * 64 + ks * 16 + hi * 8);
        Bx[ks] = *(const bf16x8*)(P.gw + ((size_t)((dir * 2 + 1) * 4 + hd) * 64 + chl) * 64 + ks * 16 + hi * 8);
    }
    const float bav = P.ba[dir * 256 + ch], bxv = P.bx[dir * 256 + ch];
    const float sp8 = 8.0f * log1pf(expf(-P.lam[dir * 256 + ch]));
    const float nsp8 = -sp8, ba2 = bav * -1.4426950408889634f, bx2 = bxv * -1.4426950408889634f;
    const bool small_la = __all(sp8 <= 0.125f);
    const int chunk = pp == 0 ? half : 2 * pp + half;
    const int pos = dir == 0 ? chunk : (chunk == 1 ? 0 : (chunk == 0 ? 1 : 35 - chunk));
    float Hrun = 0.f, Arun = 1.f;
    if (PASS == 2) {
        const float* ag = P.agg + ((size_t)(b * 2 + dir) * NPOS) * 512 + ch * 2;
#pragma unroll 1
        for (int p0 = 0; p0 < pos; p0 += 11) {
            f32x2 e[11];
#pragma unroll
            for (int q = 0; q < 11; ++q) e[q] = (p0 + q) < pos ? *(const f32x2*)(ag + (size_t)(p0 + q) * 512) : (f32x2){1.0f, 0.0f};
#pragma unroll
            for (int q = 0; q < 11; ++q) Hrun = e[q].x * Hrun + e[q].y;
        }
    }
    float yv[4][16];
    const int tau = ((r32 >> 2) & 1) * 16 + (r32 >> 3) * 4 + (r32 & 3);
    const int firsthi = dir;
#pragma unroll
    for (int ii = 0; ii < 4; ++ii) {
        const int tile = dir == 0 ? ii : 3 - ii, tb = half * 128 + tile * 32;
        f32x16 ra = {}, ix = {};
#pragma unroll
        for (int ks = 0; ks < 4; ++ks) {
            const bf16x8 af = *(const bf16x8*)(XC + (tb + tau) * XC_ROWB + (ks * 16 + hi * 8) * 2);
            ra = __builtin_amdgcn_mfma_f32_32x32x16_bf16(af, Ba[ks], ra, 0, 0, 0);
            ix = __builtin_amdgcn_mfma_f32_32x32x16_bf16(af, Bx[ks], ix, 0, 0, 0);
        }
        float av[16], bv[16];
        if (small_la) { asm volatile("; lru: series expm1" ::: "memory");
#pragma unroll
            for (int r = 0; r < 16; ++r) {
                const float xcv = bf2f(*(const bf16_t*)(XC + (tb + hi * 16 + r) * XC_ROWB + chl * 2));
                const float rr = __builtin_amdgcn_rcpf(1.0f + __builtin_amdgcn_exp2f(fmaf(ra[r], -1.4426950408889634f, ba2)));
                const float iv = __builtin_amdgcn_rcpf(1.0f + __builtin_amdgcn_exp2f(fmaf(ix[r], -1.4426950408889634f, bx2)));
                const float la = nsp8 * rr;
                const float em = la * fmaf(la, fmaf(la, fmaf(la, 0.041666668f, 0.16666667f), 0.5f), 1.0f);
                av[r] = 1.0f + em; bv[r] = __builtin_amdgcn_sqrtf(-fmaf(em, em, em + em)) * (iv * xcv);
            }
        } else {
#pragma unroll
            for (int r = 0; r < 16; ++r) {
                const float xcv = bf2f(*(const bf16_t*)(XC + (tb + hi * 16 + r) * XC_ROWB + chl * 2));
                const float rr = __builtin_amdgcn_rcpf(1.0f + __builtin_amdgcn_exp2f(fmaf(ra[r], -1.4426950408889634f, ba2)));
                const float iv = __builtin_amdgcn_rcpf(1.0f + __builtin_amdgcn_exp2f(fmaf(ix[r], -1.4426950408889634f, bx2)));
                const float em = fexpm1_neg(nsp8 * rr);
                av[r] = 1.0f + em; bv[r] = __builtin_amdgcn_sqrtf(-fmaf(em, em, em + em)) * (iv * xcv);
            }
        }
        float hl[16], cl[16]; float h = 0.f, c = 1.f;
        if (dir == 0) {
#pragma unroll
            for (int r = 0; r < 16; ++r) { h = av[r] * h + bv[r]; c *= av[r]; hl[r] = h; cl[r] = c; }
        } else {
#pragma unroll
            for (int r = 15; r >= 0; --r) { h = av[r] * h + bv[r]; c *= av[r]; hl[r] = h; cl[r] = c; }
        }
        const float H1 = __shfl(h, r32 + 32 * firsthi), A1 = __shfl(c, r32 + 32 * firsthi);
        const float H2 = __shfl(h, r32 + 32 * (1 - firsthi)), A2 = __shfl(c, r32 + 32 * (1 - firsthi));
        const float Hin1 = Hrun, Hin2 = A1 * Hrun + H1;
        const float Hmine = (hi == firsthi) ? Hin1 : Hin2;
        Hrun = A2 * Hin2 + H2; Arun = Arun * A1 * A2;
        if (PASS == 2) {
#pragma unroll
            for (int r = 0; r < 16; ++r) yv[ii][r] = hl[r] + cl[r] * Hmine;
        }
    }
    if (PASS == 1) {
        if (hi == 0) *(f32x2*)(P.agg + ((size_t)(b * 2 + dir) * NPOS + pos) * 512 + ch * 2) = (f32x2){Arun, Hrun};
        __syncthreads();
    } else {
        if (dir == 0) {
#pragma unroll
            for (int ii = 0; ii < 4; ++ii)
#pragma unroll
                for (int r = 0; r < 16; ++r) Y[(half * 128 + ii * 32 + hi * 16 + r) * 64 + chl] = yv[ii][r];
        }
        __syncthreads();
        if (dir == 1) {
#pragma unroll
            for (int ii = 0; ii < 4; ++ii)
#pragma unroll
                for (int r = 0; r < 16; ++r) Y[(half * 128 + (3 - ii) * 32 + hi * 16 + r) * 64 + chl] += yv[ii][r];
        }
        __syncthreads();
        const int c8 = tid & 7;
#pragma unroll
        for (int i = 0; i < 4; ++i) {
            const int tk = (tid >> 3) + 64 * i; const size_t row = (size_t)pm * 256 + tk;
            const f32x4 y0 = *(const f32x4*)(Y + tk * 64 + c8 * 8), y1 = *(const f32x4*)(Y + tk * 64 + c8 * 8 + 4);
            const u32x4 g = *(const u32x4*)(P.z + row * ZW + Z_LG + hd * 64 + c8 * 8);
            const f32x4 o0 = y0 * (f32x4){gelu_tanh(bflo(g.x)), gelu_tanh(bfhi(g.x)), gelu_tanh(bflo(g.y)), gelu_tanh(bfhi(g.y))};
            const f32x4 o1 = y1 * (f32x4){gelu_tanh(bflo(g.z)), gelu_tanh(bfhi(g.z)), gelu_tanh(bflo(g.w)), gelu_tanh(bfhi(g.w))};
            *(u32x4*)(P.mix + row * D_MODEL + hd * 64 + c8 * 8) = epi::pack8(o0, o1);
        }
        __syncthreads();
    }
}

constexpr int PL_PU = 0, PL_MX = 272 * 128;
template <int GI>
__device__ __forceinline__ void pool_item_g(const bf16_t* z, const bf16_t* pw, bf16_t* mix, int pm, char* lds) {
    constexpr int g = GI, W = 2 << GI;
    int tid = threadIdx.x; asm volatile("" : "+v"(tid));
    const int  wid = __builtin_amdgcn_readfirstlane(tid >> 6), lane = tid & 63, r32 = lane & 31, hi = lane >> 5;
    const int b = pm / PPB, pp = pm - b * PPB;
    const int L = pp == 0 ? CTX : SEQ, seqbase = b * TPB + (pp == 0 ? 0 : CTX), t0 = pp == 0 ? 0 : (pp - 1) * 256;
    char* PU = lds + PL_PU; char* MX = lds + PL_MX;
    const int c8 = tid & 7;
#pragma unroll
    for (int i = 0; i < 5; ++i) { const int hr = (tid >> 3) + 64 * i, ts = t0 - 8 + hr;
        if (hr < 272 && ts >= 0 && ts < L) *(u32x4*)(PU + hr * 128 + c8 * 16) = *(const u32x4*)(z + (size_t)(seqbase + ts) * ZW + Z_PU + g * 64 + c8 * 8); }
    __syncthreads();
#pragma unroll
    for (int i = 0; i < 4; ++i) {
        const int tk = (tid >> 3) + 64 * i, ts = t0 + tk;
        f32x4 s0 = {0.f, 0.f, 0.f, 0.f}, s1 = {0.f, 0.f, 0.f, 0.f}; int cnt = 0;
#pragma unroll
        for (int k = 0; k < W; ++k) {
            const int tt = ts - W / 2 + k;
            if (tt >= 0 && tt < L) { const u32x4 v = *(const u32x4*)(PU + (tk + 8 - W / 2 + k) * 128 + c8 * 16); ++cnt;
                s0 += (f32x4){bflo(v.x), bfhi(v.x), bflo(v.y), bfhi(v.y)}; s1 += (f32x4){bflo(v.z), bfhi(v.z), bflo(v.w), bfhi(v.w)}; } }
        const float inv = __builtin_amdgcn_rcpf((float)cnt);
        const u32x4 v = *(const u32x4*)(PU + (tk + 8) * 128 + c8 * 16);
        s0 = s0 * inv - (f32x4){bflo(v.x), bfhi(v.x), bflo(v.y), bfhi(v.y)}; s1 = s1 * inv - (f32x4){bflo(v.z), bfhi(v.z), bflo(v.w), bfhi(v.w)};
        *(u32x4*)(MX + tk * XC_ROWB + c8 * 16) = epi::pack8(s0, s1);
    }
    __syncthreads();
    f32x16 c0 = {}, c1 = {};
#pragma unroll
    for (int ks = 0; ks < 4; ++ks) {
        const bf16x8 bf = *(const bf16x8*)(MX + (wid * 32 + r32) * XC_ROWB + (ks * 16 + hi * 8) * 2);
        const bf16x8 a0 = *(const bf16x8*)(pw + ((size_t)g * 64 + r32) * 64 + ks * 16 + hi * 8);
        const bf16x8 a1 = *(const bf16x8*)(pw + ((size_t)g * 64 + 32 + r32) * 64 + ks * 16 + hi * 8);
        c0 = __builtin_amdgcn_mfma_f32_32x32x16_bf16(a0, bf, c0, 0, 0, 0);
        c1 = __builtin_amdgcn_mfma_f32_32x32x16_bf16(a1, bf, c1, 0, 0, 0);
    }
    bf16_t* OT = (bf16_t*)PU;
#pragma unroll
    for (int q = 0; q < 4; ++q) {
        u32x2 w0, w1; w0.x = cvt_pk_bf16(c0[4 * q], c0[4 * q + 1]); w0.y = cvt_pk_bf16(c0[4 * q + 2], c0[4 * q + 3]);
        w1.x = cvt_pk_bf16(c1[4 * q], c1[4 * q + 1]); w1.y = cvt_pk_bf16(c1[4 * q + 2], c1[4 * q + 3]);
        *(u32x2*)(OT + (wid * 32 + r32) * 64 + 4 * hi + 8 * q) = w0; *(u32x2*)(OT + (wid * 32 + r32) * 64 + 32 + 4 * hi + 8 * q) = w1;
    }
    __syncthreads();
#pragma unroll
    for (int i = 0; i < 4; ++i) { const int tk = (tid >> 3) + 64 * i;
        *(u32x4*)(mix + ((size_t)pm * 256 + tk) * D_MODEL + 768 + g * 64 + c8 * 8) = *(const u32x4*)(OT + tk * 64 + c8 * 8); }
    __syncthreads();
}
__device__ __forceinline__ void pool_item(const bf16_t* z, const bf16_t* pw, bf16_t* mix, int pm, int g, char* lds) {
    if (g == 0) pool_item_g<0>(z, pw, mix, pm, lds); else if (g == 1) pool_item_g<1>(z, pw, mix, pm, lds); else if (g == 2) pool_item_g<2>(z, pw, mix, pm, lds); else pool_item_g<3>(z, pw, mix, pm, lds);
}

__device__ __forceinline__ void transpose_tile(const float* W, int N, bf16_t* WT, int Kp, int k0, int nphys, int srcbase, bool rperm, const float* kscale, const float* nscale, bool zero, LAS float* scr, int lane) {
    const int nl = lane & 31, sc = srcbase + (rperm ? rope_logical(nl) : nl);
    const float nsv = nscale ? nscale[nl] : 1.0f;
#pragma unroll 8
    for (int i = 0; i < 32; ++i) { const int kk = 2 * i + (lane >> 5);
        float v = zero ? 0.f : W[(size_t)(k0 + kk) * N + sc] * nsv; if (kscale) v *= kscale[k0 + kk];
        scr[kk * 33 + nl] = v; }
    asm volatile("s_waitcnt lgkmcnt(0)" ::: "memory");
    const int c = lane & 7;
#pragma unroll
    for (int j = 0; j < 4; ++j) { const int n = (lane >> 3) + 8 * j; const LAS float* s = scr + (8 * c) * 33 + n;
        u32x4 o; o.x = cvt_pk_bf16(s[0 * 33], s[1 * 33]); o.y = cvt_pk_bf16(s[2 * 33], s[3 * 33]); o.z = cvt_pk_bf16(s[4 * 33], s[5 * 33]); o.w = cvt_pk_bf16(s[6 * 33], s[7 * 33]);
        *(u32x4*)(WT + (size_t)(nphys + n) * Kp + k0 + 8 * c) = o; }
    asm volatile("s_waitcnt lgkmcnt(0)" ::: "memory");
}
__device__ __forceinline__ float wave_sum(float v) {
#pragma unroll
    for (int o = 1; o < 64; o <<= 1) v += __shfl_xor(v, o);
    return v;
}
}
constexpr int NWAVES = 8;
constexpr size_t MiB = 1u << 20;
constexpr size_t WS_CTL = 0, CTL_ZERO_BYTES = 64 * 1024;
constexpr size_t WS_MODPART = 1 * MiB;
constexpr size_t WS_VEC = 5 * MiB;
constexpr size_t WS_BIASIN = WS_VEC + 512 * 1024;
constexpr size_t WS_BIASFF = WS_BIASIN + 128 * 1024;
constexpr size_t WS_RTAB = WS_BIASFF + 320 * 1024;
constexpr size_t WS_RVEC = 17 * MiB + 512 * 1024;
constexpr size_t WS_AGG = 6 * MiB;
constexpr size_t WS_SSQX = 8 * MiB;
constexpr size_t WS_SSQKV = 11 * MiB;
constexpr size_t WS_SSQQ = 14 * MiB;
constexpr size_t WS_WT = 18 * MiB, WT_LAYER = 23 * MiB;
constexpr size_t WT_IN = 0, WT_UQ = 3 * MiB, WT_UKV = WT_UQ + 640 * 1024, WT_OUT = WT_UKV + 512 * 1024, WT_FF1 = WT_OUT + 2 * MiB, WT_FF2 = WT_FF1 + 8 * MiB, WT_GATE = WT_FF2 + 8 * MiB, WT_POOL = WT_GATE + 128 * 1024;
static_assert(WT_POOL + 32 * 1024 <= WT_LAYER, "weights per layer");
constexpr size_t WS_XG = 72 * MiB;
constexpr size_t WS_U = 208 * MiB;
constexpr size_t WS_Z = WS_U, WS_Q = WS_Z + 102 * MiB, WS_K = WS_Q + 51 * MiB, WS_V = WS_K + 51 * MiB;
constexpr size_t WS_END = WS_U + 272 * MiB;
static_assert(WS_V + 34 * MiB <= WS_END && WS_END <= 512 * MiB, "d_ws map");
enum { VEC_GM1 = 0, VEC_G1 = 1, VEC_GM2 = 2, VEC_G2 = 3, VEC_SH1 = 4, VEC_SH2 = 5 };

constexpr int LDS_BYTES = 147456;
constexpr int LDSCTL_OFF = 131072, MISC_OFF = LDSCTL_OFF + 320;

typedef GAS unsigned gu32;
#define RLX_AGENT __ATOMIC_RELAXED, __HIP_MEMORY_SCOPE_AGENT
#define XB_TMO      128
#define XB_XCNT(j)  (256  + 64 * (j))
#define XB_XSUB(j)  (1280 + 64 * (j))
#define XB_XGEN(j)  (2304 + 64 * (j))
#define XB_TOP      3328
#define XB_TOPGEN   3392
#define XCD_BAR_WORDS 3456
#define XB_SPIN_CAP (1u << 20)
__device__ __forceinline__ unsigned xb_ld(unsigned* p)              { return __hip_atomic_load(p, __ATOMIC_RELAXED, __HIP_MEMORY_SCOPE_AGENT); }
__device__ __forceinline__ unsigned xb_add(unsigned* p, unsigned v) { return __hip_atomic_fetch_add(p, v, __ATOMIC_RELAXED, __HIP_MEMORY_SCOPE_AGENT); }
__device__ __forceinline__ unsigned xb_xcc_id() { return (unsigned)__builtin_amdgcn_s_getreg((3 << 11) | 20) & 0xFu; }
#define XB_SPIN(cond, bar) do { unsigned _sp = 0; while (cond) { __builtin_amdgcn_s_sleep(1); \
    if ((++_sp & 255u) == 0u) { if (xb_ld(&(bar)[XB_TMO])) break; if (_sp > XB_SPIN_CAP) { atomicAdd(&(bar)[XB_TMO], 1u); break; } } } } while (0)
struct XcdBarrier { unsigned* bar; unsigned x; volatile LAS unsigned* st; };
__device__ __forceinline__ XcdBarrier xcd_barrier_post(unsigned* bar, volatile LAS unsigned* st) {
    XcdBarrier b; b.bar = bar; b.x = xb_xcc_id(); b.st = st;
    if (threadIdx.x == 0) (void)xb_add(&bar[XB_XCNT(b.x)], 1u);
    return b;
}
__device__ __forceinline__ void xcd_barrier_complete(unsigned* bar, unsigned x, unsigned& nloc, unsigned& nx) {
    const unsigned G = gridDim.x * gridDim.y * gridDim.z;
    unsigned sum, cnt, mine, sp = 0u;
    for (;;) {
        sum = 0u; cnt = 0u; mine = 0u;
#pragma unroll
        for (unsigned j = 0; j < 16; ++j) { const unsigned c = xb_ld(&bar[XB_XCNT(j)]); sum += c; cnt += (c > 0u) ? 1u : 0u; mine = (j == x) ? c : mine; }
        if (sum == G) break;
        __builtin_amdgcn_s_sleep(1);
        if ((++sp & 255u) == 0u) { if (xb_ld(&bar[XB_TMO])) break; if (sp > XB_SPIN_CAP) { atomicAdd(&bar[XB_TMO], 1u); break; } }
    }
    nloc = mine > 0u ? mine : 1u; nx = cnt > 0u ? cnt : 1u;
}
__device__ __forceinline__ void xcd_barrier(const XcdBarrier& b) {
    asm volatile("s_waitcnt vmcnt(0)" ::: "memory");
    __syncthreads();
    if (threadIdx.x == 0) {
        unsigned* bar = b.bar;
        __builtin_amdgcn_s_waitcnt(0);
        unsigned nloc = b.st[0], nx = b.st[1];
        if (nloc == 0u) { xcd_barrier_complete(bar, b.x, nloc, nx); b.st[0] = nloc; b.st[1] = nx; }
        const unsigned old = xb_add(&bar[XB_XSUB(b.x)], 1u);
        const unsigned gen = old / nloc;
        if (old + 1u == (gen + 1u) * nloc) {
            __builtin_amdgcn_fence(__ATOMIC_RELEASE, "agent");
            asm volatile("s_waitcnt vmcnt(0)" ::: "memory");
            const unsigned og = xb_add(&bar[XB_TOP], 1u);
            const unsigned tg = og / nx;
            if (og + 1u == (tg + 1u) * nx) xb_add(&bar[XB_TOPGEN], 1u);
            else XB_SPIN(xb_ld(&bar[XB_TOPGEN]) == tg, bar);
            __builtin_amdgcn_fence(__ATOMIC_ACQUIRE, "agent");
            xb_add(&bar[XB_XGEN(b.x)], 1u);
            asm volatile("s_waitcnt vmcnt(0)" ::: "memory");
        } else {
            XB_SPIN(xb_ld(&bar[XB_XGEN(b.x)]) == gen, bar);
            __builtin_amdgcn_fence(__ATOMIC_ACQUIRE, "agent");
            asm volatile("s_waitcnt vmcnt(0)" ::: "memory");
        }
    }
    __syncthreads();
}


__device__ __forceinline__ void ctx_combine(unsigned char* ws, float* out, const float* rgmv, const float* gatev, const float* gmv, int gw, int NGW, int lane_in) {
    int lane = lane_in; asm volatile("" : "+v"(lane));
    const float* slab = out + (size_t)18 * 1024 * 1024;
    bf16_t* xg_ = (bf16_t*)(ws + WS_XG); float* ssq_ = (float*)(ws + WS_SSQX);
    for (int cr = gw; cr < BATCH * CTX; cr += NGW) {
        const size_t urow = (size_t)(cr >> 8) * TPB + (cr & 255); float ss = 0.f;
#pragma unroll
        for (int j = 0; j < 4; ++j) { const int col = 256 * j + 4 * lane;
            f32x4 a = *(const f32x4*)(slab + (size_t)cr * D_MODEL + col);
#pragma unroll
            for (int ks = 1; ks < 4; ++ks) a += *(const f32x4*)(slab + ((size_t)ks * (BATCH * CTX) + cr) * D_MODEL + col);
            const u32x2 w = *(const u32x2*)(xg_ + urow * D_MODEL + col);
            const f32x4 x = (f32x4){bflo(w.x), bfhi(w.x), bflo(w.y), bfhi(w.y)} * *(const f32x4*)(rgmv + col) + *(const f32x4*)(gatev + col) * a;
            ss += epi::sq4(x);
            const f32x4 t = x * *(const f32x4*)(gmv + col); u32x2 o; o.x = cvt_pk_bf16(t[0], t[1]); o.y = cvt_pk_bf16(t[2], t[3]); *(u32x2*)(xg_ + urow * D_MODEL + col) = o; }
        ss = thin::wave_sum(ss);
        if (lane < 16) ssq_[urow * 16 + lane] = lane == 0 ? ss : 0.f;
    }
}

struct Args { const float* in[27]; float* out; unsigned char* ws; int ph_lo, ph_hi; };
constexpr int NPHASE = 15;

__global__ void __launch_bounds__(NWAVES * 64, 2) fwd_kernel(Args args) {
    extern __shared__ __attribute__((aligned(16))) unsigned char lds_raw[];
    LAS unsigned char* lds = (LAS unsigned char*)lds_raw;
    char* ldsg = (char*)lds_raw;
    const int tid = threadIdx.x, lane = tid & 63, wave = __builtin_amdgcn_readfirstlane(tid >> 6);
    const int G = gridDim.x; const int bx = blockIdx.x; const int vcu = (G % 8 == 0) ? (bx % 8) * (G / 8) + bx / 8 : bx;
    unsigned char* ws = args.ws;
    typedef __attribute__((address_space(4))) const Args* KArgs;
#define KA(i) (((KArgs)__builtin_amdgcn_kernarg_segment_ptr())->in[i])
#define x_in KA(0)
#define c_in KA(1)
#define ctx_in KA(2)
#define cctx_in KA(3)
#define w_mod KA(4)
#define b_mod KA(5)
#define g_norm1 KA(6)
#define g_norm2 KA(7)
#define w_in KA(8)
#define conv_w KA(9)
#define conv_b KA(10)
#define lru_w_a KA(11)
#define lru_b_a KA(12)
#define lru_w_x KA(13)
#define lru_b_x KA(14)
#define lru_lambda KA(15)
#define g_q_lat KA(16)
#define w_uq KA(17)
#define g_kv_lat KA(18)
#define w_ukv KA(19)
#define g_qn KA(20)
#define g_kn KA(21)
#define w_pool KA(22)
#define pool_scale KA(23)
#define w_out KA(24)
#define w_ff1 KA(25)
#define w_ff2 KA(26)
    float* out = args.out;
#define modpart ((float*)(ws + WS_MODPART))
#define vec ((float*)(ws + WS_VEC))
#define bias_in ((float*)(ws + WS_BIASIN))
#define bias_ff ((float*)(ws + WS_BIASFF))
#define rtab ((float*)(ws + WS_RTAB))
#define agg ((float*)(ws + WS_AGG))
#define ssqx ((float*)(ws + WS_SSQX))
#define ssqkv ((float*)(ws + WS_SSQKV))
#define ssqq ((float*)(ws + WS_SSQQ))
#define rvec ((float*)(ws + WS_RVEC))
#define xg ((bf16_t*)(ws + WS_XG))
#define mix ((bf16_t*)out)
#define U ((bf16_t*)(ws + WS_U))
#define zb ((bf16_t*)(ws + WS_Z))
#define Qb ((bf16_t*)(ws + WS_Q))
#define Kb ((bf16_t*)(ws + WS_K))
#define Vb ((bf16_t*)(ws + WS_V))

    for (int u = tid; u < (LDS_BYTES - LDSCTL_OFF) / 4; u += NWAVES * 64) ((LAS unsigned*)(lds + LDSCTL_OFF))[u] = 0u;
    __syncthreads();
    const bool single = (args.ph_hi - args.ph_lo) > 1;
    XcdBarrier bar; bar.bar = (unsigned*)(ws + WS_CTL); bar.x = 0; bar.st = nullptr;
    if (single) bar = xcd_barrier_post((unsigned*)(ws + WS_CTL), (volatile LAS unsigned*)(lds + MISC_OFF) + 8);
    const int lo = args.ph_lo, hi = args.ph_hi;
#ifndef PHASE_MASK
#define PHASE_MASK 0x7FF
#endif
#define IN(k) (lo <= (k) && (k) < hi)
#ifndef GATE_PD
#define GATE_PD 1
#endif
#ifndef DUP_MASK
#define DUP_MASK 0x7FF
#endif
#define EN(j) (((PHASE_MASK >> (j)) & 1) && (rep_ > 0 || NREP_CUR == 1 || ((DUP_MASK >> (j)) & 1)))
#ifndef DUP_PHASE
#define DUP_PHASE (-1)
#endif
#define NREP(k) (((k) == DUP_PHASE) ? 2 : 1)
#define SEAM(k) do { if (IN(k) && IN((k) + 1)) xcd_barrier(bar); } while (0)
    const int gw = vcu * NWAVES + wave, NGW = G * NWAVES;

    for (int rep_ = 0, NREP_CUR = NREP(0); rep_ < NREP_CUR; ++rep_) { if (rep_) xcd_barrier(bar);
    if (EN(0) && IN(0)) {
        float* sl = (float*)ldsg;
        for (int i = tid; i < 9 * 1024; i += NWAVES * 64) { const float v = i < 8192 ? c_in[i] : cctx_in[i - 8192]; sl[i] = v / (1.0f + expf(-v)); }
        __syncthreads();
        for (int it = gw; it < 2 * 96 * 8; it += NGW) {
            const int l = it / 768, r = it - l * 768, cg = r >> 3, ks = r & 7;
            float acc[9];
#pragma unroll
            for (int b = 0; b < 9; ++b) acc[b] = 0.f;
            const float* wp = w_mod + ((size_t)l * 1024 + ks * 128) * 6144 + cg * 64 + lane;
#pragma unroll 8
            for (int kk = 0; kk < 128; ++kk) { const float w = wp[(size_t)kk * 6144];
#pragma unroll
                for (int b = 0; b < 9; ++b) acc[b] += sl[b * 1024 + ks * 128 + kk] * w; }
#pragma unroll
            for (int b = 0; b < 9; ++b) modpart[((size_t)(ks * 2 + l) * 9 + b) * 6144 + cg * 64 + lane] = acc[b];
        }
        __syncthreads();
        if (bx == 0) for (int i = tid; i < 512; i += NWAVES * 64) { const int pos = i >> 3, f = i & 7; const float fr = powf(10000.0f, -(float)f / 8.0f), ang = (float)pos * fr; rtab[i * 2] = cosf(ang); rtab[i * 2 + 1] = sinf(ang); }
        LAS float* scr = (LAS float*)(lds + wave * 16384);
        constexpr int I_IN = 768, I_UQ = 144, I_UKV = 128, I_OUT = 512, I_FF1 = 2048, I_FF2 = 2048, I_G = 32, I_P = 8, I_L = I_IN + I_UQ + I_UKV + I_OUT + I_FF1 + I_FF2 + I_G + I_P;
        for (int it = gw; it < 2 * I_L; it += NGW) {
            const int l = it / I_L; int r = it - l * I_L; bf16_t* wt = (bf16_t*)(ws + WS_WT + (size_t)l * WT_LAYER);
            if (r < I_IN) { const int pg = r >> 4, kb = r & 15; int src = 0; bool z0 = false, rp = false;
                if (pg < 16) src = 32 * pg; else if (pg < 24) src = 896 + 32 * (pg - 16); else if (pg < 32) src = 1184 + 32 * (pg - 24); else if (pg < 44) src = 512 + 32 * (pg - 32); else if (pg == 44) { src = 1152; rp = true; } else z0 = true;
                thin::transpose_tile(w_in + (size_t)l * 1024 * D_IN, D_IN, wt + WT_IN / 2, 1024, kb * 64, pg * 32, src, rp, nullptr, nullptr, z0, scr, lane); continue; } r -= I_IN;
            if (r < I_UQ) { const int pg = r / 6, kb = r - pg * 6;
                thin::transpose_tile(w_uq + (size_t)l * 384 * 768, 768, wt + WT_UQ / 2, 384, kb * 64, pg * 32, pg * 32, (pg % 3) == 2, g_q_lat + l * 384, nullptr, false, scr, lane); continue; } r -= I_UQ;
            if (r < I_UKV) { const int pg = r >> 2, kb = r & 3, pn = pg >> 3, bj = (pg >> 2) & 1, wc = pg & 3;
                const int src = pn < 2 ? (4 * pn + wc) * 128 + 32 * bj : (4 * (pn - 2) + wc) * 128 + 64 + 32 * bj;
                thin::transpose_tile(w_ukv + (size_t)l * 256 * 1024, 1024, wt + WT_UKV / 2, 256, kb * 64, pg * 32, src, false, g_kv_lat + l * 256, nullptr, false, scr, lane); continue; } r -= I_UKV;
            if (r < I_OUT) { const int pg = r >> 4, kb = r & 15;
                thin::transpose_tile(w_out + (size_t)l * 1024 * 1024, 1024, wt + WT_OUT / 2, 1024, kb * 64, pg * 32, pg * 32, false, nullptr, nullptr, false, scr, lane); continue; } r -= I_OUT;
            if (r < I_FF1) { const int pg = r >> 4, kb = r & 15;
                thin::transpose_tile(w_ff1 + (size_t)l * 1024 * 4096, 4096, wt + WT_FF1 / 2, 1024, kb * 64, pg * 32, pg * 32, false, nullptr, nullptr, false, scr, lane); continue; } r -= I_FF1;
            if (r < I_FF2) { const int pg = r >> 6, kb = r & 63;
                thin::transpose_tile(w_ff2 + (size_t)l * 4096 * 1024, 1024, wt + WT_FF2 / 2, 4096, kb * 64, pg * 32, pg * 32, false, nullptr, nullptr, false, scr, lane); continue; } r -= I_FF2;
            if (r < I_G) { const int mat = r >> 1, pg = r & 1, dir = mat >> 3, gate = (mat >> 2) & 1, hd = mat & 3;
                const float* src = (gate ? lru_w_x : lru_w_a) + ((size_t)((l * 2 + dir) * 4 + hd)) * 4096;
                thin::transpose_tile(src, 64, wt + WT_GATE / 2 + (size_t)mat * 4096, 64, 0, pg * 32, pg * 32, false, nullptr, nullptr, false, scr, lane); continue; } r -= I_G;
            { const int g = r >> 1, pg = r & 1;
                thin::transpose_tile(w_pool + (size_t)(l * 4 + g) * 4096, 64, wt + WT_POOL / 2 + (size_t)g * 4096, 64, 0, pg * 32, pg * 32, false, nullptr, pool_scale + l * 256 + g * 64 + pg * 32, false, scr, lane); }
        }
        __syncthreads();
    }
    } SEAM(0);
    for (int rep_ = 0, NREP_CUR = NREP(1); rep_ < NREP_CUR; ++rep_) { if (rep_) xcd_barrier(bar);
    if (EN(0) && IN(1)) {
        const int gt = vcu * (NWAVES * 64) + tid;
        if (gt < 2 * 9 * 1024) {
            const int l = gt / 9216, r = gt - l * 9216, b = r >> 10, j = r & 1023;
            float m[6];
#pragma unroll
            for (int s = 0; s < 6; ++s) { float a = b_mod[l * 6144 + s * 1024 + j];
#pragma unroll
                for (int ks = 0; ks < 8; ++ks) a += modpart[((size_t)(ks * 2 + l) * 9 + b) * 6144 + s * 1024 + j];
                m[s] = a; }
            float* v = vec + (size_t)(l * 9 + b) * 6144 + j;
            float gm1 = g_norm1[l * 1024 + j] * (1.0f + m[1]), gm2 = g_norm2[l * 1024 + j] * (1.0f + m[4]);
            gm1 = fabsf(gm1) < 1e-20f ? 1e-20f : gm1; gm2 = fabsf(gm2) < 1e-20f ? 1e-20f : gm2;
            v[VEC_GM1 * 1024] = gm1; v[VEC_G1 * 1024] = m[2];
            v[VEC_GM2 * 1024] = gm2; v[VEC_G2 * 1024] = m[5];
            rvec[(size_t)(l * 9 + b) * 2048 + j] = 1.0f / gm1; rvec[(size_t)(l * 9 + b) * 2048 + 1024 + j] = 1.0f / gm2;
            v[VEC_SH1 * 1024] = m[0]; v[VEC_SH2 * 1024] = m[3];
        }
    }
    } SEAM(1);
    for (int rep_ = 0, NREP_CUR = NREP(2); rep_ < NREP_CUR; ++rep_) { if (rep_) xcd_barrier(bar);
    if (EN(0) && IN(2)) {
        float* sl = (float*)ldsg;
        for (int combo = 0; combo < 4; ++combo) {
            const int l = combo >> 1, mat = combo & 1, N = mat ? D_FF : ZW;
            __syncthreads();
            for (int i = tid; i < 9 * 1024; i += NWAVES * 64) sl[i] = vec[(size_t)(l * 9 + (i >> 10)) * 6144 + (mat ? VEC_SH2 : VEC_SH1) * 1024 + (i & 1023)];
            __syncthreads();
            const bf16_t* wt = (const bf16_t*)(ws + WS_WT + (size_t)l * WT_LAYER + (mat ? WT_FF1 : WT_IN));
            float* bo = (mat ? bias_ff : bias_in) + (size_t)l * 9 * N;
            for (int n = gw; n < N; n += NGW) {
                const u32x4 w0 = *(const u32x4*)(wt + (size_t)n * 1024 + 8 * lane), w1 = *(const u32x4*)(wt + (size_t)n * 1024 + 512 + 8 * lane);
                float wv[16] = {bflo(w0.x), bfhi(w0.x), bflo(w0.y), bfhi(w0.y), bflo(w0.z), bfhi(w0.z), bflo(w0.w), bfhi(w0.w), bflo(w1.x), bfhi(w1.x), bflo(w1.y), bfhi(w1.y), bflo(w1.z), bfhi(w1.z), bflo(w1.w), bfhi(w1.w)};
#pragma unroll
                for (int b = 0; b < 9; ++b) { float s = 0.f;
#pragma unroll
                    for (int i = 0; i < 8; ++i) s += wv[i] * sl[b * 1024 + 8 * lane + i] + wv[8 + i] * sl[b * 1024 + 512 + 8 * lane + i];
                    s = thin::wave_sum(s); if (lane == 0) bo[b * N + n] = s; }
            }
        }
        for (int r0 = gw * 2; r0 < MROWS; r0 += NGW * 2) {
            f32x4 v[2][4]; const float* gmv[2];
#pragma unroll
            for (int q = 0; q < 2; ++q) { const int r = r0 + q, b = r / TPB, tt = r - b * TPB, bidx = tt < CTX ? 8 : b;
                const float* src = tt < CTX ? ctx_in + ((size_t)b * CTX + tt) * D_MODEL : x_in + ((size_t)b * SEQ + (tt - CTX)) * D_MODEL;
                gmv[q] = vec + (size_t)(0 * 9 + bidx) * 6144 + VEC_GM1 * 1024;
#pragma unroll
                for (int j = 0; j < 4; ++j) v[q][j] = *(const f32x4*)(src + 256 * j + 4 * lane); }
#pragma unroll
            for (int q = 0; q < 2; ++q) { const int r = r0 + q; float ss = 0.f;
#pragma unroll
                for (int j = 0; j < 4; ++j) { const f32x4 g4 = *(const f32x4*)(gmv[q] + 256 * j + 4 * lane); ss += epi::sq4(v[q][j]);
                    const f32x4 t = v[q][j] * g4; u32x2 w; w.x = cvt_pk_bf16(t[0], t[1]); w.y = cvt_pk_bf16(t[2], t[3]); *(u32x2*)(xg + (size_t)r * D_MODEL + 256 * j + 4 * lane) = w; }
                ss = thin::wave_sum(ss);
                if (lane < 16) ssqx[(size_t)r * 16 + lane] = lane == 0 ? ss : 0.f; }
        }
    }
    } SEAM(2);
    for (int l = 0; l < DEPTH; ++l) {
        const int p0 = 3 + 6 * l; const bool lastl = (l == DEPTH - 1);
        const unsigned char* wtl = ws + WS_WT + (size_t)l * WT_LAYER;
        const float* vl = vec + (size_t)l * 9 * 6144;
    for (int rep_ = 0, NREP_CUR = NREP(p0); rep_ < NREP_CUR; ++rep_) { if (rep_) xcd_barrier(bar);
        if (EN(1) && IN(p0)) {
            pg8::Gemm g{xg, (const bf16_t*)(wtl + WT_IN)}; pg8::StaticOrder S; S.init(NPAN, ZW / 256, G, bx, 0);
            epi::EpiIn E{zb, ssqx, bias_in + (size_t)l * 9 * ZW, ssqkv, g_kn + l * 96, rtab};
            pg8::gemm_phase<1024, 1024, 1024, false>(lds, g, S, E);
        }
        } SEAM(p0);
    for (int rep_ = 0, NREP_CUR = NREP(p0 + 1); rep_ < NREP_CUR; ++rep_) { if (rep_) xcd_barrier(bar);
        if (IN(p0 + 1)) {
            if (EN(2)) { pg8::Gemm g{zb + Z_QL, (const bf16_t*)(wtl + WT_UQ)}; pg8::StaticOrder S; S.init(lastl ? 128 : NPAN, 3, G, bx, lastl ? 1 : 0);
              epi::EpiQ E{Qb, ssqq, g_qn + l * 96, rtab}; pg8::gemm_phase<384, ZW, 384, false>(lds, g, S, E); }
            if (EN(3)) { pg8::Gemm g{zb + Z_KVL, (const bf16_t*)(wtl + WT_UKV)}; pg8::StaticOrder S; S.init(NPAN, 4, G, (bx + 96) % G, 0);
              epi::EpiKV E{Kb, Vb, zb, ssqkv, g_kn + l * 96}; pg8::gemm_phase<256, ZW, 256, false>(lds, g, S, E); }
            thin::LruP P{zb, conv_w + l * 1024, conv_b + l * 256, (const bf16_t*)(wtl + WT_GATE), lru_b_a + l * 512, lru_b_x + l * 512, lru_lambda + l * 512, agg, mix};
            if (EN(4)) for (int it = G - 1 - vcu; it < NPAN * 4; it += G) thin::lru_item<1>(P, it >> 2, it & 3, ldsg);
            if (!EN(5)) {} else if (lastl) { for (int it = vcu; it < 128 * 4; it += G) { const int pl = it >> 2; thin::pool_item(zb, (const bf16_t*)(wtl + WT_POOL), mix, pl + pl / 16 + 1, it & 3, ldsg); } }
            else { for (int it = vcu; it < NPAN * 4; it += G) thin::pool_item(zb, (const bf16_t*)(wtl + WT_POOL), mix, it >> 2, it & 3, ldsg); }
        }
        } SEAM(p0 + 1);
    for (int rep_ = 0, NREP_CUR = NREP(p0 + 2); rep_ < NREP_CUR; ++rep_) { if (rep_) xcd_barrier(bar);
        if (IN(p0 + 2)) {
#ifndef SHIFT_THRESH
#define SHIFT_THRESH 64.0f
#endif
            float negB2; bool shifted;
            {
                const float* gq = g_qn + l * 96; const float* gk = g_kn + l * 96;
                float mq = fmaxf(fabsf(gq[lane]), lane < 32 ? fabsf(gq[64 + lane]) : 0.f), mk = fmaxf(fabsf(gk[lane]), lane < 32 ? fabsf(gk[64 + lane]) : 0.f);
#pragma unroll
                for (int o = 1; o < 64; o <<= 1) { mq = fmaxf(mq, __shfl_xor(mq, o)); mk = fmaxf(mk, __shfl_xor(mk, o)); }
                negB2 = -(96.0f * 1.02f * QSCALE) * mq * mk;
                shifted = __builtin_amdgcn_readfirstlane(negB2 < -SHIFT_THRESH ? 1 : 0) != 0;
                if (!shifted) negB2 = 0.f;
            }
            thin::LruP P{zb, conv_w + l * 1024, conv_b + l * 256, (const bf16_t*)(wtl + WT_GATE), lru_b_a + l * 512, lru_b_x + l * 512, lru_lambda + l * 512, agg, mix};
            if (!EN(6)) {} else if (lastl) { for (int it = vcu; it < 128 * 4; it += G) { const int pl = it >> 2; thin::lru_item<2>(P, pl + pl / 16 + 1, it & 3, ldsg); } }
            else { for (int it = vcu; it < NPAN * 4; it += G) thin::lru_item<2>(P, it >> 2, it & 3, ldsg); }
            if (EN(7)) for (int it = vcu; it < 1024; it += G) {
                const int bh = it >> 4, qp = it & 15, b = bh >> 3, h = bh & 7;
                #ifdef ATT_VAR
                if (rep_ == 0 && NREP(p0 + 2) == 2) att::attn_unit<ATT_VAR>(Qb, Kb, Vb, mix, ssqkv, ssqq, negB2, b * TPB + CTX + qp * 256, b * TPB, TPB, h, ldsg); else
#endif
                if (shifted) att::attn_unit<9>(Qb, Kb, Vb, mix, ssqkv, ssqq, negB2, b * TPB + CTX + qp * 256, b * TPB, TPB, h, ldsg);
                else att::attn_unit<0>(Qb, Kb, Vb, mix, ssqkv, ssqq, negB2, b * TPB + CTX + qp * 256, b * TPB, TPB, h, ldsg);
            }
            if (EN(7) && !lastl) for (int it = G - 1 - vcu; it < 64; it += G) { const int b = it >> 3, h = it & 7;
                if (shifted) att::attn_unit<9>(Qb, Kb, Vb, mix, ssqkv, ssqq, negB2, b * TPB, b * TPB, CTX, h, ldsg); else att::attn_unit<0>(Qb, Kb, Vb, mix, ssqkv, ssqq, negB2, b * TPB, b * TPB, CTX, h, ldsg); }
        }
        } SEAM(p0 + 2);
    for (int rep_ = 0, NREP_CUR = NREP(p0 + 3); rep_ < NREP_CUR; ++rep_) { if (rep_) xcd_barrier(bar);
        if (EN(8) && IN(p0 + 3)) {
            pg8::Gemm g{mix, (const bf16_t*)(wtl + WT_OUT)}; pg8::StaticOrder S; S.init((lastl || GATE_PD) ? 128 : NPAN, 4, G, bx, (lastl || GATE_PD) ? 1 : 0);
            if (l == 0) { epi::EpiRes<true, false> E{x_in, ctx_in, nullptr, xg, ssqx, vl + VEC_G1 * 1024, nullptr, vl + VEC_GM2 * 1024}; pg8::gemm_phase<1024, 1024, 1024, false>(lds, g, S, E); }
            else { epi::EpiRes<false, false> E{nullptr, nullptr, nullptr, xg, ssqx, vl + VEC_G1 * 1024, rvec + (size_t)l * 9 * 2048, vl + VEC_GM2 * 1024}; pg8::gemm_phase<1024, 1024, 1024, false>(lds, g, S, E); }
        }
        } SEAM(p0 + 3);
    for (int rep_ = 0, NREP_CUR = NREP(p0 + 4); rep_ < NREP_CUR; ++rep_) { if (rep_) xcd_barrier(bar);
        if (EN(9) && IN(p0 + 4)) {
            unsigned* gate0 = (unsigned*)(ws + WS_CTL) + 4096;
            if (GATE_PD && !lastl) {
                pg8::Gemm gd{mix, (const bf16_t*)(wtl + WT_OUT)}; pg8::CtxProdOrder SP; SP.init(bx, 128, 3, 4, 0, 1, gate0);
                epi::EpiRes<true, false> Ed{x_in, ctx_in, nullptr, xg, ssqx, vl + VEC_G1 * 1024, nullptr, vl + VEC_GM2 * 1024}; pg8::gemm_phase<1024, 1024, 1024, false>(lds, gd, SP, Ed);
            }
            pg8::Gemm g{xg, (const bf16_t*)(wtl + WT_FF1)}; pg8::StaticOrder S; S.init(lastl ? 128 : NPAN, 16, G, bx, lastl ? 1 : 0);
            epi::EpiFF1 E{U, ssqx, bias_ff + (size_t)l * 9 * D_FF};
            if (GATE_PD && !lastl) { pg8::GatedOrder SG; SG.init(16, G, bx, gate0, 32u, (unsigned*)(ws + WS_CTL) + XB_TMO); pg8::gemm_phase<1024, 1024, 1024, false>(lds, g, SG, E); } else
#ifdef NULL_DUP
            if (rep_ == 0 && NREP_CUR == 2) { epi::EpiSink E0{(float*)(ws + WS_CTL + 65536)}; pg8::gemm_phase<1024, 1024, 1024, false>(lds, g, S, E0); } else
#endif
            pg8::gemm_phase<1024, 1024, 1024, false>(lds, g, S, E);
        }
        } SEAM(p0 + 4);
    for (int rep_ = 0, NREP_CUR = NREP(p0 + 5); rep_ < NREP_CUR; ++rep_) { if (rep_) xcd_barrier(bar);
        if (EN(10) && IN(p0 + 5)) {
            pg8::Gemm g{U, (const bf16_t*)(wtl + WT_FF2)}; pg8::StaticOrder S; S.init(lastl ? 128 : NPAN, 4, G, bx, lastl ? 1 : 0);
#ifdef NULL_DUP
            if (rep_ == 0 && NREP_CUR == 2) { pg8::StaticOrder SL; SL.init(128, 4, G, bx, 1); epi::EpiSink E0{(float*)(ws + WS_CTL + 65536)}; pg8::gemm_phase<4096, 4096, 4096, true>(lds, g, SL, E0); } else
#endif
            if (lastl) { epi::EpiRes<false, true> E{nullptr, nullptr, out, xg, nullptr, vl + VEC_G2 * 1024, rvec + (size_t)l * 9 * 2048 + 1024, nullptr}; pg8::gemm_phase<4096, 4096, 4096, true>(lds, g, S, E); }
            else {
                { pg8::StaticOrder SL; SL.init(128, 4, G, bx, 1);
                  epi::EpiRes<false, false> E{nullptr, nullptr, nullptr, xg, ssqx, vl + VEC_G2 * 1024, rvec + (size_t)l * 9 * 2048 + 1024, vec + (size_t)(l + 1) * 9 * 6144 + VEC_GM1 * 1024}; pg8::gemm_phase<4096, 4096, 4096, true>(lds, g, SL, E); }
                float* slab = out + (size_t)18 * 1024 * 1024;
                { pg8::CtxSplitOrder SC{4, 4, 1024, G, bx, 1}; epi::EpiSlab E{slab, 1024}; pg8::gemm_phase<1024, 4096, 4096, true>(lds, g, SC, E); }
                xcd_barrier(bar);
                ctx_combine(ws, out, rvec + (size_t)(l * 9 + 8) * 2048 + 1024, vl + 8 * 6144 + VEC_G2 * 1024, vec + (size_t)(l + 1) * 9 * 6144 + 8 * 6144 + VEC_GM1 * 1024, gw, NGW, lane);
            }
        }
        } if (!lastl) SEAM(p0 + 5);
    }
#undef IN
#undef SEAM
}


#ifdef DBG_DUMP
__global__ void dbg_dump(const bf16_t* buf, int pitch, int coloff, int ncols, float* out) {
    for (size_t i = blockIdx.x * (size_t)blockDim.x + threadIdx.x; i < (size_t)BATCH * SEQ * D_MODEL; i += (size_t)gridDim.x * blockDim.x) {
        const int c = (int)(i & 1023); const size_t rt = i >> 10; const int b = (int)(rt / SEQ), t = (int)(rt - (size_t)b * SEQ);
        out[i] = c < ncols ? bf2f(buf[((size_t)b * TPB + CTX + t) * pitch + coloff + c]) : 0.f;
    }
}
#endif
#ifndef N_LAUNCH_MODE
#define N_LAUNCH_MODE 1
#endif
extern "C" void kernel_launch(void* const* d_in, const int* in_sizes, int n_in, void* d_out, int out_size, void* d_ws, size_t ws_size, hipStream_t stream) {
    static int grid = 0;
    if (grid == 0) {
        if (n_in != 27 || in_sizes[0] != BATCH * SEQ * D_MODEL || out_size != BATCH * SEQ * D_MODEL || ws_size < WS_END) { fprintf(stderr, "kernel_launch: unexpected shapes (n_in %d, in0 %d, out %d, ws %zu < %zu)\n", n_in, n_in > 0 ? in_sizes[0] : -1, out_size, ws_size, (size_t)WS_END); grid = -1; return; }
        int dev = 0, cus = 0, per_cu = 0;
        if (hipGetDevice(&dev) != hipSuccess || hipDeviceGetAttribute(&cus, hipDeviceAttributeMultiprocessorCount, dev) != hipSuccess) { grid = -1; return; }
        if (hipFuncSetAttribute((const void*)fwd_kernel, hipFuncAttributeMaxDynamicSharedMemorySize, LDS_BYTES) != hipSuccess) { fprintf(stderr, "kernel_launch: hipFuncSetAttribute failed\n"); grid = -1; return; }
        if (hipOccupancyMaxActiveBlocksPerMultiprocessor(&per_cu, (const void*)fwd_kernel, NWAVES * 64, LDS_BYTES) != hipSuccess || per_cu < 1) { fprintf(stderr, "kernel_launch: occupancy query says %d blocks per CU\n", per_cu); (void)hipGetLastError(); grid = -1; return; }
        grid = cus;
    }
    if (grid < 0) return;
    (void)hipMemsetAsync((char*)d_ws + WS_CTL, 0, CTL_ZERO_BYTES, stream);
    Args a{};
    for (int i = 0; i < 27; ++i) a.in[i] = (const float*)d_in[i];
    a.out = (float*)d_out; a.ws = (unsigned char*)d_ws;
#if N_LAUNCH_MODE
    a.ph_lo = 0; a.ph_hi = NPHASE;
    void* kargs[] = {&a};
    hipError_t e = hipLaunchCooperativeKernel((const void*)fwd_kernel, dim3(grid), dim3(NWAVES * 64), kargs, LDS_BYTES, stream);
    if (e != hipSuccess) fprintf(stderr, "kernel_launch: cooperative launch failed: %s\n", hipGetErrorString(e));
#else
#ifndef DBG_STOP_PHASE
#define DBG_STOP_PHASE NPHASE
#endif
    for (int p = 0; p < DBG_STOP_PHASE; ++p) { a.ph_lo = p; a.ph_hi = p + 1; hipLaunchKernelGGL(fwd_kernel, dim3(grid), dim3(NWAVES * 64), LDS_BYTES, stream, a); }
#ifdef DBG_DUMP
    hipLaunchKernelGGL(dbg_dump, dim3(2048), dim3(256), 0, stream, (const bf16_t*)((unsigned char*)d_ws + DBG_DUMP_OFF), DBG_DUMP_PITCH, DBG_DUMP_COL, DBG_DUMP_NCOLS, (float*)d_out);
#endif
#endif
}
```

```cpp
#include <hip/hip_runtime.h>
#include <cstdio>
#include <cstdint>

#define LAS __attribute__((address_space(3)))
#define GAS __attribute__((address_space(1)))
typedef unsigned short bf16_t;
typedef short bf16x8 __attribute__((ext_vector_type(8)));
typedef short s16x4 __attribute__((ext_vector_type(4)));
typedef float f32x4 __attribute__((ext_vector_type(4)));
typedef float f32x2 __attribute__((ext_vector_type(2)));
typedef float f32x16 __attribute__((ext_vector_type(16)));
typedef unsigned u32x4 __attribute__((ext_vector_type(4)));
typedef unsigned u32x2 __attribute__((ext_vector_type(2)));

constexpr int D_MODEL = 1024, BATCH = 8, SEQ = 4096, DEPTH = 2, CTX = 256, D_IN = 1440, D_FF = 4096;
constexpr int TPB = SEQ + CTX;
constexpr int MROWS = BATCH * TPB;
constexpr int PPB = TPB / 256;
constexpr int NPAN = MROWS / 256;
constexpr int ZW = 1536;
constexpr int Z_LX = 0, Z_LG = 256, Z_KVL = 512, Z_PU = 768, Z_QL = 1024, Z_KR = 1408;
constexpr float EPS = 1e-6f;
constexpr float QSCALE = 0.10206207261596575f * 1.4426950408889634f;

typedef __bf16 bf16x2_t __attribute__((ext_vector_type(2)));
__device__ __forceinline__ unsigned cvt_pk_bf16(float lo, float hi) { f32x2 v = {lo, hi}; bf16x2_t b = __builtin_convertvector(v, bf16x2_t); return __builtin_bit_cast(unsigned, b); }
__device__ __forceinline__ float bf2f(unsigned short h) { return __uint_as_float((unsigned)h << 16); }
__device__ __forceinline__ float bflo(unsigned w) { return __uint_as_float(w << 16); }
__device__ __forceinline__ float bfhi(unsigned w) { return __uint_as_float(w & 0xffff0000u); }
__device__ __forceinline__ unsigned short f2bf(float f) { unsigned u = __float_as_uint(f); return (unsigned short)((u + 0x7fffu + ((u >> 16) & 1u)) >> 16); }

namespace pg8 {
constexpr int BM = 256, BK = 64, HALF = 128, HTB = HALF * BK * 2, STAGE_BYTES = 8 * HTB, NXCD = 8, WGM = 8;
__host__ __device__ __forceinline__ int lds_byte(int r, int c) { const int st = (r >> 4) * 2 + (c >> 5), rr = r & 15, cc = c & 31, ob = rr * 64 + cc * 2; return st * 1024 + (ob ^ (((ob >> 9) & 1) << 5)); }
__host__ __device__ __forceinline__ void stage_rc(int b, int& R, int& C) { const int st = b / 1024, sb = b % 1024, swz = sb ^ (((sb >> 9) & 1) << 5); R = (st >> 1) * 16 + swz / 64; C = (st & 1) * 32 + (swz % 64) / 2; }
__host__ __device__ __forceinline__ int perm32(int rho) { const int n = rho >> 4, i = rho & 15; return 8 * (i >> 2) + 4 * n + (i & 3); }

struct Unit { int pm, pn; unsigned koffA, koffB; };
struct Gemm { const bf16_t* A; const bf16_t* Bt; };

struct StaticOrder {
    int nM, nN, nwg, G, c, latonly;
    __device__ void init(int nM_, int nN_, int G_, int c_, int latonly_) { nM = nM_; nN = nN_; nwg = nM * nN; G = G_; c = c_; latonly = latonly_; }
    __device__ bool next(int i, Unit& u) const {
        const long L = (long)i * G + c; if (L >= nwg) return false;
        int wgid = (int)L; { const int q = nwg / NXCD, r = nwg % NXCD, xcd = wgid % NXCD, off = wgid / NXCD; wgid = (xcd < r ? xcd * (q + 1) : r * (q + 1) + (xcd - r) * q) + off; }
        const int nig = WGM * nN, gid = wgid / nig, fm = gid * WGM, gsz = (nM - fm) < WGM ? (nM - fm) : WGM;
        int pm = fm + ((wgid % nig) % gsz); u.pn = (wgid % nig) / gsz;
        if (latonly) pm = pm + pm / 16 + 1;
        u.pm = pm; u.koffA = 0u; u.koffB = 0u; return true;
    }
    __device__ __forceinline__ void a_ready(const Unit&) const {}
    __device__ __forceinline__ void done(const Unit&) const {}
};
struct CtxSplitOrder {
    int nN, NS, KS, G, c, ablk;
    __device__ bool next(int i, Unit& u) const {
        const int L = i * G + c; if (L >= 8 * nN * NS) return false;
        const int ks = L % NS, t = L / NS; u.pn = t % nN; u.pm = (t / nN) * 17; u.koffB = (unsigned)(ks * KS * 2); u.koffA = ablk ? (unsigned)(ks * (KS / 32) * 16384) : u.koffB; return true;
    }
    __device__ __forceinline__ void a_ready(const Unit&) const {}
    __device__ __forceinline__ void done(const Unit&) const {}
};
struct CtxProdOrder {
    int unit, nsel; unsigned pnlist; unsigned* ready;
    __device__ __forceinline__ void init(int c, int c0, int cstride, int nsel_, unsigned pnlist_, unsigned* ready_) { const int d = c - c0; unit = (d >= 0 && d % cstride == 0 && d / cstride < 8 * nsel_) ? d / cstride : -1; nsel = nsel_; pnlist = pnlist_; ready = ready_; }
    __device__ __forceinline__ bool next(int i, Unit& u) const { if (i != 0 || unit < 0) return false; u.pm = 17 * (unit / nsel); u.pn = (int)((pnlist >> (4 * (unit % nsel))) & 15u); u.koffA = 0u; u.koffB = 0u; return true; }
    __device__ __forceinline__ void a_ready(const Unit&) const {}
    __device__ __forceinline__ void done(const Unit& u) const {
        asm volatile("s_waitcnt vmcnt(0)" ::: "memory");
        __builtin_amdgcn_fence(__ATOMIC_RELEASE, "agent");
        asm volatile("s_waitcnt vmcnt(0)" ::: "memory");
        if ((threadIdx.x & 63) == 0) (void)__hip_atomic_fetch_add(ready + 64 * (u.pm / 17), 1u, __ATOMIC_RELAXED, __HIP_MEMORY_SCOPE_AGENT);
    }
};
struct GatedOrder {
    int nN, nwg, G, c; const unsigned* ready; unsigned need; unsigned* tmo;
    __device__ __forceinline__ void init(int nN_, int G_, int c_, const unsigned* ready_, unsigned need_, unsigned* tmo_) { nN = nN_; nwg = 136 * nN_; G = G_; c = c_; ready = ready_; need = need_; tmo = tmo_; }
    __device__ __forceinline__ bool next(int i, Unit& u) const {
        const long L = (long)i * G + c; if (L >= nwg) return false;
        int wgid = (int)L; { const int q = nwg / NXCD, r = nwg % NXCD, xcd = wgid % NXCD, off = wgid / NXCD; wgid = (xcd < r ? xcd * (q + 1) : r * (q + 1) + (xcd - r) * q) + off; }
        const int nig = WGM * nN, gid = wgid / nig, fm = gid * WGM;
        const int q = fm + ((wgid % nig) % WGM); u.pn = (wgid % nig) / WGM;
        u.pm = q < 128 ? q + q / 16 + 1 : (q - 128) * 17; u.koffA = 0u; u.koffB = 0u; return true;
    }
    __device__ __forceinline__ void a_ready(const Unit& u) const {
        if (u.pm % 17 != 0) return;
        if (threadIdx.x < 64) {
            const unsigned* w = ready + 64 * (u.pm / 17); unsigned sp = 0u;
            while ((unsigned)__builtin_amdgcn_readfirstlane(__hip_atomic_load(w, __ATOMIC_RELAXED, __HIP_MEMORY_SCOPE_AGENT)) < need) {
                __builtin_amdgcn_s_sleep(2);
                if ((++sp & 255u) == 0u) { if (__hip_atomic_load(tmo, __ATOMIC_RELAXED, __HIP_MEMORY_SCOPE_AGENT)) break; if (sp > (1u << 20)) { if (threadIdx.x == 0) atomicAdd(tmo, 1u); break; } } }
            __builtin_amdgcn_fence(__ATOMIC_ACQUIRE, "agent");
            asm volatile("s_waitcnt vmcnt(0)" ::: "memory");
        }
        asm volatile("" ::: "memory"); __builtin_amdgcn_s_barrier(); asm volatile("" ::: "memory");
    }
    __device__ __forceinline__ void done(const Unit&) const {}
};

template <int K, int LDA, int LDB, bool ABLK, class Epi, class Sched>
__device__ __forceinline__ void gemm_phase(LAS unsigned char* lds, const Gemm g, const Sched& S, const Epi& E) {
    int tid = threadIdx.x; asm volatile("" : "+v"(tid));
    const int  wid = __builtin_amdgcn_readfirstlane(tid >> 6), lane = tid & 63, wr = wid >> 2, wc = wid & 3, fr = lane & 15, fq = lane >> 4;
    constexpr int nt = K / BK;
    unsigned voffA[2], voffB[2];
#pragma unroll
    for (int i = 0; i < 2; ++i) { int R, C; stage_rc(tid * 16 + i * 8192, R, C); const int Rb = Epi::PERM ? ((R & ~31) + perm32(R & 31)) : R;
        voffA[i] = ABLK ? (unsigned)((C >> 5) * 16384 + (R >> 4) * 1024 + ((R & 15) * 32 + (C & 31)) * 2) : (unsigned)(R * LDA + C) * 2u; voffB[i] = (unsigned)(Rb * LDB + C) * 2u; }
    const size_t kstep = (size_t)(BK * 2);
    const size_t kstepA = ABLK ? (size_t)32768 : kstep;
    const size_t hstepA = ABLK ? (size_t)8192 : (size_t)HALF * LDA * 2, tstepA = ABLK ? (size_t)(LDA / 32) * 16384 : 2 * hstepA;
    const size_t hstepB = (size_t)HALF * LDB * 2, tstepB = 2 * hstepB;
    const unsigned ldsw = (unsigned)wid * 1024u;
    const int aoff = lds_byte(wr * 64 + fr, fq * 8), boff = lds_byte(wc * 32 + fr, fq * 8);
#define PG8_SA(b, h) (((b) * 2 + (h)) * HTB)
#define PG8_SB(b, h) ((4 + (b) * 2 + (h)) * HTB)
#define PG8_STAGE(bufoff, gbase, voff) do { _Pragma("unroll") for (int _i = 0; _i < 2; ++_i) \
        __builtin_amdgcn_global_load_lds((const unsigned*)((const char*)(gbase) + (voff)[_i]), (LAS unsigned*)(lds + (bufoff) + ldsw + _i * 8192), 16, 0, 0); } while (0)
#define PG8_LDA(dst, b, h) do { _Pragma("unroll") for (int m = 0; m < 4; ++m) _Pragma("unroll") for (int k = 0; k < 2; ++k) dst[m][k] = *(const LAS bf16x8*)(lds + PG8_SA(b, h) + aoff + m * 2048 + k * 1024); } while (0)
#define PG8_LDB(dst, b, h) do { _Pragma("unroll") for (int n = 0; n < 2; ++n) _Pragma("unroll") for (int k = 0; k < 2; ++k) dst[n][k] = *(const LAS bf16x8*)(lds + PG8_SB(b, h) + boff + n * 2048 + k * 1024); } while (0)
#define PG8_MMA(ai, bj, At, Bt) do { __builtin_amdgcn_s_setprio(1); _Pragma("unroll") for (int m = 0; m < 4; ++m) _Pragma("unroll") for (int n = 0; n < 2; ++n) _Pragma("unroll") for (int k = 0; k < 2; ++k) \
        acc[ai][bj][m][n] = __builtin_amdgcn_mfma_f32_16x16x32_bf16(Bt[n][k], At[m][k], acc[ai][bj][m][n], 0, 0, 0); __builtin_amdgcn_s_setprio(0); } while (0)
#define PG8_WAIT_V(n) asm volatile("s_waitcnt vmcnt(" #n ")" ::: "memory")
#define PG8_WAIT_L(n) asm volatile("s_waitcnt lgkmcnt(" #n ")" ::: "memory")
#define PG8_BAR __builtin_amdgcn_s_barrier()
#define PG8_SCHED __builtin_amdgcn_sched_barrier(0)
    Unit cur, nxt; int ui = 0;
    if (!S.next(0, cur)) return;
    f32x4 acc[2][2][4][2];
#pragma unroll
    for (int a = 0; a < 2; ++a)
#pragma unroll
        for (int b = 0; b < 2; ++b)
#pragma unroll
            for (int m = 0; m < 4; ++m)
#pragma unroll
                for (int n = 0; n < 2; ++n) acc[a][b][m][n] = (f32x4){0.f, 0.f, 0.f, 0.f};
    bf16x8 At[4][2], B0[2][2], B1[2][2];
    const char* cA = (const char*)g.A + (size_t)cur.pm * tstepA + cur.koffA; const char* cB = (const char*)g.Bt + (size_t)cur.pn * tstepB + cur.koffB;
    S.a_ready(cur);
    PG8_STAGE(PG8_SB(0, 0), cB, voffB); PG8_STAGE(PG8_SB(0, 1), cB + hstepB, voffB); PG8_STAGE(PG8_SA(0, 0), cA, voffA); PG8_STAGE(PG8_SA(0, 1), cA + hstepA, voffA);
    if (wr == 1) PG8_BAR;
    PG8_WAIT_V(2); PG8_BAR;
    PG8_STAGE(PG8_SB(1, 0), cB + kstep, voffB); PG8_STAGE(PG8_SA(1, 0), cA + kstepA, voffA); PG8_STAGE(PG8_SB(1, 1), cB + hstepB + kstep, voffB);
    PG8_WAIT_V(6); PG8_BAR;
    for (;;) {
        const bool has_next = S.next(ui + 1, nxt);
        const char* nA = has_next ? (const char*)g.A + (size_t)nxt.pm * tstepA + nxt.koffA : cA; const char* nB = has_next ? (const char*)g.Bt + (size_t)nxt.pn * tstepB + nxt.koffB : cB;
#pragma unroll 1
        for (int t = 0; t < nt; t += 2) {
            const bool last = (t == nt - 2);
            const char* a1 = cA + (size_t)(t + 1) * kstepA;
            const char* a2 = last ? nA : cA + (size_t)(t + 2) * kstepA; const char* b2 = last ? nB : cB + (size_t)(t + 2) * kstep;
            const char* a3 = a2 + kstepA; const char* b3 = b2 + kstep;
            if (last && has_next) S.a_ready(nxt);
            PG8_LDB(B0, 0, 0); PG8_LDB(B1, 0, 1); PG8_SCHED; PG8_LDA(At, 0, 0); PG8_STAGE(PG8_SA(1, 1), a1 + hstepA, voffA);
            PG8_WAIT_V(8); PG8_WAIT_L(0); PG8_BAR; PG8_MMA(0, 0, At, B0); PG8_MMA(0, 1, At, B1); PG8_BAR; PG8_SCHED;
            PG8_LDA(At, 0, 1); PG8_STAGE(PG8_SB(0, 0), b2, voffB); PG8_STAGE(PG8_SB(0, 1), b2 + hstepB, voffB); PG8_STAGE(PG8_SA(0, 0), a2, voffA);
            PG8_WAIT_V(8); PG8_WAIT_L(0); PG8_BAR; PG8_MMA(1, 0, At, B0); PG8_MMA(1, 1, At, B1); PG8_BAR; PG8_SCHED;
            PG8_LDB(B0, 1, 0); PG8_LDB(B1, 1, 1); PG8_SCHED; PG8_LDA(At, 1, 0); PG8_STAGE(PG8_SA(0, 1), a2 + hstepA, voffA);
            PG8_WAIT_V(8); PG8_WAIT_L(0); PG8_BAR; PG8_MMA(0, 0, At, B0); PG8_MMA(0, 1, At, B1); PG8_BAR; PG8_SCHED;
            PG8_LDA(At, 1, 1); PG8_STAGE(PG8_SB(1, 0), b3, voffB); PG8_STAGE(PG8_SB(1, 1), b3 + hstepB, voffB); PG8_STAGE(PG8_SA(1, 0), a3, voffA);
            PG8_WAIT_V(8); PG8_WAIT_L(0); PG8_BAR; PG8_MMA(1, 0, At, B0); PG8_MMA(1, 1, At, B1); PG8_BAR; PG8_SCHED;
        }
        if (wr == 0) PG8_BAR;
        { int fr2 = fr, fq2 = fq; asm volatile("" : "+v"(fr2), "+v"(fq2));
          E(acc, cur, wr, wc, fr2, fq2); }
        S.done(cur);
        if (!has_next) break;
#pragma unroll
        for (int a = 0; a < 2; ++a)
#pragma unroll
            for (int b = 0; b < 2; ++b)
#pragma unroll
                for (int m = 0; m < 4; ++m)
#pragma unroll
                    for (int n = 0; n < 2; ++n) acc[a][b][m][n] = (f32x4){0.f, 0.f, 0.f, 0.f};
        cur = nxt; cA = nA; cB = nB; ++ui;
        if (wr == 1) PG8_BAR;
    }
    PG8_WAIT_V(0);
    PG8_BAR;
#undef PG8_SA
#undef PG8_SB
#undef PG8_STAGE
#undef PG8_LDA
#undef PG8_LDB
#undef PG8_MMA
#undef PG8_WAIT_V
#undef PG8_WAIT_L
#undef PG8_BAR
#undef PG8_SCHED
}
}
namespace epi {
using pg8::Unit;
typedef f32x4 Acc[2][2][4][2];
__device__ __forceinline__ float sum4(f32x4 v) { return (v[0] + v[1]) + (v[2] + v[3]); }
__device__ __forceinline__ float sq4(f32x4 v) { return (v[0] * v[0] + v[1] * v[1]) + (v[2] * v[2] + v[3] * v[3]); }
__device__ __forceinline__ float red_fq(float s) { s += __shfl_xor(s, 16); s += __shfl_xor(s, 32); return s; }
__device__ __forceinline__ u32x4 pack8(f32x4 a, f32x4 b) { u32x4 w; w.x = cvt_pk_bf16(a[0], a[1]); w.y = cvt_pk_bf16(a[2], a[3]); w.z = cvt_pk_bf16(b[0], b[1]); w.w = cvt_pk_bf16(b[2], b[3]); return w; }
__device__ __forceinline__ void rope4(f32x4& x1, f32x4& x2, const float* rtab, int t, int fq) {
    const int idx = (fq >> 1) ? (t & 63) : (t >> 6);
    const f32x4 c0 = *(const f32x4*)(rtab + (idx * 8 + (fq & 1) * 4) * 2), c1 = *(const f32x4*)(rtab + (idx * 8 + (fq & 1) * 4) * 2 + 4);
    const f32x4 cs = (f32x4){c0[0], c0[2], c1[0], c1[2]}, sn = (f32x4){c0[1], c0[3], c1[1], c1[3]};
    const f32x4 y1 = x1 * cs - x2 * sn, y2 = x2 * cs + x1 * sn; x1 = y1; x2 = y2;
}
__device__ __forceinline__ float row_rstd16(const float* ssq, int row, int fq, float inv_n) {
    const f32x4 p = *(const f32x4*)(ssq + (size_t)row * 16 + 4 * fq); return rsqrtf(red_fq(sum4(p)) * inv_n + EPS);
}

struct EpiIn {
    static constexpr bool PERM = true;
    bf16_t* z; const float* ssqx; const float* bias; float* ssqkv; const float* gkn; const float* rtab;
    __device__ __forceinline__ void operator()(const Acc& acc, const Unit& u, int wr, int wc, int fr, int fq) const {
        const int pm = u.pm, pn = u.pn, b = pm / PPB, pp = pm - b * PPB, bidx = pp == 0 ? 8 : b;
        const float* bia = bias + bidx * ZW + pn * 256 + wc * 32 + 8 * fq;
        f32x4 bv[2][2];
#pragma unroll
        for (int bj = 0; bj < 2; ++bj)
#pragma unroll
            for (int n = 0; n < 2; ++n) bv[bj][n] = *(const f32x4*)(bia + bj * 128 + 4 * n);
        const int ax = fq >> 1, f0 = (fq & 1) * 4;
        const f32x4 gk1 = *(const f32x4*)(gkn + 64 + ax * 16 + f0), gk2 = *(const f32x4*)(gkn + 64 + ax * 16 + 8 + f0);
#pragma unroll
        for (int ai = 0; ai < 2; ++ai)
#pragma unroll
            for (int m = 0; m < 4; ++m) {
                const int rl = ai * 128 + wr * 64 + m * 16 + fr, row = pm * 256 + rl;
                const float rs = row_rstd16(ssqx, row, fq, 1.0f / 1024.0f);
                f32x4 v[2][2];
#pragma unroll
                for (int bj = 0; bj < 2; ++bj)
#pragma unroll
                    for (int n = 0; n < 2; ++n) v[bj][n] = acc[ai][bj][m][n] * rs + bv[bj][n];
                if (pn == 2 || pn == 4) {
                    const float s = red_fq((sq4(v[0][0]) + sq4(v[0][1])) + (sq4(v[1][0]) + sq4(v[1][1])));
                    if (fq == 0) ssqkv[(size_t)row * 16 + (pn == 2 ? wc : 4 + wc)] = s;
                }
                if (pn == 5) {
                    const float s = red_fq(sq4(v[0][0]) + sq4(v[0][1]));
                    if (fq == 0) ssqkv[(size_t)row * 16 + 8 + wc] = s;
                    if (wc == 0) {
                        const float s1 = red_fq(sq4(v[1][0]) + sq4(v[1][1]));
                        if (fq == 0) ssqkv[(size_t)row * 16 + 12] = s1;
                        v[1][0] = v[1][0] * gk1; v[1][1] = v[1][1] * gk2;
                        if (pp != 0) rope4(v[1][0], v[1][1], rtab, (pp - 1) * 256 + rl, fq);
                    }
                }
                bf16_t* zp = z + (size_t)row * ZW + pn * 256 + wc * 32 + 8 * fq;
#pragma unroll
                for (int bj = 0; bj < 2; ++bj) *(u32x4*)(zp + bj * 128) = pack8(v[bj][0], v[bj][1]);
                asm volatile("" ::: "memory");
            }
    }
};

struct EpiQ {
    static constexpr bool PERM = true;
    bf16_t* Q; float* ssqq; const float* gqn; const float* rtab;
    __device__ __forceinline__ void operator()(const Acc& acc, const Unit& u, int wr, int wc, int fr, int fq) const {
        const int pm = u.pm, pn = u.pn, b = pm / PPB, pp = pm - b * PPB;
        const int ax = fq >> 1, f0 = (fq & 1) * 4;
        f32x4 g0[2], g1[2]; int part[2], grp[2];
#pragma unroll
        for (int bj = 0; bj < 2; ++bj) {
            grp[bj] = pn * 8 + bj * 4 + wc; part[bj] = grp[bj] % 3;
            if (part[bj] < 2) { g0[bj] = *(const f32x4*)(gqn + 32 * part[bj] + 8 * fq); g1[bj] = *(const f32x4*)(gqn + 32 * part[bj] + 8 * fq + 4); }
            else { g0[bj] = *(const f32x4*)(gqn + 64 + ax * 16 + f0); g1[bj] = *(const f32x4*)(gqn + 64 + ax * 16 + 8 + f0); }
        }
#pragma unroll
        for (int ai = 0; ai < 2; ++ai)
#pragma unroll
            for (int m = 0; m < 4; ++m) {
                const int rl = ai * 128 + wr * 64 + m * 16 + fr, row = pm * 256 + rl;
                bf16_t* qp = Q + (size_t)row * 768 + pn * 256 + wc * 32 + 8 * fq;
#pragma unroll
                for (int bj = 0; bj < 2; ++bj) {
                    const f32x4 a0 = acc[ai][bj][m][0], a1 = acc[ai][bj][m][1];
                    const float s = red_fq(sq4(a0) + sq4(a1));
                    if (fq == 0) ssqq[(size_t)row * 24 + grp[bj]] = s;
                    f32x4 v0 = a0 * g0[bj], v1 = a1 * g1[bj];
                    if (part[bj] == 2 && pp != 0) rope4(v0, v1, rtab, (pp - 1) * 256 + rl, fq);
                    *(u32x4*)(qp + bj * 128) = pack8(v0, v1);
                }
                asm volatile("" ::: "memory");
            }
    }
};

struct EpiKV {
    static constexpr bool PERM = true;
    bf16_t* Kb; bf16_t* Vb; const bf16_t* z; const float* ssqkv; const float* gkn;
    __device__ __forceinline__ void operator()(const Acc& acc, const Unit& u, int wr, int wc, int fr, int fq) const {
        const int pm = u.pm, pn = u.pn;
        f32x4 gk[2][2];
#pragma unroll
        for (int bj = 0; bj < 2; ++bj)
#pragma unroll
            for (int n = 0; n < 2; ++n) gk[bj][n] = *(const f32x4*)(gkn + 32 * bj + 8 * fq + 4 * n);
#pragma unroll
        for (int ai = 0; ai < 2; ++ai)
#pragma unroll
            for (int m = 0; m < 4; ++m) {
                const int rl = ai * 128 + wr * 64 + m * 16 + fr, row = pm * 256 + rl;
                const f32x4 st = *(const f32x4*)(ssqkv + (size_t)row * 16);
                const float s = rsqrtf(sum4(st) * (1.0f / 256.0f) + EPS);
                if (pn < 2) {
                    const int head = 4 * pn + wc;
                    const float ss = red_fq((sq4(acc[ai][0][m][0]) + sq4(acc[ai][0][m][1])) + (sq4(acc[ai][1][m][0]) + sq4(acc[ai][1][m][1])));
                    const float sskr = ssqkv[(size_t)row * 16 + 12];
                    const float rk = rsqrtf((s * s * ss + sskr) * (1.0f / 96.0f) + EPS);
                    const float sk = s * rk;
                    bf16_t* kp = Kb + (size_t)row * 768 + head * 96;
#pragma unroll
                    for (int bj = 0; bj < 2; ++bj) *(u32x4*)(kp + 32 * bj + 8 * fq) = pack8(acc[ai][bj][m][0] * gk[bj][0] * sk, acc[ai][bj][m][1] * gk[bj][1] * sk);
                    const u32x4 kr = *(const u32x4*)(z + (size_t)row * ZW + Z_KR + 8 * fq);
                    u32x4 o;
                    o.x = cvt_pk_bf16(bflo(kr.x) * rk, bfhi(kr.x) * rk); o.y = cvt_pk_bf16(bflo(kr.y) * rk, bfhi(kr.y) * rk);
                    o.z = cvt_pk_bf16(bflo(kr.z) * rk, bfhi(kr.z) * rk); o.w = cvt_pk_bf16(bflo(kr.w) * rk, bfhi(kr.w) * rk);
                    *(u32x4*)(kp + 64 + 8 * fq) = o;
                } else {
                    const int head = 4 * (pn - 2) + wc;
                    bf16_t* vp = Vb + (size_t)row * 512 + head * 64;
#pragma unroll
                    for (int bj = 0; bj < 2; ++bj) *(u32x4*)(vp + 32 * bj + 8 * fq) = pack8(acc[ai][bj][m][0] * s, acc[ai][bj][m][1] * s);
                }
                if (m & 1) asm volatile("" ::: "memory");
            }
    }
};

template <bool IN_F32, bool OUT_F32>
struct EpiRes {
    static constexpr bool PERM = true;
    const float* xin_lat; const float* xin_ctx; float* xout; bf16_t* xg; float* ssqx; const float* gate; const float* rgm_prev; const float* gm;
    __device__ __forceinline__ void operator()(const Acc& acc, const Unit& u, int wr, int wc, int fr, int fq) const {
        const int pm = u.pm, pn = u.pn, b = pm / PPB, pp = pm - b * PPB, bidx = pp == 0 ? 8 : b;
        const size_t rbase = pp == 0 ? (size_t)b * 256 : (size_t)b * SEQ + (size_t)(pp - 1) * 256;
        const float* xi = IN_F32 ? (pp == 0 ? xin_ctx : xin_lat) + rbase * D_MODEL : nullptr;
        float* xo = OUT_F32 ? xout + rbase * D_MODEL : nullptr;
        const int col0 = pn * 256 + wc * 32 + 8 * fq;
        f32x4 gv[2][2], mv[2][2], rv[2][2];
#pragma unroll
        for (int bj = 0; bj < 2; ++bj)
#pragma unroll
            for (int n = 0; n < 2; ++n) { gv[bj][n] = *(const f32x4*)(gate + bidx * 6144 + col0 + bj * 128 + n * 4);
                mv[bj][n] = OUT_F32 ? (f32x4){0.f, 0.f, 0.f, 0.f} : *(const f32x4*)(gm + bidx * 6144 + col0 + bj * 128 + n * 4);
                rv[bj][n] = IN_F32 ? (f32x4){0.f, 0.f, 0.f, 0.f} : *(const f32x4*)(rgm_prev + bidx * 2048 + col0 + bj * 128 + n * 4); }
#pragma unroll
        for (int ai = 0; ai < 2; ++ai)
#pragma unroll
            for (int m = 0; m < 4; ++m) {
                const int rl = ai * 128 + wr * 64 + m * 16 + fr; const size_t urow = (size_t)pm * 256 + rl, off = urow * D_MODEL + col0;
                float ss = 0.f;
#pragma unroll
                for (int bj = 0; bj < 2; ++bj) {
                    f32x4 x0, x1;
                    if (IN_F32) { x0 = *(const f32x4*)(xi + (size_t)rl * D_MODEL + col0 + bj * 128); x1 = *(const f32x4*)(xi + (size_t)rl * D_MODEL + col0 + bj * 128 + 4); }
                    else { const u32x4 w = *(const u32x4*)(xg + off + bj * 128); x0 = (f32x4){bflo(w.x), bfhi(w.x), bflo(w.y), bfhi(w.y)} * rv[bj][0]; x1 = (f32x4){bflo(w.z), bfhi(w.z), bflo(w.w), bfhi(w.w)} * rv[bj][1]; }
                    x0 += gv[bj][0] * acc[ai][bj][m][0]; x1 += gv[bj][1] * acc[ai][bj][m][1];
                    if (OUT_F32) { *(f32x4*)(xo + (size_t)rl * D_MODEL + col0 + bj * 128) = x0; *(f32x4*)(xo + (size_t)rl * D_MODEL + col0 + bj * 128 + 4) = x1; }
                    else { ss += sq4(x0) + sq4(x1); *(u32x4*)(xg + off + bj * 128) = pack8(x0 * mv[bj][0], x1 * mv[bj][1]); }
                }
                if (!OUT_F32) { ss = red_fq(ss); if (fq == 0) ssqx[urow * 16 + pn * 4 + wc] = ss; }
                asm volatile("" ::: "memory");
            }
    }
};

struct EpiSlab {
    static constexpr bool PERM = true;
    float* slab; int KS;
    __device__ __forceinline__ void operator()(const Acc& acc, const Unit& u, int wr, int wc, int fr, int fq) const {
        const int cp = u.pm / PPB, ks = (int)(u.koffB / (unsigned)(2 * KS));
        float* sp = slab + ((size_t)(ks * (BATCH * CTX) + cp * 256)) * D_MODEL + u.pn * 256 + wc * 32 + 8 * fq;
#pragma unroll
        for (int ai = 0; ai < 2; ++ai)
#pragma unroll
            for (int m = 0; m < 4; ++m) { float* rp = sp + (size_t)(ai * 128 + wr * 64 + m * 16 + fr) * D_MODEL;
#pragma unroll
                for (int bj = 0; bj < 2; ++bj) { *(f32x4*)(rp + bj * 128) = acc[ai][bj][m][0]; *(f32x4*)(rp + bj * 128 + 4) = acc[ai][bj][m][1]; } }
    }
};

struct EpiFF1 {
    static constexpr bool PERM = true;
    bf16_t* U; const float* ssqx; const float* bias;
    __device__ __forceinline__ void operator()(const Acc& acc, const Unit& u, int wr, int wc, int fr, int fq) const {
        const int pm = u.pm, pn = u.pn, b = pm / PPB, pp = pm - b * PPB, bidx = pp == 0 ? 8 : b;
        const float* bia = bias + bidx * D_FF + pn * 256 + wc * 32 + 8 * fq;
        f32x4 bv[2][2];
#pragma unroll
        for (int bj = 0; bj < 2; ++bj)
#pragma unroll
            for (int n = 0; n < 2; ++n) bv[bj][n] = *(const f32x4*)(bia + bj * 128 + 4 * n);
#pragma unroll
        for (int ai = 0; ai < 2; ++ai)
#pragma unroll
            for (int m = 0; m < 4; ++m) {
                const int row = pm * 256 + ai * 128 + wr * 64 + m * 16 + fr;
                const float rs = row_rstd16(ssqx, row, fq, 1.0f / 1024.0f);
                bf16_t* up = U + (((size_t)pm * 128 + pn * 8 + wc) * 16 + (ai * 8 + wr * 4 + m)) * 512 + fr * 32 + 8 * fq;
#pragma unroll
                for (int bj = 0; bj < 2; ++bj) {
                    f32x4 v0 = acc[ai][bj][m][0] * rs + bv[bj][0], v1 = acc[ai][bj][m][1] * rs + bv[bj][1];
#pragma unroll
                    for (int e = 0; e < 4; ++e) { const float a = fmaxf(v0[e], 0.f), c = fmaxf(v1[e], 0.f); v0[e] = a * a; v1[e] = c * c; }
#ifndef U_NT
#define U_NT 1
#endif
#if U_NT
                    __builtin_nontemporal_store(pack8(v0, v1), (u32x4*)(up + (size_t)bj * 4 * 16 * 512));
#else
                    *(u32x4*)(up + (size_t)bj * 4 * 16 * 512) = pack8(v0, v1);
#endif
                }
                asm volatile("" ::: "memory");
            }
    }
};
struct EpiSink {
    static constexpr bool PERM = true;
    float* dummy;
    __device__ __forceinline__ void operator()(const Acc& acc, const Unit& u, int wr, int wc, int fr, int fq) const {
        f32x4 s = {0.f, 0.f, 0.f, 0.f};
#pragma unroll
        for (int ai = 0; ai < 2; ++ai)
#pragma unroll
            for (int bj = 0; bj < 2; ++bj)
#pragma unroll
                for (int m = 0; m < 4; ++m) s += acc[ai][bj][m][0] + acc[ai][bj][m][1];
        const float t = s[0] + s[1] + s[2] + s[3];
        if (t == 1.2345678e33f) dummy[u.pm] = t;
    }
};
}
namespace att {
constexpr int NW = 8, QBLK = 32, KVBLK = 64, DQK = 96, DV = 64;
constexpr int KROWB = 208;
constexpr int SHM_K = KVBLK * KROWB, SHM_V = KVBLK * DV * 2;
constexpr int NSLOT = 3;
constexpr int LDS_V = 0, LDS_K = NSLOT * SHM_V, LDS_WS = LDS_K + NSLOT * SHM_K, LDS_OST = LDS_WS + NW * 64 * 4, LDS_BYTES = LDS_OST + NW * 4096;
#define SBAR() __builtin_amdgcn_sched_barrier(0)
__device__ __forceinline__ int crow(int r, int hi) { return (r & 3) + 8 * (r >> 2) + 4 * hi; }

template <int VAR> __device__ __forceinline__ void partialSM(f32x16& p0, float shift) {
  if (VAR == 1) return;
  if (VAR == 9) {
#pragma unroll
    for (int r = 0; r < 16; ++r) p0[r] -= shift; }
#pragma unroll
  for (int r = 0; r < 16; ++r) p0[r] = __builtin_amdgcn_exp2f(p0[r]);
}
template <int VAR> __device__ __forceinline__ void finishSM(f32x16& p0, f32x16& p1, float shift, float& l_reg, bf16x8& pa0, bf16x8& pa1, bf16x8& pa2, bf16x8& pa3) {
  if (VAR == 9) {
#pragma unroll
    for (int r = 0; r < 16; ++r) p1[r] -= shift; }
  if (VAR != 1) {
#pragma unroll
  for (int r = 0; r < 16; ++r) p1[r] = __builtin_amdgcn_exp2f(p1[r]); }
  float ps = 0;
#pragma unroll
  for (int r = 0; r < 16; ++r) ps += p0[r];
#pragma unroll
  for (int r = 0; r < 16; ++r) ps += p1[r];
  l_reg += ps;
#define PK4(P, BASE, OUT) do { u32x4 w = {cvt_pk_bf16(P[BASE + 0], P[BASE + 1]), cvt_pk_bf16(P[BASE + 2], P[BASE + 3]), cvt_pk_bf16(P[BASE + 4], P[BASE + 5]), cvt_pk_bf16(P[BASE + 6], P[BASE + 7])}; \
    OUT = *reinterpret_cast<bf16x8*>(&w); } while (0)
  PK4(p0, 0, pa0); PK4(p0, 8, pa1); PK4(p1, 0, pa2); PK4(p1, 8, pa3);
#undef PK4
}
#define KFR(KS, d0, half) (*reinterpret_cast<const bf16x8*>((KS) + (r32 + 32 * (half)) * KROWB + ((d0) * 16 + hi * 8) * 2))
__device__ __forceinline__ void kread4(bf16x8* kf, const char* Ks, int r32, int hi) { kf[0] = KFR(Ks, 0, 0); kf[1] = KFR(Ks, 0, 1); kf[2] = KFR(Ks, 1, 0); kf[3] = KFR(Ks, 1, 1); }
#define MF(A_, B_, C_) __builtin_amdgcn_mfma_f32_32x32x16_bf16(A_, B_, C_, 0, 0, 0)
template <bool FIN, int VAR>
__device__ __forceinline__ void qkt_fin(f32x16& p0, f32x16& p1, const char* Ks, const bf16x8* qr, int r32, int hi,
                                        f32x16& f0, f32x16& f1, float shift, float& l_reg, bf16x8& pa0, bf16x8& pa1, bf16x8& pa2, bf16x8& pa3) {
  bf16x8 kf[4]; kf[0] = VAR == 8 ? qr[0] : KFR(Ks, 0, 0); kf[1] = VAR == 8 ? qr[0] : KFR(Ks, 0, 1); kf[2] = VAR == 8 ? qr[1] : KFR(Ks, 1, 0); kf[3] = VAR == 8 ? qr[1] : KFR(Ks, 1, 1);
  SBAR();
  const bf16x8 b0 = VAR == 8 ? qr[2] : KFR(Ks, 2, 0), b1 = VAR == 8 ? qr[2] : KFR(Ks, 2, 1), b2 = VAR == 8 ? qr[3] : KFR(Ks, 3, 0), b3 = VAR == 8 ? qr[3] : KFR(Ks, 3, 1);
  p0 = MF(kf[0], qr[0], f32x16{}); p1 = MF(kf[1], qr[0], f32x16{});
  p0 = MF(kf[2], qr[1], p0); p1 = MF(kf[3], qr[1], p1);
  if (FIN) {
    if (VAR == 9) {
#pragma unroll
      for (int r = 0; r < 16; ++r) f1[r] -= shift; }
    if (VAR != 1) {
#pragma unroll
      for (int r = 0; r < 16; ++r) f1[r] = __builtin_amdgcn_exp2f(f1[r]); }
  }
  SBAR();
  const bf16x8 c0 = VAR == 8 ? qr[4] : KFR(Ks, 4, 0), c1 = VAR == 8 ? qr[4] : KFR(Ks, 4, 1), c2 = VAR == 8 ? qr[5] : KFR(Ks, 5, 0), c3 = VAR == 8 ? qr[5] : KFR(Ks, 5, 1);
  p0 = MF(b0, qr[2], p0); p1 = MF(b1, qr[2], p1);
  p0 = MF(b2, qr[3], p0); p1 = MF(b3, qr[3], p1);
  if (FIN) {
    float ps = 0;
#pragma unroll
    for (int r = 0; r < 16; ++r) ps += f0[r];
#pragma unroll
    for (int r = 0; r < 16; ++r) ps += f1[r];
    l_reg += ps;
  }
  SBAR();
  p0 = MF(c0, qr[4], p0); p1 = MF(c1, qr[4], p1);
  p0 = MF(c2, qr[5], p0); p1 = MF(c3, qr[5], p1);
  if (FIN) {
#define PK4(P, BASE, OUT) do { u32x4 w = {cvt_pk_bf16(P[BASE + 0], P[BASE + 1]), cvt_pk_bf16(P[BASE + 2], P[BASE + 3]), cvt_pk_bf16(P[BASE + 4], P[BASE + 5]), cvt_pk_bf16(P[BASE + 6], P[BASE + 7])}; \
    OUT = *reinterpret_cast<bf16x8*>(&w); } while (0)
    PK4(f0, 0, pa0); PK4(f0, 8, pa1); PK4(f1, 0, pa2); PK4(f1, 8, pa3);
#undef PK4
  }
}
#undef MF
__device__ __forceinline__ int v_st(int k, int c) { return ((k >> 3) * 2 + (c >> 5)) * 512 + ((k & 7) * 32 + (c & 31)) * 2; }
__device__ __forceinline__ int v_rd_base(int lane) { return ((lane & 3) << 3) | (((lane >> 2) & 3) << 6) | (((lane >> 4) & 1) << 5) | (((lane >> 5) & 1) << 8); }
constexpr int v_rd_off(int d0, int ks, int half) { return d0 * 512 + ks * 2048 + half * 1024; }
template <int OFF> __device__ __forceinline__ s16x4 tr_read(int vb) {
  s16x4 r; asm volatile("ds_read_b64_tr_b16 %0, %1 offset:%2" : "=&v"(r) : "v"(vb), "i"(OFF) : "memory"); return r;
}
template <int D0> __device__ __forceinline__ void pv_one(f32x16& od, int vb, bf16x8 pa0, bf16x8 pa1, bf16x8 pa2, bf16x8 pa3) {
  const s16x4 l0 = tr_read<v_rd_off(D0, 0, 0)>(vb), h0 = tr_read<v_rd_off(D0, 0, 1)>(vb), l1 = tr_read<v_rd_off(D0, 1, 0)>(vb), h1 = tr_read<v_rd_off(D0, 1, 1)>(vb);
  const s16x4 l2 = tr_read<v_rd_off(D0, 2, 0)>(vb), h2 = tr_read<v_rd_off(D0, 2, 1)>(vb), l3 = tr_read<v_rd_off(D0, 3, 0)>(vb), h3 = tr_read<v_rd_off(D0, 3, 1)>(vb);
  asm volatile("s_waitcnt lgkmcnt(0)" ::: "memory"); SBAR();
#define PK(L, H) (bf16x8){L[0], L[1], L[2], L[3], H[0], H[1], H[2], H[3]}
  od = __builtin_amdgcn_mfma_f32_32x32x16_bf16(PK(l0, h0), pa0, od, 0, 0, 0);
  od = __builtin_amdgcn_mfma_f32_32x32x16_bf16(PK(l1, h1), pa1, od, 0, 0, 0);
  od = __builtin_amdgcn_mfma_f32_32x32x16_bf16(PK(l2, h2), pa2, od, 0, 0, 0);
  od = __builtin_amdgcn_mfma_f32_32x32x16_bf16(PK(l3, h3), pa3, od, 0, 0, 0);
#undef PK
}
__device__ __forceinline__ void pv_d0(f32x16* o, int vb, bf16x8 pa0, bf16x8 pa1, bf16x8 pa2, bf16x8 pa3) {
  pv_one<0>(o[0], vb, pa0, pa1, pa2, pa3); pv_one<1>(o[1], vb, pa0, pa1, pa2, pa3);
}

template <int VAR>
__device__ __forceinline__ void attn_unit(const bf16_t* __restrict__ Qraw, const bf16_t* __restrict__ Kb, const bf16_t* __restrict__ Vb, bf16_t* mix,
                                          const float* ssqkv, const float* ssqq, float negB2, int qrow0, int krow0, int nkeys, int h, char* lds) {
  if (VAR == 10) return;
  int tid = threadIdx.x; asm volatile("" : "+v"(tid));
    const int  wid = __builtin_amdgcn_readfirstlane(tid >> 6), lane = tid & 63, r32 = lane & 31, hi = lane >> 5;
  char* V_lds = lds + LDS_V; char* K_lds = lds + LDS_K;
  float l_reg = 0; f32x16 o[2] = {}; bf16x8 qr[6];
  const float shift = -negB2;
  {
    const int row = qrow0 + wid * QBLK + r32;
    const f32x4 pa = *(const f32x4*)(ssqkv + (size_t)row * 16 + 4), pb = *(const f32x4*)(ssqkv + (size_t)row * 16 + 8);
    const float sql = rsqrtf(((pa[0] + pa[1]) + (pa[2] + pa[3]) + (pb[0] + pb[1]) + (pb[2] + pb[3])) * (1.0f / 384.0f) + EPS);
    const float ssh = ssqq[(size_t)row * 24 + 3 * h] + ssqq[(size_t)row * 24 + 3 * h + 1] + ssqq[(size_t)row * 24 + 3 * h + 2];
    const float sc = sql * rsqrtf(sql * sql * ssh * (1.0f / 96.0f) + EPS) * QSCALE;
    const bf16_t* Qw = Qraw + (size_t)row * 768 + h * 96 + hi * 8;
#pragma unroll
    for (int d0 = 0; d0 < 6; ++d0) { const u32x4 w = *(const u32x4*)(Qw + d0 * 16); u32x4 o4;
      o4.x = cvt_pk_bf16(bflo(w.x) * sc, bfhi(w.x) * sc); o4.y = cvt_pk_bf16(bflo(w.y) * sc, bfhi(w.y) * sc);
      o4.z = cvt_pk_bf16(bflo(w.z) * sc, bfhi(w.z) * sc); o4.w = cvt_pk_bf16(bflo(w.w) * sc, bfhi(w.w) * sc);
      qr[d0] = *reinterpret_cast<bf16x8*>(&o4); }
  }
  const int kk0 = tid / 12, kc0 = tid - kk0 * 12, kk1 = (tid + 512) / 12, kc1 = (tid + 512) - kk1 * 12, vk = tid >> 3, vc = tid & 7;
  const bf16_t* Kh = Kb + (size_t)krow0 * 768 + h * 96; const bf16_t* Vh = Vb + (size_t)krow0 * 512 + h * 64;
  const unsigned kof0 = (unsigned)(kk0 * 768 + kc0 * 8) * 2u, kof1 = (unsigned)(kk1 * 768 + kc1 * 8) * 2u, vof = (unsigned)(vk * 512 + vc * 8) * 2u;
  const int kst0 = kk0 * KROWB + kc0 * 16, kst1 = kk1 * KROWB + kc1 * 16, vst = v_st(vk, vc * 8);
  const __amdgpu_buffer_rsrc_t krs = __builtin_amdgcn_make_buffer_rsrc((void*)Kh, 0, nkeys * 768 * 2, 0x00020000);
  const __amdgpu_buffer_rsrc_t vrs = __builtin_amdgcn_make_buffer_rsrc((void*)Vh, 0, nkeys * 512 * 2, 0x00020000);
  const bool two = wid < 4;
  const int vb0 = (int)(uintptr_t)V_lds + v_rd_base(lane);
  bf16x8 sk0, sk1, sv;
#define LOADK(t) do { if (VAR == 4) break; const int so_ = (t) * (KVBLK * 768 * 2); sk0 = __builtin_bit_cast(bf16x8, __builtin_amdgcn_raw_buffer_load_b128(krs, kof0, so_, 0)); if (two) sk1 = __builtin_bit_cast(bf16x8, __builtin_amdgcn_raw_buffer_load_b128(krs, kof1, so_, 0)); } while (0)
#define LOADV(t) do { if (VAR == 4) break; sv = __builtin_bit_cast(bf16x8, __builtin_amdgcn_raw_buffer_load_b128(vrs, vof, (t) * (KVBLK * 512 * 2), 0)); } while (0)
#define WRITEK(slot) do { if (VAR == 4) break; *(bf16x8*)(K_lds + (slot) * SHM_K + kst0) = sk0; if (two) *(bf16x8*)(K_lds + (slot) * SHM_K + kst1) = sk1; } while (0)
#define WRITEV(slot) do { if (VAR == 4) break; *(bf16x8*)(V_lds + (slot) * SHM_V + vst) = sv; } while (0)
#define PV(slot) do { if (VAR != 2) pv_d0(o, vb0 + (slot) * SHM_V, pa0, pa1, pa2, pa3); else { asm volatile("" :: "v"(pa0), "v"(pa1), "v"(pa2), "v"(pa3)); } } while (0)
#define QFS(FIN, P0, P1, F0, F1, KQ) qkt_fin<FIN, VAR>(P0, P1, K_lds + (KQ) * SHM_K, qr, r32, hi, F0, F1, shift, l_reg, pa0, pa1, pa2, pa3)
#define QF(FIN, P0, P1, F0, F1) QFS(FIN, P0, P1, F0, F1, kq)
  f32x16 pA0, pA1, pB0, pB1; bf16x8 pa0, pa1, pa2, pa3; const int NT = nkeys / KVBLK;
  LOADK(0); LOADV(0); WRITEK(0); WRITEV(0); LOADK(1); WRITEK(1); LOADK(2); LOADV(1);
  __syncthreads();
  int sa = 2, sb = 1, kq = 0;
#define ROT() do { sa = (sa == 2) ? 0 : sa + 1; sb = (sb == 2) ? 0 : sb + 1; kq = (kq == 2) ? 0 : kq + 1; } while (0)
  SBAR(); QF(false, pA0, pA1, pA0, pA1); SBAR(); partialSM<VAR>(pA0, shift); WRITEK(sa); WRITEV(sb); LOADK(3); LOADV(2); __syncthreads();
  ROT();
#define STEP_U(PC0, PC1, PP0, PP1, s_, KQ, SA, SB) do { SBAR(); QFS(true, PC0, PC1, PP0, PP1, KQ); SBAR(); PV(SA); SBAR(); partialSM<VAR>(PC0, shift); \
    WRITEK(SA); WRITEV(SB); LOADK((s_) + 3); LOADV((s_) + 2); __syncthreads(); } while (0)
  int j = 1;
#ifdef ATT_UNROLL6
  for (; j + 8 < NT; j += 6) {
    STEP_U(pB0, pB1, pA0, pA1, j,     1, 0, 2);
    STEP_U(pA0, pA1, pB0, pB1, j + 1, 2, 1, 0);
    STEP_U(pB0, pB1, pA0, pA1, j + 2, 0, 2, 1);
    STEP_U(pA0, pA1, pB0, pB1, j + 3, 1, 0, 2);
    STEP_U(pB0, pB1, pA0, pA1, j + 4, 2, 1, 0);
    STEP_U(pA0, pA1, pB0, pB1, j + 5, 0, 2, 1);
  }
#endif
  for (; j + 1 < NT; j += 2) {
    SBAR(); QF(true, pB0, pB1, pA0, pA1); SBAR(); PV(sa); SBAR(); partialSM<VAR>(pB0, shift);
    WRITEK(sa); WRITEV(sb); if (j + 3 < NT) LOADK(j + 3); LOADV(j + 2); __syncthreads();
    ROT();
    const bool t3 = (j + 3 < NT);
    SBAR(); QF(true, pA0, pA1, pB0, pB1); SBAR(); PV(sa); SBAR(); partialSM<VAR>(pA0, shift);
    if (t3) WRITEK(sa); WRITEV(sb); if (j + 4 < NT) LOADK(j + 4); if (t3) LOADV(j + 3); __syncthreads();
    ROT();
  }
  SBAR(); QF(true, pB0, pB1, pA0, pA1); SBAR(); PV(sa); partialSM<VAR>(pB0, shift);
  finishSM<VAR>(pB0, pB1, shift, l_reg, pa0, pa1, pa2, pa3); SBAR();
  ROT();
  PV(sa);
  { auto rr = __builtin_amdgcn_permlane32_swap(__float_as_uint(l_reg), __float_as_uint(l_reg), false, false); l_reg = __uint_as_float(rr[0]) + __uint_as_float(rr[1]); }
  const float rl = __builtin_amdgcn_rcpf(l_reg);
  { bf16_t* stg = (bf16_t*)(lds + LDS_OST) + wid * 2048;
#pragma unroll
    for (int d0 = 0; d0 < 2; ++d0)
#pragma unroll
      for (int g = 0; g < 4; ++g) { u32x2 w; w.x = cvt_pk_bf16(o[d0][4 * g] * rl, o[d0][4 * g + 1] * rl); w.y = cvt_pk_bf16(o[d0][4 * g + 2] * rl, o[d0][4 * g + 3] * rl);
        *(u32x2*)(stg + r32 * 64 + d0 * 32 + 8 * g + 4 * hi) = w; }
    asm volatile("s_waitcnt lgkmcnt(0)" ::: "memory");
    bf16_t* Ow = mix + (size_t)(qrow0 + wid * QBLK) * D_MODEL + 256 + h * 64;
#pragma unroll
    for (int i = 0; i < 4; ++i) { const int row = i * 8 + (lane >> 3), ch = lane & 7; const u32x4 v = *(const u32x4*)(stg + row * 64 + ch * 8); *(u32x4*)(Ow + (size_t)row * D_MODEL + ch * 8) = v; } }
  __syncthreads();
#undef LOADK
#undef LOADV
#undef WRITEK
#undef WRITEV
#undef ROT
#undef QF
#undef QFS
#undef STEP_U
#undef PV
}
#undef SBAR
}
namespace thin {
__device__ __forceinline__ float fexp(float x) { return __builtin_amdgcn_exp2f(x * 1.4426950408889634f); }
__device__ __forceinline__ float sigmoidf_(float x) { return __builtin_amdgcn_rcpf(1.0f + fexp(-x)); }
__device__ __forceinline__ float gelu_tanh(float x) { return x * __builtin_amdgcn_rcpf(1.0f + __builtin_amdgcn_exp2f(x * fmaf(x * x, -0.10294323f, -2.3022082f))); }
__device__ __forceinline__ float fexpm1_neg(float x) { const float p = x * (1.0f + x * (0.5f + x * (0.16666667f + x * (0.041666668f + x * 0.0083333338f)))); const float e = fexp(x) - 1.0f; return x > -0.25f ? p : e; }
__device__ __forceinline__ int rope_logical(int p) { const int q = p >> 3, i = p & 7; return (q >> 1) * 16 + (i >> 2) * 8 + (q & 1) * 4 + (i & 3); }

constexpr int XC_ROWB = 144;
constexpr int LRU_XC = 0, LRU_Y = 256 * XC_ROWB;
constexpr int NPOS = 34;

struct LruP { const bf16_t* z; const float* convw; const float* convb; const bf16_t* gw; const float* ba; const float* bx; const float* lam; float* agg; bf16_t* mix; };

template <int PASS>
__device__ __forceinline__ void lru_item(const LruP& P, int pm, int hd, char* lds) {
    int tid = threadIdx.x; asm volatile("" : "+v"(tid));
    const int  wid = __builtin_amdgcn_readfirstlane(tid >> 6), lane = tid & 63, r32 = lane & 31, hi = lane >> 5;
    const int b = pm / PPB, pp = pm - b * PPB;
    const int L = pp == 0 ? CTX : SEQ, seqbase = b * TPB + (pp == 0 ? 0 : CTX), t0 = pp == 0 ? 0 : (pp - 1) * 256;
    char* XC = lds + LRU_XC; float* Y = (float*)(lds + LRU_Y);
    {
        const int c8 = tid & 7, ch = hd * 64 + c8 * 8;
        f32x4 w[4][2];
#pragma unroll
        for (int k = 0; k < 4; ++k) { w[k][0] = *(const f32x4*)(P.convw + k * 256 + ch); w[k][1] = *(const f32x4*)(P.convw + k * 256 + ch + 4); }
        const f32x4 cb0 = *(const f32x4*)(P.convb + ch), cb1 = *(const f32x4*)(P.convb + ch + 4);
#pragma unroll
        for (int i = 0; i < 4; ++i) {
            const int tk = (tid >> 3) + 64 * i, ts = t0 + tk;
            f32x4 a0 = cb0, a1 = cb1;
#pragma unroll
            for (int k = 0; k < 4; ++k) { const int tsrc = ts + k - 1;
                if (tsrc >= 0 && tsrc < L) { const u32x4 v = *(const u32x4*)(P.z + (size_t)(seqbase + tsrc) * ZW + Z_LX + ch);
                    a0 += w[k][0] * (f32x4){bflo(v.x), bfhi(v.x), bflo(v.y), bfhi(v.y)}; a1 += w[k][1] * (f32x4){bflo(v.z), bfhi(v.z), bflo(v.w), bfhi(v.w)}; } }
            *(u32x4*)(XC + tk * XC_ROWB + c8 * 16) = epi::pack8(a0, a1);
        }
    }
    __syncthreads();
    const int dir = wid & 1, cb = (wid >> 1) & 1, half = wid >> 2;
    const int chl = cb * 32 + r32, ch = hd * 64 + chl;
    bf16x8 Ba[4], Bx[4];
#pragma unroll
    for (int ks = 0; ks < 4; ++ks) {
        Ba[ks] = *(const bf16x8*)(P.gw + ((size_t)((dir * 2 + 0) * 4 + hd) * 64 + chl) * 64 + ks * 16 + hi * 8);
        Bx[ks] = *(const bf16x8*)(P.gw + ((size_t)((dir * 2 + 1) * 4 + hd) * 64 + chl) * 64 + ks * 16 + hi * 8);
    }
    const float bav = P.ba[dir * 256 + ch], bxv = P.bx[dir * 256 + ch];
    const float sp8 = 8.0f * log1pf(expf(-P.lam[dir * 256 + ch]));
    const float nsp8 = -sp8, ba2 = bav * -1.4426950408889634f, bx2 = bxv * -1.4426950408889634f;
    const bool small_la = __all(sp8 <= 0.125f);
    const int chunk = pp == 0 ? half : 2 * pp + half;
    const int pos = dir == 0 ? chunk : (chunk == 1 ? 0 : (chunk == 0 ? 1 : 35 - chunk));
    float Hrun = 0.f, Arun = 1.f;
    if (PASS == 2) {
        const float* ag = P.agg + ((size_t)(b * 2 + dir) * NPOS) * 512 + ch * 2;
#pragma unroll 1
        for (int p0 = 0; p0 < pos; p0 += 11) {
            f32x2 e[11];
#pragma unroll
            for (int q = 0; q < 11; ++q) e[q] = (p0 + q) < pos ? *(const f32x2*)(ag + (size_t)(p0 + q) * 512) : (f32x2){1.0f, 0.0f};
#pragma unroll
            for (int q = 0; q < 11; ++q) Hrun = e[q].x * Hrun + e[q].y;
        }
    }
    float yv[4][16];
    const int tau = ((r32 >> 2) & 1) * 16 + (r32 >> 3) * 4 + (r32 & 3);
    const int firsthi = dir;
#pragma unroll
    for (int ii = 0; ii < 4; ++ii) {
        const int tile = dir == 0 ? ii : 3 - ii, tb = half * 128 + tile * 32;
        f32x16 ra = {}, ix = {};
#pragma unroll
        for (int ks = 0; ks < 4; ++ks) {
            const bf16x8 af = *(const bf16x8*)(XC + (tb + tau) * XC_ROWB + (ks * 16 + hi * 8) * 2);
            ra = __builtin_amdgcn_mfma_f32_32x32x16_bf16(af, Ba[ks], ra, 0, 0, 0);
            ix = __builtin_amdgcn_mfma_f32_32x32x16_bf16(af, Bx[ks], ix, 0, 0, 0);
        }
        float av[16], bv[16];
        if (small_la) { asm volatile("; lru: series expm1" ::: "memory");
#pragma unroll
            for (int r = 0; r < 16; ++r) {
                const float xcv = bf2f(*(const bf16_t*)(XC + (tb + hi * 16 + r) * XC_ROWB + chl * 2));
                const float rr = __builtin_amdgcn_rcpf(1.0f + __builtin_amdgcn_exp2f(fmaf(ra[r], -1.4426950408889634f, ba2)));
                const float iv = __builtin_amdgcn_rcpf(1.0f + __builtin_amdgcn_exp2f(fmaf(ix[r], -1.4426950408889634f, bx2)));
                const float la = nsp8 * rr;
                const float em = la * fmaf(la, fmaf(la, fmaf(la, 0.041666668f, 0.16666667f), 0.5f), 1.0f);
                av[r] = 1.0f + em; bv[r] = __builtin_amdgcn_sqrtf(-fmaf(em, em, em + em)) * (iv * xcv);
            }
        } else {
#pragma unroll
            for (int r = 0; r < 16; ++r) {
                const float xcv = bf2f(*(const bf16_t*)(XC + (tb + hi * 16 + r) * XC_ROWB + chl * 2));
                const float rr = __builtin_amdgcn_rcpf(1.0f + __builtin_amdgcn_exp2f(fmaf(ra[r], -1.4426950408889634f, ba2)));
                const float iv = __builtin_amdgcn_rcpf(1.0f + __builtin_amdgcn_exp2f(fmaf(ix[r], -1.4426950408889634f, bx2)));
                const float em = fexpm1_neg(nsp8 * rr);
                av[r] = 1.0f + em; bv[r] = __builtin_amdgcn_sqrtf(-fmaf(em, em, em + em)) * (iv * xcv);
            }
        }
        float hl[16], cl[16]; float h = 0.f, c = 1.f;
        if (dir == 0) {
#pragma unroll
            for (int r = 0; r < 16; ++r) { h = av[r] * h + bv[r]; c *= av[r]; hl[r] = h; cl[r] = c; }
        } else {
#pragma unroll
            for (int r = 15; r >= 0; --r) { h = av[r] * h + bv[r]; c *= av[r]; hl[r] = h; cl[r] = c; }
        }
        const float H1 = __shfl(h, r32 + 32 * firsthi), A1 = __shfl(c, r32 + 32 * firsthi);
        const float H2 = __shfl(h, r32 + 32 * (1 - firsthi)), A2 = __shfl(c, r32 + 32 * (1 - firsthi));
        const float Hin1 = Hrun, Hin2 = A1 * Hrun + H1;
        const float Hmine = (hi == firsthi) ? Hin1 : Hin2;
        Hrun = A2 * Hin2 + H2; Arun = Arun * A1 * A2;
        if (PASS == 2) {
#pragma unroll
            for (int r = 0; r < 16; ++r) yv[ii][r] = hl[r] + cl[r] * Hmine;
        }
    }
    if (PASS == 1) {
        if (hi == 0) *(f32x2*)(P.agg + ((size_t)(b * 2 + dir) * NPOS + pos) * 512 + ch * 2) = (f32x2){Arun, Hrun};
        __syncthreads();
    } else {
        if (dir == 0) {
#pragma unroll
            for (int ii = 0; ii < 4; ++ii)
#pragma unroll
                for (int r = 0; r < 16; ++r) Y[(half * 128 + ii * 32 + hi * 16 + r) * 64 + chl] = yv[ii][r];
        }
        __syncthreads();
        if (dir == 1) {
#pragma unroll
            for (int ii = 0; ii < 4; ++ii)
#pragma unroll
                for (int r = 0; r < 16; ++r) Y[(half * 128 + (3 - ii) * 32 + hi * 16 + r) * 64 + chl] += yv[ii][r];
        }
        __syncthreads();
        const int c8 = tid & 7;
#pragma unroll
        for (int i = 0; i < 4; ++i) {
            const int tk = (tid >> 3) + 64 * i; const size_t row = (size_t)pm * 256 + tk;
            const f32x4 y0 = *(const f32x4*)(Y + tk * 64 + c8 * 8), y1 = *(const f32x4*)(Y + tk * 64 + c8 * 8 + 4);
            const u32x4 g = *(const u32x4*)(P.z + row * ZW + Z_LG + hd * 64 + c8 * 8);
            const f32x4 o0 = y0 * (f32x4){gelu_tanh(bflo(g.x)), gelu_tanh(bfhi(g.x)), gelu_tanh(bflo(g.y)), gelu_tanh(bfhi(g.y))};
            const f32x4 o1 = y1 * (f32x4){gelu_tanh(bflo(g.z)), gelu_tanh(bfhi(g.z)), gelu_tanh(bflo(g.w)), gelu_tanh(bfhi(g.w))};
            *(u32x4*)(P.mix + row * D_MODEL + hd * 64 + c8 * 8) = epi::pack8(o0, o1);
        }
        __syncthreads();
    }
}

constexpr int PL_PU = 0, PL_MX = 272 * 128;
template <int GI>
__device__ __forceinline__ void pool_item_g(const bf16_t* z, const bf16_t* pw, bf16_t* mix, int pm, char* lds) {
    constexpr int g = GI, W = 2 << GI;
    int tid = threadIdx.x; asm volatile("" : "+v"(tid));
    const int  wid = __builtin_amdgcn_readfirstlane(tid >> 6), lane = tid & 63, r32 = lane & 31, hi = lane >> 5;
    const int b = pm / PPB, pp = pm - b * PPB;
    const int L = pp == 0 ? CTX : SEQ, seqbase = b * TPB + (pp == 0 ? 0 : CTX), t0 = pp == 0 ? 0 : (pp - 1) * 256;
    char* PU = lds + PL_PU; char* MX = lds + PL_MX;
    const int c8 = tid & 7;
#pragma unroll
    for (int i = 0; i < 5; ++i) { const int hr = (tid >> 3) + 64 * i, ts = t0 - 8 + hr;
        if (hr < 272 && ts >= 0 && ts < L) *(u32x4*)(PU + hr * 128 + c8 * 16) = *(const u32x4*)(z + (size_t)(seqbase + ts) * ZW + Z_PU + g * 64 + c8 * 8); }
    __syncthreads();
#pragma unroll
    for (int i = 0; i < 4; ++i) {
        const int tk = (tid >> 3) + 64 * i, ts = t0 + tk;
        f32x4 s0 = {0.f, 0.f, 0.f, 0.f}, s1 = {0.f, 0.f, 0.f, 0.f}; int cnt = 0;
#pragma unroll
        for (int k = 0; k < W; ++k) {
            const int tt = ts - W / 2 + k;
            if (tt >= 0 && tt < L) { const u32x4 v = *(const u32x4*)(PU + (tk + 8 - W / 2 + k) * 128 + c8 * 16); ++cnt;
                s0 += (f32x4){bflo(v.x), bfhi(v.x), bflo(v.y), bfhi(v.y)}; s1 += (f32x4){bflo(v.z), bfhi(v.z), bflo(v.w), bfhi(v.w)}; } }
        const float inv = __builtin_amdgcn_rcpf((float)cnt);
        const u32x4 v = *(const u32x4*)(PU + (tk + 8) * 128 + c8 * 16);
        s0 = s0 * inv - (f32x4){bflo(v.x), bfhi(v.x), bflo(v.y), bfhi(v.y)}; s1 = s1 * inv - (f32x4){bflo(v.z), bfhi(v.z), bflo(v.w), bfhi(v.w)};
        *(u32x4*)(MX + tk * XC_ROWB + c8 * 16) = epi::pack8(s0, s1);
    }
    __syncthreads();
    f32x16 c0 = {}, c1 = {};
#pragma unroll
    for (int ks = 0; ks < 4; ++ks) {
        const bf16x8 bf = *(const bf16x8*)(MX + (wid * 32 + r32) * XC_ROWB + (ks * 16 + hi * 8) * 2);
        const bf16x8 a0 = *(const bf16x8*)(pw + ((size_t)g * 64 + r32) * 64 + ks * 16 + hi * 8);
        const bf16x8 a1 = *(const bf16x8*)(pw + ((size_t)g * 64 + 32 + r32) * 64 + ks * 16 + hi * 8);
        c0 = __builtin_amdgcn_mfma_f32_32x32x16_bf16(a0, bf, c0, 0, 0, 0);
        c1 = __builtin_amdgcn_mfma_f32_32x32x16_bf16(a1, bf, c1, 0, 0, 0);
    }
    bf16_t* OT = (bf16_t*)PU;
#pragma unroll
    for (int q = 0; q < 4; ++q) {
        u32x2 w0, w1; w0.x = cvt_pk_bf16(c0[4 * q], c0[4 * q + 1]); w0.y = cvt_pk_bf16(c0[4 * q + 2], c0[4 * q + 3]);
        w1.x = cvt_pk_bf16(c1[4 * q], c1[4 * q + 1]); w1.y = cvt_pk_bf16(c1[4 * q + 2], c1[4 * q + 3]);
        *(u32x2*)(OT + (wid * 32 + r32) * 64 + 4 * hi + 8 * q) = w0; *(u32x2*)(OT + (wid * 32 + r32) * 64 + 32 + 4 * hi + 8 * q) = w1;
    }
    __syncthreads();
#pragma unroll
    for (int i = 0; i < 4; ++i) { const int tk = (tid >> 3) + 64 * i;
        *(u32x4*)(mix + ((size_t)pm * 256 + tk) * D_MODEL + 768 + g * 64 + c8 * 8) = *(const u32x4*)(OT + tk * 64 + c8 * 8); }
    __syncthreads();
}
__device__ __forceinline__ void pool_item(const bf16_t* z, const bf16_t* pw, bf16_t* mix, int pm, int g, char* lds) {
    if (g == 0) pool_item_g<0>(z, pw, mix, pm, lds); else if (g == 1) pool_item_g<1>(z, pw, mix, pm, lds); else if (g == 2) pool_item_g<2>(z, pw, mix, pm, lds); else pool_item_g<3>(z, pw, mix, pm, lds);
}

__device__ __forceinline__ void transpose_tile(const float* W, int N, bf16_t* WT, int Kp, int k0, int nphys, int srcbase, bool rperm, const float* kscale, const float* nscale, bool zero, LAS float* scr, int lane) {
    const int nl = lane & 31, sc = srcbase + (rperm ? rope_logical(nl) : nl);
    const float nsv = nscale ? nscale[nl] : 1.0f;
#pragma unroll 8
    for (int i = 0; i < 32; ++i) { const int kk = 2 * i + (lane >> 5);
        float v = zero ? 0.f : W[(size_t)(k0 + kk) * N + sc] * nsv; if (kscale) v *= kscale[k0 + kk];
        scr[kk * 33 + nl] = v; }
    asm volatile("s_waitcnt lgkmcnt(0)" ::: "memory");
    const int c = lane & 7;
#pragma unroll
    for (int j = 0; j < 4; ++j) { const int n = (lane >> 3) + 8 * j; const LAS float* s = scr + (8 * c) * 33 + n;
        u32x4 o; o.x = cvt_pk_bf16(s[0 * 33], s[1 * 33]); o.y = cvt_pk_bf16(s[2 * 33], s[3 * 33]); o.z = cvt_pk_bf16(s[4 * 33], s[5 * 33]); o.w = cvt_pk_bf16(s[6 * 33], s[7 * 33]);
        *(u32x4*)(WT + (size_t)(nphys + n) * Kp + k0 + 8 * c) = o; }
    asm volatile("s_waitcnt lgkmcnt(0)" ::: "memory");
}
__device__ __forceinline__ float wave_sum(float v) {
#pragma unroll
    for (int o = 1; o < 64; o <<= 1) v += __shfl_xor(v, o);
    return v;
}
}
constexpr int NWAVES = 8;
constexpr size_t MiB = 1u << 20;
constexpr size_t WS_CTL = 0, CTL_ZERO_BYTES = 64 * 1024;
constexpr size_t WS_MODPART = 1 * MiB;
constexpr size_t WS_VEC = 5 * MiB;
constexpr size_t WS_BIASIN = WS_VEC + 512 * 1024;
constexpr size_t WS_BIASFF = WS_BIASIN + 128 * 1024;
constexpr size_t WS_RTAB = WS_BIASFF + 320 * 1024;
constexpr size_t WS_RVEC = 17 * MiB + 512 * 1024;
constexpr size_t WS_AGG = 6 * MiB;
constexpr size_t WS_SSQX = 8 * MiB;
constexpr size_t WS_SSQKV = 11 * MiB;
constexpr size_t WS_SSQQ = 14 * MiB;
constexpr size_t WS_WT = 18 * MiB, WT_LAYER = 23 * MiB;
constexpr size_t WT_IN = 0, WT_UQ = 3 * MiB, WT_UKV = WT_UQ + 640 * 1024, WT_OUT = WT_UKV + 512 * 1024, WT_FF1 = WT_OUT + 2 * MiB, WT_FF2 = WT_FF1 + 8 * MiB, WT_GATE = WT_FF2 + 8 * MiB, WT_POOL = WT_GATE + 128 * 1024;
static_assert(WT_POOL + 32 * 1024 <= WT_LAYER, "weights per layer");
constexpr size_t WS_XG = 72 * MiB;
constexpr size_t WS_U = 208 * MiB;
constexpr size_t WS_Z = WS_U, WS_Q = WS_Z + 102 * MiB, WS_K = WS_Q + 51 * MiB, WS_V = WS_K + 51 * MiB;
constexpr size_t WS_END = WS_U + 272 * MiB;
static_assert(WS_V + 34 * MiB <= WS_END && WS_END <= 512 * MiB, "d_ws map");
enum { VEC_GM1 = 0, VEC_G1 = 1, VEC_GM2 = 2, VEC_G2 = 3, VEC_SH1 = 4, VEC_SH2 = 5 };

constexpr int LDS_BYTES = 147456;
constexpr int LDSCTL_OFF = 131072, MISC_OFF = LDSCTL_OFF + 320;

typedef GAS unsigned gu32;
#define RLX_AGENT __ATOMIC_RELAXED, __HIP_MEMORY_SCOPE_AGENT
#define XB_TMO      128
#define XB_XCNT(j)  (256  + 64 * (j))
#define XB_XSUB(j)  (1280 + 64 * (j))
#define XB_XGEN(j)  (2304 + 64 * (j))
#define XB_TOP      3328
#define XB_TOPGEN   3392
#define XCD_BAR_WORDS 3456
#define XB_SPIN_CAP (1u << 20)
__device__ __forceinline__ unsigned xb_ld(unsigned* p)              { return __hip_atomic_load(p, __ATOMIC_RELAXED, __HIP_MEMORY_SCOPE_AGENT); }
__device__ __forceinline__ unsigned xb_add(unsigned* p, unsigned v) { return __hip_atomic_fetch_add(p, v, __ATOMIC_RELAXED, __HIP_MEMORY_SCOPE_AGENT); }
__device__ __forceinline__ unsigned xb_xcc_id() { return (unsigned)__builtin_amdgcn_s_getreg((3 << 11) | 20) & 0xFu; }
#define XB_SPIN(cond, bar) do { unsigned _sp = 0; while (cond) { __builtin_amdgcn_s_sleep(1); \
    if ((++_sp & 255u) == 0u) { if (xb_ld(&(bar)[XB_TMO])) break; if (_sp > XB_SPIN_CAP) { atomicAdd(&(bar)[XB_TMO], 1u); break; } } } } while (0)
struct XcdBarrier { unsigned* bar; unsigned x; volatile LAS unsigned* st; };
__device__ __forceinline__ XcdBarrier xcd_barrier_post(unsigned* bar, volatile LAS unsigned* st) {
    XcdBarrier b; b.bar = bar; b.x = xb_xcc_id(); b.st = st;
    if (threadIdx.x == 0) (void)xb_add(&bar[XB_XCNT(b.x)], 1u);
    return b;
}
__device__ __forceinline__ void xcd_barrier_complete(unsigned* bar, unsigned x, unsigned& nloc, unsigned& nx) {
    const unsigned G = gridDim.x * gridDim.y * gridDim.z;
    unsigned sum, cnt, mine, sp = 0u;
    for (;;) {
        sum = 0u; cnt = 0u; mine = 0u;
#pragma unroll
        for (unsigned j = 0; j < 16; ++j) { const unsigned c = xb_ld(&bar[XB_XCNT(j)]); sum += c; cnt += (c > 0u) ? 1u : 0u; mine = (j == x) ? c : mine; }
        if (sum == G) break;
        __builtin_amdgcn_s_sleep(1);
        if ((++sp & 255u) == 0u) { if (xb_ld(&bar[XB_TMO])) break; if (sp > XB_SPIN_CAP) { atomicAdd(&bar[XB_TMO], 1u); break; } }
    }
    nloc = mine > 0u ? mine : 1u; nx = cnt > 0u ? cnt : 1u;
}
__device__ __forceinline__ void xcd_barrier(const XcdBarrier& b) {
    asm volatile("s_waitcnt vmcnt(0)" ::: "memory");
    __syncthreads();
    if (threadIdx.x == 0) {
        unsigned* bar = b.bar;
        __builtin_amdgcn_s_waitcnt(0);
        unsigned nloc = b.st[0], nx = b.st[1];
        if (nloc == 0u) { xcd_barrier_complete(bar, b.x, nloc, nx); b.st[0] = nloc; b.st[1] = nx; }
        const unsigned old = xb_add(&bar[XB_XSUB(b.x)], 1u);
        const unsigned gen = old / nloc;
        if (old + 1u == (gen + 1u) * nloc) {
            __builtin_amdgcn_fence(__ATOMIC_RELEASE, "agent");
            asm volatile("s_waitcnt vmcnt(0)" ::: "memory");
            const unsigned og = xb_add(&bar[XB_TOP], 1u);
            const unsigned tg = og / nx;
            if (og + 1u == (tg + 1u) * nx) xb_add(&bar[XB_TOPGEN], 1u);
            else XB_SPIN(xb_ld(&bar[XB_TOPGEN]) == tg, bar);
            __builtin_amdgcn_fence(__ATOMIC_ACQUIRE, "agent");
            xb_add(&bar[XB_XGEN(b.x)], 1u);
            asm volatile("s_waitcnt vmcnt(0)" ::: "memory");
        } else {
            XB_SPIN(xb_ld(&bar[XB_XGEN(b.x)]) == gen, bar);
            __builtin_amdgcn_fence(__ATOMIC_ACQUIRE, "agent");
            asm volatile("s_waitcnt vmcnt(0)" ::: "memory");
        }
    }
    __syncthreads();
}


__device__ __forceinline__ void gate_wait(const unsigned* w, unsigned need, unsigned* tmo) {
    if (threadIdx.x < 64) { unsigned sp = 0u;
        while ((unsigned)__builtin_amdgcn_readfirstlane(xb_ld((unsigned*)w)) < need) { __builtin_amdgcn_s_sleep(2);
            if ((++sp & 255u) == 0u) { if (xb_ld(tmo)) break; if (sp > XB_SPIN_CAP) { if (threadIdx.x == 0) atomicAdd(tmo, 1u); break; } } }
        __builtin_amdgcn_fence(__ATOMIC_ACQUIRE, "agent");
        asm volatile("s_waitcnt vmcnt(0)" ::: "memory"); }
    __syncthreads();
}

__device__ __forceinline__ void ctx_combine(unsigned char* ws, float* out, const float* rgmv, const float* gatev, const float* gmv, int gw, int NGW, int lane_in) {
    int lane = lane_in; asm volatile("" : "+v"(lane));
    const float* slab = out + (size_t)18 * 1024 * 1024;
    bf16_t* xg_ = (bf16_t*)(ws + WS_XG); float* ssq_ = (float*)(ws + WS_SSQX);
    for (int cr = gw; cr < BATCH * CTX; cr += NGW) {
        const size_t urow = (size_t)(cr >> 8) * TPB + (cr & 255); float ss = 0.f;
#pragma unroll
        for (int j = 0; j < 4; ++j) { const int col = 256 * j + 4 * lane;
            f32x4 a = *(const f32x4*)(slab + (size_t)cr * D_MODEL + col);
#pragma unroll
            for (int ks = 1; ks < 4; ++ks) a += *(const f32x4*)(slab + ((size_t)ks * (BATCH * CTX) + cr) * D_MODEL + col);
            const u32x2 w = *(const u32x2*)(xg_ + urow * D_MODEL + col);
            const f32x4 x = (f32x4){bflo(w.x), bfhi(w.x), bflo(w.y), bfhi(w.y)} * *(const f32x4*)(rgmv + col) + *(const f32x4*)(gatev + col) * a;
            ss += epi::sq4(x);
            const f32x4 t = x * *(const f32x4*)(gmv + col); u32x2 o; o.x = cvt_pk_bf16(t[0], t[1]); o.y = cvt_pk_bf16(t[2], t[3]); *(u32x2*)(xg_ + urow * D_MODEL + col) = o; }
        ss = thin::wave_sum(ss);
        if (lane < 16) ssq_[urow * 16 + lane] = lane == 0 ? ss : 0.f;
    }
}

struct Args { const float* in[27]; float* out; unsigned char* ws; int ph_lo, ph_hi; };
constexpr int NPHASE = 15;

__global__ void __launch_bounds__(NWAVES * 64, 2) fwd_kernel(Args args) {
    extern __shared__ __attribute__((aligned(16))) unsigned char lds_raw[];
    LAS unsigned char* lds = (LAS unsigned char*)lds_raw;
    char* ldsg = (char*)lds_raw;
    const int tid = threadIdx.x, lane = tid & 63, wave = __builtin_amdgcn_readfirstlane(tid >> 6);
    const int G = gridDim.x; const int bx = blockIdx.x; const int vcu = (G % 8 == 0) ? (bx % 8) * (G / 8) + bx / 8 : bx;
    unsigned char* ws = args.ws;
    typedef __attribute__((address_space(4))) const Args* KArgs;
#define KA(i) (((KArgs)__builtin_amdgcn_kernarg_segment_ptr())->in[i])
#define x_in KA(0)
#define c_in KA(1)
#define ctx_in KA(2)
#define cctx_in KA(3)
#define w_mod KA(4)
#define b_mod KA(5)
#define g_norm1 KA(6)
#define g_norm2 KA(7)
#define w_in KA(8)
#define conv_w KA(9)
#define conv_b KA(10)
#define lru_w_a KA(11)
#define lru_b_a KA(12)
#define lru_w_x KA(13)
#define lru_b_x KA(14)
#define lru_lambda KA(15)
#define g_q_lat KA(16)
#define w_uq KA(17)
#define g_kv_lat KA(18)
#define w_ukv KA(19)
#define g_qn KA(20)
#define g_kn KA(21)
#define w_pool KA(22)
#define pool_scale KA(23)
#define w_out KA(24)
#define w_ff1 KA(25)
#define w_ff2 KA(26)
    float* out = args.out;
#define modpart ((float*)(ws + WS_MODPART))
#define vec ((float*)(ws + WS_VEC))
#define bias_in ((float*)(ws + WS_BIASIN))
#define bias_ff ((float*)(ws + WS_BIASFF))
#define rtab ((float*)(ws + WS_RTAB))
#define agg ((float*)(ws + WS_AGG))
#define ssqx ((float*)(ws + WS_SSQX))
#define ssqkv ((float*)(ws + WS_SSQKV))
#define ssqq ((float*)(ws + WS_SSQQ))
#define rvec ((float*)(ws + WS_RVEC))
#define xg ((bf16_t*)(ws + WS_XG))
#define mix ((bf16_t*)out)
#define U ((bf16_t*)(ws + WS_U))
#define zb ((bf16_t*)(ws + WS_Z))
#define Qb ((bf16_t*)(ws + WS_Q))
#define Kb ((bf16_t*)(ws + WS_K))
#define Vb ((bf16_t*)(ws + WS_V))

    for (int u = tid; u < (LDS_BYTES - LDSCTL_OFF) / 4; u += NWAVES * 64) ((LAS unsigned*)(lds + LDSCTL_OFF))[u] = 0u;
    __syncthreads();
    const bool single = (args.ph_hi - args.ph_lo) > 1;
    XcdBarrier bar; bar.bar = (unsigned*)(ws + WS_CTL); bar.x = 0; bar.st = nullptr;
    if (single) bar = xcd_barrier_post((unsigned*)(ws + WS_CTL), (volatile LAS unsigned*)(lds + MISC_OFF) + 8);
    const int lo = args.ph_lo, hi = args.ph_hi;
#ifndef PHASE_MASK
#define PHASE_MASK 0x7FF
#endif
#define IN(k) (lo <= (k) && (k) < hi)
#ifndef GATE_PA
#define GATE_PA 1
#endif
#ifndef GATE_PD
#define GATE_PD 1
#endif
#ifndef DUP_MASK
#define DUP_MASK 0x7FF
#endif
#define EN(j) (((PHASE_MASK >> (j)) & 1) && (rep_ > 0 || NREP_CUR == 1 || ((DUP_MASK >> (j)) & 1)))
#ifndef DUP_PHASE
#define DUP_PHASE (-1)
#endif
#define NREP(k) (((k) == DUP_PHASE) ? 2 : 1)
#define SEAM(k) do { if (IN(k) && IN((k) + 1)) xcd_barrier(bar); } while (0)
    const int gw = vcu * NWAVES + wave, NGW = G * NWAVES;

    for (int rep_ = 0, NREP_CUR = NREP(0); rep_ < NREP_CUR; ++rep_) { if (rep_) xcd_barrier(bar);
    if (EN(0) && IN(0)) {
        float* sl = (float*)ldsg;
        for (int i = tid; i < 9 * 1024; i += NWAVES * 64) { const float v = i < 8192 ? c_in[i] : cctx_in[i - 8192]; sl[i] = v / (1.0f + expf(-v)); }
        __syncthreads();
        for (int it = gw; it < 2 * 96 * 8; it += NGW) {
            const int l = it / 768, r = it - l * 768, cg = r >> 3, ks = r & 7;
            float acc[9];
#pragma unroll
            for (int b = 0; b < 9; ++b) acc[b] = 0.f;
            const float* wp = w_mod + ((size_t)l * 1024 + ks * 128) * 6144 + cg * 64 + lane;
#pragma unroll 8
            for (int kk = 0; kk < 128; ++kk) { const float w = wp[(size_t)kk * 6144];
#pragma unroll
                for (int b = 0; b < 9; ++b) acc[b] += sl[b * 1024 + ks * 128 + kk] * w; }
#pragma unroll
            for (int b = 0; b < 9; ++b) modpart[((size_t)(ks * 2 + l) * 9 + b) * 6144 + cg * 64 + lane] = acc[b];
        }
        __syncthreads();
        if (bx == 0) for (int i = tid; i < 512; i += NWAVES * 64) { const int pos = i >> 3, f = i & 7; const float fr = powf(10000.0f, -(float)f / 8.0f), ang = (float)pos * fr; rtab[i * 2] = cosf(ang); rtab[i * 2 + 1] = sinf(ang); }
        LAS float* scr = (LAS float*)(lds + wave * 16384);
        constexpr int I_IN = 768, I_UQ = 144, I_UKV = 128, I_OUT = 512, I_FF1 = 2048, I_FF2 = 2048, I_G = 32, I_P = 8, I_L = I_IN + I_UQ + I_UKV + I_OUT + I_FF1 + I_FF2 + I_G + I_P;
        for (int it = gw; it < 2 * I_L; it += NGW) {
            const int l = it / I_L; int r = it - l * I_L; bf16_t* wt = (bf16_t*)(ws + WS_WT + (size_t)l * WT_LAYER);
            if (r < I_IN) { const int pg = r >> 4, kb = r & 15; int src = 0; bool z0 = false, rp = false;
                if (pg < 16) src = 32 * pg; else if (pg < 24) src = 896 + 32 * (pg - 16); else if (pg < 32) src = 1184 + 32 * (pg - 24); else if (pg < 44) src = 512 + 32 * (pg - 32); else if (pg == 44) { src = 1152; rp = true; } else z0 = true;
                thin::transpose_tile(w_in + (size_t)l * 1024 * D_IN, D_IN, wt + WT_IN / 2, 1024, kb * 64, pg * 32, src, rp, nullptr, nullptr, z0, scr, lane); continue; } r -= I_IN;
            if (r < I_UQ) { const int pg = r / 6, kb = r - pg * 6;
                thin::transpose_tile(w_uq + (size_t)l * 384 * 768, 768, wt + WT_UQ / 2, 384, kb * 64, pg * 32, pg * 32, (pg % 3) == 2, g_q_lat + l * 384, nullptr, false, scr, lane); continue; } r -= I_UQ;
            if (r < I_UKV) { const int pg = r >> 2, kb = r & 3, pn = pg >> 3, bj = (pg >> 2) & 1, wc = pg & 3;
                const int src = pn < 2 ? (4 * pn + wc) * 128 + 32 * bj : (4 * (pn - 2) + wc) * 128 + 64 + 32 * bj;
                thin::transpose_tile(w_ukv + (size_t)l * 256 * 1024, 1024, wt + WT_UKV / 2, 256, kb * 64, pg * 32, src, false, g_kv_lat + l * 256, nullptr, false, scr, lane); continue; } r -= I_UKV;
            if (r < I_OUT) { const int pg = r >> 4, kb = r & 15;
                thin::transpose_tile(w_out + (size_t)l * 1024 * 1024, 1024, wt + WT_OUT / 2, 1024, kb * 64, pg * 32, pg * 32, false, nullptr, nullptr, false, scr, lane); continue; } r -= I_OUT;
            if (r < I_FF1) { const int pg = r >> 4, kb = r & 15;
                thin::transpose_tile(w_ff1 + (size_t)l * 1024 * 4096, 4096, wt + WT_FF1 / 2, 1024, kb * 64, pg * 32, pg * 32, false, nullptr, nullptr, false, scr, lane); continue; } r -= I_FF1;
            if (r < I_FF2) { const int pg = r >> 6, kb = r & 63;
                thin::transpose_tile(w_ff2 + (size_t)l * 4096 * 1024, 1024, wt + WT_FF2 / 2, 4096, kb * 64, pg * 32, pg * 32, false, nullptr, nullptr, false, scr, lane); continue; } r -= I_FF2;
            if (r < I_G) { const int mat = r >> 1, pg = r & 1, dir = mat >> 3, gate = (mat >> 2) & 1, hd = mat & 3;
                const float* src = (gate ? lru_w_x : lru_w_a) + ((size_t)((l * 2 + dir) * 4 + hd)) * 4096;
                thin::transpose_tile(src, 64, wt + WT_GATE / 2 + (size_t)mat * 4096, 64, 0, pg * 32, pg * 32, false, nullptr, nullptr, false, scr, lane); continue; } r -= I_G;
            { const int g = r >> 1, pg = r & 1;
                thin::transpose_tile(w_pool + (size_t)(l * 4 + g) * 4096, 64, wt + WT_POOL / 2 + (size_t)g * 4096, 64, 0, pg * 32, pg * 32, false, nullptr, pool_scale + l * 256 + g * 64 + pg * 32, false, scr, lane); }
        }
        __syncthreads();
    }
    } SEAM(0);
    for (int rep_ = 0, NREP_CUR = NREP(1); rep_ < NREP_CUR; ++rep_) { if (rep_) xcd_barrier(bar);
    if (EN(0) && IN(1)) {
        const int gt = vcu * (NWAVES * 64) + tid;
        if (gt < 2 * 9 * 1024) {
            const int l = gt / 9216, r = gt - l * 9216, b = r >> 10, j = r & 1023;
            float m[6];
#pragma unroll
            for (int s = 0; s < 6; ++s) { float a = b_mod[l * 6144 + s * 1024 + j];
#pragma unroll
                for (int ks = 0; ks < 8; ++ks) a += modpart[((size_t)(ks * 2 + l) * 9 + b) * 6144 + s * 1024 + j];
                m[s] = a; }
            float* v = vec + (size_t)(l * 9 + b) * 6144 + j;
            float gm1 = g_norm1[l * 1024 + j] * (1.0f + m[1]), gm2 = g_norm2[l * 1024 + j] * (1.0f + m[4]);
            gm1 = fabsf(gm1) < 1e-20f ? 1e-20f : gm1; gm2 = fabsf(gm2) < 1e-20f ? 1e-20f : gm2;
            v[VEC_GM1 * 1024] = gm1; v[VEC_G1 * 1024] = m[2];
            v[VEC_GM2 * 1024] = gm2; v[VEC_G2 * 1024] = m[5];
            rvec[(size_t)(l * 9 + b) * 2048 + j] = 1.0f / gm1; rvec[(size_t)(l * 9 + b) * 2048 + 1024 + j] = 1.0f / gm2;
            v[VEC_SH1 * 1024] = m[0]; v[VEC_SH2 * 1024] = m[3];
        }
    }
    } SEAM(1);
    for (int rep_ = 0, NREP_CUR = NREP(2); rep_ < NREP_CUR; ++rep_) { if (rep_) xcd_barrier(bar);
    if (EN(0) && IN(2)) {
        float* sl = (float*)ldsg;
        for (int combo = 0; combo < 4; ++combo) {
            const int l = combo >> 1, mat = combo & 1, N = mat ? D_FF : ZW;
            __syncthreads();
            for (int i = tid; i < 9 * 1024; i += NWAVES * 64) sl[i] = vec[(size_t)(l * 9 + (i >> 10)) * 6144 + (mat ? VEC_SH2 : VEC_SH1) * 1024 + (i & 1023)];
            __syncthreads();
            const bf16_t* wt = (const bf16_t*)(ws + WS_WT + (size_t)l * WT_LAYER + (mat ? WT_FF1 : WT_IN));
            float* bo = (mat ? bias_ff : bias_in) + (size_t)l * 9 * N;
            for (int n = gw; n < N; n += NGW) {
                const u32x4 w0 = *(const u32x4*)(wt + (size_t)n * 1024 + 8 * lane), w1 = *(const u32x4*)(wt + (size_t)n * 1024 + 512 + 8 * lane);
                float wv[16] = {bflo(w0.x), bfhi(w0.x), bflo(w0.y), bfhi(w0.y), bflo(w0.z), bfhi(w0.z), bflo(w0.w), bfhi(w0.w), bflo(w1.x), bfhi(w1.x), bflo(w1.y), bfhi(w1.y), bflo(w1.z), bfhi(w1.z), bflo(w1.w), bfhi(w1.w)};
#pragma unroll
                for (int b = 0; b < 9; ++b) { float s = 0.f;
#pragma unroll
                    for (int i = 0; i < 8; ++i) s += wv[i] * sl[b * 1024 + 8 * lane + i] + wv[8 + i] * sl[b * 1024 + 512 + 8 * lane + i];
                    s = thin::wave_sum(s); if (lane == 0) bo[b * N + n] = s; }
            }
        }
        for (int r0 = gw * 2; r0 < MROWS; r0 += NGW * 2) {
            f32x4 v[2][4]; const float* gmv[2];
#pragma unroll
            for (int q = 0; q < 2; ++q) { const int r = r0 + q, b = r / TPB, tt = r - b * TPB, bidx = tt < CTX ? 8 : b;
                const float* src = tt < CTX ? ctx_in + ((size_t)b * CTX + tt) * D_MODEL : x_in + ((size_t)b * SEQ + (tt - CTX)) * D_MODEL;
                gmv[q] = vec + (size_t)(0 * 9 + bidx) * 6144 + VEC_GM1 * 1024;
#pragma unroll
                for (int j = 0; j < 4; ++j) v[q][j] = *(const f32x4*)(src + 256 * j + 4 * lane); }
#pragma unroll
            for (int q = 0; q < 2; ++q) { const int r = r0 + q; float ss = 0.f;
#pragma unroll
                for (int j = 0; j < 4; ++j) { const f32x4 g4 = *(const f32x4*)(gmv[q] + 256 * j + 4 * lane); ss += epi::sq4(v[q][j]);
                    const f32x4 t = v[q][j] * g4; u32x2 w; w.x = cvt_pk_bf16(t[0], t[1]); w.y = cvt_pk_bf16(t[2], t[3]); *(u32x2*)(xg + (size_t)r * D_MODEL + 256 * j + 4 * lane) = w; }
                ss = thin::wave_sum(ss);
                if (lane < 16) ssqx[(size_t)r * 16 + lane] = lane == 0 ? ss : 0.f; }
        }
    }
    } SEAM(2);
    for (int l = 0; l < DEPTH; ++l) {
        const int p0 = 3 + 6 * l; const bool lastl = (l == DEPTH - 1);
        const unsigned char* wtl = ws + WS_WT + (size_t)l * WT_LAYER;
        const float* vl = vec + (size_t)l * 9 * 6144;
    for (int rep_ = 0, NREP_CUR = NREP(p0); rep_ < NREP_CUR; ++rep_) { if (rep_) xcd_barrier(bar);
        if (EN(1) && IN(p0)) {
            pg8::Gemm g{xg, (const bf16_t*)(wtl + WT_IN)}; pg8::StaticOrder S; S.init((GATE_PA && lastl) ? 128 : NPAN, ZW / 256, G, bx, (GATE_PA && lastl) ? 1 : 0);
            epi::EpiIn E{zb, ssqx, bias_in + (size_t)l * 9 * ZW, ssqkv, g_kn + l * 96, rtab};
            pg8::gemm_phase<1024, 1024, 1024, false>(lds, g, S, E);
        }
        } SEAM(p0);
    for (int rep_ = 0, NREP_CUR = NREP(p0 + 1); rep_ < NREP_CUR; ++rep_) { if (rep_) xcd_barrier(bar);
        if (IN(p0 + 1)) {
            unsigned* gate1 = (unsigned*)(ws + WS_CTL) + 4096 + 1024;
            if (GATE_PA && lastl && EN(3)) {
                pg8::Gemm ga{xg, (const bf16_t*)(wtl + WT_IN)}; pg8::CtxProdOrder SP; SP.init(bx, 192, 2, 3, 0x520u, gate1);
                epi::EpiIn Ea{zb, ssqx, bias_in + (size_t)l * 9 * ZW, ssqkv, g_kn + l * 96, rtab}; pg8::gemm_phase<1024, 1024, 1024, false>(lds, ga, SP, Ea);
            }
            if (EN(2)) { pg8::Gemm g{zb + Z_QL, (const bf16_t*)(wtl + WT_UQ)}; pg8::StaticOrder S; S.init(lastl ? 128 : NPAN, 3, G, bx, lastl ? 1 : 0);
              epi::EpiQ E{Qb, ssqq, g_qn + l * 96, rtab}; pg8::gemm_phase<384, ZW, 384, false>(lds, g, S, E); }
            if (EN(3)) { pg8::Gemm g{zb + Z_KVL, (const bf16_t*)(wtl + WT_UKV)}; pg8::StaticOrder S; S.init(NPAN, 4, G, (bx + 96) % G, 0);
              epi::EpiKV E{Kb, Vb, zb, ssqkv, g_kn + l * 96};
              if (GATE_PA && lastl) { pg8::GatedOrder SG; SG.init(4, G, (bx + 96) % G, gate1, 24u, (unsigned*)(ws + WS_CTL) + XB_TMO); pg8::gemm_phase<256, ZW, 256, false>(lds, g, SG, E); }
              else pg8::gemm_phase<256, ZW, 256, false>(lds, g, S, E); }
            thin::LruP P{zb, conv_w + l * 1024, conv_b + l * 256, (const bf16_t*)(wtl + WT_GATE), lru_b_a + l * 512, lru_b_x + l * 512, lru_lambda + l * 512, agg, mix};
            if (!EN(4)) {} else if (GATE_PA && lastl) {
                for (int it = G - 1 - vcu; it < NPAN * 4; it += G) { const int pl = it >> 2;
                    if (pl >= 128) gate_wait(gate1 + 64 * (pl - 128), 24u, (unsigned*)(ws + WS_CTL) + XB_TMO);
                    thin::lru_item<1>(P, pl < 128 ? pl + pl / 16 + 1 : (pl - 128) * 17, it & 3, ldsg); } }
            else for (int it = G - 1 - vcu; it < NPAN * 4; it += G) thin::lru_item<1>(P, it >> 2, it & 3, ldsg);
            if (!EN(5)) {} else if (lastl) { for (int it = vcu; it < 128 * 4; it += G) { const int pl = it >> 2; thin::pool_item(zb, (const bf16_t*)(wtl + WT_POOL), mix, pl + pl / 16 + 1, it & 3, ldsg); } }
            else { for (int it = vcu; it < NPAN * 4; it += G) thin::pool_item(zb, (const bf16_t*)(wtl + WT_POOL), mix, it >> 2, it & 3, ldsg); }
        }
        } SEAM(p0 + 1);
    for (int rep_ = 0, NREP_CUR = NREP(p0 + 2); rep_ < NREP_CUR; ++rep_) { if (rep_) xcd_barrier(bar);
        if (IN(p0 + 2)) {
#ifndef SHIFT_THRESH
#define SHIFT_THRESH 64.0f
#endif
            float negB2; bool shifted;
            {
                const float* gq = g_qn + l * 96; const float* gk = g_kn + l * 96;
                float mq = fmaxf(fabsf(gq[lane]), lane < 32 ? fabsf(gq[64 + lane]) : 0.f), mk = fmaxf(fabsf(gk[lane]), lane < 32 ? fabsf(gk[64 + lane]) : 0.f);
#pragma unroll
                for (int o = 1; o < 64; o <<= 1) { mq = fmaxf(mq, __shfl_xor(mq, o)); mk = fmaxf(mk, __shfl_xor(mk, o)); }
                negB2 = -(96.0f * 1.02f * QSCALE) * mq * mk;
                shifted = __builtin_amdgcn_readfirstlane(negB2 < -SHIFT_THRESH ? 1 : 0) != 0;
                if (!shifted) negB2 = 0.f;
            }
            thin::LruP P{zb, conv_w + l * 1024, conv_b + l * 256, (const bf16_t*)(wtl + WT_GATE), lru_b_a + l * 512, lru_b_x + l * 512, lru_lambda + l * 512, agg, mix};
            if (!EN(6)) {} else if (lastl) { for (int it = vcu; it < 128 * 4; it += G) { const int pl = it >> 2; thin::lru_item<2>(P, pl + pl / 16 + 1, it & 3, ldsg); } }
            else { for (int it = vcu; it < NPAN * 4; it += G) thin::lru_item<2>(P, it >> 2, it & 3, ldsg); }
            if (EN(7)) for (int it = vcu; it < 1024; it += G) {
                const int bh = it >> 4, qp = it & 15, b = bh >> 3, h = bh & 7;
                #ifdef ATT_VAR
                if (rep_ == 0 && NREP(p0 + 2) == 2) att::attn_unit<ATT_VAR>(Qb, Kb, Vb, mix, ssqkv, ssqq, negB2, b * TPB + CTX + qp * 256, b * TPB, TPB, h, ldsg); else
#endif
                if (shifted) att::attn_unit<9>(Qb, Kb, Vb, mix, ssqkv, ssqq, negB2, b * TPB + CTX + qp * 256, b * TPB, TPB, h, ldsg);
                else att::attn_unit<0>(Qb, Kb, Vb, mix, ssqkv, ssqq, negB2, b * TPB + CTX + qp * 256, b * TPB, TPB, h, ldsg);
            }
            if (EN(7) && !lastl) for (int it = G - 1 - vcu; it < 64; it += G) { const int b = it >> 3, h = it & 7;
                if (shifted) att::attn_unit<9>(Qb, Kb, Vb, mix, ssqkv, ssqq, negB2, b * TPB, b * TPB, CTX, h, ldsg); else att::attn_unit<0>(Qb, Kb, Vb, mix, ssqkv, ssqq, negB2, b * TPB, b * TPB, CTX, h, ldsg); }
        }
        } SEAM(p0 + 2);
    for (int rep_ = 0, NREP_CUR = NREP(p0 + 3); rep_ < NREP_CUR; ++rep_) { if (rep_) xcd_barrier(bar);
        if (EN(8) && IN(p0 + 3)) {
            pg8::Gemm g{mix, (const bf16_t*)(wtl + WT_OUT)}; pg8::StaticOrder S; S.init((lastl || GATE_PD) ? 128 : NPAN, 4, G, bx, (lastl || GATE_PD) ? 1 : 0);
            if (l == 0) { epi::EpiRes<true, false> E{x_in, ctx_in, nullptr, xg, ssqx, vl + VEC_G1 * 1024, nullptr, vl + VEC_GM2 * 1024}; pg8::gemm_phase<1024, 1024, 1024, false>(lds, g, S, E); }
            else { epi::EpiRes<false, false> E{nullptr, nullptr, nullptr, xg, ssqx, vl + VEC_G1 * 1024, rvec + (size_t)l * 9 * 2048, vl + VEC_GM2 * 1024}; pg8::gemm_phase<1024, 1024, 1024, false>(lds, g, S, E); }
        }
        } SEAM(p0 + 3);
    for (int rep_ = 0, NREP_CUR = NREP(p0 + 4); rep_ < NREP_CUR; ++rep_) { if (rep_) xcd_barrier(bar);
        if (EN(9) && IN(p0 + 4)) {
            unsigned* gate0 = (unsigned*)(ws + WS_CTL) + 4096;
            if (GATE_PD && !lastl) {
                pg8::Gemm gd{mix, (const bf16_t*)(wtl + WT_OUT)}; pg8::CtxProdOrder SP; SP.init(bx, 128, 3, 4, 0x3210u, gate0);
                epi::EpiRes<true, false> Ed{x_in, ctx_in, nullptr, xg, ssqx, vl + VEC_G1 * 1024, nullptr, vl + VEC_GM2 * 1024}; pg8::gemm_phase<1024, 1024, 1024, false>(lds, gd, SP, Ed);
            }
            pg8::Gemm g{xg, (const bf16_t*)(wtl + WT_FF1)}; pg8::StaticOrder S; S.init(lastl ? 128 : NPAN, 16, G, bx, lastl ? 1 : 0);
            epi::EpiFF1 E{U, ssqx, bias_ff + (size_t)l * 9 * D_FF};
            if (GATE_PD && !lastl) { pg8::GatedOrder SG; SG.init(16, G, bx, gate0, 32u, (unsigned*)(ws + WS_CTL) + XB_TMO); pg8::gemm_phase<1024, 1024, 1024, false>(lds, g, SG, E); } else
#ifdef NULL_DUP
            if (rep_ == 0 && NREP_CUR == 2) { epi::EpiSink E0{(float*)(ws + WS_CTL + 65536)}; pg8::gemm_phase<1024, 1024, 1024, false>(lds, g, S, E0); } else
#endif
            pg8::gemm_phase<1024, 1024, 1024, false>(lds, g, S, E);
        }
        } SEAM(p0 + 4);
    for (int rep_ = 0, NREP_CUR = NREP(p0 + 5); rep_ < NREP_CUR; ++rep_) { if (rep_) xcd_barrier(bar);
        if (EN(10) && IN(p0 + 5)) {
            pg8::Gemm g{U, (const bf16_t*)(wtl + WT_FF2)}; pg8::StaticOrder S; S.init(lastl ? 128 : NPAN, 4, G, bx, lastl ? 1 : 0);
#ifdef NULL_DUP
            if (rep_ == 0 && NREP_CUR == 2) { pg8::StaticOrder SL; SL.init(128, 4, G, bx, 1); epi::EpiSink E0{(float*)(ws + WS_CTL + 65536)}; pg8::gemm_phase<4096, 4096, 4096, true>(lds, g, SL, E0); } else
#endif
            if (lastl) { epi::EpiRes<false, true> E{nullptr, nullptr, out, xg, nullptr, vl + VEC_G2 * 1024, rvec + (size_t)l * 9 * 2048 + 1024, nullptr}; pg8::gemm_phase<4096, 4096, 4096, true>(lds, g, S, E); }
            else {
                { pg8::StaticOrder SL; SL.init(128, 4, G, bx, 1);
                  epi::EpiRes<false, false> E{nullptr, nullptr, nullptr, xg, ssqx, vl + VEC_G2 * 1024, rvec + (size_t)l * 9 * 2048 + 1024, vec + (size_t)(l + 1) * 9 * 6144 + VEC_GM1 * 1024}; pg8::gemm_phase<4096, 4096, 4096, true>(lds, g, SL, E); }
                float* slab = out + (size_t)18 * 1024 * 1024;
                { pg8::CtxSplitOrder SC{4, 4, 1024, G, bx, 1}; epi::EpiSlab E{slab, 1024}; pg8::gemm_phase<1024, 4096, 4096, true>(lds, g, SC, E); }
                xcd_barrier(bar);
                ctx_combine(ws, out, rvec + (size_t)(l * 9 + 8) * 2048 + 1024, vl + 8 * 6144 + VEC_G2 * 1024, vec + (size_t)(l + 1) * 9 * 6144 + 8 * 6144 + VEC_GM1 * 1024, gw, NGW, lane);
            }
        }
        } if (!lastl) SEAM(p0 + 5);
    }
#undef IN
#undef SEAM
}


#ifdef DBG_DUMP
__global__ void dbg_dump(const bf16_t* buf, int pitch, int coloff, int ncols, float* out) {
    for (size_t i = blockIdx.x * (size_t)blockDim.x + threadIdx.x; i < (size_t)BATCH * SEQ * D_MODEL; i += (size_t)gridDim.x * blockDim.x) {
        const int c = (int)(i & 1023); const size_t rt = i >> 10; const int b = (int)(rt / SEQ), t = (int)(rt - (size_t)b * SEQ);
        out[i] = c < ncols ? bf2f(buf[((size_t)b * TPB + CTX + t) * pitch + coloff + c]) : 0.f;
    }
}
#endif
#ifndef N_LAUNCH_MODE
#define N_LAUNCH_MODE 1
#endif
extern "C" void kernel_launch(void* const* d_in, const int* in_sizes, int n_in, void* d_out, int out_size, void* d_ws, size_t ws_size, hipStream_t stream) {
    static int grid = 0;
    if (grid == 0) {
        if (n_in != 27 || in_sizes[0] != BATCH * SEQ * D_MODEL || out_size != BATCH * SEQ * D_MODEL || ws_size < WS_END) { fprintf(stderr, "kernel_launch: unexpected shapes (n_in %d, in0 %d, out %d, ws %zu < %zu)\n", n_in, n_in > 0 ? in_sizes[0] : -1, out_size, ws_size, (size_t)WS_END); grid = -1; return; }
        int dev = 0, cus = 0, per_cu = 0;
        if (hipGetDevice(&dev) != hipSuccess || hipDeviceGetAttribute(&cus, hipDeviceAttributeMultiprocessorCount, dev) != hipSuccess) { grid = -1; return; }
        if (hipFuncSetAttribute((const void*)fwd_kernel, hipFuncAttributeMaxDynamicSharedMemorySize, LDS_BYTES) != hipSuccess) { fprintf(stderr, "kernel_launch: hipFuncSetAttribute failed\n"); grid = -1; return; }
        if (hipOccupancyMaxActiveBlocksPerMultiprocessor(&per_cu, (const void*)fwd_kernel, NWAVES * 64, LDS_BYTES) != hipSuccess || per_cu < 1) { fprintf(stderr, "kernel_launch: occupancy query says %d blocks per CU\n", per_cu); (void)hipGetLastError(); grid = -1; return; }
        grid = cus;
    }
    if (grid < 0) return;
    (void)hipMemsetAsync((char*)d_ws + WS_CTL, 0, CTL_ZERO_BYTES, stream);
    Args a{};
    for (int i = 0; i < 27; ++i) a.in[i] = (const float*)d_in[i];
    a.out = (float*)d_out; a.ws = (unsigned char*)d_ws;
#if N_LAUNCH_MODE
    a.ph_lo = 0; a.ph_hi = NPHASE;
    void* kargs[] = {&a};
    hipError_t e = hipLaunchCooperativeKernel((const void*)fwd_kernel, dim3(grid), dim3(NWAVES * 64), kargs, LDS_BYTES, stream);
    if (e != hipSuccess) fprintf(stderr, "kernel_launch: cooperative launch failed: %s\n", hipGetErrorString(e));
#else
#ifndef DBG_STOP_PHASE
#define DBG_STOP_PHASE NPHASE
#endif
    for (int p = 0; p < DBG_STOP_PHASE; ++p) { a.ph_lo = p; a.ph_hi = p + 1; hipLaunchKernelGGL(fwd_kernel, dim3(grid), dim3(NWAVES * 64), LDS_BYTES, stream, a); }
#ifdef DBG_DUMP
    hipLaunchKernelGGL(dbg_dump, dim3(2048), dim3(256), 0, stream, (const bf16_t*)((unsigned char*)d_ws + DBG_DUMP_OFF), DBG_DUMP_PITCH, DBG_DUMP_COL, DBG_DUMP_NCOLS, (float*)d_out);
#endif
#endif
}
```

```cpp
#include <hip/hip_runtime.h>
#include <cstdio>
#include <cstdint>

#define LAS __attribute__((address_space(3)))
#define GAS __attribute__((address_space(1)))
typedef unsigned short bf16_t;
typedef short bf16x8 __attribute__((ext_vector_type(8)));
typedef short s16x4 __attribute__((ext_vector_type(4)));
typedef float f32x4 __attribute__((ext_vector_type(4)));
typedef float f32x2 __attribute__((ext_vector_type(2)));
typedef float f32x16 __attribute__((ext_vector_type(16)));
typedef unsigned u32x4 __attribute__((ext_vector_type(4)));
typedef unsigned u32x2 __attribute__((ext_vector_type(2)));

constexpr int D_MODEL = 1024, BATCH = 8, SEQ = 4096, DEPTH = 2, CTX = 256, D_IN = 1440, D_FF = 4096;
constexpr int TPB = SEQ + CTX;
constexpr int MROWS = BATCH * TPB;
constexpr int PPB = TPB / 256;
constexpr int NPAN = MROWS / 256;
constexpr int ZW = 1536;
constexpr int Z_LX = 0, Z_LG = 256, Z_KVL = 512, Z_PU = 768, Z_QL = 1024, Z_KR = 1408;
constexpr float EPS = 1e-6f;
constexpr float QSCALE = 0.10206207261596575f * 1.4426950408889634f;

typedef __bf16 bf16x2_t __attribute__((ext_vector_type(2)));
__device__ __forceinline__ unsigned cvt_pk_bf16(float lo, float hi) { f32x2 v = {lo, hi}; bf16x2_t b = __builtin_convertvector(v, bf16x2_t); return __builtin_bit_cast(unsigned, b); }
__device__ __forceinline__ float bf2f(unsigned short h) { return __uint_as_float((unsigned)h << 16); }
__device__ __forceinline__ float bflo(unsigned w) { return __uint_as_float(w << 16); }
__device__ __forceinline__ float bfhi(unsigned w) { return __uint_as_float(w & 0xffff0000u); }
__device__ __forceinline__ unsigned short f2bf(float f) { unsigned u = __float_as_uint(f); return (unsigned short)((u + 0x7fffu + ((u >> 16) & 1u)) >> 16); }

namespace pg8 {
constexpr int BM = 256, BK = 64, HALF = 128, HTB = HALF * BK * 2, STAGE_BYTES = 8 * HTB, NXCD = 8, WGM = 8;
__host__ __device__ __forceinline__ int lds_byte(int r, int c) { const int st = (r >> 4) * 2 + (c >> 5), rr = r & 15, cc = c & 31, ob = rr * 64 + cc * 2; return st * 1024 + (ob ^ (((ob >> 9) & 1) << 5)); }
__host__ __device__ __forceinline__ void stage_rc(int b, int& R, int& C) { const int st = b / 1024, sb = b % 1024, swz = sb ^ (((sb >> 9) & 1) << 5); R = (st >> 1) * 16 + swz / 64; C = (st & 1) * 32 + (swz % 64) / 2; }
__host__ __device__ __forceinline__ int perm32(int rho) { const int n = rho >> 4, i = rho & 15; return 8 * (i >> 2) + 4 * n + (i & 3); }

struct Unit { int pm, pn; unsigned koffA, koffB; };
struct Gemm { const bf16_t* A; const bf16_t* Bt; };

struct StaticOrder {
    int nM, nN, nwg, G, c, latonly;
    __device__ void init(int nM_, int nN_, int G_, int c_, int latonly_) { nM = nM_; nN = nN_; nwg = nM * nN; G = G_; c = c_; latonly = latonly_; }
    __device__ bool next(int i, Unit& u) const {
        const long L = (long)i * G + c; if (L >= nwg) return false;
        int wgid = (int)L; { const int q = nwg / NXCD, r = nwg % NXCD, xcd = wgid % NXCD, off = wgid / NXCD; wgid = (xcd < r ? xcd * (q + 1) : r * (q + 1) + (xcd - r) * q) + off; }
        const int nig = WGM * nN, gid = wgid / nig, fm = gid * WGM, gsz = (nM - fm) < WGM ? (nM - fm) : WGM;
        int pm = fm + ((wgid % nig) % gsz); u.pn = (wgid % nig) / gsz;
        if (latonly) pm = pm + pm / 16 + 1;
        u.pm = pm; u.koffA = 0u; u.koffB = 0u; return true;
    }
    __device__ __forceinline__ void a_ready(const Unit&) const {}
    __device__ __forceinline__ void done(const Unit&) const {}
};
struct CtxSplitOrder {
    int nN, NS, KS, G, c, ablk;
    __device__ bool next(int i, Unit& u) const {
        const int L = i * G + c; if (L >= 8 * nN * NS) return false;
        const int ks = L % NS, t = L / NS; u.pn = t % nN; u.pm = (t / nN) * 17; u.koffB = (unsigned)(ks * KS * 2); u.koffA = ablk ? (unsigned)(ks * (KS / 32) * 16384) : u.koffB; return true;
    }
    __device__ __forceinline__ void a_ready(const Unit&) const {}
    __device__ __forceinline__ void done(const Unit&) const {}
};
struct CtxProdOrder {
    int unit, nsel; unsigned pnlist; unsigned* ready;
    __device__ __forceinline__ void init(int c, int c0, int cstride, int nsel_, unsigned pnlist_, unsigned* ready_) { const int d = c - c0; unit = (d >= 0 && d % cstride == 0 && d / cstride < 8 * nsel_) ? d / cstride : -1; nsel = nsel_; pnlist = pnlist_; ready = ready_; }
    __device__ __forceinline__ void init_unit(int unit_, int nsel_, unsigned pnlist_, unsigned* ready_) { unit = unit_ < 8 * nsel_ ? unit_ : -1; nsel = nsel_; pnlist = pnlist_; ready = ready_; }
    __device__ __forceinline__ bool next(int i, Unit& u) const { if (i != 0 || unit < 0) return false; u.pm = 17 * (unit / nsel); u.pn = (int)((pnlist >> (4 * (unit % nsel))) & 15u); u.koffA = 0u; u.koffB = 0u; return true; }
    __device__ __forceinline__ void a_ready(const Unit&) const {}
    __device__ __forceinline__ void done(const Unit& u) const {
        asm volatile("s_waitcnt vmcnt(0)" ::: "memory");
        __builtin_amdgcn_fence(__ATOMIC_RELEASE, "agent");
        asm volatile("s_waitcnt vmcnt(0)" ::: "memory");
        if ((threadIdx.x & 63) == 0) (void)__hip_atomic_fetch_add(ready + 64 * (u.pm / 17), 1u, __ATOMIC_RELAXED, __HIP_MEMORY_SCOPE_AGENT);
    }
};
struct GatedOrder {
    int nN, nwg, G, c; const unsigned* ready; unsigned need; unsigned* tmo;
    __device__ __forceinline__ void init(int nN_, int G_, int c_, const unsigned* ready_, unsigned need_, unsigned* tmo_) { nN = nN_; nwg = 136 * nN_; G = G_; c = c_; ready = ready_; need = need_; tmo = tmo_; }
    __device__ __forceinline__ bool next(int i, Unit& u) const {
        const long L = (long)i * G + c; if (L >= nwg) return false;
        int wgid = (int)L; { const int q = nwg / NXCD, r = nwg % NXCD, xcd = wgid % NXCD, off = wgid / NXCD; wgid = (xcd < r ? xcd * (q + 1) : r * (q + 1) + (xcd - r) * q) + off; }
        const int nig = WGM * nN, gid = wgid / nig, fm = gid * WGM;
        const int q = fm + ((wgid % nig) % WGM); u.pn = (wgid % nig) / WGM;
        u.pm = q < 128 ? q + q / 16 + 1 : (q - 128) * 17; u.koffA = 0u; u.koffB = 0u; return true;
    }
    __device__ __forceinline__ void a_ready(const Unit& u) const {
        if (u.pm % 17 != 0) return;
        if (threadIdx.x < 64) {
            const unsigned* w = ready + 64 * (u.pm / 17); unsigned sp = 0u;
            while ((unsigned)__builtin_amdgcn_readfirstlane(__hip_atomic_load(w, __ATOMIC_RELAXED, __HIP_MEMORY_SCOPE_AGENT)) < need) {
                __builtin_amdgcn_s_sleep(2);
                if ((++sp & 255u) == 0u) { if (__hip_atomic_load(tmo, __ATOMIC_RELAXED, __HIP_MEMORY_SCOPE_AGENT)) break; if (sp > (1u << 20)) { if (threadIdx.x == 0) atomicAdd(tmo, 1u); break; } } }
            __builtin_amdgcn_fence(__ATOMIC_ACQUIRE, "agent");
            asm volatile("s_waitcnt vmcnt(0)" ::: "memory");
        }
        asm volatile("" ::: "memory"); __builtin_amdgcn_s_barrier(); asm volatile("" ::: "memory");
    }
    __device__ __forceinline__ void done(const Unit&) const {}
};

template <int K, int LDA, int LDB, bool ABLK, class Epi, class Sched>
__device__ __forceinline__ void gemm_phase(LAS unsigned char* lds, const Gemm g, const Sched& S, const Epi& E) {
    int tid = threadIdx.x; asm volatile("" : "+v"(tid));
    const int  wid = __builtin_amdgcn_readfirstlane(tid >> 6), lane = tid & 63, wr = wid >> 2, wc = wid & 3, fr = lane & 15, fq = lane >> 4;
    constexpr int nt = K / BK;
    unsigned voffA[2], voffB[2];
#pragma unroll
    for (int i = 0; i < 2; ++i) { int R, C; stage_rc(tid * 16 + i * 8192, R, C); const int Rb = Epi::PERM ? ((R & ~31) + perm32(R & 31)) : R;
        voffA[i] = ABLK ? (unsigned)((C >> 5) * 16384 + (R >> 4) * 1024 + ((R & 15) * 32 + (C & 31)) * 2) : (unsigned)(R * LDA + C) * 2u; voffB[i] = (unsigned)(Rb * LDB + C) * 2u; }
    const size_t kstep = (size_t)(BK * 2);
    const size_t kstepA = ABLK ? (size_t)32768 : kstep;
    const size_t hstepA = ABLK ? (size_t)8192 : (size_t)HALF * LDA * 2, tstepA = ABLK ? (size_t)(LDA / 32) * 16384 : 2 * hstepA;
    const size_t hstepB = (size_t)HALF * LDB * 2, tstepB = 2 * hstepB;
    const unsigned ldsw = (unsigned)wid * 1024u;
    const int aoff = lds_byte(wr * 64 + fr, fq * 8), boff = lds_byte(wc * 32 + fr, fq * 8);
#define PG8_SA(b, h) (((b) * 2 + (h)) * HTB)
#define PG8_SB(b, h) ((4 + (b) * 2 + (h)) * HTB)
#define PG8_STAGE(bufoff, gbase, voff) do { _Pragma("unroll") for (int _i = 0; _i < 2; ++_i) \
        __builtin_amdgcn_global_load_lds((const unsigned*)((const char*)(gbase) + (voff)[_i]), (LAS unsigned*)(lds + (bufoff) + ldsw + _i * 8192), 16, 0, 0); } while (0)
#define PG8_LDA(dst, b, h) do { _Pragma("unroll") for (int m = 0; m < 4; ++m) _Pragma("unroll") for (int k = 0; k < 2; ++k) dst[m][k] = *(const LAS bf16x8*)(lds + PG8_SA(b, h) + aoff + m * 2048 + k * 1024); } while (0)
#define PG8_LDB(dst, b, h) do { _Pragma("unroll") for (int n = 0; n < 2; ++n) _Pragma("unroll") for (int k = 0; k < 2; ++k) dst[n][k] = *(const LAS bf16x8*)(lds + PG8_SB(b, h) + boff + n * 2048 + k * 1024); } while (0)
#define PG8_MMA(ai, bj, At, Bt) do { __builtin_amdgcn_s_setprio(1); _Pragma("unroll") for (int m = 0; m < 4; ++m) _Pragma("unroll") for (int n = 0; n < 2; ++n) _Pragma("unroll") for (int k = 0; k < 2; ++k) \
        acc[ai][bj][m][n] = __builtin_amdgcn_mfma_f32_16x16x32_bf16(Bt[n][k], At[m][k], acc[ai][bj][m][n], 0, 0, 0); __builtin_amdgcn_s_setprio(0); } while (0)
#define PG8_WAIT_V(n) asm volatile("s_waitcnt vmcnt(" #n ")" ::: "memory")
#define PG8_WAIT_L(n) asm volatile("s_waitcnt lgkmcnt(" #n ")" ::: "memory")
#define PG8_BAR __builtin_amdgcn_s_barrier()
#define PG8_SCHED __builtin_amdgcn_sched_barrier(0)
    Unit cur, nxt; int ui = 0;
    if (!S.next(0, cur)) return;
    f32x4 acc[2][2][4][2];
#pragma unroll
    for (int a = 0; a < 2; ++a)
#pragma unroll
        for (int b = 0; b < 2; ++b)
#pragma unroll
            for (int m = 0; m < 4; ++m)
#pragma unroll
                for (int n = 0; n < 2; ++n) acc[a][b][m][n] = (f32x4){0.f, 0.f, 0.f, 0.f};
    bf16x8 At[4][2], B0[2][2], B1[2][2];
    const char* cA = (const char*)g.A + (size_t)cur.pm * tstepA + cur.koffA; const char* cB = (const char*)g.Bt + (size_t)cur.pn * tstepB + cur.koffB;
    S.a_ready(cur);
    PG8_STAGE(PG8_SB(0, 0), cB, voffB); PG8_STAGE(PG8_SB(0, 1), cB + hstepB, voffB); PG8_STAGE(PG8_SA(0, 0), cA, voffA); PG8_STAGE(PG8_SA(0, 1), cA + hstepA, voffA);
    if (wr == 1) PG8_BAR;
    PG8_WAIT_V(2); PG8_BAR;
    PG8_STAGE(PG8_SB(1, 0), cB + kstep, voffB); PG8_STAGE(PG8_SA(1, 0), cA + kstepA, voffA); PG8_STAGE(PG8_SB(1, 1), cB + hstepB + kstep, voffB);
    PG8_WAIT_V(6); PG8_BAR;
    for (;;) {
        const bool has_next = S.next(ui + 1, nxt);
        const char* nA = has_next ? (const char*)g.A + (size_t)nxt.pm * tstepA + nxt.koffA : cA; const char* nB = has_next ? (const char*)g.Bt + (size_t)nxt.pn * tstepB + nxt.koffB : cB;
#pragma unroll 1
        for (int t = 0; t < nt; t += 2) {
            const bool last = (t == nt - 2);
            const char* a1 = cA + (size_t)(t + 1) * kstepA;
            const char* a2 = last ? nA : cA + (size_t)(t + 2) * kstepA; const char* b2 = last ? nB : cB + (size_t)(t + 2) * kstep;
            const char* a3 = a2 + kstepA; const char* b3 = b2 + kstep;
            if (last && has_next) S.a_ready(nxt);
            PG8_LDB(B0, 0, 0); PG8_LDB(B1, 0, 1); PG8_SCHED; PG8_LDA(At, 0, 0); PG8_STAGE(PG8_SA(1, 1), a1 + hstepA, voffA);
            PG8_WAIT_V(8); PG8_WAIT_L(0); PG8_BAR; PG8_MMA(0, 0, At, B0); PG8_MMA(0, 1, At, B1); PG8_BAR; PG8_SCHED;
            PG8_LDA(At, 0, 1); PG8_STAGE(PG8_SB(0, 0), b2, voffB); PG8_STAGE(PG8_SB(0, 1), b2 + hstepB, voffB); PG8_STAGE(PG8_SA(0, 0), a2, voffA);
            PG8_WAIT_V(8); PG8_WAIT_L(0); PG8_BAR; PG8_MMA(1, 0, At, B0); PG8_MMA(1, 1, At, B1); PG8_BAR; PG8_SCHED;
            PG8_LDB(B0, 1, 0); PG8_LDB(B1, 1, 1); PG8_SCHED; PG8_LDA(At, 1, 0); PG8_STAGE(PG8_SA(0, 1), a2 + hstepA, voffA);
            PG8_WAIT_V(8); PG8_WAIT_L(0); PG8_BAR; PG8_MMA(0, 0, At, B0); PG8_MMA(0, 1, At, B1); PG8_BAR; PG8_SCHED;
            PG8_LDA(At, 1, 1); PG8_STAGE(PG8_SB(1, 0), b3, voffB); PG8_STAGE(PG8_SB(1, 1), b3 + hstepB, voffB); PG8_STAGE(PG8_SA(1, 0), a3, voffA);
            PG8_WAIT_V(8); PG8_WAIT_L(0); PG8_BAR; PG8_MMA(1, 0, At, B0); PG8_MMA(1, 1, At, B1); PG8_BAR; PG8_SCHED;
        }
        if (wr == 0) PG8_BAR;
        { int fr2 = fr, fq2 = fq; asm volatile("" : "+v"(fr2), "+v"(fq2));
          E(acc, cur, wr, wc, fr2, fq2); }
        S.done(cur);
        if (!has_next) break;
#pragma unroll
        for (int a = 0; a < 2; ++a)
#pragma unroll
            for (int b = 0; b < 2; ++b)
#pragma unroll
                for (int m = 0; m < 4; ++m)
#pragma unroll
                    for (int n = 0; n < 2; ++n) acc[a][b][m][n] = (f32x4){0.f, 0.f, 0.f, 0.f};
        cur = nxt; cA = nA; cB = nB; ++ui;
        if (wr == 1) PG8_BAR;
    }
    PG8_WAIT_V(0);
    PG8_BAR;
#undef PG8_SA
#undef PG8_SB
#undef PG8_STAGE
#undef PG8_LDA
#undef PG8_LDB
#undef PG8_MMA
#undef PG8_WAIT_V
#undef PG8_WAIT_L
#undef PG8_BAR
#undef PG8_SCHED
}
}
namespace epi {
using pg8::Unit;
typedef f32x4 Acc[2][2][4][2];
__device__ __forceinline__ float sum4(f32x4 v) { return (v[0] + v[1]) + (v[2] + v[3]); }
__device__ __forceinline__ float sq4(f32x4 v) { return (v[0] * v[0] + v[1] * v[1]) + (v[2] * v[2] + v[3] * v[3]); }
__device__ __forceinline__ float red_fq(float s) { s += __shfl_xor(s, 16); s += __shfl_xor(s, 32); return s; }
__device__ __forceinline__ u32x4 pack8(f32x4 a, f32x4 b) { u32x4 w; w.x = cvt_pk_bf16(a[0], a[1]); w.y = cvt_pk_bf16(a[2], a[3]); w.z = cvt_pk_bf16(b[0], b[1]); w.w = cvt_pk_bf16(b[2], b[3]); return w; }
__device__ __forceinline__ void rope4(f32x4& x1, f32x4& x2, const float* rtab, int t, int fq) {
    const int idx = (fq >> 1) ? (t & 63) : (t >> 6);
    const f32x4 c0 = *(const f32x4*)(rtab + (idx * 8 + (fq & 1) * 4) * 2), c1 = *(const f32x4*)(rtab + (idx * 8 + (fq & 1) * 4) * 2 + 4);
    const f32x4 cs = (f32x4){c0[0], c0[2], c1[0], c1[2]}, sn = (f32x4){c0[1], c0[3], c1[1], c1[3]};
    const f32x4 y1 = x1 * cs - x2 * sn, y2 = x2 * cs + x1 * sn; x1 = y1; x2 = y2;
}
__device__ __forceinline__ float row_rstd16(const float* ssq, int row, int fq, float inv_n) {
    const f32x4 p = *(const f32x4*)(ssq + (size_t)row * 16 + 4 * fq); return rsqrtf(red_fq(sum4(p)) * inv_n + EPS);
}

struct EpiIn {
    static constexpr bool PERM = true;
    bf16_t* z; const float* ssqx; const float* bias; float* ssqkv; const float* gkn; const float* rtab;
    __device__ __forceinline__ void operator()(const Acc& acc, const Unit& u, int wr, int wc, int fr, int fq) const {
        const int pm = u.pm, pn = u.pn, b = pm / PPB, pp = pm - b * PPB, bidx = pp == 0 ? 8 : b;
        const float* bia = bias + bidx * ZW + pn * 256 + wc * 32 + 8 * fq;
        f32x4 bv[2][2];
#pragma unroll
        for (int bj = 0; bj < 2; ++bj)
#pragma unroll
            for (int n = 0; n < 2; ++n) bv[bj][n] = *(const f32x4*)(bia + bj * 128 + 4 * n);
        const int ax = fq >> 1, f0 = (fq & 1) * 4;
        const f32x4 gk1 = *(const f32x4*)(gkn + 64 + ax * 16 + f0), gk2 = *(const f32x4*)(gkn + 64 + ax * 16 + 8 + f0);
#pragma unroll
        for (int ai = 0; ai < 2; ++ai)
#pragma unroll
            for (int m = 0; m < 4; ++m) {
                const int rl = ai * 128 + wr * 64 + m * 16 + fr, row = pm * 256 + rl;
                const float rs = row_rstd16(ssqx, row, fq, 1.0f / 1024.0f);
                f32x4 v[2][2];
#pragma unroll
                for (int bj = 0; bj < 2; ++bj)
#pragma unroll
                    for (int n = 0; n < 2; ++n) v[bj][n] = acc[ai][bj][m][n] * rs + bv[bj][n];
                if (pn == 2 || pn == 4) {
                    const float s = red_fq((sq4(v[0][0]) + sq4(v[0][1])) + (sq4(v[1][0]) + sq4(v[1][1])));
                    if (fq == 0) ssqkv[(size_t)row * 16 + (pn == 2 ? wc : 4 + wc)] = s;
                }
                if (pn == 5) {
                    const float s = red_fq(sq4(v[0][0]) + sq4(v[0][1]));
                    if (fq == 0) ssqkv[(size_t)row * 16 + 8 + wc] = s;
                    if (wc == 0) {
                        const float s1 = red_fq(sq4(v[1][0]) + sq4(v[1][1]));
                        if (fq == 0) ssqkv[(size_t)row * 16 + 12] = s1;
                        v[1][0] = v[1][0] * gk1; v[1][1] = v[1][1] * gk2;
                        if (pp != 0) rope4(v[1][0], v[1][1], rtab, (pp - 1) * 256 + rl, fq);
                    }
                }
                bf16_t* zp = z + (size_t)row * ZW + pn * 256 + wc * 32 + 8 * fq;
#pragma unroll
                for (int bj = 0; bj < 2; ++bj) *(u32x4*)(zp + bj * 128) = pack8(v[bj][0], v[bj][1]);
                asm volatile("" ::: "memory");
            }
    }
};

struct EpiQ {
    static constexpr bool PERM = true;
    bf16_t* Q; float* ssqq; const float* gqn; const float* rtab;
    __device__ __forceinline__ void operator()(const Acc& acc, const Unit& u, int wr, int wc, int fr, int fq) const {
        const int pm = u.pm, pn = u.pn, b = pm / PPB, pp = pm - b * PPB;
        const int ax = fq >> 1, f0 = (fq & 1) * 4;
        f32x4 g0[2], g1[2]; int part[2], grp[2];
#pragma unroll
        for (int bj = 0; bj < 2; ++bj) {
            grp[bj] = pn * 8 + bj * 4 + wc; part[bj] = grp[bj] % 3;
            if (part[bj] < 2) { g0[bj] = *(const f32x4*)(gqn + 32 * part[bj] + 8 * fq); g1[bj] = *(const f32x4*)(gqn + 32 * part[bj] + 8 * fq + 4); }
            else { g0[bj] = *(const f32x4*)(gqn + 64 + ax * 16 + f0); g1[bj] = *(const f32x4*)(gqn + 64 + ax * 16 + 8 + f0); }
        }
#pragma unroll
        for (int ai = 0; ai < 2; ++ai)
#pragma unroll
            for (int m = 0; m < 4; ++m) {
                const int rl = ai * 128 + wr * 64 + m * 16 + fr, row = pm * 256 + rl;
                bf16_t* qp = Q + (size_t)row * 768 + pn * 256 + wc * 32 + 8 * fq;
#pragma unroll
                for (int bj = 0; bj < 2; ++bj) {
                    const f32x4 a0 = acc[ai][bj][m][0], a1 = acc[ai][bj][m][1];
                    const float s = red_fq(sq4(a0) + sq4(a1));
                    if (fq == 0) ssqq[(size_t)row * 24 + grp[bj]] = s;
                    f32x4 v0 = a0 * g0[bj], v1 = a1 * g1[bj];
                    if (part[bj] == 2 && pp != 0) rope4(v0, v1, rtab, (pp - 1) * 256 + rl, fq);
                    *(u32x4*)(qp + bj * 128) = pack8(v0, v1);
                }
                asm volatile("" ::: "memory");
            }
    }
};

struct EpiKV {
    static constexpr bool PERM = true;
    bf16_t* Kb; bf16_t* Vb; const bf16_t* z; const float* ssqkv; const float* gkn;
    __device__ __forceinline__ void operator()(const Acc& acc, const Unit& u, int wr, int wc, int fr, int fq) const {
        const int pm = u.pm, pn = u.pn;
        f32x4 gk[2][2];
#pragma unroll
        for (int bj = 0; bj < 2; ++bj)
#pragma unroll
            for (int n = 0; n < 2; ++n) gk[bj][n] = *(const f32x4*)(gkn + 32 * bj + 8 * fq + 4 * n);
#pragma unroll
        for (int ai = 0; ai < 2; ++ai)
#pragma unroll
            for (int m = 0; m < 4; ++m) {
                const int rl = ai * 128 + wr * 64 + m * 16 + fr, row = pm * 256 + rl;
                const f32x4 st = *(const f32x4*)(ssqkv + (size_t)row * 16);
                const float s = rsqrtf(sum4(st) * (1.0f / 256.0f) + EPS);
                if (pn < 2) {
                    const int head = 4 * pn + wc;
                    const float ss = red_fq((sq4(acc[ai][0][m][0]) + sq4(acc[ai][0][m][1])) + (sq4(acc[ai][1][m][0]) + sq4(acc[ai][1][m][1])));
                    const float sskr = ssqkv[(size_t)row * 16 + 12];
                    const float rk = rsqrtf((s * s * ss + sskr) * (1.0f / 96.0f) + EPS);
                    const float sk = s * rk;
                    bf16_t* kp = Kb + (size_t)row * 768 + head * 96;
#pragma unroll
                    for (int bj = 0; bj < 2; ++bj) *(u32x4*)(kp + 32 * bj + 8 * fq) = pack8(acc[ai][bj][m][0] * gk[bj][0] * sk, acc[ai][bj][m][1] * gk[bj][1] * sk);
                    const u32x4 kr = *(const u32x4*)(z + (size_t)row * ZW + Z_KR + 8 * fq);
                    u32x4 o;
                    o.x = cvt_pk_bf16(bflo(kr.x) * rk, bfhi(kr.x) * rk); o.y = cvt_pk_bf16(bflo(kr.y) * rk, bfhi(kr.y) * rk);
                    o.z = cvt_pk_bf16(bflo(kr.z) * rk, bfhi(kr.z) * rk); o.w = cvt_pk_bf16(bflo(kr.w) * rk, bfhi(kr.w) * rk);
                    *(u32x4*)(kp + 64 + 8 * fq) = o;
                } else {
                    const int head = 4 * (pn - 2) + wc;
                    bf16_t* vp = Vb + (size_t)row * 512 + head * 64;
#pragma unroll
                    for (int bj = 0; bj < 2; ++bj) *(u32x4*)(vp + 32 * bj + 8 * fq) = pack8(acc[ai][bj][m][0] * s, acc[ai][bj][m][1] * s);
                }
                if (m & 1) asm volatile("" ::: "memory");
            }
    }
};

template <bool IN_F32, bool OUT_F32>
struct EpiRes {
    static constexpr bool PERM = true;
    const float* xin_lat; const float* xin_ctx; float* xout; bf16_t* xg; float* ssqx; const float* gate; const float* rgm_prev; const float* gm;
    __device__ __forceinline__ void operator()(const Acc& acc, const Unit& u, int wr, int wc, int fr, int fq) const {
        const int pm = u.pm, pn = u.pn, b = pm / PPB, pp = pm - b * PPB, bidx = pp == 0 ? 8 : b;
        const size_t rbase = pp == 0 ? (size_t)b * 256 : (size_t)b * SEQ + (size_t)(pp - 1) * 256;
        const float* xi = IN_F32 ? (pp == 0 ? xin_ctx : xin_lat) + rbase * D_MODEL : nullptr;
        float* xo = OUT_F32 ? xout + rbase * D_MODEL : nullptr;
        const int col0 = pn * 256 + wc * 32 + 8 * fq;
        f32x4 gv[2][2], mv[2][2], rv[2][2];
#pragma unroll
        for (int bj = 0; bj < 2; ++bj)
#pragma unroll
            for (int n = 0; n < 2; ++n) { gv[bj][n] = *(const f32x4*)(gate + bidx * 6144 + col0 + bj * 128 + n * 4);
                mv[bj][n] = OUT_F32 ? (f32x4){0.f, 0.f, 0.f, 0.f} : *(const f32x4*)(gm + bidx * 6144 + col0 + bj * 128 + n * 4);
                rv[bj][n] = IN_F32 ? (f32x4){0.f, 0.f, 0.f, 0.f} : *(const f32x4*)(rgm_prev + bidx * 2048 + col0 + bj * 128 + n * 4); }
#pragma unroll
        for (int ai = 0; ai < 2; ++ai)
#pragma unroll
            for (int m = 0; m < 4; ++m) {
                const int rl = ai * 128 + wr * 64 + m * 16 + fr; const size_t urow = (size_t)pm * 256 + rl, off = urow * D_MODEL + col0;
                float ss = 0.f;
#pragma unroll
                for (int bj = 0; bj < 2; ++bj) {
                    f32x4 x0, x1;
                    if (IN_F32) { x0 = *(const f32x4*)(xi + (size_t)rl * D_MODEL + col0 + bj * 128); x1 = *(const f32x4*)(xi + (size_t)rl * D_MODEL + col0 + bj * 128 + 4); }
                    else { const u32x4 w = *(const u32x4*)(xg + off + bj * 128); x0 = (f32x4){bflo(w.x), bfhi(w.x), bflo(w.y), bfhi(w.y)} * rv[bj][0]; x1 = (f32x4){bflo(w.z), bfhi(w.z), bflo(w.w), bfhi(w.w)} * rv[bj][1]; }
                    x0 += gv[bj][0] * acc[ai][bj][m][0]; x1 += gv[bj][1] * acc[ai][bj][m][1];
                    if (OUT_F32) { *(f32x4*)(xo + (size_t)rl * D_MODEL + col0 + bj * 128) = x0; *(f32x4*)(xo + (size_t)rl * D_MODEL + col0 + bj * 128 + 4) = x1; }
                    else { ss += sq4(x0) + sq4(x1); *(u32x4*)(xg + off + bj * 128) = pack8(x0 * mv[bj][0], x1 * mv[bj][1]); }
                }
                if (!OUT_F32) { ss = red_fq(ss); if (fq == 0) ssqx[urow * 16 + pn * 4 + wc] = ss; }
                asm volatile("" ::: "memory");
            }
    }
};

struct EpiSlab {
    static constexpr bool PERM = true;
    float* slab; int KS;
    __device__ __forceinline__ void operator()(const Acc& acc, const Unit& u, int wr, int wc, int fr, int fq) const {
        const int cp = u.pm / PPB, ks = (int)(u.koffB / (unsigned)(2 * KS));
        float* sp = slab + ((size_t)(ks * (BATCH * CTX) + cp * 256)) * D_MODEL + u.pn * 256 + wc * 32 + 8 * fq;
#pragma unroll
        for (int ai = 0; ai < 2; ++ai)
#pragma unroll
            for (int m = 0; m < 4; ++m) { float* rp = sp + (size_t)(ai * 128 + wr * 64 + m * 16 + fr) * D_MODEL;
#pragma unroll
                for (int bj = 0; bj < 2; ++bj) { *(f32x4*)(rp + bj * 128) = acc[ai][bj][m][0]; *(f32x4*)(rp + bj * 128 + 4) = acc[ai][bj][m][1]; } }
    }
};

struct EpiFF1 {
    static constexpr bool PERM = true;
    bf16_t* U; const float* ssqx; const float* bias;
    __device__ __forceinline__ void operator()(const Acc& acc, const Unit& u, int wr, int wc, int fr, int fq) const {
        const int pm = u.pm, pn = u.pn, b = pm / PPB, pp = pm - b * PPB, bidx = pp == 0 ? 8 : b;
        const float* bia = bias + bidx * D_FF + pn * 256 + wc * 32 + 8 * fq;
        f32x4 bv[2][2];
#pragma unroll
        for (int bj = 0; bj < 2; ++bj)
#pragma unroll
            for (int n = 0; n < 2; ++n) bv[bj][n] = *(const f32x4*)(bia + bj * 128 + 4 * n);
#pragma unroll
        for (int ai = 0; ai < 2; ++ai)
#pragma unroll
            for (int m = 0; m < 4; ++m) {
                const int row = pm * 256 + ai * 128 + wr * 64 + m * 16 + fr;
                const float rs = row_rstd16(ssqx, row, fq, 1.0f / 1024.0f);
                bf16_t* up = U + (((size_t)pm * 128 + pn * 8 + wc) * 16 + (ai * 8 + wr * 4 + m)) * 512 + fr * 32 + 8 * fq;
#pragma unroll
                for (int bj = 0; bj < 2; ++bj) {
                    f32x4 v0 = acc[ai][bj][m][0] * rs + bv[bj][0], v1 = acc[ai][bj][m][1] * rs + bv[bj][1];
#pragma unroll
                    for (int e = 0; e < 4; ++e) { const float a = fmaxf(v0[e], 0.f), c = fmaxf(v1[e], 0.f); v0[e] = a * a; v1[e] = c * c; }
#ifndef U_NT
#define U_NT 1
#endif
#if U_NT
                    __builtin_nontemporal_store(pack8(v0, v1), (u32x4*)(up + (size_t)bj * 4 * 16 * 512));
#else
                    *(u32x4*)(up + (size_t)bj * 4 * 16 * 512) = pack8(v0, v1);
#endif
                }
                asm volatile("" ::: "memory");
            }
    }
};
struct EpiSink {
    static constexpr bool PERM = true;
    float* dummy;
    __device__ __forceinline__ void operator()(const Acc& acc, const Unit& u, int wr, int wc, int fr, int fq) const {
        f32x4 s = {0.f, 0.f, 0.f, 0.f};
#pragma unroll
        for (int ai = 0; ai < 2; ++ai)
#pragma unroll
            for (int bj = 0; bj < 2; ++bj)
#pragma unroll
                for (int m = 0; m < 4; ++m) s += acc[ai][bj][m][0] + acc[ai][bj][m][1];
        const float t = s[0] + s[1] + s[2] + s[3];
        if (t == 1.2345678e33f) dummy[u.pm] = t;
    }
};
}
namespace att {
constexpr int NW = 8, QBLK = 32, KVBLK = 64, DQK = 96, DV = 64;
constexpr int KROWB = 208;
constexpr int SHM_K = KVBLK * KROWB, SHM_V = KVBLK * DV * 2;
constexpr int NSLOT = 3;
constexpr int LDS_V = 0, LDS_K = NSLOT * SHM_V, LDS_WS = LDS_K + NSLOT * SHM_K, LDS_OST = LDS_WS + NW * 64 * 4, LDS_BYTES = LDS_OST + NW * 4096;
#define SBAR() __builtin_amdgcn_sched_barrier(0)
__device__ __forceinline__ int crow(int r, int hi) { return (r & 3) + 8 * (r >> 2) + 4 * hi; }

template <int VAR> __device__ __forceinline__ void partialSM(f32x16& p0, float shift) {
  if (VAR == 1) return;
  if (VAR == 9) {
#pragma unroll
    for (int r = 0; r < 16; ++r) p0[r] -= shift; }
#pragma unroll
  for (int r = 0; r < 16; ++r) p0[r] = __builtin_amdgcn_exp2f(p0[r]);
}
template <int VAR> __device__ __forceinline__ void finishSM(f32x16& p0, f32x16& p1, float shift, float& l_reg, bf16x8& pa0, bf16x8& pa1, bf16x8& pa2, bf16x8& pa3) {
  if (VAR == 9) {
#pragma unroll
    for (int r = 0; r < 16; ++r) p1[r] -= shift; }
  if (VAR != 1) {
#pragma unroll
  for (int r = 0; r < 16; ++r) p1[r] = __builtin_amdgcn_exp2f(p1[r]); }
  float ps = 0;
#pragma unroll
  for (int r = 0; r < 16; ++r) ps += p0[r];
#pragma unroll
  for (int r = 0; r < 16; ++r) ps += p1[r];
  l_reg += ps;
#define PK4(P, BASE, OUT) do { u32x4 w = {cvt_pk_bf16(P[BASE + 0], P[BASE + 1]), cvt_pk_bf16(P[BASE + 2], P[BASE + 3]), cvt_pk_bf16(P[BASE + 4], P[BASE + 5]), cvt_pk_bf16(P[BASE + 6], P[BASE + 7])}; \
    OUT = *reinterpret_cast<bf16x8*>(&w); } while (0)
  PK4(p0, 0, pa0); PK4(p0, 8, pa1); PK4(p1, 0, pa2); PK4(p1, 8, pa3);
#undef PK4
}
#define KFR(KS, d0, half) (*reinterpret_cast<const bf16x8*>((KS) + (r32 + 32 * (half)) * KROWB + ((d0) * 16 + hi * 8) * 2))
__device__ __forceinline__ void kread4(bf16x8* kf, const char* Ks, int r32, int hi) { kf[0] = KFR(Ks, 0, 0); kf[1] = KFR(Ks, 0, 1); kf[2] = KFR(Ks, 1, 0); kf[3] = KFR(Ks, 1, 1); }
#define MF(A_, B_, C_) __builtin_amdgcn_mfma_f32_32x32x16_bf16(A_, B_, C_, 0, 0, 0)
template <bool FIN, int VAR>
__device__ __forceinline__ void qkt_fin(f32x16& p0, f32x16& p1, const char* Ks, const bf16x8* qr, int r32, int hi,
                                        f32x16& f0, f32x16& f1, float shift, float& l_reg, bf16x8& pa0, bf16x8& pa1, bf16x8& pa2, bf16x8& pa3) {
  bf16x8 kf[4]; kf[0] = VAR == 8 ? qr[0] : KFR(Ks, 0, 0); kf[1] = VAR == 8 ? qr[0] : KFR(Ks, 0, 1); kf[2] = VAR == 8 ? qr[1] : KFR(Ks, 1, 0); kf[3] = VAR == 8 ? qr[1] : KFR(Ks, 1, 1);
  SBAR();
  const bf16x8 b0 = VAR == 8 ? qr[2] : KFR(Ks, 2, 0), b1 = VAR == 8 ? qr[2] : KFR(Ks, 2, 1), b2 = VAR == 8 ? qr[3] : KFR(Ks, 3, 0), b3 = VAR == 8 ? qr[3] : KFR(Ks, 3, 1);
  p0 = MF(kf[0], qr[0], f32x16{}); p1 = MF(kf[1], qr[0], f32x16{});
  p0 = MF(kf[2], qr[1], p0); p1 = MF(kf[3], qr[1], p1);
  if (FIN) {
    if (VAR == 9) {
#pragma unroll
      for (int r = 0; r < 16; ++r) f1[r] -= shift; }
    if (VAR != 1) {
#pragma unroll
      for (int r = 0; r < 16; ++r) f1[r] = __builtin_amdgcn_exp2f(f1[r]); }
  }
  SBAR();
  const bf16x8 c0 = VAR == 8 ? qr[4] : KFR(Ks, 4, 0), c1 = VAR == 8 ? qr[4] : KFR(Ks, 4, 1), c2 = VAR == 8 ? qr[5] : KFR(Ks, 5, 0), c3 = VAR == 8 ? qr[5] : KFR(Ks, 5, 1);
  p0 = MF(b0, qr[2], p0); p1 = MF(b1, qr[2], p1);
  p0 = MF(b2, qr[3], p0); p1 = MF(b3, qr[3], p1);
  if (FIN) {
    float ps = 0;
#pragma unroll
    for (int r = 0; r < 16; ++r) ps += f0[r];
#pragma unroll
    for (int r = 0; r < 16; ++r) ps += f1[r];
    l_reg += ps;
  }
  SBAR();
  p0 = MF(c0, qr[4], p0); p1 = MF(c1, qr[4], p1);
  p0 = MF(c2, qr[5], p0); p1 = MF(c3, qr[5], p1);
  if (FIN) {
#define PK4(P, BASE, OUT) do { u32x4 w = {cvt_pk_bf16(P[BASE + 0], P[BASE + 1]), cvt_pk_bf16(P[BASE + 2], P[BASE + 3]), cvt_pk_bf16(P[BASE + 4], P[BASE + 5]), cvt_pk_bf16(P[BASE + 6], P[BASE + 7])}; \
    OUT = *reinterpret_cast<bf16x8*>(&w); } while (0)
    PK4(f0, 0, pa0); PK4(f0, 8, pa1); PK4(f1, 0, pa2); PK4(f1, 8, pa3);
#undef PK4
  }
}
#undef MF
__device__ __forceinline__ int v_st(int k, int c) { return ((k >> 3) * 2 + (c >> 5)) * 512 + ((k & 7) * 32 + (c & 31)) * 2; }
__device__ __forceinline__ int v_rd_base(int lane) { return ((lane & 3) << 3) | (((lane >> 2) & 3) << 6) | (((lane >> 4) & 1) << 5) | (((lane >> 5) & 1) << 8); }
constexpr int v_rd_off(int d0, int ks, int half) { return d0 * 512 + ks * 2048 + half * 1024; }
template <int OFF> __device__ __forceinline__ s16x4 tr_read(int vb) {
  s16x4 r; asm volatile("ds_read_b64_tr_b16 %0, %1 offset:%2" : "=&v"(r) : "v"(vb), "i"(OFF) : "memory"); return r;
}
template <int D0> __device__ __forceinline__ void pv_one(f32x16& od, int vb, bf16x8 pa0, bf16x8 pa1, bf16x8 pa2, bf16x8 pa3) {
  const s16x4 l0 = tr_read<v_rd_off(D0, 0, 0)>(vb), h0 = tr_read<v_rd_off(D0, 0, 1)>(vb), l1 = tr_read<v_rd_off(D0, 1, 0)>(vb), h1 = tr_read<v_rd_off(D0, 1, 1)>(vb);
  const s16x4 l2 = tr_read<v_rd_off(D0, 2, 0)>(vb), h2 = tr_read<v_rd_off(D0, 2, 1)>(vb), l3 = tr_read<v_rd_off(D0, 3, 0)>(vb), h3 = tr_read<v_rd_off(D0, 3, 1)>(vb);
  asm volatile("s_waitcnt lgkmcnt(0)" ::: "memory"); SBAR();
#define PK(L, H) (bf16x8){L[0], L[1], L[2], L[3], H[0], H[1], H[2], H[3]}
  od = __builtin_amdgcn_mfma_f32_32x32x16_bf16(PK(l0, h0), pa0, od, 0, 0, 0);
  od = __builtin_amdgcn_mfma_f32_32x32x16_bf16(PK(l1, h1), pa1, od, 0, 0, 0);
  od = __builtin_amdgcn_mfma_f32_32x32x16_bf16(PK(l2, h2), pa2, od, 0, 0, 0);
  od = __builtin_amdgcn_mfma_f32_32x32x16_bf16(PK(l3, h3), pa3, od, 0, 0, 0);
#undef PK
}
__device__ __forceinline__ void pv_d0(f32x16* o, int vb, bf16x8 pa0, bf16x8 pa1, bf16x8 pa2, bf16x8 pa3) {
  pv_one<0>(o[0], vb, pa0, pa1, pa2, pa3); pv_one<1>(o[1], vb, pa0, pa1, pa2, pa3);
}

template <int VAR>
__device__ __forceinline__ void attn_unit(const bf16_t* __restrict__ Qraw, const bf16_t* __restrict__ Kb, const bf16_t* __restrict__ Vb, bf16_t* mix,
                                          const float* ssqkv, const float* ssqq, float negB2, int qrow0, int krow0, int nkeys, int h, char* lds) {
  if (VAR == 10) return;
  int tid = threadIdx.x; asm volatile("" : "+v"(tid));
    const int  wid = __builtin_amdgcn_readfirstlane(tid >> 6), lane = tid & 63, r32 = lane & 31, hi = lane >> 5;
  char* V_lds = lds + LDS_V; char* K_lds = lds + LDS_K;
  float l_reg = 0; f32x16 o[2] = {}; bf16x8 qr[6];
  const float shift = -negB2;
  {
    const int row = qrow0 + wid * QBLK + r32;
    const f32x4 pa = *(const f32x4*)(ssqkv + (size_t)row * 16 + 4), pb = *(const f32x4*)(ssqkv + (size_t)row * 16 + 8);
    const float sql = rsqrtf(((pa[0] + pa[1]) + (pa[2] + pa[3]) + (pb[0] + pb[1]) + (pb[2] + pb[3])) * (1.0f / 384.0f) + EPS);
    const float ssh = ssqq[(size_t)row * 24 + 3 * h] + ssqq[(size_t)row * 24 + 3 * h + 1] + ssqq[(size_t)row * 24 + 3 * h + 2];
    const float sc = sql * rsqrtf(sql * sql * ssh * (1.0f / 96.0f) + EPS) * QSCALE;
    const bf16_t* Qw = Qraw + (size_t)row * 768 + h * 96 + hi * 8;
#pragma unroll
    for (int d0 = 0; d0 < 6; ++d0) { const u32x4 w = *(const u32x4*)(Qw + d0 * 16); u32x4 o4;
      o4.x = cvt_pk_bf16(bflo(w.x) * sc, bfhi(w.x) * sc); o4.y = cvt_pk_bf16(bflo(w.y) * sc, bfhi(w.y) * sc);
      o4.z = cvt_pk_bf16(bflo(w.z) * sc, bfhi(w.z) * sc); o4.w = cvt_pk_bf16(bflo(w.w) * sc, bfhi(w.w) * sc);
      qr[d0] = *reinterpret_cast<bf16x8*>(&o4); }
  }
  const int kk0 = tid / 12, kc0 = tid - kk0 * 12, kk1 = (tid + 512) / 12, kc1 = (tid + 512) - kk1 * 12, vk = tid >> 3, vc = tid & 7;
  const bf16_t* Kh = Kb + (size_t)krow0 * 768 + h * 96; const bf16_t* Vh = Vb + (size_t)krow0 * 512 + h * 64;
  const unsigned kof0 = (unsigned)(kk0 * 768 + kc0 * 8) * 2u, kof1 = (unsigned)(kk1 * 768 + kc1 * 8) * 2u, vof = (unsigned)(vk * 512 + vc * 8) * 2u;
  const int kst0 = kk0 * KROWB + kc0 * 16, kst1 = kk1 * KROWB + kc1 * 16, vst = v_st(vk, vc * 8);
  const __amdgpu_buffer_rsrc_t krs = __builtin_amdgcn_make_buffer_rsrc((void*)Kh, 0, nkeys * 768 * 2, 0x00020000);
  const __amdgpu_buffer_rsrc_t vrs = __builtin_amdgcn_make_buffer_rsrc((void*)Vh, 0, nkeys * 512 * 2, 0x00020000);
  const bool two = wid < 4;
  const int vb0 = (int)(uintptr_t)V_lds + v_rd_base(lane);
  bf16x8 sk0, sk1, sv;
#define LOADK(t) do { if (VAR == 4) break; const int so_ = (t) * (KVBLK * 768 * 2); sk0 = __builtin_bit_cast(bf16x8, __builtin_amdgcn_raw_buffer_load_b128(krs, kof0, so_, 0)); if (two) sk1 = __builtin_bit_cast(bf16x8, __builtin_amdgcn_raw_buffer_load_b128(krs, kof1, so_, 0)); } while (0)
#define LOADV(t) do { if (VAR == 4) break; sv = __builtin_bit_cast(bf16x8, __builtin_amdgcn_raw_buffer_load_b128(vrs, vof, (t) * (KVBLK * 512 * 2), 0)); } while (0)
#define WRITEK(slot) do { if (VAR == 4) break; *(bf16x8*)(K_lds + (slot) * SHM_K + kst0) = sk0; if (two) *(bf16x8*)(K_lds + (slot) * SHM_K + kst1) = sk1; } while (0)
#define WRITEV(slot) do { if (VAR == 4) break; *(bf16x8*)(V_lds + (slot) * SHM_V + vst) = sv; } while (0)
#define PV(slot) do { if (VAR != 2) pv_d0(o, vb0 + (slot) * SHM_V, pa0, pa1, pa2, pa3); else { asm volatile("" :: "v"(pa0), "v"(pa1), "v"(pa2), "v"(pa3)); } } while (0)
#define QFS(FIN, P0, P1, F0, F1, KQ) qkt_fin<FIN, VAR>(P0, P1, K_lds + (KQ) * SHM_K, qr, r32, hi, F0, F1, shift, l_reg, pa0, pa1, pa2, pa3)
#define QF(FIN, P0, P1, F0, F1) QFS(FIN, P0, P1, F0, F1, kq)
  f32x16 pA0, pA1, pB0, pB1; bf16x8 pa0, pa1, pa2, pa3; const int NT = nkeys / KVBLK;
  LOADK(0); LOADV(0); WRITEK(0); WRITEV(0); LOADK(1); WRITEK(1); LOADK(2); LOADV(1);
  __syncthreads();
  int sa = 2, sb = 1, kq = 0;
#define ROT() do { sa = (sa == 2) ? 0 : sa + 1; sb = (sb == 2) ? 0 : sb + 1; kq = (kq == 2) ? 0 : kq + 1; } while (0)
  SBAR(); QF(false, pA0, pA1, pA0, pA1); SBAR(); partialSM<VAR>(pA0, shift); WRITEK(sa); WRITEV(sb); LOADK(3); LOADV(2); __syncthreads();
  ROT();
#define STEP_U(PC0, PC1, PP0, PP1, s_, KQ, SA, SB) do { SBAR(); QFS(true, PC0, PC1, PP0, PP1, KQ); SBAR(); PV(SA); SBAR(); partialSM<VAR>(PC0, shift); \
    WRITEK(SA); WRITEV(SB); LOADK((s_) + 3); LOADV((s_) + 2); __syncthreads(); } while (0)
  int j = 1;
#ifdef ATT_UNROLL6
  for (; j + 8 < NT; j += 6) {
    STEP_U(pB0, pB1, pA0, pA1, j,     1, 0, 2);
    STEP_U(pA0, pA1, pB0, pB1, j + 1, 2, 1, 0);
    STEP_U(pB0, pB1, pA0, pA1, j + 2, 0, 2, 1);
    STEP_U(pA0, pA1, pB0, pB1, j + 3, 1, 0, 2);
    STEP_U(pB0, pB1, pA0, pA1, j + 4, 2, 1, 0);
    STEP_U(pA0, pA1, pB0, pB1, j + 5, 0, 2, 1);
  }
#endif
  for (; j + 1 < NT; j += 2) {
    SBAR(); QF(true, pB0, pB1, pA0, pA1); SBAR(); PV(sa); SBAR(); partialSM<VAR>(pB0, shift);
    WRITEK(sa); WRITEV(sb); if (j + 3 < NT) LOADK(j + 3); LOADV(j + 2); __syncthreads();
    ROT();
    const bool t3 = (j + 3 < NT);
    SBAR(); QF(true, pA0, pA1, pB0, pB1); SBAR(); PV(sa); SBAR(); partialSM<VAR>(pA0, shift);
    if (t3) WRITEK(sa); WRITEV(sb); if (j + 4 < NT) LOADK(j + 4); if (t3) LOADV(j + 3); __syncthreads();
    ROT();
  }
  SBAR(); QF(true, pB0, pB1, pA0, pA1); SBAR(); PV(sa); partialSM<VAR>(pB0, shift);
  finishSM<VAR>(pB0, pB1, shift, l_reg, pa0, pa1, pa2, pa3); SBAR();
  ROT();
  PV(sa);
  { auto rr = __builtin_amdgcn_permlane32_swap(__float_as_uint(l_reg), __float_as_uint(l_reg), false, false); l_reg = __uint_as_float(rr[0]) + __uint_as_float(rr[1]); }
  const float rl = __builtin_amdgcn_rcpf(l_reg);
  { bf16_t* stg = (bf16_t*)(lds + LDS_OST) + wid * 2048;
#pragma unroll
    for (int d0 = 0; d0 < 2; ++d0)
#pragma unroll
      for (int g = 0; g < 4; ++g) { u32x2 w; w.x = cvt_pk_bf16(o[d0][4 * g] * rl, o[d0][4 * g + 1] * rl); w.y = cvt_pk_bf16(o[d0][4 * g + 2] * rl, o[d0][4 * g + 3] * rl);
        *(u32x2*)(stg + r32 * 64 + d0 * 32 + 8 * g + 4 * hi) = w; }
    asm volatile("s_waitcnt lgkmcnt(0)" ::: "memory");
    bf16_t* Ow = mix + (size_t)(qrow0 + wid * QBLK) * D_MODEL + 256 + h * 64;
#pragma unroll
    for (int i = 0; i < 4; ++i) { const int row = i * 8 + (lane >> 3), ch = lane & 7; const u32x4 v = *(const u32x4*)(stg + row * 64 + ch * 8); *(u32x4*)(Ow + (size_t)row * D_MODEL + ch * 8) = v; } }
  __syncthreads();
#undef LOADK
#undef LOADV
#undef WRITEK
#undef WRITEV
#undef ROT
#undef QF
#undef QFS
#undef STEP_U
#undef PV
}
#undef SBAR
}
namespace thin {
__device__ __forceinline__ float fexp(float x) { return __builtin_amdgcn_exp2f(x * 1.4426950408889634f); }
__device__ __forceinline__ float sigmoidf_(float x) { return __builtin_amdgcn_rcpf(1.0f + fexp(-x)); }
__device__ __forceinline__ float gelu_tanh(float x) { return x * __builtin_amdgcn_rcpf(1.0f + __builtin_amdgcn_exp2f(x * fmaf(x * x, -0.10294323f, -2.3022082f))); }
__device__ __forceinline__ float fexpm1_neg(float x) { const float p = x * (1.0f + x * (0.5f + x * (0.16666667f + x * (0.041666668f + x * 0.0083333338f)))); const float e = fexp(x) - 1.0f; return x > -0.25f ? p : e; }
__device__ __forceinline__ int rope_logical(int p) { const int q = p >> 3, i = p & 7; return (q >> 1) * 16 + (i >> 2) * 8 + (q & 1) * 4 + (i & 3); }

constexpr int XC_ROWB = 144;
constexpr int LRU_XC = 0, LRU_Y = 256 * XC_ROWB;
constexpr int NPOS = 34;

struct LruP { const bf16_t* z; const float* convw; const float* convb; const bf16_t* gw; const float* ba; const float* bx; const float* lam; float* agg; bf16_t* mix; };

template <int PASS>
__device__ __forceinline__ void lru_item(const LruP& P, int pm, int hd, char* lds) {
    int tid = threadIdx.x; asm volatile("" : "+v"(tid));
    const int  wid = __builtin_amdgcn_readfirstlane(tid >> 6), lane = tid & 63, r32 = lane & 31, hi = lane >> 5;
    const int b = pm / PPB, pp = pm - b * PPB;
    const int L = pp == 0 ? CTX : SEQ, seqbase = b * TPB + (pp == 0 ? 0 : CTX), t0 = pp == 0 ? 0 : (pp - 1) * 256;
    char* XC = lds + LRU_XC; float* Y = (float*)(lds + LRU_Y);
    {
        const int c8 = tid & 7, ch = hd * 64 + c8 * 8;
        f32x4 w[4][2];
#pragma unroll
        for (int k = 0; k < 4; ++k) { w[k][0] = *(const f32x4*)(P.convw + k * 256 + ch); w[k][1] = *(const f32x4*)(P.convw + k * 256 + ch + 4); }
        const f32x4 cb0 = *(const f32x4*)(P.convb + ch), cb1 = *(const f32x4*)(P.convb + ch + 4);
#pragma unroll
        for (int i = 0; i < 4; ++i) {
            const int tk = (tid >> 3) + 64 * i, ts = t0 + tk;
            f32x4 a0 = cb0, a1 = cb1;
#pragma unroll
            for (int k = 0; k < 4; ++k) { const int tsrc = ts + k - 1;
                if (tsrc >= 0 && tsrc < L) { const u32x4 v = *(const u32x4*)(P.z + (size_t)(seqbase + tsrc) * ZW + Z_LX + ch);
                    a0 += w[k][0] * (f32x4){bflo(v.x), bfhi(v.x), bflo(v.y), bfhi(v.y)}; a1 += w[k][1] * (f32x4){bflo(v.z), bfhi(v.z), bflo(v.w), bfhi(v.w)}; } }
            *(u32x4*)(XC + tk * XC_ROWB + c8 * 16) = epi::pack8(a0, a1);
        }
    }
    __syncthreads();
    const int dir = wid & 1, cb = (wid >> 1) & 1, half = wid >> 2;
    const int chl = cb * 32 + r32, ch = hd * 64 + chl;
    bf16x8 Ba[4], Bx[4];
#pragma unroll
    for (int ks = 0; ks < 4; ++ks) {
        Ba[ks] = *(const bf16x8*)(P.gw + ((size_t)((dir * 2 + 0) * 4 + hd) * 64 + chl) * 64 + ks * 16 + hi * 8);
        Bx[ks] = *(const bf16x8*)(P.gw + ((size_t)((dir * 2 + 1) * 4 + hd) * 64 + chl) * 64 + ks * 16 + hi * 8);
    }
    const float bav = P.ba[dir * 256 + ch], bxv = P.bx[dir * 256 + ch];
    const float sp8 = 8.0f * log1pf(expf(-P.lam[dir * 256 + ch]));
    const float nsp8 = -sp8, ba2 = bav * -1.4426950408889634f, bx2 = bxv * -1.4426950408889634f;
    const bool small_la = __all(sp8 <= 0.125f);
    const int chunk = pp == 0 ? half : 2 * pp + half;
    const int pos = dir == 0 ? chunk : (chunk == 1 ? 0 : (chunk == 0 ? 1 : 35 - chunk));
    float Hrun = 0.f, Arun = 1.f;
    if (PASS == 2) {
        const float* ag = P.agg + ((size_t)(b * 2 + dir) * NPOS) * 512 + ch * 2;
#pragma unroll 1
        for (int p0 = 0; p0 < pos; p0 += 11) {
            f32x2 e[11];
#pragma unroll
            for (int q = 0; q < 11; ++q) e[q] = (p0 + q) < pos ? *(const f32x2*)(ag + (size_t)(p0 + q) * 512) : (f32x2){1.0f, 0.0f};
#pragma unroll
            for (int q = 0; q < 11; ++q) Hrun = e[q].x * Hrun + e[q].y;
        }
    }
    float yv[4][16];
    const int tau = ((r32 >> 2) & 1) * 16 + (r32 >> 3) * 4 + (r32 & 3);
    const int firsthi = dir;
#pragma unroll
    for (int ii = 0; ii < 4; ++ii) {
        const int tile = dir == 0 ? ii : 3 - ii, tb = half * 128 + tile * 32;
        f32x16 ra = {}, ix = {};
#pragma unroll
        for (int ks = 0; ks < 4; ++ks) {
            const bf16x8 af = *(const bf16x8*)(XC + (tb + tau) * XC_ROWB + (ks * 16 + hi * 8) * 2);
            ra = __builtin_amdgcn_mfma_f32_32x32x16_bf16(af, Ba[ks], ra, 0, 0, 0);
            ix = __builtin_amdgcn_mfma_f32_32x32x16_bf16(af, Bx[ks], ix, 0, 0, 0);
        }
        float av[16], bv[16];
        if (small_la) { asm volatile("; lru: series expm1" ::: "memory");
#pragma unroll
            for (int r = 0; r < 16; ++r) {
                const float xcv = bf2f(*(const bf16_t*)(XC + (tb + hi * 16 + r) * XC_ROWB + chl * 2));
                const float rr = __builtin_amdgcn_rcpf(1.0f + __builtin_amdgcn_exp2f(fmaf(ra[r], -1.4426950408889634f, ba2)));
                const float iv = __builtin_amdgcn_rcpf(1.0f + __builtin_amdgcn_exp2f(fmaf(ix[r], -1.4426950408889634f, bx2)));
                const float la = nsp8 * rr;
                const float em = la * fmaf(la, fmaf(la, fmaf(la, 0.041666668f, 0.16666667f), 0.5f), 1.0f);
                av[r] = 1.0f + em; bv[r] = __builtin_amdgcn_sqrtf(-fmaf(em, em, em + em)) * (iv * xcv);
            }
        } else {
#pragma unroll
            for (int r = 0; r < 16; ++r) {
                const float xcv = bf2f(*(const bf16_t*)(XC + (tb + hi * 16 + r) * XC_ROWB + chl * 2));
                const float rr = __builtin_amdgcn_rcpf(1.0f + __builtin_amdgcn_exp2f(fmaf(ra[r], -1.4426950408889634f, ba2)));
                const float iv = __builtin_amdgcn_rcpf(1.0f + __builtin_amdgcn_exp2f(fmaf(ix[r], -1.4426950408889634f, bx2)));
                const float em = fexpm1_neg(nsp8 * rr);
                av[r] = 1.0f + em; bv[r] = __builtin_amdgcn_sqrtf(-fmaf(em, em, em + em)) * (iv * xcv);
            }
        }
        float hl[16], cl[16]; float h = 0.f, c = 1.f;
        if (dir == 0) {
#pragma unroll
            for (int r = 0; r < 16; ++r) { h = av[r] * h + bv[r]; c *= av[r]; hl[r] = h; cl[r] = c; }
        } else {
#pragma unroll
            for (int r = 15; r >= 0; --r) { h = av[r] * h + bv[r]; c *= av[r]; hl[r] = h; cl[r] = c; }
        }
        const float H1 = __shfl(h, r32 + 32 * firsthi), A1 = __shfl(c, r32 + 32 * firsthi);
        const float H2 = __shfl(h, r32 + 32 * (1 - firsthi)), A2 = __shfl(c, r32 + 32 * (1 - firsthi));
        const float Hin1 = Hrun, Hin2 = A1 * Hrun + H1;
        const float Hmine = (hi == firsthi) ? Hin1 : Hin2;
        Hrun = A2 * Hin2 + H2; Arun = Arun * A1 * A2;
        if (PASS == 2) {
#pragma unroll
            for (int r = 0; r < 16; ++r) yv[ii][r] = hl[r] + cl[r] * Hmine;
        }
    }
    if (PASS == 1) {
        if (hi == 0) *(f32x2*)(P.agg + ((size_t)(b * 2 + dir) * NPOS + pos) * 512 + ch * 2) = (f32x2){Arun, Hrun};
        __syncthreads();
    } else {
        if (dir == 0) {
#pragma unroll
            for (int ii = 0; ii < 4; ++ii)
#pragma unroll
                for (int r = 0; r < 16; ++r) Y[(half * 128 + ii * 32 + hi * 16 + r) * 64 + chl] = yv[ii][r];
        }
        __syncthreads();
        if (dir == 1) {
#pragma unroll
            for (int ii = 0; ii < 4; ++ii)
#pragma unroll
                for (int r = 0; r < 16; ++r) Y[(half * 128 + (3 - ii) * 32 + hi * 16 + r) * 64 + chl] += yv[ii][r];
        }
        __syncthreads();
        const int c8 = tid & 7;
#pragma unroll
        for (int i = 0; i < 4; ++i) {
            const int tk = (tid >> 3) + 64 * i; const size_t row = (size_t)pm * 256 + tk;
            const f32x4 y0 = *(const f32x4*)(Y + tk * 64 + c8 * 8), y1 = *(const f32x4*)(Y + tk * 64 + c8 * 8 + 4);
            const u32x4 g = *(const u32x4*)(P.z + row * ZW + Z_LG + hd * 64 + c8 * 8);
            const f32x4 o0 = y0 * (f32x4){gelu_tanh(bflo(g.x)), gelu_tanh(bfhi(g.x)), gelu_tanh(bflo(g.y)), gelu_tanh(bfhi(g.y))};
            const f32x4 o1 = y1 * (f32x4){gelu_tanh(bflo(g.z)), gelu_tanh(bfhi(g.z)), gelu_tanh(bflo(g.w)), gelu_tanh(bfhi(g.w))};
            *(u32x4*)(P.mix + row * D_MODEL + hd * 64 + c8 * 8) = epi::pack8(o0, o1);
        }
        __syncthreads();
    }
}

constexpr int PL_PU = 0, PL_MX = 272 * 128;
template <int GI>
__device__ __forceinline__ void pool_item_g(const bf16_t* z, const bf16_t* pw, bf16_t* mix, int pm, char* lds) {
    constexpr int g = GI, W = 2 << GI;
    int tid = threadIdx.x; asm volatile("" : "+v"(tid));
    const int  wid = __builtin_amdgcn_readfirstlane(tid >> 6), lane = tid & 63, r32 = lane & 31, hi = lane >> 5;
    const int b = pm / PPB, pp = pm - b * PPB;
    const int L = pp == 0 ? CTX : SEQ, seqbase = b * TPB + (pp == 0 ? 0 : CTX), t0 = pp == 0 ? 0 : (pp - 1) * 256;
    char* PU = lds + PL_PU; char* MX = lds + PL_MX;
    const int c8 = tid & 7;
#pragma unroll
    for (int i = 0; i < 5; ++i) { const int hr = (tid >> 3) + 64 * i, ts = t0 - 8 + hr;
        if (hr < 272 && ts >= 0 && ts < L) *(u32x4*)(PU + hr * 128 + c8 * 16) = *(const u32x4*)(z + (size_t)(seqbase + ts) * ZW + Z_PU + g * 64 + c8 * 8); }
    __syncthreads();
#pragma unroll
    for (int i = 0; i < 4; ++i) {
        const int tk = (tid >> 3) + 64 * i, ts = t0 + tk;
        f32x4 s0 = {0.f, 0.f, 0.f, 0.f}, s1 = {0.f, 0.f, 0.f, 0.f}; int cnt = 0;
#pragma unroll
        for (int k = 0; k < W; ++k) {
            const int tt = ts - W / 2 + k;
            if (tt >= 0 && tt < L) { const u32x4 v = *(const u32x4*)(PU + (tk + 8 - W / 2 + k) * 128 + c8 * 16); ++cnt;
                s0 += (f32x4){bflo(v.x), bfhi(v.x), bflo(v.y), bfhi(v.y)}; s1 += (f32x4){bflo(v.z), bfhi(v.z), bflo(v.w), bfhi(v.w)}; } }
        const float inv = __builtin_amdgcn_rcpf((float)cnt);
        const u32x4 v = *(const u32x4*)(PU + (tk + 8) * 128 + c8 * 16);
        s0 = s0 * inv - (f32x4){bflo(v.x), bfhi(v.x), bflo(v.y), bfhi(v.y)}; s1 = s1 * inv - (f32x4){bflo(v.z), bfhi(v.z), bflo(v.w), bfhi(v.w)};
        *(u32x4*)(MX + tk * XC_ROWB + c8 * 16) = epi::pack8(s0, s1);
    }
    __syncthreads();
    f32x16 c0 = {}, c1 = {};
#pragma unroll
    for (int ks = 0; ks < 4; ++ks) {
        const bf16x8 bf = *(const bf16x8*)(MX + (wid * 32 + r32) * XC_ROWB + (ks * 16 + hi * 8) * 2);
        const bf16x8 a0 = *(const bf16x8*)(pw + ((size_t)g * 64 + r32) * 64 + ks * 16 + hi * 8);
        const bf16x8 a1 = *(const bf16x8*)(pw + ((size_t)g * 64 + 32 + r32) * 64 + ks * 16 + hi * 8);
        c0 = __builtin_amdgcn_mfma_f32_32x32x16_bf16(a0, bf, c0, 0, 0, 0);
        c1 = __builtin_amdgcn_mfma_f32_32x32x16_bf16(a1, bf, c1, 0, 0, 0);
    }
    bf16_t* OT = (bf16_t*)PU;
#pragma unroll
    for (int q = 0; q < 4; ++q) {
        u32x2 w0, w1; w0.x = cvt_pk_bf16(c0[4 * q], c0[4 * q + 1]); w0.y = cvt_pk_bf16(c0[4 * q + 2], c0[4 * q + 3]);
        w1.x = cvt_pk_bf16(c1[4 * q], c1[4 * q + 1]); w1.y = cvt_pk_bf16(c1[4 * q + 2], c1[4 * q + 3]);
        *(u32x2*)(OT + (wid * 32 + r32) * 64 + 4 * hi + 8 * q) = w0; *(u32x2*)(OT + (wid * 32 + r32) * 64 + 32 + 4 * hi + 8 * q) = w1;
    }
    __syncthreads();
#pragma unroll
    for (int i = 0; i < 4; ++i) { const int tk = (tid >> 3) + 64 * i;
        *(u32x4*)(mix + ((size_t)pm * 256 + tk) * D_MODEL + 768 + g * 64 + c8 * 8) = *(const u32x4*)(OT + tk * 64 + c8 * 8); }
    __syncthreads();
}
__device__ __forceinline__ void pool_item(const bf16_t* z, const bf16_t* pw, bf16_t* mix, int pm, int g, char* lds) {
    if (g == 0) pool_item_g<0>(z, pw, mix, pm, lds); else if (g == 1) pool_item_g<1>(z, pw, mix, pm, lds); else if (g == 2) pool_item_g<2>(z, pw, mix, pm, lds); else pool_item_g<3>(z, pw, mix, pm, lds);
}

__device__ __forceinline__ void transpose_tile(const float* W, int N, bf16_t* WT, int Kp, int k0, int nphys, int srcbase, bool rperm, const float* kscale, const float* nscale, bool zero, LAS float* scr, int lane) {
    const int nl = lane & 31, sc = srcbase + (rperm ? rope_logical(nl) : nl);
    const float nsv = nscale ? nscale[nl] : 1.0f;
#pragma unroll 8
    for (int i = 0; i < 32; ++i) { const int kk = 2 * i + (lane >> 5);
        float v = zero ? 0.f : W[(size_t)(k0 + kk) * N + sc] * nsv; if (kscale) v *= kscale[k0 + kk];
        scr[kk * 33 + nl] = v; }
    asm volatile("s_waitcnt lgkmcnt(0)" ::: "memory");
    const int c = lane & 7;
#pragma unroll
    for (int j = 0; j < 4; ++j) { const int n = (lane >> 3) + 8 * j; const LAS float* s = scr + (8 * c) * 33 + n;
        u32x4 o; o.x = cvt_pk_bf16(s[0 * 33], s[1 * 33]); o.y = cvt_pk_bf16(s[2 * 33], s[3 * 33]); o.z = cvt_pk_bf16(s[4 * 33], s[5 * 33]); o.w = cvt_pk_bf16(s[6 * 33], s[7 * 33]);
        *(u32x4*)(WT + (size_t)(nphys + n) * Kp + k0 + 8 * c) = o; }
    asm volatile("s_waitcnt lgkmcnt(0)" ::: "memory");
}
__device__ __forceinline__ float wave_sum(float v) {
#pragma unroll
    for (int o = 1; o < 64; o <<= 1) v += __shfl_xor(v, o);
    return v;
}
}
constexpr int NWAVES = 8;
constexpr size_t MiB = 1u << 20;
constexpr size_t WS_CTL = 0, CTL_ZERO_BYTES = 64 * 1024;
constexpr size_t WS_MODPART = 1 * MiB;
constexpr size_t WS_VEC = 5 * MiB;
constexpr size_t WS_BIASIN = WS_VEC + 512 * 1024;
constexpr size_t WS_BIASFF = WS_BIASIN + 128 * 1024;
constexpr size_t WS_RTAB = WS_BIASFF + 320 * 1024;
constexpr size_t WS_RVEC = 17 * MiB + 512 * 1024;
constexpr size_t WS_AGG = 6 * MiB;
constexpr size_t WS_SSQX = 8 * MiB;
constexpr size_t WS_SSQKV = 11 * MiB;
constexpr size_t WS_SSQQ = 14 * MiB;
constexpr size_t WS_WT = 18 * MiB, WT_LAYER = 23 * MiB;
constexpr size_t WT_IN = 0, WT_UQ = 3 * MiB, WT_UKV = WT_UQ + 640 * 1024, WT_OUT = WT_UKV + 512 * 1024, WT_FF1 = WT_OUT + 2 * MiB, WT_FF2 = WT_FF1 + 8 * MiB, WT_GATE = WT_FF2 + 8 * MiB, WT_POOL = WT_GATE + 128 * 1024;
static_assert(WT_POOL + 32 * 1024 <= WT_LAYER, "weights per layer");
constexpr size_t WS_XG = 72 * MiB;
constexpr size_t WS_U = 208 * MiB;
constexpr size_t WS_Z = WS_U, WS_Q = WS_Z + 102 * MiB, WS_K = WS_Q + 51 * MiB, WS_V = WS_K + 51 * MiB;
constexpr size_t WS_END = WS_U + 272 * MiB;
static_assert(WS_V + 34 * MiB <= WS_END && WS_END <= 512 * MiB, "d_ws map");
enum { VEC_GM1 = 0, VEC_G1 = 1, VEC_GM2 = 2, VEC_G2 = 3, VEC_SH1 = 4, VEC_SH2 = 5 };

constexpr int LDS_BYTES = 147456;
constexpr int LDSCTL_OFF = 131072, MISC_OFF = LDSCTL_OFF + 320;

typedef GAS unsigned gu32;
#define RLX_AGENT __ATOMIC_RELAXED, __HIP_MEMORY_SCOPE_AGENT
#define XB_TMO      128
#define XB_XCNT(j)  (256  + 64 * (j))
#define XB_XSUB(j)  (1280 + 64 * (j))
#define XB_XGEN(j)  (2304 + 64 * (j))
#define XB_TOP      3328
#define XB_TOPGEN   3392
#define XCD_BAR_WORDS 3456
#define XB_SPIN_CAP (1u << 20)
__device__ __forceinline__ unsigned xb_ld(unsigned* p)              { return __hip_atomic_load(p, __ATOMIC_RELAXED, __HIP_MEMORY_SCOPE_AGENT); }
__device__ __forceinline__ unsigned xb_add(unsigned* p, unsigned v) { return __hip_atomic_fetch_add(p, v, __ATOMIC_RELAXED, __HIP_MEMORY_SCOPE_AGENT); }
__device__ __forceinline__ unsigned xb_xcc_id() { return (unsigned)__builtin_amdgcn_s_getreg((3 << 11) | 20) & 0xFu; }
#define XB_SPIN(cond, bar) do { unsigned _sp = 0; while (cond) { __builtin_amdgcn_s_sleep(1); \
    if ((++_sp & 255u) == 0u) { if (xb_ld(&(bar)[XB_TMO])) break; if (_sp > XB_SPIN_CAP) { atomicAdd(&(bar)[XB_TMO], 1u); break; } } } } while (0)
struct XcdBarrier { unsigned* bar; unsigned x; volatile LAS unsigned* st; };
__device__ __forceinline__ XcdBarrier xcd_barrier_post(unsigned* bar, volatile LAS unsigned* st) {
    XcdBarrier b; b.bar = bar; b.x = xb_xcc_id(); b.st = st;
    if (threadIdx.x == 0) (void)xb_add(&bar[XB_XCNT(b.x)], 1u);
    return b;
}
__device__ __forceinline__ void xcd_barrier_complete(unsigned* bar, unsigned x, unsigned& nloc, unsigned& nx) {
    const unsigned G = gridDim.x * gridDim.y * gridDim.z;
    unsigned sum, cnt, mine, sp = 0u;
    for (;;) {
        sum = 0u; cnt = 0u; mine = 0u;
#pragma unroll
        for (unsigned j = 0; j < 16; ++j) { const unsigned c = xb_ld(&bar[XB_XCNT(j)]); sum += c; cnt += (c > 0u) ? 1u : 0u; mine = (j == x) ? c : mine; }
        if (sum == G) break;
        __builtin_amdgcn_s_sleep(1);
        if ((++sp & 255u) == 0u) { if (xb_ld(&bar[XB_TMO])) break; if (sp > XB_SPIN_CAP) { atomicAdd(&bar[XB_TMO], 1u); break; } }
    }
    nloc = mine > 0u ? mine : 1u; nx = cnt > 0u ? cnt : 1u;
}
__device__ __forceinline__ void xcd_barrier(const XcdBarrier& b) {
    asm volatile("s_waitcnt vmcnt(0)" ::: "memory");
    __syncthreads();
    if (threadIdx.x == 0) {
        unsigned* bar = b.bar;
        __builtin_amdgcn_s_waitcnt(0);
        unsigned nloc = b.st[0], nx = b.st[1];
        if (nloc == 0u) { xcd_barrier_complete(bar, b.x, nloc, nx); b.st[0] = nloc; b.st[1] = nx; }
        const unsigned old = xb_add(&bar[XB_XSUB(b.x)], 1u);
        const unsigned gen = old / nloc;
        if (old + 1u == (gen + 1u) * nloc) {
            __builtin_amdgcn_fence(__ATOMIC_RELEASE, "agent");
            asm volatile("s_waitcnt vmcnt(0)" ::: "memory");
            const unsigned og = xb_add(&bar[XB_TOP], 1u);
            const unsigned tg = og / nx;
            if (og + 1u == (tg + 1u) * nx) xb_add(&bar[XB_TOPGEN], 1u);
            else XB_SPIN(xb_ld(&bar[XB_TOPGEN]) == tg, bar);
            __builtin_amdgcn_fence(__ATOMIC_ACQUIRE, "agent");
            xb_add(&bar[XB_XGEN(b.x)], 1u);
            asm volatile("s_waitcnt vmcnt(0)" ::: "memory");
        } else {
            XB_SPIN(xb_ld(&bar[XB_XGEN(b.x)]) == gen, bar);
            __builtin_amdgcn_fence(__ATOMIC_ACQUIRE, "agent");
            asm volatile("s_waitcnt vmcnt(0)" ::: "memory");
        }
    }
    __syncthreads();
}


__device__ __forceinline__ void gate_wait(const unsigned* w, unsigned need, unsigned* tmo) {
    if (threadIdx.x < 64) { unsigned sp = 0u;
        while ((unsigned)__builtin_amdgcn_readfirstlane(xb_ld((unsigned*)w)) < need) { __builtin_amdgcn_s_sleep(2);
            if ((++sp & 255u) == 0u) { if (xb_ld(tmo)) break; if (sp > XB_SPIN_CAP) { if (threadIdx.x == 0) atomicAdd(tmo, 1u); break; } } }
        __builtin_amdgcn_fence(__ATOMIC_ACQUIRE, "agent");
        asm volatile("s_waitcnt vmcnt(0)" ::: "memory"); }
    __syncthreads();
}

__device__ __forceinline__ void ctx_combine(unsigned char* ws, float* out, const float* rgmv, const float* gatev, const float* gmv, int gw, int NGW, int lane_in) {
    int lane = lane_in; asm volatile("" : "+v"(lane)); lane &= 63;
    const float* slab = out + (size_t)18 * 1024 * 1024;
    bf16_t* xg_ = (bf16_t*)(ws + WS_XG); float* ssq_ = (float*)(ws + WS_SSQX);
    for (int cr = gw; cr < BATCH * CTX; cr += NGW) {
        const size_t urow = (size_t)(cr >> 8) * TPB + (cr & 255); float ss = 0.f;
#pragma unroll
        for (int j = 0; j < 4; ++j) { const int col = 256 * j + 4 * lane;
            f32x4 a = *(const f32x4*)(slab + (size_t)cr * D_MODEL + col);
#pragma unroll
            for (int ks = 1; ks < 4; ++ks) a += *(const f32x4*)(slab + ((size_t)ks * (BATCH * CTX) + cr) * D_MODEL + col);
            const u32x2 w = *(const u32x2*)(xg_ + urow * D_MODEL + col);
            const f32x4 x = (f32x4){bflo(w.x), bfhi(w.x), bflo(w.y), bfhi(w.y)} * *(const f32x4*)(rgmv + col) + *(const f32x4*)(gatev + col) * a;
            ss += epi::sq4(x);
            const f32x4 t = x * *(const f32x4*)(gmv + col); u32x2 o; o.x = cvt_pk_bf16(t[0], t[1]); o.y = cvt_pk_bf16(t[2], t[3]); *(u32x2*)(xg_ + urow * D_MODEL + col) = o; }
        ss = thin::wave_sum(ss);
        if (lane < 16) ssq_[urow * 16 + lane] = lane == 0 ? ss : 0.f;
    }
}

struct Args { const float* in[27]; float* out; unsigned char* ws; int ph_lo, ph_hi; };
constexpr int NPHASE = 15;

__global__ void __launch_bounds__(NWAVES * 64, 2) fwd_kernel(Args args) {
    extern __shared__ __attribute__((aligned(16))) unsigned char lds_raw[];
    LAS unsigned char* lds = (LAS unsigned char*)lds_raw;
    char* ldsg = (char*)lds_raw;
    const int tid = threadIdx.x, wave = __builtin_amdgcn_readfirstlane(tid >> 6); int lane = tid & 63;
#define RELANE() do { int t_ = threadIdx.x; asm volatile("" : "+v"(t_)); lane = t_ & 63; } while (0)
    const int G = gridDim.x; const int bx = blockIdx.x; const int vcu = (G % 8 == 0) ? (bx % 8) * (G / 8) + bx / 8 : bx;
    unsigned char* ws = args.ws;
    typedef __attribute__((address_space(4))) const Args* KArgs;
#define KA(i) (((KArgs)__builtin_amdgcn_kernarg_segment_ptr())->in[i])
#define x_in KA(0)
#define c_in KA(1)
#define ctx_in KA(2)
#define cctx_in KA(3)
#define w_mod KA(4)
#define b_mod KA(5)
#define g_norm1 KA(6)
#define g_norm2 KA(7)
#define w_in KA(8)
#define conv_w KA(9)
#define conv_b KA(10)
#define lru_w_a KA(11)
#define lru_b_a KA(12)
#define lru_w_x KA(13)
#define lru_b_x KA(14)
#define lru_lambda KA(15)
#define g_q_lat KA(16)
#define w_uq KA(17)
#define g_kv_lat KA(18)
#define w_ukv KA(19)
#define g_qn KA(20)
#define g_kn KA(21)
#define w_pool KA(22)
#define pool_scale KA(23)
#define w_out KA(24)
#define w_ff1 KA(25)
#define w_ff2 KA(26)
    float* out = args.out;
#define modpart ((float*)(ws + WS_MODPART))
#define vec ((float*)(ws + WS_VEC))
#define bias_in ((float*)(ws + WS_BIASIN))
#define bias_ff ((float*)(ws + WS_BIASFF))
#define rtab ((float*)(ws + WS_RTAB))
#define agg ((float*)(ws + WS_AGG))
#define ssqx ((float*)(ws + WS_SSQX))
#define ssqkv ((float*)(ws + WS_SSQKV))
#define ssqq ((float*)(ws + WS_SSQQ))
#define rvec ((float*)(ws + WS_RVEC))
#define xg ((bf16_t*)(ws + WS_XG))
#define mix ((bf16_t*)out)
#define U ((bf16_t*)(ws + WS_U))
#define zb ((bf16_t*)(ws + WS_Z))
#define Qb ((bf16_t*)(ws + WS_Q))
#define Kb ((bf16_t*)(ws + WS_K))
#define Vb ((bf16_t*)(ws + WS_V))

    for (int u = tid; u < (LDS_BYTES - LDSCTL_OFF) / 4; u += NWAVES * 64) ((LAS unsigned*)(lds + LDSCTL_OFF))[u] = 0u;
    __syncthreads();
    const bool single = (args.ph_hi - args.ph_lo) > 1;
    XcdBarrier bar; bar.bar = (unsigned*)(ws + WS_CTL); bar.x = 0; bar.st = nullptr;
    if (single) bar = xcd_barrier_post((unsigned*)(ws + WS_CTL), (volatile LAS unsigned*)(lds + MISC_OFF) + 8);
    const int lo = args.ph_lo, hi = args.ph_hi;
#ifndef PHASE_MASK
#define PHASE_MASK 0x7FF
#endif
#define IN(k) (lo <= (k) && (k) < hi)
#ifndef GATE_PA
#define GATE_PA 1
#endif
#ifndef GATE_PD
#define GATE_PD 1
#endif
#ifndef DUP_MASK
#define DUP_MASK 0x7FF
#endif
#define EN(j) (((PHASE_MASK >> (j)) & 1) && (rep_ > 0 || NREP_CUR == 1 || ((DUP_MASK >> (j)) & 1)))
#ifndef DUP_PHASE
#define DUP_PHASE (-1)
#endif
#define NREP(k) (((k) == DUP_PHASE) ? 2 : 1)
#define SEAM(k) do { if (IN(k) && IN((k) + 1)) xcd_barrier(bar); } while (0)
    const int gw = vcu * NWAVES + wave, NGW = G * NWAVES;

    for (int rep_ = 0, NREP_CUR = NREP(0); rep_ < NREP_CUR; ++rep_) { if (rep_) xcd_barrier(bar);
    if (EN(0) && IN(0)) {
        float* sl = (float*)ldsg;
        for (int i = tid; i < 9 * 1024; i += NWAVES * 64) { const float v = i < 8192 ? c_in[i] : cctx_in[i - 8192]; sl[i] = v / (1.0f + expf(-v)); }
        __syncthreads();
        for (int it = gw; it < 2 * 96 * 8; it += NGW) {
            const int l = it / 768, r = it - l * 768, cg = r >> 3, ks = r & 7;
            float acc[9];
#pragma unroll
            for (int b = 0; b < 9; ++b) acc[b] = 0.f;
            const float* wp = w_mod + ((size_t)l * 1024 + ks * 128) * 6144 + cg * 64 + lane;
#pragma unroll 8
            for (int kk = 0; kk < 128; ++kk) { const float w = wp[(size_t)kk * 6144];
#pragma unroll
                for (int b = 0; b < 9; ++b) acc[b] += sl[b * 1024 + ks * 128 + kk] * w; }
#pragma unroll
            for (int b = 0; b < 9; ++b) modpart[((size_t)(ks * 2 + l) * 9 + b) * 6144 + cg * 64 + lane] = acc[b];
        }
        __syncthreads();
        if (bx == 0) for (int i = tid; i < 512; i += NWAVES * 64) { const int pos = i >> 3, f = i & 7; const float fr = powf(10000.0f, -(float)f / 8.0f), ang = (float)pos * fr; rtab[i * 2] = cosf(ang); rtab[i * 2 + 1] = sinf(ang); }
        LAS float* scr = (LAS float*)(lds + wave * 16384);
        constexpr int I_IN = 768, I_UQ = 144, I_UKV = 128, I_OUT = 512, I_FF1 = 2048, I_FF2 = 2048, I_G = 32, I_P = 8, I_L = I_IN + I_UQ + I_UKV + I_OUT + I_FF1 + I_FF2 + I_G + I_P;
        for (int it = gw; it < 2 * I_L; it += NGW) {
            const int l = it / I_L; int r = it - l * I_L; bf16_t* wt = (bf16_t*)(ws + WS_WT + (size_t)l * WT_LAYER);
            if (r < I_IN) { const int pg = r >> 4, kb = r & 15; int src = 0; bool z0 = false, rp = false;
                if (pg < 16) src = 32 * pg; else if (pg < 24) src = 896 + 32 * (pg - 16); else if (pg < 32) src = 1184 + 32 * (pg - 24); else if (pg < 44) src = 512 + 32 * (pg - 32); else if (pg == 44) { src = 1152; rp = true; } else z0 = true;
                thin::transpose_tile(w_in + (size_t)l * 1024 * D_IN, D_IN, wt + WT_IN / 2, 1024, kb * 64, pg * 32, src, rp, nullptr, nullptr, z0, scr, lane); continue; } r -= I_IN;
            if (r < I_UQ) { const int pg = r / 6, kb = r - pg * 6;
                thin::transpose_tile(w_uq + (size_t)l * 384 * 768, 768, wt + WT_UQ / 2, 384, kb * 64, pg * 32, pg * 32, (pg % 3) == 2, g_q_lat + l * 384, nullptr, false, scr, lane); continue; } r -= I_UQ;
            if (r < I_UKV) { const int pg = r >> 2, kb = r & 3, pn = pg >> 3, bj = (pg >> 2) & 1, wc = pg & 3;
                const int src = pn < 2 ? (4 * pn + wc) * 128 + 32 * bj : (4 * (pn - 2) + wc) * 128 + 64 + 32 * bj;
                thin::transpose_tile(w_ukv + (size_t)l * 256 * 1024, 1024, wt + WT_UKV / 2, 256, kb * 64, pg * 32, src, false, g_kv_lat + l * 256, nullptr, false, scr, lane); continue; } r -= I_UKV;
            if (r < I_OUT) { const int pg = r >> 4, kb = r & 15;
                thin::transpose_tile(w_out + (size_t)l * 1024 * 1024, 1024, wt + WT_OUT / 2, 1024, kb * 64, pg * 32, pg * 32, false, nullptr, nullptr, false, scr, lane); continue; } r -= I_OUT;
            if (r < I_FF1) { const int pg = r >> 4, kb = r & 15;
                thin::transpose_tile(w_ff1 + (size_t)l * 1024 * 4096, 4096, wt + WT_FF1 / 2, 1024, kb * 64, pg * 32, pg * 32, false, nullptr, nullptr, false, scr, lane); continue; } r -= I_FF1;
            if (r < I_FF2) { const int pg = r >> 6, kb = r & 63;
                thin::transpose_tile(w_ff2 + (size_t)l * 4096 * 1024, 1024, wt + WT_FF2 / 2, 4096, kb * 64, pg * 32, pg * 32, false, nullptr, nullptr, false, scr, lane); continue; } r -= I_FF2;
            if (r < I_G) { const int mat = r >> 1, pg = r & 1, dir = mat >> 3, gate = (mat >> 2) & 1, hd = mat & 3;
                const float* src = (gate ? lru_w_x : lru_w_a) + ((size_t)((l * 2 + dir) * 4 + hd)) * 4096;
                thin::transpose_tile(src, 64, wt + WT_GATE / 2 + (size_t)mat * 4096, 64, 0, pg * 32, pg * 32, false, nullptr, nullptr, false, scr, lane); continue; } r -= I_G;
            { const int g = r >> 1, pg = r & 1;
                thin::transpose_tile(w_pool + (size_t)(l * 4 + g) * 4096, 64, wt + WT_POOL / 2 + (size_t)g * 4096, 64, 0, pg * 32, pg * 32, false, nullptr, pool_scale + l * 256 + g * 64 + pg * 32, false, scr, lane); }
        }
        __syncthreads();
    }
    } SEAM(0);
    for (int rep_ = 0, NREP_CUR = NREP(1); rep_ < NREP_CUR; ++rep_) { if (rep_) xcd_barrier(bar);
    if (EN(0) && IN(1)) {
        const int gt = vcu * (NWAVES * 64) + tid;
        if (gt < 2 * 9 * 1024) {
            const int l = gt / 9216, r = gt - l * 9216, b = r >> 10, j = r & 1023;
            float m[6];
#pragma unroll
            for (int s = 0; s < 6; ++s) { float a = b_mod[l * 6144 + s * 1024 + j];
#pragma unroll
                for (int ks = 0; ks < 8; ++ks) a += modpart[((size_t)(ks * 2 + l) * 9 + b) * 6144 + s * 1024 + j];
                m[s] = a; }
            float* v = vec + (size_t)(l * 9 + b) * 6144 + j;
            float gm1 = g_norm1[l * 1024 + j] * (1.0f + m[1]), gm2 = g_norm2[l * 1024 + j] * (1.0f + m[4]);
            gm1 = fabsf(gm1) < 1e-20f ? 1e-20f : gm1; gm2 = fabsf(gm2) < 1e-20f ? 1e-20f : gm2;
            v[VEC_GM1 * 1024] = gm1; v[VEC_G1 * 1024] = m[2];
            v[VEC_GM2 * 1024] = gm2; v[VEC_G2 * 1024] = m[5];
            rvec[(size_t)(l * 9 + b) * 2048 + j] = 1.0f / gm1; rvec[(size_t)(l * 9 + b) * 2048 + 1024 + j] = 1.0f / gm2;
            v[VEC_SH1 * 1024] = m[0]; v[VEC_SH2 * 1024] = m[3];
        }
    }
    } SEAM(1);
    for (int rep_ = 0, NREP_CUR = NREP(2); rep_ < NREP_CUR; ++rep_) { if (rep_) xcd_barrier(bar);
    if (EN(0) && IN(2)) {
        RELANE();
        float* sl = (float*)ldsg;
        for (int combo = 0; combo < 4; ++combo) {
            const int l = combo >> 1, mat = combo & 1, N = mat ? D_FF : ZW;
            __syncthreads();
            for (int i = tid; i < 9 * 1024; i += NWAVES * 64) sl[i] = vec[(size_t)(l * 9 + (i >> 10)) * 6144 + (mat ? VEC_SH2 : VEC_SH1) * 1024 + (i & 1023)];
            __syncthreads();
            const bf16_t* wt = (const bf16_t*)(ws + WS_WT + (size_t)l * WT_LAYER + (mat ? WT_FF1 : WT_IN));
            float* bo = (mat ? bias_ff : bias_in) + (size_t)l * 9 * N;
            for (int n = gw; n < N; n += NGW) {
                const u32x4 w0 = *(const u32x4*)(wt + (size_t)n * 1024 + 8 * lane), w1 = *(const u32x4*)(wt + (size_t)n * 1024 + 512 + 8 * lane);
                float wv[16] = {bflo(w0.x), bfhi(w0.x), bflo(w0.y), bfhi(w0.y), bflo(w0.z), bfhi(w0.z), bflo(w0.w), bfhi(w0.w), bflo(w1.x), bfhi(w1.x), bflo(w1.y), bfhi(w1.y), bflo(w1.z), bfhi(w1.z), bflo(w1.w), bfhi(w1.w)};
#pragma unroll
                for (int b = 0; b < 9; ++b) { float s = 0.f;
#pragma unroll
                    for (int i = 0; i < 8; ++i) s += wv[i] * sl[b * 1024 + 8 * lane + i] + wv[8 + i] * sl[b * 1024 + 512 + 8 * lane + i];
                    s = thin::wave_sum(s); if (lane == 0) bo[b * N + n] = s; }
            }
        }
        RELANE();
        for (int r0 = gw * 2; r0 < MROWS; r0 += NGW * 2) {
            f32x4 v[2][4]; const float* gmv[2];
#pragma unroll
            for (int q = 0; q < 2; ++q) { const int r = r0 + q, b = r / TPB, tt = r - b * TPB, bidx = tt < CTX ? 8 : b;
                const float* src = tt < CTX ? ctx_in + ((size_t)b * CTX + tt) * D_MODEL : x_in + ((size_t)b * SEQ + (tt - CTX)) * D_MODEL;
                gmv[q] = vec + (size_t)(0 * 9 + bidx) * 6144 + VEC_GM1 * 1024;
#pragma unroll
                for (int j = 0; j < 4; ++j) v[q][j] = *(const f32x4*)(src + 256 * j + 4 * lane); }
#pragma unroll
            for (int q = 0; q < 2; ++q) { const int r = r0 + q; float ss = 0.f;
#pragma unroll
                for (int j = 0; j < 4; ++j) { const f32x4 g4 = *(const f32x4*)(gmv[q] + 256 * j + 4 * lane); ss += epi::sq4(v[q][j]);
                    const f32x4 t = v[q][j] * g4; u32x2 w; w.x = cvt_pk_bf16(t[0], t[1]); w.y = cvt_pk_bf16(t[2], t[3]); *(u32x2*)(xg + (size_t)r * D_MODEL + 256 * j + 4 * lane) = w; }
                ss = thin::wave_sum(ss);
                if (lane < 16) ssqx[(size_t)r * 16 + lane] = lane == 0 ? ss : 0.f; }
        }
    }
    } SEAM(2);
    for (int l = 0; l < DEPTH; ++l) {
        const int p0 = 3 + 6 * l; const bool lastl = (l == DEPTH - 1);
        const unsigned char* wtl = ws + WS_WT + (size_t)l * WT_LAYER;
        const float* vl = vec + (size_t)l * 9 * 6144;
    for (int rep_ = 0, NREP_CUR = NREP(p0); rep_ < NREP_CUR; ++rep_) { if (rep_) xcd_barrier(bar);
        if (EN(1) && IN(p0)) {
            pg8::Gemm g{xg, (const bf16_t*)(wtl + WT_IN)}; pg8::StaticOrder S; S.init(GATE_PA ? 128 : NPAN, ZW / 256, G, bx, GATE_PA ? 1 : 0);
            epi::EpiIn E{zb, ssqx, bias_in + (size_t)l * 9 * ZW, ssqkv, g_kn + l * 96, rtab};
            pg8::gemm_phase<1024, 1024, 1024, false>(lds, g, S, E);
        }
        } SEAM(p0);
    for (int rep_ = 0, NREP_CUR = NREP(p0 + 1); rep_ < NREP_CUR; ++rep_) { if (rep_) xcd_barrier(bar);
        if (IN(p0 + 1)) {
            unsigned* gate1 = (unsigned*)(ws + WS_CTL) + 4096 + 1024 + 1024 * l; unsigned* tmo = (unsigned*)(ws + WS_CTL) + XB_TMO;
            const unsigned need = lastl ? 24u : 48u;
            if (GATE_PA && EN(3)) {
                pg8::Gemm ga{xg, (const bf16_t*)(wtl + WT_IN)}; pg8::CtxProdOrder SP;
                if (lastl) SP.init(bx, 192, 2, 3, 0x520u, gate1);
                else SP.init_unit((bx >= 192 && (bx & 7) >= 1 && (bx & 7) <= 6) ? ((bx - 192) >> 3) * 6 + (bx & 7) - 1 : -1, 6, 0x543210u, gate1);
                epi::EpiIn Ea{zb, ssqx, bias_in + (size_t)l * 9 * ZW, ssqkv, g_kn + l * 96, rtab}; pg8::gemm_phase<1024, 1024, 1024, false>(lds, ga, SP, Ea);
            }
            thin::LruP P{zb, conv_w + l * 1024, conv_b + l * 256, (const bf16_t*)(wtl + WT_GATE), lru_b_a + l * 512, lru_b_x + l * 512, lru_lambda + l * 512, agg, mix};
            if (GATE_PA) {
                if (EN(4)) for (int it = G - 1 - vcu; it < 128 * 4; it += G) { const int pl = it >> 2; thin::lru_item<1>(P, pl + pl / 16 + 1, it & 3, ldsg); }
                if (EN(5)) for (int it = vcu; it < 128 * 4; it += G) { const int pl = it >> 2; thin::pool_item(zb, (const bf16_t*)(wtl + WT_POOL), mix, pl + pl / 16 + 1, it & 3, ldsg); }
            }
            if (EN(2)) { pg8::Gemm g{zb + Z_QL, (const bf16_t*)(wtl + WT_UQ)}; epi::EpiQ E{Qb, ssqq, g_qn + l * 96, rtab};
              if (GATE_PA && !lastl) { pg8::GatedOrder SG; SG.init(3, G, bx, gate1, need, tmo); pg8::gemm_phase<384, ZW, 384, false>(lds, g, SG, E); }
              else { pg8::StaticOrder S; S.init(lastl ? 128 : NPAN, 3, G, bx, lastl ? 1 : 0); pg8::gemm_phase<384, ZW, 384, false>(lds, g, S, E); } }
            if (EN(3)) { pg8::Gemm g{zb + Z_KVL, (const bf16_t*)(wtl + WT_UKV)}; epi::EpiKV E{Kb, Vb, zb, ssqkv, g_kn + l * 96};
              if (GATE_PA) { pg8::GatedOrder SG; SG.init(4, G, (bx + 96) % G, gate1, need, tmo); pg8::gemm_phase<256, ZW, 256, false>(lds, g, SG, E); }
              else { pg8::StaticOrder S; S.init(NPAN, 4, G, (bx + 96) % G, 0); pg8::gemm_phase<256, ZW, 256, false>(lds, g, S, E); } }
            if (GATE_PA) {
                if (EN(4) && G - 1 - vcu < 32) { const int it = G - 1 - vcu; gate_wait(gate1 + 64 * (it >> 2), need, tmo); thin::lru_item<1>(P, (it >> 2) * 17, it & 3, ldsg); }
                if (EN(5) && !lastl && vcu < 32) { gate_wait(gate1 + 64 * (vcu >> 2), need, tmo); thin::pool_item(zb, (const bf16_t*)(wtl + WT_POOL), mix, (vcu >> 2) * 17, vcu & 3, ldsg); }
            } else {
                if (EN(4)) for (int it = G - 1 - vcu; it < NPAN * 4; it += G) thin::lru_item<1>(P, it >> 2, it & 3, ldsg);
                if (!EN(5)) {} else if (lastl) { for (int it = vcu; it < 128 * 4; it += G) { const int pl = it >> 2; thin::pool_item(zb, (const bf16_t*)(wtl + WT_POOL), mix, pl + pl / 16 + 1, it & 3, ldsg); } }
                else { for (int it = vcu; it < NPAN * 4; it += G) thin::pool_item(zb, (const bf16_t*)(wtl + WT_POOL), mix, it >> 2, it & 3, ldsg); }
            }
        }
        } SEAM(p0 + 1);
    for (int rep_ = 0, NREP_CUR = NREP(p0 + 2); rep_ < NREP_CUR; ++rep_) { if (rep_) xcd_barrier(bar);
        if (IN(p0 + 2)) {
#ifndef SHIFT_THRESH
#define SHIFT_THRESH 64.0f
#endif
            float negB2; bool shifted;
            {
                const float* gq = g_qn + l * 96; const float* gk = g_kn + l * 96;
                int ln = threadIdx.x; asm volatile("" : "+v"(ln)); ln &= 63;
                float mq = fmaxf(fabsf(gq[ln]), ln < 32 ? fabsf(gq[64 + ln]) : 0.f), mk = fmaxf(fabsf(gk[ln]), ln < 32 ? fabsf(gk[64 + ln]) : 0.f);
#pragma unroll
                for (int o = 1; o < 64; o <<= 1) { mq = fmaxf(mq, __shfl_xor(mq, o)); mk = fmaxf(mk, __shfl_xor(mk, o)); }
                negB2 = -(96.0f * 1.02f * QSCALE) * mq * mk;
                shifted = __builtin_amdgcn_readfirstlane(negB2 < -SHIFT_THRESH ? 1 : 0) != 0;
                if (!shifted) negB2 = 0.f;
            }
            thin::LruP P{zb, conv_w + l * 1024, conv_b + l * 256, (const bf16_t*)(wtl + WT_GATE), lru_b_a + l * 512, lru_b_x + l * 512, lru_lambda + l * 512, agg, mix};
            if (!EN(6)) {} else if (lastl) { for (int it = vcu; it < 128 * 4; it += G) { const int pl = it >> 2; thin::lru_item<2>(P, pl + pl / 16 + 1, it & 3, ldsg); } }
            else { for (int it = vcu; it < NPAN * 4; it += G) thin::lru_item<2>(P, it >> 2, it & 3, ldsg); }
            if (EN(7)) for (int it = vcu; it < 1024; it += G) {
                const int bh = it >> 4, qp = it & 15, b = bh >> 3, h = bh & 7;
                #ifdef ATT_VAR
                if (rep_ == 0 && NREP(p0 + 2) == 2) att::attn_unit<ATT_VAR>(Qb, Kb, Vb, mix, ssqkv, ssqq, negB2, b * TPB + CTX + qp * 256, b * TPB, TPB, h, ldsg); else
#endif
                if (shifted) att::attn_unit<9>(Qb, Kb, Vb, mix, ssqkv, ssqq, negB2, b * TPB + CTX + qp * 256, b * TPB, TPB, h, ldsg);
                else att::attn_unit<0>(Qb, Kb, Vb, mix, ssqkv, ssqq, negB2, b * TPB + CTX + qp * 256, b * TPB, TPB, h, ldsg);
            }
            if (EN(7) && !lastl) for (int it = G - 1 - vcu; it < 64; it += G) { const int b = it >> 3, h = it & 7;
                if (shifted) att::attn_unit<9>(Qb, Kb, Vb, mix, ssqkv, ssqq, negB2, b * TPB, b * TPB, CTX, h, ldsg); else att::attn_unit<0>(Qb, Kb, Vb, mix, ssqkv, ssqq, negB2, b * TPB, b * TPB, CTX, h, ldsg); }
        }
        } SEAM(p0 + 2);
    for (int rep_ = 0, NREP_CUR = NREP(p0 + 3); rep_ < NREP_CUR; ++rep_) { if (rep_) xcd_barrier(bar);
        if (EN(8) && IN(p0 + 3)) {
            pg8::Gemm g{mix, (const bf16_t*)(wtl + WT_OUT)}; pg8::StaticOrder S; S.init((lastl || GATE_PD) ? 128 : NPAN, 4, G, bx, (lastl || GATE_PD) ? 1 : 0);
            if (l == 0) { epi::EpiRes<true, false> E{x_in, ctx_in, nullptr, xg, ssqx, vl + VEC_G1 * 1024, nullptr, vl + VEC_GM2 * 1024}; pg8::gemm_phase<1024, 1024, 1024, false>(lds, g, S, E); }
            else { epi::EpiRes<false, false> E{nullptr, nullptr, nullptr, xg, ssqx, vl + VEC_G1 * 1024, rvec + (size_t)l * 9 * 2048, vl + VEC_GM2 * 1024}; pg8::gemm_phase<1024, 1024, 1024, false>(lds, g, S, E); }
        }
        } SEAM(p0 + 3);
    for (int rep_ = 0, NREP_CUR = NREP(p0 + 4); rep_ < NREP_CUR; ++rep_) { if (rep_) xcd_barrier(bar);
        if (EN(9) && IN(p0 + 4)) {
            unsigned* gate0 = (unsigned*)(ws + WS_CTL) + 4096;
            if (GATE_PD && !lastl) {
                pg8::Gemm gd{mix, (const bf16_t*)(wtl + WT_OUT)}; pg8::CtxProdOrder SP; SP.init(bx, 128, 3, 4, 0x3210u, gate0);
                epi::EpiRes<true, false> Ed{x_in, ctx_in, nullptr, xg, ssqx, vl + VEC_G1 * 1024, nullptr, vl + VEC_GM2 * 1024}; pg8::gemm_phase<1024, 1024, 1024, false>(lds, gd, SP, Ed);
            }
            pg8::Gemm g{xg, (const bf16_t*)(wtl + WT_FF1)}; pg8::StaticOrder S; S.init(lastl ? 128 : NPAN, 16, G, bx, lastl ? 1 : 0);
            epi::EpiFF1 E{U, ssqx, bias_ff + (size_t)l * 9 * D_FF};
            if (GATE_PD && !lastl) { pg8::GatedOrder SG; SG.init(16, G, bx, gate0, 32u, (unsigned*)(ws + WS_CTL) + XB_TMO); pg8::gemm_phase<1024, 1024, 1024, false>(lds, g, SG, E); } else
#ifdef NULL_DUP
            if (rep_ == 0 && NREP_CUR == 2) { epi::EpiSink E0{(float*)(ws + WS_CTL + 65536)}; pg8::gemm_phase<1024, 1024, 1024, false>(lds, g, S, E0); } else
#endif
            pg8::gemm_phase<1024, 1024, 1024, false>(lds, g, S, E);
        }
        } SEAM(p0 + 4);
    for (int rep_ = 0, NREP_CUR = NREP(p0 + 5); rep_ < NREP_CUR; ++rep_) { if (rep_) xcd_barrier(bar);
        if (EN(10) && IN(p0 + 5)) {
            pg8::Gemm g{U, (const bf16_t*)(wtl + WT_FF2)}; pg8::StaticOrder S; S.init(lastl ? 128 : NPAN, 4, G, bx, lastl ? 1 : 0);
#ifdef NULL_DUP
            if (rep_ == 0 && NREP_CUR == 2) { pg8::StaticOrder SL; SL.init(128, 4, G, bx, 1); epi::EpiSink E0{(float*)(ws + WS_CTL + 65536)}; pg8::gemm_phase<4096, 4096, 4096, true>(lds, g, SL, E0); } else
#endif
            if (lastl) { epi::EpiRes<false, true> E{nullptr, nullptr, out, xg, nullptr, vl + VEC_G2 * 1024, rvec + (size_t)l * 9 * 2048 + 1024, nullptr}; pg8::gemm_phase<4096, 4096, 4096, true>(lds, g, S, E); }
            else {
                { pg8::StaticOrder SL; SL.init(128, 4, G, bx, 1);
                  epi::EpiRes<false, false> E{nullptr, nullptr, nullptr, xg, ssqx, vl + VEC_G2 * 1024, rvec + (size_t)l * 9 * 2048 + 1024, vec + (size_t)(l + 1) * 9 * 6144 + VEC_GM1 * 1024}; pg8::gemm_phase<4096, 4096, 4096, true>(lds, g, SL, E); }
                float* slab = out + (size_t)18 * 1024 * 1024;
                { pg8::CtxSplitOrder SC{4, 4, 1024, G, bx, 1}; epi::EpiSlab E{slab, 1024}; pg8::gemm_phase<1024, 4096, 4096, true>(lds, g, SC, E); }
                xcd_barrier(bar);
                ctx_combine(ws, out, rvec + (size_t)(l * 9 + 8) * 2048 + 1024, vl + 8 * 6144 + VEC_G2 * 1024, vec + (size_t)(l + 1) * 9 * 6144 + 8 * 6144 + VEC_GM1 * 1024, gw, NGW, (int)threadIdx.x);
            }
        }
        } if (!lastl) SEAM(p0 + 5);
    }
#undef IN
#undef SEAM
}


#ifdef DBG_DUMP
__global__ void dbg_dump(const bf16_t* buf, int pitch, int coloff, int ncols, float* out) {
    for (size_t i = blockIdx.x * (size_t)blockDim.x + threadIdx.x; i < (size_t)BATCH * SEQ * D_MODEL; i += (size_t)gridDim.x * blockDim.x) {
        const int c = (int)(i & 1023); const size_t rt = i >> 10; const int b = (int)(rt / SEQ), t = (int)(rt - (size_t)b * SEQ);
        out[i] = c < ncols ? bf2f(buf[((size_t)b * TPB + CTX + t) * pitch + coloff + c]) : 0.f;
    }
}
#endif
#ifndef N_LAUNCH_MODE
#define N_LAUNCH_MODE 1
#endif
extern "C" void kernel_launch(void* const* d_in, const int* in_sizes, int n_in, void* d_out, int out_size, void* d_ws, size_t ws_size, hipStream_t stream) {
    static int grid = 0;
    if (grid == 0) {
        if (n_in != 27 || in_sizes[0] != BATCH * SEQ * D_MODEL || out_size != BATCH * SEQ * D_MODEL || ws_size < WS_END) { fprintf(stderr, "kernel_launch: unexpected shapes (n_in %d, in0 %d, out %d, ws %zu < %zu)\n", n_in, n_in > 0 ? in_sizes[0] : -1, out_size, ws_size, (size_t)WS_END); grid = -1; return; }
        int dev = 0, cus = 0, per_cu = 0;
        if (hipGetDevice(&dev) != hipSuccess || hipDeviceGetAttribute(&cus, hipDeviceAttributeMultiprocessorCount, dev) != hipSuccess) { grid = -1; return; }
        if (hipFuncSetAttribute((const void*)fwd_kernel, hipFuncAttributeMaxDynamicSharedMemorySize, LDS_BYTES) != hipSuccess) { fprintf(stderr, "kernel_launch: hipFuncSetAttribute failed\n"); grid = -1; return; }
        if (hipOccupancyMaxActiveBlocksPerMultiprocessor(&per_cu, (const void*)fwd_kernel, NWAVES * 64, LDS_BYTES) != hipSuccess || per_cu < 1) { fprintf(stderr, "kernel_launch: occupancy query says %d blocks per CU\n", per_cu); (void)hipGetLastError(); grid = -1; return; }
        grid = cus;
    }
    if (grid < 0) return;
    (void)hipMemsetAsync((char*)d_ws + WS_CTL, 0, CTL_ZERO_BYTES, stream);
    Args a{};
    for (int i = 0; i < 27; ++i) a.in[i] = (const float*)d_in[i];
    a.out = (float*)d_out; a.ws = (unsigned char*)d_ws;
#if N_LAUNCH_MODE
    a.ph_lo = 0; a.ph_hi = NPHASE;
    void* kargs[] = {&a};
    hipError_t e = hipLaunchCooperativeKernel((const void*)fwd_kernel, dim3(grid), dim3(NWAVES * 64), kargs, LDS_BYTES, stream);
    if (e != hipSuccess) fprintf(stderr, "kernel_launch: cooperative launch failed: %s\n", hipGetErrorString(e));
#else
#ifndef DBG_STOP_PHASE
#define DBG_STOP_PHASE NPHASE
#endif
    for (int p = 0; p < DBG_STOP_PHASE; ++p) { a.ph_lo = p; a.ph_hi = p + 1; hipLaunchKernelGGL(fwd_kernel, dim3(grid), dim3(NWAVES * 64), LDS_BYTES, stream, a); }
#ifdef DBG_DUMP
    hipLaunchKernelGGL(dbg_dump, dim3(2048), dim3(256), 0, stream, (const bf16_t*)((unsigned char*)d_ws + DBG_DUMP_OFF), DBG_DUMP_PITCH, DBG_DUMP_COL, DBG_DUMP_NCOLS, (float*)d_out);
#endif
#endif
}
```

```cpp
#define KAHEAD 1
#define PVPSM 1
#include <hip/hip_runtime.h>
#include <cstdio>
#include <cstdint>

#define LAS __attribute__((address_space(3)))
#define GAS __attribute__((address_space(1)))
typedef unsigned short bf16_t;
typedef short bf16x8 __attribute__((ext_vector_type(8)));
typedef short s16x4 __attribute__((ext_vector_type(4)));
typedef float f32x4 __attribute__((ext_vector_type(4)));
typedef float f32x2 __attribute__((ext_vector_type(2)));
typedef float f32x16 __attribute__((ext_vector_type(16)));
typedef unsigned u32x4 __attribute__((ext_vector_type(4)));
typedef unsigned u32x2 __attribute__((ext_vector_type(2)));

constexpr int D_MODEL = 1024, BATCH = 8, SEQ = 4096, DEPTH = 2, CTX = 256, D_IN = 1440, D_FF = 4096;
constexpr int TPB = SEQ + CTX;
constexpr int MROWS = BATCH * TPB;
constexpr int PPB = TPB / 256;
constexpr int NPAN = MROWS / 256;
constexpr int ZW = 1536;
constexpr int Z_LX = 0, Z_LG = 256, Z_KVL = 512, Z_PU = 768, Z_QL = 1024, Z_KR = 1408;
constexpr float EPS = 1e-6f;
constexpr float QSCALE = 0.10206207261596575f * 1.4426950408889634f;

typedef __bf16 bf16x2_t __attribute__((ext_vector_type(2)));
__device__ __forceinline__ unsigned cvt_pk_bf16(float lo, float hi) { f32x2 v = {lo, hi}; bf16x2_t b = __builtin_convertvector(v, bf16x2_t); return __builtin_bit_cast(unsigned, b); }
__device__ __forceinline__ float bf2f(unsigned short h) { return __uint_as_float((unsigned)h << 16); }
__device__ __forceinline__ float bflo(unsigned w) { return __uint_as_float(w << 16); }
__device__ __forceinline__ float bfhi(unsigned w) { return __uint_as_float(w & 0xffff0000u); }
__device__ __forceinline__ unsigned short f2bf(float f) { unsigned u = __float_as_uint(f); return (unsigned short)((u + 0x7fffu + ((u >> 16) & 1u)) >> 16); }

namespace pg8 {
constexpr int BM = 256, BK = 64, HALF = 128, HTB = HALF * BK * 2, STAGE_BYTES = 8 * HTB, NXCD = 8, WGM = 8;
__host__ __device__ __forceinline__ int lds_byte(int r, int c) { const int st = (r >> 4) * 2 + (c >> 5), rr = r & 15, cc = c & 31, ob = rr * 64 + cc * 2; return st * 1024 + (ob ^ (((ob >> 9) & 1) << 5)); }
__host__ __device__ __forceinline__ void stage_rc(int b, int& R, int& C) { const int st = b / 1024, sb = b % 1024, swz = sb ^ (((sb >> 9) & 1) << 5); R = (st >> 1) * 16 + swz / 64; C = (st & 1) * 32 + (swz % 64) / 2; }
__host__ __device__ __forceinline__ int perm32(int rho) { const int n = rho >> 4, i = rho & 15; return 8 * (i >> 2) + 4 * n + (i & 3); }

struct Unit { int pm, pn; unsigned koffA, koffB; };
struct Gemm { const bf16_t* A; const bf16_t* Bt; };

struct StaticOrder {
    int nM, nN, nwg, G, c, latonly;
    __device__ void init(int nM_, int nN_, int G_, int c_, int latonly_) { nM = nM_; nN = nN_; nwg = nM * nN; G = G_; c = c_; latonly = latonly_; }
    __device__ bool next(int i, Unit& u) const {
        const long L = (long)i * G + c; if (L >= nwg) return false;
        int wgid = (int)L; { const int q = nwg / NXCD, r = nwg % NXCD, xcd = wgid % NXCD, off = wgid / NXCD; wgid = (xcd < r ? xcd * (q + 1) : r * (q + 1) + (xcd - r) * q) + off; }
        const int nig = WGM * nN, gid = wgid / nig, fm = gid * WGM, gsz = (nM - fm) < WGM ? (nM - fm) : WGM;
        int pm = fm + ((wgid % nig) % gsz); u.pn = (wgid % nig) / gsz;
        if (latonly) pm = pm + pm / 16 + 1;
        u.pm = pm; u.koffA = 0u; u.koffB = 0u; return true;
    }
    __device__ __forceinline__ void a_ready(const Unit&) const {}
    __device__ __forceinline__ void done(const Unit&) const {}
};
struct CtxSplitOrder {
    int nN, NS, KS, G, c, ablk;
    __device__ bool next(int i, Unit& u) const {
        const int L = i * G + c; if (L >= 8 * nN * NS) return false;
        const int ks = L % NS, t = L / NS; u.pn = t % nN; u.pm = (t / nN) * 17; u.koffB = (unsigned)(ks * KS * 2); u.koffA = ablk ? (unsigned)(ks * (KS / 32) * 16384) : u.koffB; return true;
    }
    __device__ __forceinline__ void a_ready(const Unit&) const {}
    __device__ __forceinline__ void done(const Unit&) const {}
};
struct CtxProdOrder {
    int unit, nsel; unsigned pnlist; unsigned* ready;
    __device__ __forceinline__ void init(int c, int c0, int cstride, int nsel_, unsigned pnlist_, unsigned* ready_) { const int d = c - c0; unit = (d >= 0 && d % cstride == 0 && d / cstride < 8 * nsel_) ? d / cstride : -1; nsel = nsel_; pnlist = pnlist_; ready = ready_; }
    __device__ __forceinline__ void init_unit(int unit_, int nsel_, unsigned pnlist_, unsigned* ready_) { unit = unit_ < 8 * nsel_ ? unit_ : -1; nsel = nsel_; pnlist = pnlist_; ready = ready_; }
    __device__ __forceinline__ bool next(int i, Unit& u) const { if (i != 0 || unit < 0) return false; u.pm = 17 * (unit / nsel); u.pn = (int)((pnlist >> (4 * (unit % nsel))) & 15u); u.koffA = 0u; u.koffB = 0u; return true; }
    __device__ __forceinline__ void a_ready(const Unit&) const {}
    __device__ __forceinline__ void done(const Unit& u) const {
        asm volatile("s_waitcnt vmcnt(0)" ::: "memory");
        __builtin_amdgcn_fence(__ATOMIC_RELEASE, "agent");
        asm volatile("s_waitcnt vmcnt(0)" ::: "memory");
        if ((threadIdx.x & 63) == 0) (void)__hip_atomic_fetch_add(ready + 64 * (u.pm / 17), 1u, __ATOMIC_RELAXED, __HIP_MEMORY_SCOPE_AGENT);
    }
};
struct GatedOrder {
    int nN, nwg, G, c; const unsigned* ready; unsigned need; unsigned* tmo;
    __device__ __forceinline__ void init(int nN_, int G_, int c_, const unsigned* ready_, unsigned need_, unsigned* tmo_) { nN = nN_; nwg = 136 * nN_; G = G_; c = c_; ready = ready_; need = need_; tmo = tmo_; }
    __device__ __forceinline__ bool next(int i, Unit& u) const {
        const long L = (long)i * G + c; if (L >= nwg) return false;
        int wgid = (int)L; { const int q = nwg / NXCD, r = nwg % NXCD, xcd = wgid % NXCD, off = wgid / NXCD; wgid = (xcd < r ? xcd * (q + 1) : r * (q + 1) + (xcd - r) * q) + off; }
        const int nig = WGM * nN, gid = wgid / nig, fm = gid * WGM;
        const int q = fm + ((wgid % nig) % WGM); u.pn = (wgid % nig) / WGM;
        u.pm = q < 128 ? q + q / 16 + 1 : (q - 128) * 17; u.koffA = 0u; u.koffB = 0u; return true;
    }
    __device__ __forceinline__ void a_ready(const Unit& u) const {
        if (u.pm % 17 != 0) return;
        if (threadIdx.x < 64) {
            const unsigned* w = ready + 64 * (u.pm / 17); unsigned sp = 0u;
            while ((unsigned)__builtin_amdgcn_readfirstlane(__hip_atomic_load(w, __ATOMIC_RELAXED, __HIP_MEMORY_SCOPE_AGENT)) < need) {
                __builtin_amdgcn_s_sleep(2);
                if ((++sp & 255u) == 0u) { if (__hip_atomic_load(tmo, __ATOMIC_RELAXED, __HIP_MEMORY_SCOPE_AGENT)) break; if (sp > (1u << 20)) { if (threadIdx.x == 0) atomicAdd(tmo, 1u); break; } } }
            __builtin_amdgcn_fence(__ATOMIC_ACQUIRE, "agent");
            asm volatile("s_waitcnt vmcnt(0)" ::: "memory");
        }
        asm volatile("" ::: "memory"); __builtin_amdgcn_s_barrier(); asm volatile("" ::: "memory");
    }
    __device__ __forceinline__ void done(const Unit&) const {}
};

template <int K, int LDA, int LDB, bool ABLK, class Epi, class Sched>
__device__ __forceinline__ void gemm_phase(LAS unsigned char* lds, const Gemm g, const Sched& S, const Epi& E) {
    int tid = threadIdx.x; asm volatile("" : "+v"(tid));
    const int  wid = __builtin_amdgcn_readfirstlane(tid >> 6), lane = tid & 63, wr = wid >> 2, wc = wid & 3, fr = lane & 15, fq = lane >> 4;
    constexpr int nt = K / BK;
    unsigned voffA[2], voffB[2];
#pragma unroll
    for (int i = 0; i < 2; ++i) { int R, C; stage_rc(tid * 16 + i * 8192, R, C); const int Rb = Epi::PERM ? ((R & ~31) + perm32(R & 31)) : R;
        voffA[i] = ABLK ? (unsigned)((C >> 5) * 16384 + (R >> 4) * 1024 + ((R & 15) * 32 + (C & 31)) * 2) : (unsigned)(R * LDA + C) * 2u; voffB[i] = (unsigned)(Rb * LDB + C) * 2u; }
    const size_t kstep = (size_t)(BK * 2);
    const size_t kstepA = ABLK ? (size_t)32768 : kstep;
    const size_t hstepA = ABLK ? (size_t)8192 : (size_t)HALF * LDA * 2, tstepA = ABLK ? (size_t)(LDA / 32) * 16384 : 2 * hstepA;
    const size_t hstepB = (size_t)HALF * LDB * 2, tstepB = 2 * hstepB;
    const unsigned ldsw = (unsigned)wid * 1024u;
    const int aoff = lds_byte(wr * 64 + fr, fq * 8), boff = lds_byte(wc * 32 + fr, fq * 8);
#define PG8_SA(b, h) (((b) * 2 + (h)) * HTB)
#define PG8_SB(b, h) ((4 + (b) * 2 + (h)) * HTB)
#define PG8_STAGE(bufoff, gbase, voff) do { _Pragma("unroll") for (int _i = 0; _i < 2; ++_i) \
        __builtin_amdgcn_global_load_lds((const unsigned*)((const char*)(gbase) + (voff)[_i]), (LAS unsigned*)(lds + (bufoff) + ldsw + _i * 8192), 16, 0, 0); } while (0)
#define PG8_LDA(dst, b, h) do { _Pragma("unroll") for (int m = 0; m < 4; ++m) _Pragma("unroll") for (int k = 0; k < 2; ++k) dst[m][k] = *(const LAS bf16x8*)(lds + PG8_SA(b, h) + aoff + m * 2048 + k * 1024); } while (0)
#define PG8_LDB(dst, b, h) do { _Pragma("unroll") for (int n = 0; n < 2; ++n) _Pragma("unroll") for (int k = 0; k < 2; ++k) dst[n][k] = *(const LAS bf16x8*)(lds + PG8_SB(b, h) + boff + n * 2048 + k * 1024); } while (0)
#define PG8_MMA(ai, bj, At, Bt) do { __builtin_amdgcn_s_setprio(1); _Pragma("unroll") for (int m = 0; m < 4; ++m) _Pragma("unroll") for (int n = 0; n < 2; ++n) _Pragma("unroll") for (int k = 0; k < 2; ++k) \
        acc[ai][bj][m][n] = __builtin_amdgcn_mfma_f32_16x16x32_bf16(Bt[n][k], At[m][k], acc[ai][bj][m][n], 0, 0, 0); __builtin_amdgcn_s_setprio(0); } while (0)
#define PG8_WAIT_V(n) asm volatile("s_waitcnt vmcnt(" #n ")" ::: "memory")
#define PG8_WAIT_L(n) asm volatile("s_waitcnt lgkmcnt(" #n ")" ::: "memory")
#define PG8_BAR __builtin_amdgcn_s_barrier()
#define PG8_SCHED __builtin_amdgcn_sched_barrier(0)
    Unit cur, nxt; int ui = 0;
    if (!S.next(0, cur)) return;
    f32x4 acc[2][2][4][2];
#pragma unroll
    for (int a = 0; a < 2; ++a)
#pragma unroll
        for (int b = 0; b < 2; ++b)
#pragma unroll
            for (int m = 0; m < 4; ++m)
#pragma unroll
                for (int n = 0; n < 2; ++n) acc[a][b][m][n] = (f32x4){0.f, 0.f, 0.f, 0.f};
    bf16x8 At[4][2], B0[2][2], B1[2][2];
    const char* cA = (const char*)g.A + (size_t)cur.pm * tstepA + cur.koffA; const char* cB = (const char*)g.Bt + (size_t)cur.pn * tstepB + cur.koffB;
    S.a_ready(cur);
    PG8_STAGE(PG8_SB(0, 0), cB, voffB); PG8_STAGE(PG8_SB(0, 1), cB + hstepB, voffB); PG8_STAGE(PG8_SA(0, 0), cA, voffA); PG8_STAGE(PG8_SA(0, 1), cA + hstepA, voffA);
    if (wr == 1) PG8_BAR;
    PG8_WAIT_V(2); PG8_BAR;
    PG8_STAGE(PG8_SB(1, 0), cB + kstep, voffB); PG8_STAGE(PG8_SA(1, 0), cA + kstepA, voffA); PG8_STAGE(PG8_SB(1, 1), cB + hstepB + kstep, voffB);
    PG8_WAIT_V(6); PG8_BAR;
    for (;;) {
        const bool has_next = S.next(ui + 1, nxt);
        const char* nA = has_next ? (const char*)g.A + (size_t)nxt.pm * tstepA + nxt.koffA : cA; const char* nB = has_next ? (const char*)g.Bt + (size_t)nxt.pn * tstepB + nxt.koffB : cB;
#pragma unroll 1
        for (int t = 0; t < nt; t += 2) {
            const bool last = (t == nt - 2);
            const char* a1 = cA + (size_t)(t + 1) * kstepA;
            const char* a2 = last ? nA : cA + (size_t)(t + 2) * kstepA; const char* b2 = last ? nB : cB + (size_t)(t + 2) * kstep;
            const char* a3 = a2 + kstepA; const char* b3 = b2 + kstep;
            if (last && has_next) S.a_ready(nxt);
            PG8_LDB(B0, 0, 0); PG8_LDB(B1, 0, 1); PG8_SCHED; PG8_LDA(At, 0, 0); PG8_STAGE(PG8_SA(1, 1), a1 + hstepA, voffA);
            PG8_WAIT_V(8); PG8_WAIT_L(0); PG8_BAR; PG8_MMA(0, 0, At, B0); PG8_MMA(0, 1, At, B1); PG8_BAR; PG8_SCHED;
            PG8_LDA(At, 0, 1); PG8_STAGE(PG8_SB(0, 0), b2, voffB); PG8_STAGE(PG8_SB(0, 1), b2 + hstepB, voffB); PG8_STAGE(PG8_SA(0, 0), a2, voffA);
            PG8_WAIT_V(8); PG8_WAIT_L(0); PG8_BAR; PG8_MMA(1, 0, At, B0); PG8_MMA(1, 1, At, B1); PG8_BAR; PG8_SCHED;
            PG8_LDB(B0, 1, 0); PG8_LDB(B1, 1, 1); PG8_SCHED; PG8_LDA(At, 1, 0); PG8_STAGE(PG8_SA(0, 1), a2 + hstepA, voffA);
            PG8_WAIT_V(8); PG8_WAIT_L(0); PG8_BAR; PG8_MMA(0, 0, At, B0); PG8_MMA(0, 1, At, B1); PG8_BAR; PG8_SCHED;
            PG8_LDA(At, 1, 1); PG8_STAGE(PG8_SB(1, 0), b3, voffB); PG8_STAGE(PG8_SB(1, 1), b3 + hstepB, voffB); PG8_STAGE(PG8_SA(1, 0), a3, voffA);
            PG8_WAIT_V(8); PG8_WAIT_L(0); PG8_BAR; PG8_MMA(1, 0, At, B0); PG8_MMA(1, 1, At, B1); PG8_BAR; PG8_SCHED;
        }
        if (wr == 0) PG8_BAR;
        { int fr2 = fr, fq2 = fq; asm volatile("" : "+v"(fr2), "+v"(fq2));
          E(acc, cur, wr, wc, fr2, fq2); }
        S.done(cur);
        if (!has_next) break;
#pragma unroll
        for (int a = 0; a < 2; ++a)
#pragma unroll
            for (int b = 0; b < 2; ++b)
#pragma unroll
                for (int m = 0; m < 4; ++m)
#pragma unroll
                    for (int n = 0; n < 2; ++n) acc[a][b][m][n] = (f32x4){0.f, 0.f, 0.f, 0.f};
        cur = nxt; cA = nA; cB = nB; ++ui;
        if (wr == 1) PG8_BAR;
    }
    PG8_WAIT_V(0);
    PG8_BAR;
#undef PG8_SA
#undef PG8_SB
#undef PG8_STAGE
#undef PG8_LDA
#undef PG8_LDB
#undef PG8_MMA
#undef PG8_WAIT_V
#undef PG8_WAIT_L
#undef PG8_BAR
#undef PG8_SCHED
}
}
namespace epi {
using pg8::Unit;
typedef f32x4 Acc[2][2][4][2];
__device__ __forceinline__ float sum4(f32x4 v) { return (v[0] + v[1]) + (v[2] + v[3]); }
__device__ __forceinline__ float sq4(f32x4 v) { return (v[0] * v[0] + v[1] * v[1]) + (v[2] * v[2] + v[3] * v[3]); }
__device__ __forceinline__ float red_fq(float s) { s += __shfl_xor(s, 16); s += __shfl_xor(s, 32); return s; }
__device__ __forceinline__ u32x4 pack8(f32x4 a, f32x4 b) { u32x4 w; w.x = cvt_pk_bf16(a[0], a[1]); w.y = cvt_pk_bf16(a[2], a[3]); w.z = cvt_pk_bf16(b[0], b[1]); w.w = cvt_pk_bf16(b[2], b[3]); return w; }
__device__ __forceinline__ void rope4(f32x4& x1, f32x4& x2, const float* rtab, int t, int fq) {
    const int idx = (fq >> 1) ? (t & 63) : (t >> 6);
    const f32x4 c0 = *(const f32x4*)(rtab + (idx * 8 + (fq & 1) * 4) * 2), c1 = *(const f32x4*)(rtab + (idx * 8 + (fq & 1) * 4) * 2 + 4);
    const f32x4 cs = (f32x4){c0[0], c0[2], c1[0], c1[2]}, sn = (f32x4){c0[1], c0[3], c1[1], c1[3]};
    const f32x4 y1 = x1 * cs - x2 * sn, y2 = x2 * cs + x1 * sn; x1 = y1; x2 = y2;
}
__device__ __forceinline__ float row_rstd16(const float* ssq, int row, int fq, float inv_n) {
    const f32x4 p = *(const f32x4*)(ssq + (size_t)row * 16 + 4 * fq); return rsqrtf(red_fq(sum4(p)) * inv_n + EPS);
}

struct EpiIn {
    static constexpr bool PERM = true;
    bf16_t* z; const float* ssqx; const float* bias; float* ssqkv; const float* gkn; const float* rtab;
    __device__ __forceinline__ void operator()(const Acc& acc, const Unit& u, int wr, int wc, int fr, int fq) const {
        const int pm = u.pm, pn = u.pn, b = pm / PPB, pp = pm - b * PPB, bidx = pp == 0 ? 8 : b;
        const float* bia = bias + bidx * ZW + pn * 256 + wc * 32 + 8 * fq;
        f32x4 bv[2][2];
#pragma unroll
        for (int bj = 0; bj < 2; ++bj)
#pragma unroll
            for (int n = 0; n < 2; ++n) bv[bj][n] = *(const f32x4*)(bia + bj * 128 + 4 * n);
        const int ax = fq >> 1, f0 = (fq & 1) * 4;
        const f32x4 gk1 = *(const f32x4*)(gkn + 64 + ax * 16 + f0), gk2 = *(const f32x4*)(gkn + 64 + ax * 16 + 8 + f0);
#pragma unroll
        for (int ai = 0; ai < 2; ++ai)
#pragma unroll
            for (int m = 0; m < 4; ++m) {
                const int rl = ai * 128 + wr * 64 + m * 16 + fr, row = pm * 256 + rl;
                const float rs = row_rstd16(ssqx, row, fq, 1.0f / 1024.0f);
                f32x4 v[2][2];
#pragma unroll
                for (int bj = 0; bj < 2; ++bj)
#pragma unroll
                    for (int n = 0; n < 2; ++n) v[bj][n] = acc[ai][bj][m][n] * rs + bv[bj][n];
                if (pn == 2 || pn == 4) {
                    const float s = red_fq((sq4(v[0][0]) + sq4(v[0][1])) + (sq4(v[1][0]) + sq4(v[1][1])));
                    if (fq == 0) ssqkv[(size_t)row * 16 + (pn == 2 ? wc : 4 + wc)] = s;
                }
                if (pn == 5) {
                    const float s = red_fq(sq4(v[0][0]) + sq4(v[0][1]));
                    if (fq == 0) ssqkv[(size_t)row * 16 + 8 + wc] = s;
                    if (wc == 0) {
                        const float s1 = red_fq(sq4(v[1][0]) + sq4(v[1][1]));
                        if (fq == 0) ssqkv[(size_t)row * 16 + 12] = s1;
                        v[1][0] = v[1][0] * gk1; v[1][1] = v[1][1] * gk2;
                        if (pp != 0) rope4(v[1][0], v[1][1], rtab, (pp - 1) * 256 + rl, fq);
                    }
                }
                bf16_t* zp = z + (size_t)row * ZW + pn * 256 + wc * 32 + 8 * fq;
#pragma unroll
                for (int bj = 0; bj < 2; ++bj) *(u32x4*)(zp + bj * 128) = pack8(v[bj][0], v[bj][1]);
                asm volatile("" ::: "memory");
            }
    }
};

struct EpiQ {
    static constexpr bool PERM = true;
    bf16_t* Q; float* ssqq; const float* gqn; const float* rtab;
    __device__ __forceinline__ void operator()(const Acc& acc, const Unit& u, int wr, int wc, int fr, int fq) const {
        const int pm = u.pm, pn = u.pn, b = pm / PPB, pp = pm - b * PPB;
        const int ax = fq >> 1, f0 = (fq & 1) * 4;
        f32x4 g0[2], g1[2]; int part[2], grp[2];
#pragma unroll
        for (int bj = 0; bj < 2; ++bj) {
            grp[bj] = pn * 8 + bj * 4 + wc; part[bj] = grp[bj] % 3;
            if (part[bj] < 2) { g0[bj] = *(const f32x4*)(gqn + 32 * part[bj] + 8 * fq); g1[bj] = *(const f32x4*)(gqn + 32 * part[bj] + 8 * fq + 4); }
            else { g0[bj] = *(const f32x4*)(gqn + 64 + ax * 16 + f0); g1[bj] = *(const f32x4*)(gqn + 64 + ax * 16 + 8 + f0); }
        }
#pragma unroll
        for (int ai = 0; ai < 2; ++ai)
#pragma unroll
            for (int m = 0; m < 4; ++m) {
                const int rl = ai * 128 + wr * 64 + m * 16 + fr, row = pm * 256 + rl;
                bf16_t* qp = Q + (size_t)row * 768 + pn * 256 + wc * 32 + 8 * fq;
#pragma unroll
                for (int bj = 0; bj < 2; ++bj) {
                    const f32x4 a0 = acc[ai][bj][m][0], a1 = acc[ai][bj][m][1];
                    const float s = red_fq(sq4(a0) + sq4(a1));
                    if (fq == 0) ssqq[(size_t)row * 24 + grp[bj]] = s;
                    f32x4 v0 = a0 * g0[bj], v1 = a1 * g1[bj];
                    if (part[bj] == 2 && pp != 0) rope4(v0, v1, rtab, (pp - 1) * 256 + rl, fq);
                    *(u32x4*)(qp + bj * 128) = pack8(v0, v1);
                }
                asm volatile("" ::: "memory");
            }
    }
};

struct EpiKV {
    static constexpr bool PERM = true;
    bf16_t* Kb; bf16_t* Vb; const bf16_t* z; const float* ssqkv; const float* gkn;
    __device__ __forceinline__ void operator()(const Acc& acc, const Unit& u, int wr, int wc, int fr, int fq) const {
        const int pm = u.pm, pn = u.pn;
        f32x4 gk[2][2];
#pragma unroll
        for (int bj = 0; bj < 2; ++bj)
#pragma unroll
            for (int n = 0; n < 2; ++n) gk[bj][n] = *(const f32x4*)(gkn + 32 * bj + 8 * fq + 4 * n);
#pragma unroll
        for (int ai = 0; ai < 2; ++ai)
#pragma unroll
            for (int m = 0; m < 4; ++m) {
                const int rl = ai * 128 + wr * 64 + m * 16 + fr, row = pm * 256 + rl;
                const f32x4 st = *(const f32x4*)(ssqkv + (size_t)row * 16);
                const float s = rsqrtf(sum4(st) * (1.0f / 256.0f) + EPS);
                if (pn < 2) {
                    const int head = 4 * pn + wc;
                    const float ss = red_fq((sq4(acc[ai][0][m][0]) + sq4(acc[ai][0][m][1])) + (sq4(acc[ai][1][m][0]) + sq4(acc[ai][1][m][1])));
                    const float sskr = ssqkv[(size_t)row * 16 + 12];
                    const float rk = rsqrtf((s * s * ss + sskr) * (1.0f / 96.0f) + EPS);
                    const float sk = s * rk;
                    bf16_t* kp = Kb + (size_t)row * 768 + head * 96;
#pragma unroll
                    for (int bj = 0; bj < 2; ++bj) *(u32x4*)(kp + 32 * bj + 8 * fq) = pack8(acc[ai][bj][m][0] * gk[bj][0] * sk, acc[ai][bj][m][1] * gk[bj][1] * sk);
                    const u32x4 kr = *(const u32x4*)(z + (size_t)row * ZW + Z_KR + 8 * fq);
                    u32x4 o;
                    o.x = cvt_pk_bf16(bflo(kr.x) * rk, bfhi(kr.x) * rk); o.y = cvt_pk_bf16(bflo(kr.y) * rk, bfhi(kr.y) * rk);
                    o.z = cvt_pk_bf16(bflo(kr.z) * rk, bfhi(kr.z) * rk); o.w = cvt_pk_bf16(bflo(kr.w) * rk, bfhi(kr.w) * rk);
                    *(u32x4*)(kp + 64 + 8 * fq) = o;
                } else {
                    const int head = 4 * (pn - 2) + wc;
                    bf16_t* vp = Vb + (size_t)row * 512 + head * 64;
#pragma unroll
                    for (int bj = 0; bj < 2; ++bj) *(u32x4*)(vp + 32 * bj + 8 * fq) = pack8(acc[ai][bj][m][0] * s, acc[ai][bj][m][1] * s);
                }
                if (m & 1) asm volatile("" ::: "memory");
            }
    }
};

template <bool IN_F32, bool OUT_F32>
struct EpiRes {
    static constexpr bool PERM = true;
    const float* xin_lat; const float* xin_ctx; float* xout; bf16_t* xg; float* ssqx; const float* gate; const float* rgm_prev; const float* gm;
    __device__ __forceinline__ void operator()(const Acc& acc, const Unit& u, int wr, int wc, int fr, int fq) const {
        const int pm = u.pm, pn = u.pn, b = pm / PPB, pp = pm - b * PPB, bidx = pp == 0 ? 8 : b;
        const size_t rbase = pp == 0 ? (size_t)b * 256 : (size_t)b * SEQ + (size_t)(pp - 1) * 256;
        const float* xi = IN_F32 ? (pp == 0 ? xin_ctx : xin_lat) + rbase * D_MODEL : nullptr;
        float* xo = OUT_F32 ? xout + rbase * D_MODEL : nullptr;
        const int col0 = pn * 256 + wc * 32 + 8 * fq;
        f32x4 gv[2][2], mv[2][2], rv[2][2];
#pragma unroll
        for (int bj = 0; bj < 2; ++bj)
#pragma unroll
            for (int n = 0; n < 2; ++n) { gv[bj][n] = *(const f32x4*)(gate + bidx * 6144 + col0 + bj * 128 + n * 4);
                mv[bj][n] = OUT_F32 ? (f32x4){0.f, 0.f, 0.f, 0.f} : *(const f32x4*)(gm + bidx * 6144 + col0 + bj * 128 + n * 4);
                rv[bj][n] = IN_F32 ? (f32x4){0.f, 0.f, 0.f, 0.f} : *(const f32x4*)(rgm_prev + bidx * 2048 + col0 + bj * 128 + n * 4); }
#pragma unroll
        for (int ai = 0; ai < 2; ++ai)
#pragma unroll
            for (int m = 0; m < 4; ++m) {
                const int rl = ai * 128 + wr * 64 + m * 16 + fr; const size_t urow = (size_t)pm * 256 + rl, off = urow * D_MODEL + col0;
                float ss = 0.f;
#pragma unroll
                for (int bj = 0; bj < 2; ++bj) {
                    f32x4 x0, x1;
                    if (IN_F32) { x0 = *(const f32x4*)(xi + (size_t)rl * D_MODEL + col0 + bj * 128); x1 = *(const f32x4*)(xi + (size_t)rl * D_MODEL + col0 + bj * 128 + 4); }
                    else { const u32x4 w = *(const u32x4*)(xg + off + bj * 128); x0 = (f32x4){bflo(w.x), bfhi(w.x), bflo(w.y), bfhi(w.y)} * rv[bj][0]; x1 = (f32x4){bflo(w.z), bfhi(w.z), bflo(w.w), bfhi(w.w)} * rv[bj][1]; }
                    x0 += gv[bj][0] * acc[ai][bj][m][0]; x1 += gv[bj][1] * acc[ai][bj][m][1];
                    if (OUT_F32) { *(f32x4*)(xo + (size_t)rl * D_MODEL + col0 + bj * 128) = x0; *(f32x4*)(xo + (size_t)rl * D_MODEL + col0 + bj * 128 + 4) = x1; }
                    else { ss += sq4(x0) + sq4(x1); *(u32x4*)(xg + off + bj * 128) = pack8(x0 * mv[bj][0], x1 * mv[bj][1]); }
                }
                if (!OUT_F32) { ss = red_fq(ss); if (fq == 0) ssqx[urow * 16 + pn * 4 + wc] = ss; }
                asm volatile("" ::: "memory");
            }
    }
};

struct EpiSlab {
    static constexpr bool PERM = true;
    float* slab; int KS;
    __device__ __forceinline__ void operator()(const Acc& acc, const Unit& u, int wr, int wc, int fr, int fq) const {
        const int cp = u.pm / PPB, ks = (int)(u.koffB / (unsigned)(2 * KS));
        float* sp = slab + ((size_t)(ks * (BATCH * CTX) + cp * 256)) * D_MODEL + u.pn * 256 + wc * 32 + 8 * fq;
#pragma unroll
        for (int ai = 0; ai < 2; ++ai)
#pragma unroll
            for (int m = 0; m < 4; ++m) { float* rp = sp + (size_t)(ai * 128 + wr * 64 + m * 16 + fr) * D_MODEL;
#pragma unroll
                for (int bj = 0; bj < 2; ++bj) { *(f32x4*)(rp + bj * 128) = acc[ai][bj][m][0]; *(f32x4*)(rp + bj * 128 + 4) = acc[ai][bj][m][1]; } }
    }
};

struct EpiFF1 {
    static constexpr bool PERM = true;
    bf16_t* U; const float* ssqx; const float* bias;
    __device__ __forceinline__ void operator()(const Acc& acc, const Unit& u, int wr, int wc, int fr, int fq) const {
        const int pm = u.pm, pn = u.pn, b = pm / PPB, pp = pm - b * PPB, bidx = pp == 0 ? 8 : b;
        const float* bia = bias + bidx * D_FF + pn * 256 + wc * 32 + 8 * fq;
        f32x4 bv[2][2];
#pragma unroll
        for (int bj = 0; bj < 2; ++bj)
#pragma unroll
            for (int n = 0; n < 2; ++n) bv[bj][n] = *(const f32x4*)(bia + bj * 128 + 4 * n);
#pragma unroll
        for (int ai = 0; ai < 2; ++ai)
#pragma unroll
            for (int m = 0; m < 4; ++m) {
                const int row = pm * 256 + ai * 128 + wr * 64 + m * 16 + fr;
                const float rs = row_rstd16(ssqx, row, fq, 1.0f / 1024.0f);
                bf16_t* up = U + (((size_t)pm * 128 + pn * 8 + wc) * 16 + (ai * 8 + wr * 4 + m)) * 512 + fr * 32 + 8 * fq;
#pragma unroll
                for (int bj = 0; bj < 2; ++bj) {
                    f32x4 v0 = acc[ai][bj][m][0] * rs + bv[bj][0], v1 = acc[ai][bj][m][1] * rs + bv[bj][1];
#pragma unroll
                    for (int e = 0; e < 4; ++e) { const float a = fmaxf(v0[e], 0.f), c = fmaxf(v1[e], 0.f); v0[e] = a * a; v1[e] = c * c; }
#ifndef U_NT
#define U_NT 1
#endif
#if U_NT
                    __builtin_nontemporal_store(pack8(v0, v1), (u32x4*)(up + (size_t)bj * 4 * 16 * 512));
#else
                    *(u32x4*)(up + (size_t)bj * 4 * 16 * 512) = pack8(v0, v1);
#endif
                }
                asm volatile("" ::: "memory");
            }
    }
};
struct EpiSink {
    static constexpr bool PERM = true;
    float* dummy;
    __device__ __forceinline__ void operator()(const Acc& acc, const Unit& u, int wr, int wc, int fr, int fq) const {
        f32x4 s = {0.f, 0.f, 0.f, 0.f};
#pragma unroll
        for (int ai = 0; ai < 2; ++ai)
#pragma unroll
            for (int bj = 0; bj < 2; ++bj)
#pragma unroll
                for (int m = 0; m < 4; ++m) s += acc[ai][bj][m][0] + acc[ai][bj][m][1];
        const float t = s[0] + s[1] + s[2] + s[3];
        if (t == 1.2345678e33f) dummy[u.pm] = t;
    }
};
}
namespace att {
constexpr int NW = 8, QBLK = 32, KVBLK = 64, DQK = 96, DV = 64;
constexpr int KROWB = 208;
constexpr int SHM_K = KVBLK * KROWB, SHM_V = KVBLK * DV * 2;
constexpr int NSLOT = 3;
constexpr int LDS_V = 0, LDS_K = NSLOT * SHM_V, LDS_WS = LDS_K + NSLOT * SHM_K, LDS_OST = LDS_WS + NW * 64 * 4, LDS_BYTES = LDS_OST + NW * 4096;
#define SBAR() __builtin_amdgcn_sched_barrier(0)
__device__ __forceinline__ int crow(int r, int hi) { return (r & 3) + 8 * (r >> 2) + 4 * hi; }

template <int VAR> __device__ __forceinline__ void partialSM(f32x16& p0, float shift) {
  if (VAR == 1) return;
  if (VAR == 9) {
#pragma unroll
    for (int r = 0; r < 16; ++r) p0[r] -= shift; }
#pragma unroll
  for (int r = 0; r < 16; ++r) p0[r] = __builtin_amdgcn_exp2f(p0[r]);
}
template <int VAR> __device__ __forceinline__ void finishSM(f32x16& p0, f32x16& p1, float shift, float& l_reg, bf16x8& pa0, bf16x8& pa1, bf16x8& pa2, bf16x8& pa3) {
  if (VAR == 9) {
#pragma unroll
    for (int r = 0; r < 16; ++r) p1[r] -= shift; }
  if (VAR != 1) {
#pragma unroll
  for (int r = 0; r < 16; ++r) p1[r] = __builtin_amdgcn_exp2f(p1[r]); }
  float ps = 0;
#pragma unroll
  for (int r = 0; r < 16; ++r) ps += p0[r];
#pragma unroll
  for (int r = 0; r < 16; ++r) ps += p1[r];
  l_reg += ps;
#define PK4(P, BASE, OUT) do { u32x4 w = {cvt_pk_bf16(P[BASE + 0], P[BASE + 1]), cvt_pk_bf16(P[BASE + 2], P[BASE + 3]), cvt_pk_bf16(P[BASE + 4], P[BASE + 5]), cvt_pk_bf16(P[BASE + 6], P[BASE + 7])}; \
    OUT = *reinterpret_cast<bf16x8*>(&w); } while (0)
  PK4(p0, 0, pa0); PK4(p0, 8, pa1); PK4(p1, 0, pa2); PK4(p1, 8, pa3);
#undef PK4
}
#define KFR(KS, d0, half) (*reinterpret_cast<const bf16x8*>((KS) + (r32 + 32 * (half)) * KROWB + ((d0) * 16 + hi * 8) * 2))
__device__ __forceinline__ void kread4(bf16x8* kf, const char* Ks, int r32, int hi) { kf[0] = KFR(Ks, 0, 0); kf[1] = KFR(Ks, 0, 1); kf[2] = KFR(Ks, 1, 0); kf[3] = KFR(Ks, 1, 1); }
#define MF(A_, B_, C_) (VAR == 32 ? nomf(A_, B_, C_) : __builtin_amdgcn_mfma_f32_32x32x16_bf16(A_, B_, C_, 0, 0, 0))
__device__ __forceinline__ f32x16 nomf(bf16x8 a, bf16x8 b, f32x16 c) { asm volatile("" :: "v"(a), "v"(b)); c[0] += 1.0f; return c; }
template <bool FIN, int VAR>
__device__ __forceinline__ void qkt_fin(f32x16& p0, f32x16& p1, const char* Ks, const bf16x8* qr, int r32, int hi,
                                        f32x16& f0, f32x16& f1, float shift, float& l_reg, bf16x8& pa0, bf16x8& pa1, bf16x8& pa2, bf16x8& pa3, bf16x8* kfa) {
#ifdef KAHEAD
  bf16x8 kf[4] = {kfa[0], kfa[1], kfa[2], kfa[3]};
#else
  bf16x8 kf[4]; kf[0] = VAR == 8 ? qr[0] : KFR(Ks, 0, 0); kf[1] = VAR == 8 ? qr[0] : KFR(Ks, 0, 1); kf[2] = VAR == 8 ? qr[1] : KFR(Ks, 1, 0); kf[3] = VAR == 8 ? qr[1] : KFR(Ks, 1, 1);
#endif
  SBAR();
  const bf16x8 b0 = VAR == 8 ? qr[2] : KFR(Ks, 2, 0), b1 = VAR == 8 ? qr[2] : KFR(Ks, 2, 1), b2 = VAR == 8 ? qr[3] : KFR(Ks, 3, 0), b3 = VAR == 8 ? qr[3] : KFR(Ks, 3, 1);
  p0 = MF(kf[0], qr[0], f32x16{}); p1 = MF(kf[1], qr[0], f32x16{});
  p0 = MF(kf[2], qr[1], p0); p1 = MF(kf[3], qr[1], p1);
  if (FIN) {
    if (VAR == 9) {
#pragma unroll
      for (int r = 0; r < 16; ++r) f1[r] -= shift; }
    if (VAR != 1) {
#pragma unroll
      for (int r = 0; r < 16; ++r) f1[r] = __builtin_amdgcn_exp2f(f1[r]); }
  }
  SBAR();
  const bf16x8 c0 = VAR == 8 ? qr[4] : KFR(Ks, 4, 0), c1 = VAR == 8 ? qr[4] : KFR(Ks, 4, 1), c2 = VAR == 8 ? qr[5] : KFR(Ks, 5, 0), c3 = VAR == 8 ? qr[5] : KFR(Ks, 5, 1);
  p0 = MF(b0, qr[2], p0); p1 = MF(b1, qr[2], p1);
  p0 = MF(b2, qr[3], p0); p1 = MF(b3, qr[3], p1);
  if (FIN) {
    float ps = 0;
#pragma unroll
    for (int r = 0; r < 16; ++r) ps += f0[r];
#pragma unroll
    for (int r = 0; r < 16; ++r) ps += f1[r];
    l_reg += ps;
  }
  SBAR();
  p0 = MF(c0, qr[4], p0); p1 = MF(c1, qr[4], p1);
  p0 = MF(c2, qr[5], p0); p1 = MF(c3, qr[5], p1);
  if (FIN) {
#define PK4(P, BASE, OUT) do { u32x4 w = {cvt_pk_bf16(P[BASE + 0], P[BASE + 1]), cvt_pk_bf16(P[BASE + 2], P[BASE + 3]), cvt_pk_bf16(P[BASE + 4], P[BASE + 5]), cvt_pk_bf16(P[BASE + 6], P[BASE + 7])}; \
    OUT = *reinterpret_cast<bf16x8*>(&w); } while (0)
    PK4(f0, 0, pa0); PK4(f0, 8, pa1); PK4(f1, 0, pa2); PK4(f1, 8, pa3);
#undef PK4
  }
}
#undef MF
__device__ __forceinline__ int v_st(int k, int c) { return ((k >> 3) * 2 + (c >> 5)) * 512 + ((k & 7) * 32 + (c & 31)) * 2; }
__device__ __forceinline__ int v_rd_base(int lane) { return ((lane & 3) << 3) | (((lane >> 2) & 3) << 6) | (((lane >> 4) & 1) << 5) | (((lane >> 5) & 1) << 8); }
constexpr int v_rd_off(int d0, int ks, int half) { return d0 * 512 + ks * 2048 + half * 1024; }
template <int OFF> __device__ __forceinline__ s16x4 tr_read(int vb) {
  s16x4 r; asm volatile("ds_read_b64_tr_b16 %0, %1 offset:%2" : "=&v"(r) : "v"(vb), "i"(OFF) : "memory"); return r;
}
template <int D0> __device__ __forceinline__ void pv_one(f32x16& od, int vb, bf16x8 pa0, bf16x8 pa1, bf16x8 pa2, bf16x8 pa3) {
  const s16x4 l0 = tr_read<v_rd_off(D0, 0, 0)>(vb), h0 = tr_read<v_rd_off(D0, 0, 1)>(vb), l1 = tr_read<v_rd_off(D0, 1, 0)>(vb), h1 = tr_read<v_rd_off(D0, 1, 1)>(vb);
  const s16x4 l2 = tr_read<v_rd_off(D0, 2, 0)>(vb), h2 = tr_read<v_rd_off(D0, 2, 1)>(vb), l3 = tr_read<v_rd_off(D0, 3, 0)>(vb), h3 = tr_read<v_rd_off(D0, 3, 1)>(vb);
  asm volatile("s_waitcnt lgkmcnt(0)" ::: "memory"); SBAR();
#define PK(L, H) (bf16x8){L[0], L[1], L[2], L[3], H[0], H[1], H[2], H[3]}
  od = __builtin_amdgcn_mfma_f32_32x32x16_bf16(PK(l0, h0), pa0, od, 0, 0, 0);
  od = __builtin_amdgcn_mfma_f32_32x32x16_bf16(PK(l1, h1), pa1, od, 0, 0, 0);
  od = __builtin_amdgcn_mfma_f32_32x32x16_bf16(PK(l2, h2), pa2, od, 0, 0, 0);
  od = __builtin_amdgcn_mfma_f32_32x32x16_bf16(PK(l3, h3), pa3, od, 0, 0, 0);
#undef PK
}
__device__ __forceinline__ void pv_d0(f32x16* o, int vb, bf16x8 pa0, bf16x8 pa1, bf16x8 pa2, bf16x8 pa3) {
  pv_one<0>(o[0], vb, pa0, pa1, pa2, pa3); pv_one<1>(o[1], vb, pa0, pa1, pa2, pa3);
}

template <int VAR> __device__ __forceinline__ void pv_psm(f32x16* o, int vb, bf16x8 pa0, bf16x8 pa1, bf16x8 pa2, bf16x8 pa3, f32x16& p0, float shift) {
  pv_one<0>(o[0], vb, pa0, pa1, pa2, pa3);
  if (VAR == 9) {
#pragma unroll
    for (int r = 0; r < 8; ++r) p0[r] -= shift; }
#pragma unroll
  for (int r = 0; r < 8; ++r) p0[r] = __builtin_amdgcn_exp2f(p0[r]);
  SBAR();
  pv_one<1>(o[1], vb, pa0, pa1, pa2, pa3);
  if (VAR == 9) {
#pragma unroll
    for (int r = 8; r < 16; ++r) p0[r] -= shift; }
#pragma unroll
  for (int r = 8; r < 16; ++r) p0[r] = __builtin_amdgcn_exp2f(p0[r]);
}

template <int VAR>
__device__ __forceinline__ void attn_unit(const bf16_t* __restrict__ Qraw, const bf16_t* __restrict__ Kb, const bf16_t* __restrict__ Vb, bf16_t* mix,
                                          const float* ssqkv, const float* ssqq, float negB2, int qrow0, int krow0, int nkeys, int h, char* lds) {
  if (VAR == 10) return;
  int tid = threadIdx.x; asm volatile("" : "+v"(tid));
    const int  wid = __builtin_amdgcn_readfirstlane(tid >> 6), lane = tid & 63, r32 = lane & 31, hi = lane >> 5;
  char* V_lds = lds + LDS_V; char* K_lds = lds + LDS_K;
  float l_reg = 0; f32x16 o[2] = {}; bf16x8 qr[6];
  const float shift = -negB2;
  {
    const int row = qrow0 + wid * QBLK + r32;
    const f32x4 pa = *(const f32x4*)(ssqkv + (size_t)row * 16 + 4), pb = *(const f32x4*)(ssqkv + (size_t)row * 16 + 8);
    const float sql = rsqrtf(((pa[0] + pa[1]) + (pa[2] + pa[3]) + (pb[0] + pb[1]) + (pb[2] + pb[3])) * (1.0f / 384.0f) + EPS);
    const float ssh = ssqq[(size_t)row * 24 + 3 * h] + ssqq[(size_t)row * 24 + 3 * h + 1] + ssqq[(size_t)row * 24 + 3 * h + 2];
    const float sc = sql * rsqrtf(sql * sql * ssh * (1.0f / 96.0f) + EPS) * QSCALE;
    const bf16_t* Qw = Qraw + (size_t)row * 768 + h * 96 + hi * 8;
#pragma unroll
    for (int d0 = 0; d0 < 6; ++d0) { const u32x4 w = *(const u32x4*)(Qw + d0 * 16); u32x4 o4;
      o4.x = cvt_pk_bf16(bflo(w.x) * sc, bfhi(w.x) * sc); o4.y = cvt_pk_bf16(bflo(w.y) * sc, bfhi(w.y) * sc);
      o4.z = cvt_pk_bf16(bflo(w.z) * sc, bfhi(w.z) * sc); o4.w = cvt_pk_bf16(bflo(w.w) * sc, bfhi(w.w) * sc);
      qr[d0] = *reinterpret_cast<bf16x8*>(&o4); }
  }
  const int kk0 = tid / 12, kc0 = tid - kk0 * 12, kk1 = (tid + 512) / 12, kc1 = (tid + 512) - kk1 * 12, vk = tid >> 3, vc = tid & 7;
  const bf16_t* Kh = Kb + (size_t)krow0 * 768 + h * 96; const bf16_t* Vh = Vb + (size_t)krow0 * 512 + h * 64;
  const unsigned kof0 = (unsigned)(kk0 * 768 + kc0 * 8) * 2u, kof1 = (unsigned)(kk1 * 768 + kc1 * 8) * 2u, vof = (unsigned)(vk * 512 + vc * 8) * 2u;
  const int kst0 = kk0 * KROWB + kc0 * 16, kst1 = kk1 * KROWB + kc1 * 16, vst = v_st(vk, vc * 8);
  const __amdgpu_buffer_rsrc_t krs = __builtin_amdgcn_make_buffer_rsrc((void*)Kh, 0, nkeys * 768 * 2, 0x00020000);
  const __amdgpu_buffer_rsrc_t vrs = __builtin_amdgcn_make_buffer_rsrc((void*)Vh, 0, nkeys * 512 * 2, 0x00020000);
  const bool two = wid < 4;
  const int vb0 = (int)(uintptr_t)V_lds + v_rd_base(lane);
  bf16x8 sk0, sk1, sv;
#define LOADK(t) do { if (VAR == 4) break; const int so_ = (t) * (KVBLK * 768 * 2); sk0 = __builtin_bit_cast(bf16x8, __builtin_amdgcn_raw_buffer_load_b128(krs, kof0, so_, 0)); if (two) sk1 = __builtin_bit_cast(bf16x8, __builtin_amdgcn_raw_buffer_load_b128(krs, kof1, so_, 0)); } while (0)
#define LOADV(t) do { if (VAR == 4) break; sv = __builtin_bit_cast(bf16x8, __builtin_amdgcn_raw_buffer_load_b128(vrs, vof, (t) * (KVBLK * 512 * 2), 0)); } while (0)
#define WRITEK(slot) do { if (VAR == 4) break; *(bf16x8*)(K_lds + (slot) * SHM_K + kst0) = sk0; if (two) *(bf16x8*)(K_lds + (slot) * SHM_K + kst1) = sk1; } while (0)
#define WRITEV(slot) do { if (VAR == 4) break; *(bf16x8*)(V_lds + (slot) * SHM_V + vst) = sv; } while (0)
#define PV(slot) do { if (VAR != 2) pv_d0(o, vb0 + (slot) * SHM_V, pa0, pa1, pa2, pa3); else { asm volatile("" :: "v"(pa0), "v"(pa1), "v"(pa2), "v"(pa3)); } } while (0)
#define QFS(FIN, P0, P1, F0, F1, KQ) qkt_fin<FIN, VAR>(P0, P1, K_lds + (KQ) * SHM_K, qr, r32, hi, F0, F1, shift, l_reg, pa0, pa1, pa2, pa3, kfa)
#ifdef KAHEAD
#define KRD(slot) kread4(kfa, K_lds + (slot) * SHM_K, r32, hi)
#else
#define KRD(slot) do {} while (0)
#endif
#define QF(FIN, P0, P1, F0, F1) QFS(FIN, P0, P1, F0, F1, kq)
  f32x16 pA0, pA1, pB0, pB1; bf16x8 pa0, pa1, pa2, pa3; bf16x8 kfa[4]; const int NT = nkeys / KVBLK;
  LOADK(0); LOADV(0); WRITEK(0); WRITEV(0); LOADK(1); WRITEK(1); LOADK(2); LOADV(1);
  __syncthreads();
  KRD(0);
  int sa = 2, sb = 1, kq = 0;
#define ROT() do { sa = (sa == 2) ? 0 : sa + 1; sb = (sb == 2) ? 0 : sb + 1; kq = (kq == 2) ? 0 : kq + 1; } while (0)
  SBAR(); QF(false, pA0, pA1, pA0, pA1); SBAR(); KRD(sb); partialSM<VAR>(pA0, shift); WRITEK(sa); WRITEV(sb); LOADK(3); LOADV(2); __syncthreads();
  ROT();
#define STEP_U(PC0, PC1, PP0, PP1, s_, KQ, SA, SB) do { SBAR(); QFS(true, PC0, PC1, PP0, PP1, KQ); SBAR(); PV(SA); SBAR(); partialSM<VAR>(PC0, shift); \
    WRITEK(SA); WRITEV(SB); LOADK((s_) + 3); LOADV((s_) + 2); __syncthreads(); } while (0)
  int j = 1;
#ifdef ATT_UNROLL6
  for (; j + 8 < NT; j += 6) {
    STEP_U(pB0, pB1, pA0, pA1, j,     1, 0, 2);
    STEP_U(pA0, pA1, pB0, pB1, j + 1, 2, 1, 0);
    STEP_U(pB0, pB1, pA0, pA1, j + 2, 0, 2, 1);
    STEP_U(pA0, pA1, pB0, pB1, j + 3, 1, 0, 2);
    STEP_U(pB0, pB1, pA0, pA1, j + 4, 2, 1, 0);
    STEP_U(pA0, pA1, pB0, pB1, j + 5, 0, 2, 1);
  }
#endif
  for (; j + 1 < NT; j += 2) {
#ifdef PVPSM
    SBAR(); QF(true, pB0, pB1, pA0, pA1); SBAR(); pv_psm<VAR>(o, vb0 + sa * SHM_V, pa0, pa1, pa2, pa3, pB0, shift); SBAR(); KRD(sb);
#else
    SBAR(); QF(true, pB0, pB1, pA0, pA1); SBAR(); PV(sa); SBAR(); KRD(sb); partialSM<VAR>(pB0, shift);
#endif
    WRITEK(sa); WRITEV(sb); if (j + 3 < NT) LOADK(j + 3); LOADV(j + 2); if (VAR != 16) __syncthreads();
    ROT();
    const bool t3 = (j + 3 < NT);
#ifdef PVPSM
    SBAR(); QF(true, pA0, pA1, pB0, pB1); SBAR(); pv_psm<VAR>(o, vb0 + sa * SHM_V, pa0, pa1, pa2, pa3, pA0, shift); SBAR(); KRD(sb);
#else
    SBAR(); QF(true, pA0, pA1, pB0, pB1); SBAR(); PV(sa); SBAR(); KRD(sb); partialSM<VAR>(pA0, shift);
#endif
    if (t3) WRITEK(sa); WRITEV(sb); if (j + 4 < NT) LOADK(j + 4); if (t3) LOADV(j + 3); if (VAR != 16) __syncthreads();
    ROT();
  }
  SBAR(); QF(true, pB0, pB1, pA0, pA1); SBAR(); PV(sa); partialSM<VAR>(pB0, shift);
  finishSM<VAR>(pB0, pB1, shift, l_reg, pa0, pa1, pa2, pa3); SBAR();
  ROT();
  PV(sa);
  { auto rr = __builtin_amdgcn_permlane32_swap(__float_as_uint(l_reg), __float_as_uint(l_reg), false, false); l_reg = __uint_as_float(rr[0]) + __uint_as_float(rr[1]); }
  const float rl = __builtin_amdgcn_rcpf(l_reg);
  { bf16_t* stg = (bf16_t*)(lds + LDS_OST) + wid * 2048;
#pragma unroll
    for (int d0 = 0; d0 < 2; ++d0)
#pragma unroll
      for (int g = 0; g < 4; ++g) { u32x2 w; w.x = cvt_pk_bf16(o[d0][4 * g] * rl, o[d0][4 * g + 1] * rl); w.y = cvt_pk_bf16(o[d0][4 * g + 2] * rl, o[d0][4 * g + 3] * rl);
        *(u32x2*)(stg + r32 * 64 + d0 * 32 + 8 * g + 4 * hi) = w; }
    asm volatile("s_waitcnt lgkmcnt(0)" ::: "memory");
    bf16_t* Ow = mix + (size_t)(qrow0 + wid * QBLK) * D_MODEL + 256 + h * 64;
#pragma unroll
    for (int i = 0; i < 4; ++i) { const int row = i * 8 + (lane >> 3), ch = lane & 7; const u32x4 v = *(const u32x4*)(stg + row * 64 + ch * 8); *(u32x4*)(Ow + (size_t)row * D_MODEL + ch * 8) = v; } }
  __syncthreads();
#undef LOADK
#undef LOADV
#undef WRITEK
#undef WRITEV
#undef ROT
#undef QF
#undef QFS
#undef KRD
#undef STEP_U
#undef PV
}
#undef SBAR
}
namespace thin {
__device__ __forceinline__ float fexp(float x) { return __builtin_amdgcn_exp2f(x * 1.4426950408889634f); }
__device__ __forceinline__ float sigmoidf_(float x) { return __builtin_amdgcn_rcpf(1.0f + fexp(-x)); }
__device__ __forceinline__ float gelu_tanh(float x) { return x * __builtin_amdgcn_rcpf(1.0f + __builtin_amdgcn_exp2f(x * fmaf(x * x, -0.10294323f, -2.3022082f))); }
__device__ __forceinline__ float fexpm1_neg(float x) { const float p = x * (1.0f + x * (0.5f + x * (0.16666667f + x * (0.041666668f + x * 0.0083333338f)))); const float e = fexp(x) - 1.0f; return x > -0.25f ? p : e; }
__device__ __forceinline__ int rope_logical(int p) { const int q = p >> 3, i = p & 7; return (q >> 1) * 16 + (i >> 2) * 8 + (q & 1) * 4 + (i & 3); }

constexpr int XC_ROWB = 144;
constexpr int LRU_XC = 0, LRU_Y = 256 * XC_ROWB;
constexpr int NPOS = 34;

struct LruP { const bf16_t* z; const float* convw; const float* convb; const bf16_t* gw; const float* ba; const float* bx; const float* lam; float* agg; bf16_t* mix; };

template <int PASS>
__device__ __forceinline__ void lru_item(const LruP& P, int pm, int hd, char* lds) {
    int tid = threadIdx.x; asm volatile("" : "+v"(tid));
    const int  wid = __builtin_amdgcn_readfirstlane(tid >> 6), lane = tid & 63, r32 = lane & 31, hi = lane >> 5;
    const int b = pm / PPB, pp = pm - b * PPB;
    const int L = pp == 0 ? CTX : SEQ, seqbase = b * TPB + (pp == 0 ? 0 : CTX), t0 = pp == 0 ? 0 : (pp - 1) * 256;
    char* XC = lds + LRU_XC; float* Y = (float*)(lds + LRU_Y);
    {
        const int c8 = tid & 7, ch = hd * 64 + c8 * 8;
        f32x4 w[4][2];
#pragma unroll
        for (int k = 0; k < 4; ++k) { w[k][0] = *(const f32x4*)(P.convw + k * 256 + ch); w[k][1] = *(const f32x4*)(P.convw + k * 256 + ch + 4); }
        const f32x4 cb0 = *(const f32x4*)(P.convb + ch), cb1 = *(const f32x4*)(P.convb + ch + 4);
#pragma unroll
        for (int i = 0; i < 4; ++i) {
            const int tk = (tid >> 3) + 64 * i, ts = t0 + tk;
            f32x4 a0 = cb0, a1 = cb1;
#pragma unroll
            for (int k = 0; k < 4; ++k) { const int tsrc = ts + k - 1;
                if (tsrc >= 0 && tsrc < L) { const u32x4 v = *(const u32x4*)(P.z + (size_t)(seqbase + tsrc) * ZW + Z_LX + ch);
                    a0 += w[k][0] * (f32x4){bflo(v.x), bfhi(v.x), bflo(v.y), bfhi(v.y)}; a1 += w[k][1] * (f32x4){bflo(v.z), bfhi(v.z), bflo(v.w), bfhi(v.w)}; } }
            *(u32x4*)(XC + tk * XC_ROWB + c8 * 16) = epi::pack8(a0, a1);
        }
    }
    __syncthreads();
    const int dir = wid & 1, cb = (wid >> 1) & 1, half = wid >> 2;
    const int chl = cb * 32 + r32, ch = hd * 64 + chl;
    bf16x8 Ba[4], Bx[4];
#pragma unroll
    for (int ks = 0; ks < 4; ++ks) {
        Ba[ks] = *(const bf16x8*)(P.gw + ((size_t)((dir * 2 + 0) * 4 + hd) * 64 + chl) * 64 + ks * 16 + hi * 8);
        Bx[ks] = *(const bf16x8*)(P.gw + ((size_t)((dir * 2 + 1) * 4 + hd) * 64 + chl) * 64 + ks * 16 + hi * 8);
    }
    const float bav = P.ba[dir * 256 + ch], bxv = P.bx[dir * 256 + ch];
    const float sp8 = 8.0f * log1pf(expf(-P.lam[dir * 256 + ch]));
    const float nsp8 = -sp8, ba2 = bav * -1.4426950408889634f, bx2 = bxv * -1.4426950408889634f;
    const bool small_la = __all(sp8 <= 0.125f);
    const int chunk = pp == 0 ? half : 2 * pp + half;
    const int pos = dir == 0 ? chunk : (chunk == 1 ? 0 : (chunk == 0 ? 1 : 35 - chunk));
    float Hrun = 0.f, Arun = 1.f;
    if (PASS == 2) {
        const float* ag = P.agg + ((size_t)(b * 2 + dir) * NPOS) * 512 + ch * 2;
#pragma unroll 1
        for (int p0 = 0; p0 < pos; p0 += 11) {
            f32x2 e[11];
#pragma unroll
            for (int q = 0; q < 11; ++q) e[q] = (p0 + q) < pos ? *(const f32x2*)(ag + (size_t)(p0 + q) * 512) : (f32x2){1.0f, 0.0f};
#pragma unroll
            for (int q = 0; q < 11; ++q) Hrun = e[q].x * Hrun + e[q].y;
        }
    }
    float yv[4][16];
    const int tau = ((r32 >> 2) & 1) * 16 + (r32 >> 3) * 4 + (r32 & 3);
    const int firsthi = dir;
#pragma unroll
    for (int ii = 0; ii < 4; ++ii) {
        const int tile = dir == 0 ? ii : 3 - ii, tb = half * 128 + tile * 32;
        f32x16 ra = {}, ix = {};
#pragma unroll
        for (int ks = 0; ks < 4; ++ks) {
            const bf16x8 af = *(const bf16x8*)(XC + (tb + tau) * XC_ROWB + (ks * 16 + hi * 8) * 2);
            ra = __builtin_amdgcn_mfma_f32_32x32x16_bf16(af, Ba[ks], ra, 0, 0, 0);
            ix = __builtin_amdgcn_mfma_f32_32x32x16_bf16(af, Bx[ks], ix, 0, 0, 0);
        }
        float av[16], bv[16];
        if (small_la) { asm volatile("; lru: series expm1" ::: "memory");
#pragma unroll
            for (int r = 0; r < 16; ++r) {
                const float xcv = bf2f(*(const bf16_t*)(XC + (tb + hi * 16 + r) * XC_ROWB + chl * 2));
                const float rr = __builtin_amdgcn_rcpf(1.0f + __builtin_amdgcn_exp2f(fmaf(ra[r], -1.4426950408889634f, ba2)));
                const float iv = __builtin_amdgcn_rcpf(1.0f + __builtin_amdgcn_exp2f(fmaf(ix[r], -1.4426950408889634f, bx2)));
                const float la = nsp8 * rr;
                const float em = la * fmaf(la, fmaf(la, fmaf(la, 0.041666668f, 0.16666667f), 0.5f), 1.0f);
                av[r] = 1.0f + em; bv[r] = __builtin_amdgcn_sqrtf(-fmaf(em, em, em + em)) * (iv * xcv);
            }
        } else {
#pragma unroll
            for (int r = 0; r < 16; ++r) {
                const float xcv = bf2f(*(const bf16_t*)(XC + (tb + hi * 16 + r) * XC_ROWB + chl * 2));
                const float rr = __builtin_amdgcn_rcpf(1.0f + __builtin_amdgcn_exp2f(fmaf(ra[r], -1.4426950408889634f, ba2)));
                const float iv = __builtin_amdgcn_rcpf(1.0f + __builtin_amdgcn_exp2f(fmaf(ix[r], -1.4426950408889634f, bx2)));
                const float em = fexpm1_neg(nsp8 * rr);
                av[r] = 1.0f + em; bv[r] = __builtin_amdgcn_sqrtf(-fmaf(em, em, em + em)) * (iv * xcv);
            }
        }
        float hl[16], cl[16]; float h = 0.f, c = 1.f;
        if (dir == 0) {
#pragma unroll
            for (int r = 0; r < 16; ++r) { h = av[r] * h + bv[r]; c *= av[r]; hl[r] = h; cl[r] = c; }
        } else {
#pragma unroll
            for (int r = 15; r >= 0; --r) { h = av[r] * h + bv[r]; c *= av[r]; hl[r] = h; cl[r] = c; }
        }
        const float H1 = __shfl(h, r32 + 32 * firsthi), A1 = __shfl(c, r32 + 32 * firsthi);
        const float H2 = __shfl(h, r32 + 32 * (1 - firsthi)), A2 = __shfl(c, r32 + 32 * (1 - firsthi));
        const float Hin1 = Hrun, Hin2 = A1 * Hrun + H1;
        const float Hmine = (hi == firsthi) ? Hin1 : Hin2;
        Hrun = A2 * Hin2 + H2; Arun = Arun * A1 * A2;
        if (PASS == 2) {
#pragma unroll
            for (int r = 0; r < 16; ++r) yv[ii][r] = hl[r] + cl[r] * Hmine;
        }
    }
    if (PASS == 1) {
        if (hi == 0) *(f32x2*)(P.agg + ((size_t)(b * 2 + dir) * NPOS + pos) * 512 + ch * 2) = (f32x2){Arun, Hrun};
        __syncthreads();
    } else {
        if (dir == 0) {
#pragma unroll
            for (int ii = 0; ii < 4; ++ii)
#pragma unroll
                for (int r = 0; r < 16; ++r) Y[(half * 128 + ii * 32 + hi * 16 + r) * 64 + chl] = yv[ii][r];
        }
        __syncthreads();
        if (dir == 1) {
#pragma unroll
            for (int ii = 0; ii < 4; ++ii)
#pragma unroll
                for (int r = 0; r < 16; ++r) Y[(half * 128 + (3 - ii) * 32 + hi * 16 + r) * 64 + chl] += yv[ii][r];
        }
        __syncthreads();
        const int c8 = tid & 7;
#pragma unroll
        for (int i = 0; i < 4; ++i) {
            const int tk = (tid >> 3) + 64 * i; const size_t row = (size_t)pm * 256 + tk;
            const f32x4 y0 = *(const f32x4*)(Y + tk * 64 + c8 * 8), y1 = *(const f32x4*)(Y + tk * 64 + c8 * 8 + 4);
            const u32x4 g = *(const u32x4*)(P.z + row * ZW + Z_LG + hd * 64 + c8 * 8);
            const f32x4 o0 = y0 * (f32x4){gelu_tanh(bflo(g.x)), gelu_tanh(bfhi(g.x)), gelu_tanh(bflo(g.y)), gelu_tanh(bfhi(g.y))};
            const f32x4 o1 = y1 * (f32x4){gelu_tanh(bflo(g.z)), gelu_tanh(bfhi(g.z)), gelu_tanh(bflo(g.w)), gelu_tanh(bfhi(g.w))};
            *(u32x4*)(P.mix + row * D_MODEL + hd * 64 + c8 * 8) = epi::pack8(o0, o1);
        }
        __syncthreads();
    }
}

constexpr int PL_PU = 0, PL_MX = 272 * 128;
template <int GI>
__device__ __forceinline__ void pool_item_g(const bf16_t* z, const bf16_t* pw, bf16_t* mix, int pm, char* lds) {
    constexpr int g = GI, W = 2 << GI;
    int tid = threadIdx.x; asm volatile("" : "+v"(tid));
    const int  wid = __builtin_amdgcn_readfirstlane(tid >> 6), lane = tid & 63, r32 = lane & 31, hi = lane >> 5;
    const int b = pm / PPB, pp = pm - b * PPB;
    const int L = pp == 0 ? CTX : SEQ, seqbase = b * TPB + (pp == 0 ? 0 : CTX), t0 = pp == 0 ? 0 : (pp - 1) * 256;
    char* PU = lds + PL_PU; char* MX = lds + PL_MX;
    const int c8 = tid & 7;
#pragma unroll
    for (int i = 0; i < 5; ++i) { const int hr = (tid >> 3) + 64 * i, ts = t0 - 8 + hr;
        if (hr < 272 && ts >= 0 && ts < L) *(u32x4*)(PU + hr * 128 + c8 * 16) = *(const u32x4*)(z + (size_t)(seqbase + ts) * ZW + Z_PU + g * 64 + c8 * 8); }
    __syncthreads();
#pragma unroll
    for (int i = 0; i < 4; ++i) {
        const int tk = (tid >> 3) + 64 * i, ts = t0 + tk;
        f32x4 s0 = {0.f, 0.f, 0.f, 0.f}, s1 = {0.f, 0.f, 0.f, 0.f}; int cnt = 0;
#pragma unroll
        for (int k = 0; k < W; ++k) {
            const int tt = ts - W / 2 + k;
            if (tt >= 0 && tt < L) { const u32x4 v = *(const u32x4*)(PU + (tk + 8 - W / 2 + k) * 128 + c8 * 16); ++cnt;
                s0 += (f32x4){bflo(v.x), bfhi(v.x), bflo(v.y), bfhi(v.y)}; s1 += (f32x4){bflo(v.z), bfhi(v.z), bflo(v.w), bfhi(v.w)}; } }
        const float inv = __builtin_amdgcn_rcpf((float)cnt);
        const u32x4 v = *(const u32x4*)(PU + (tk + 8) * 128 + c8 * 16);
        s0 = s0 * inv - (f32x4){bflo(v.x), bfhi(v.x), bflo(v.y), bfhi(v.y)}; s1 = s1 * inv - (f32x4){bflo(v.z), bfhi(v.z), bflo(v.w), bfhi(v.w)};
        *(u32x4*)(MX + tk * XC_ROWB + c8 * 16) = epi::pack8(s0, s1);
    }
    __syncthreads();
    f32x16 c0 = {}, c1 = {};
#pragma unroll
    for (int ks = 0; ks < 4; ++ks) {
        const bf16x8 bf = *(const bf16x8*)(MX + (wid * 32 + r32) * XC_ROWB + (ks * 16 + hi * 8) * 2);
        const bf16x8 a0 = *(const bf16x8*)(pw + ((size_t)g * 64 + r32) * 64 + ks * 16 + hi * 8);
        const bf16x8 a1 = *(const bf16x8*)(pw + ((size_t)g * 64 + 32 + r32) * 64 + ks * 16 + hi * 8);
        c0 = __builtin_amdgcn_mfma_f32_32x32x16_bf16(a0, bf, c0, 0, 0, 0);
        c1 = __builtin_amdgcn_mfma_f32_32x32x16_bf16(a1, bf, c1, 0, 0, 0);
    }
    bf16_t* OT = (bf16_t*)PU;
#pragma unroll
    for (int q = 0; q < 4; ++q) {
        u32x2 w0, w1; w0.x = cvt_pk_bf16(c0[4 * q], c0[4 * q + 1]); w0.y = cvt_pk_bf16(c0[4 * q + 2], c0[4 * q + 3]);
        w1.x = cvt_pk_bf16(c1[4 * q], c1[4 * q + 1]); w1.y = cvt_pk_bf16(c1[4 * q + 2], c1[4 * q + 3]);
        *(u32x2*)(OT + (wid * 32 + r32) * 64 + 4 * hi + 8 * q) = w0; *(u32x2*)(OT + (wid * 32 + r32) * 64 + 32 + 4 * hi + 8 * q) = w1;
    }
    __syncthreads();
#pragma unroll
    for (int i = 0; i < 4; ++i) { const int tk = (tid >> 3) + 64 * i;
        *(u32x4*)(mix + ((size_t)pm * 256 + tk) * D_MODEL + 768 + g * 64 + c8 * 8) = *(const u32x4*)(OT + tk * 64 + c8 * 8); }
    __syncthreads();
}
__device__ __forceinline__ void pool_item(const bf16_t* z, const bf16_t* pw, bf16_t* mix, int pm, int g, char* lds) {
    if (g == 0) pool_item_g<0>(z, pw, mix, pm, lds); else if (g == 1) pool_item_g<1>(z, pw, mix, pm, lds); else if (g == 2) pool_item_g<2>(z, pw, mix, pm, lds); else pool_item_g<3>(z, pw, mix, pm, lds);
}

__device__ __forceinline__ void transpose_tile(const float* W, int N, bf16_t* WT, int Kp, int k0, int nphys, int srcbase, bool rperm, const float* kscale, const float* nscale, bool zero, LAS float* scr, int lane) {
    const int nl = lane & 31, sc = srcbase + (rperm ? rope_logical(nl) : nl);
    const float nsv = nscale ? nscale[nl] : 1.0f;
#pragma unroll 8
    for (int i = 0; i < 32; ++i) { const int kk = 2 * i + (lane >> 5);
        float v = zero ? 0.f : W[(size_t)(k0 + kk) * N + sc] * nsv; if (kscale) v *= kscale[k0 + kk];
        scr[kk * 33 + nl] = v; }
    asm volatile("s_waitcnt lgkmcnt(0)" ::: "memory");
    const int c = lane & 7;
#pragma unroll
    for (int j = 0; j < 4; ++j) { const int n = (lane >> 3) + 8 * j; const LAS float* s = scr + (8 * c) * 33 + n;
        u32x4 o; o.x = cvt_pk_bf16(s[0 * 33], s[1 * 33]); o.y = cvt_pk_bf16(s[2 * 33], s[3 * 33]); o.z = cvt_pk_bf16(s[4 * 33], s[5 * 33]); o.w = cvt_pk_bf16(s[6 * 33], s[7 * 33]);
        *(u32x4*)(WT + (size_t)(nphys + n) * Kp + k0 + 8 * c) = o; }
    asm volatile("s_waitcnt lgkmcnt(0)" ::: "memory");
}
__device__ __forceinline__ float wave_sum(float v) {
#pragma unroll
    for (int o = 1; o < 64; o <<= 1) v += __shfl_xor(v, o);
    return v;
}
}
constexpr int NWAVES = 8;
constexpr size_t MiB = 1u << 20;
constexpr size_t WS_CTL = 0, CTL_ZERO_BYTES = 64 * 1024;
constexpr size_t WS_MODPART = 1 * MiB;
constexpr size_t WS_VEC = 5 * MiB;
constexpr size_t WS_BIASIN = WS_VEC + 512 * 1024;
constexpr size_t WS_BIASFF = WS_BIASIN + 128 * 1024;
constexpr size_t WS_RTAB = WS_BIASFF + 320 * 1024;
constexpr size_t WS_RVEC = 17 * MiB + 512 * 1024;
constexpr size_t WS_AGG = 6 * MiB;
constexpr size_t WS_SSQX = 8 * MiB;
constexpr size_t WS_SSQKV = 11 * MiB;
constexpr size_t WS_SSQQ = 14 * MiB;
constexpr size_t WS_WT = 18 * MiB, WT_LAYER = 23 * MiB;
constexpr size_t WT_IN = 0, WT_UQ = 3 * MiB, WT_UKV = WT_UQ + 640 * 1024, WT_OUT = WT_UKV + 512 * 1024, WT_FF1 = WT_OUT + 2 * MiB, WT_FF2 = WT_FF1 + 8 * MiB, WT_GATE = WT_FF2 + 8 * MiB, WT_POOL = WT_GATE + 128 * 1024;
static_assert(WT_POOL + 32 * 1024 <= WT_LAYER, "weights per layer");
constexpr size_t WS_XG = 72 * MiB;
constexpr size_t WS_U = 208 * MiB;
constexpr size_t WS_Z = WS_U, WS_Q = WS_Z + 102 * MiB, WS_K = WS_Q + 51 * MiB, WS_V = WS_K + 51 * MiB;
constexpr size_t WS_END = WS_U + 272 * MiB;
static_assert(WS_V + 34 * MiB <= WS_END && WS_END <= 512 * MiB, "d_ws map");
enum { VEC_GM1 = 0, VEC_G1 = 1, VEC_GM2 = 2, VEC_G2 = 3, VEC_SH1 = 4, VEC_SH2 = 5 };

constexpr int LDS_BYTES = 147456;
constexpr int LDSCTL_OFF = 131072, MISC_OFF = LDSCTL_OFF + 320;

typedef GAS unsigned gu32;
#define RLX_AGENT __ATOMIC_RELAXED, __HIP_MEMORY_SCOPE_AGENT
#define XB_TMO      128
#define XB_XCNT(j)  (256  + 64 * (j))
#define XB_XSUB(j)  (1280 + 64 * (j))
#define XB_XGEN(j)  (2304 + 64 * (j))
#define XB_TOP      3328
#define XB_TOPGEN   3392
#define XCD_BAR_WORDS 3456
#define XB_SPIN_CAP (1u << 20)
__device__ __forceinline__ unsigned xb_ld(unsigned* p)              { return __hip_atomic_load(p, __ATOMIC_RELAXED, __HIP_MEMORY_SCOPE_AGENT); }
__device__ __forceinline__ unsigned xb_add(unsigned* p, unsigned v) { return __hip_atomic_fetch_add(p, v, __ATOMIC_RELAXED, __HIP_MEMORY_SCOPE_AGENT); }
__device__ __forceinline__ unsigned xb_xcc_id() { return (unsigned)__builtin_amdgcn_s_getreg((3 << 11) | 20) & 0xFu; }
#define XB_SPIN(cond, bar) do { unsigned _sp = 0; while (cond) { __builtin_amdgcn_s_sleep(1); \
    if ((++_sp & 255u) == 0u) { if (xb_ld(&(bar)[XB_TMO])) break; if (_sp > XB_SPIN_CAP) { atomicAdd(&(bar)[XB_TMO], 1u); break; } } } } while (0)
struct XcdBarrier { unsigned* bar; unsigned x; volatile LAS unsigned* st; };
__device__ __forceinline__ XcdBarrier xcd_barrier_post(unsigned* bar, volatile LAS unsigned* st) {
    XcdBarrier b; b.bar = bar; b.x = xb_xcc_id(); b.st = st;
    if (threadIdx.x == 0) (void)xb_add(&bar[XB_XCNT(b.x)], 1u);
    return b;
}
__device__ __forceinline__ void xcd_barrier_complete(unsigned* bar, unsigned x, unsigned& nloc, unsigned& nx) {
    const unsigned G = gridDim.x * gridDim.y * gridDim.z;
    unsigned sum, cnt, mine, sp = 0u;
    for (;;) {
        sum = 0u; cnt = 0u; mine = 0u;
#pragma unroll
        for (unsigned j = 0; j < 16; ++j) { const unsigned c = xb_ld(&bar[XB_XCNT(j)]); sum += c; cnt += (c > 0u) ? 1u : 0u; mine = (j == x) ? c : mine; }
        if (sum == G) break;
        __builtin_amdgcn_s_sleep(1);
        if ((++sp & 255u) == 0u) { if (xb_ld(&bar[XB_TMO])) break; if (sp > XB_SPIN_CAP) { atomicAdd(&bar[XB_TMO], 1u); break; } }
    }
    nloc = mine > 0u ? mine : 1u; nx = cnt > 0u ? cnt : 1u;
}
__device__ __forceinline__ void xcd_barrier(const XcdBarrier& b) {
    asm volatile("s_waitcnt vmcnt(0)" ::: "memory");
    __syncthreads();
    if (threadIdx.x == 0) {
        unsigned* bar = b.bar;
        __builtin_amdgcn_s_waitcnt(0);
        unsigned nloc = b.st[0], nx = b.st[1];
        if (nloc == 0u) { xcd_barrier_complete(bar, b.x, nloc, nx); b.st[0] = nloc; b.st[1] = nx; }
        const unsigned old = xb_add(&bar[XB_XSUB(b.x)], 1u);
        const unsigned gen = old / nloc;
        if (old + 1u == (gen + 1u) * nloc) {
            __builtin_amdgcn_fence(__ATOMIC_RELEASE, "agent");
            asm volatile("s_waitcnt vmcnt(0)" ::: "memory");
            const unsigned og = xb_add(&bar[XB_TOP], 1u);
            const unsigned tg = og / nx;
            if (og + 1u == (tg + 1u) * nx) xb_add(&bar[XB_TOPGEN], 1u);
            else XB_SPIN(xb_ld(&bar[XB_TOPGEN]) == tg, bar);
            __builtin_amdgcn_fence(__ATOMIC_ACQUIRE, "agent");
            xb_add(&bar[XB_XGEN(b.x)], 1u);
            asm volatile("s_waitcnt vmcnt(0)" ::: "memory");
        } else {
            XB_SPIN(xb_ld(&bar[XB_XGEN(b.x)]) == gen, bar);
            __builtin_amdgcn_fence(__ATOMIC_ACQUIRE, "agent");
            asm volatile("s_waitcnt vmcnt(0)" ::: "memory");
        }
    }
    __syncthreads();
}


__device__ __forceinline__ void gate_wait(const unsigned* w, unsigned need, unsigned* tmo) {
    if (threadIdx.x < 64) { unsigned sp = 0u;
        while ((unsigned)__builtin_amdgcn_readfirstlane(xb_ld((unsigned*)w)) < need) { __builtin_amdgcn_s_sleep(2);
            if ((++sp & 255u) == 0u) { if (xb_ld(tmo)) break; if (sp > XB_SPIN_CAP) { if (threadIdx.x == 0) atomicAdd(tmo, 1u); break; } } }
        __builtin_amdgcn_fence(__ATOMIC_ACQUIRE, "agent");
        asm volatile("s_waitcnt vmcnt(0)" ::: "memory"); }
    __syncthreads();
}

__device__ __forceinline__ void ctx_combine(unsigned char* ws, float* out, const float* rgmv, const float* gatev, const float* gmv, int gw, int NGW, int lane_in) {
    int lane = lane_in; asm volatile("" : "+v"(lane)); lane &= 63;
    const float* slab = out + (size_t)18 * 1024 * 1024;
    bf16_t* xg_ = (bf16_t*)(ws + WS_XG); float* ssq_ = (float*)(ws + WS_SSQX);
    for (int cr = gw; cr < BATCH * CTX; cr += NGW) {
        const size_t urow = (size_t)(cr >> 8) * TPB + (cr & 255); float ss = 0.f;
#pragma unroll
        for (int j = 0; j < 4; ++j) { const int col = 256 * j + 4 * lane;
            f32x4 a = *(const f32x4*)(slab + (size_t)cr * D_MODEL + col);
#pragma unroll
            for (int ks = 1; ks < 4; ++ks) a += *(const f32x4*)(slab + ((size_t)ks * (BATCH * CTX) + cr) * D_MODEL + col);
            const u32x2 w = *(const u32x2*)(xg_ + urow * D_MODEL + col);
            const f32x4 x = (f32x4){bflo(w.x), bfhi(w.x), bflo(w.y), bfhi(w.y)} * *(const f32x4*)(rgmv + col) + *(const f32x4*)(gatev + col) * a;
            ss += epi::sq4(x);
            const f32x4 t = x * *(const f32x4*)(gmv + col); u32x2 o; o.x = cvt_pk_bf16(t[0], t[1]); o.y = cvt_pk_bf16(t[2], t[3]); *(u32x2*)(xg_ + urow * D_MODEL + col) = o; }
        ss = thin::wave_sum(ss);
        if (lane < 16) ssq_[urow * 16 + lane] = lane == 0 ? ss : 0.f;
    }
}

struct Args { const float* in[27]; float* out; unsigned char* ws; int ph_lo, ph_hi; };
constexpr int NPHASE = 15;

__global__ void __launch_bounds__(NWAVES * 64, 2) fwd_kernel(Args args) {
    extern __shared__ __attribute__((aligned(16))) unsigned char lds_raw[];
    LAS unsigned char* lds = (LAS unsigned char*)lds_raw;
    char* ldsg = (char*)lds_raw;
    const int tid = threadIdx.x, wave = __builtin_amdgcn_readfirstlane(tid >> 6); int lane = tid & 63;
#define RELANE() do { int t_ = threadIdx.x; asm volatile("" : "+v"(t_)); lane = t_ & 63; } while (0)
    const int G = gridDim.x; const int bx = blockIdx.x; const int vcu = (G % 8 == 0) ? (bx % 8) * (G / 8) + bx / 8 : bx;
    unsigned char* ws = args.ws;
    typedef __attribute__((address_space(4))) const Args* KArgs;
#define KA(i) (((KArgs)__builtin_amdgcn_kernarg_segment_ptr())->in[i])
#define x_in KA(0)
#define c_in KA(1)
#define ctx_in KA(2)
#define cctx_in KA(3)
#define w_mod KA(4)
#define b_mod KA(5)
#define g_norm1 KA(6)
#define g_norm2 KA(7)
#define w_in KA(8)
#define conv_w KA(9)
#define conv_b KA(10)
#define lru_w_a KA(11)
#define lru_b_a KA(12)
#define lru_w_x KA(13)
#define lru_b_x KA(14)
#define lru_lambda KA(15)
#define g_q_lat KA(16)
#define w_uq KA(17)
#define g_kv_lat KA(18)
#define w_ukv KA(19)
#define g_qn KA(20)
#define g_kn KA(21)
#define w_pool KA(22)
#define pool_scale KA(23)
#define w_out KA(24)
#define w_ff1 KA(25)
#define w_ff2 KA(26)
    float* out = args.out;
#define modpart ((float*)(ws + WS_MODPART))
#define vec ((float*)(ws + WS_VEC))
#define bias_in ((float*)(ws + WS_BIASIN))
#define bias_ff ((float*)(ws + WS_BIASFF))
#define rtab ((float*)(ws + WS_RTAB))
#define agg ((float*)(ws + WS_AGG))
#define ssqx ((float*)(ws + WS_SSQX))
#define ssqkv ((float*)(ws + WS_SSQKV))
#define ssqq ((float*)(ws + WS_SSQQ))
#define rvec ((float*)(ws + WS_RVEC))
#define xg ((bf16_t*)(ws + WS_XG))
#define mix ((bf16_t*)out)
#define U ((bf16_t*)(ws + WS_U))
#define zb ((bf16_t*)(ws + WS_Z))
#define Qb ((bf16_t*)(ws + WS_Q))
#define Kb ((bf16_t*)(ws + WS_K))
#define Vb ((bf16_t*)(ws + WS_V))

    for (int u = tid; u < (LDS_BYTES - LDSCTL_OFF) / 4; u += NWAVES * 64) ((LAS unsigned*)(lds + LDSCTL_OFF))[u] = 0u;
    __syncthreads();
    const bool single = (args.ph_hi - args.ph_lo) > 1;
    XcdBarrier bar; bar.bar = (unsigned*)(ws + WS_CTL); bar.x = 0; bar.st = nullptr;
    if (single) bar = xcd_barrier_post((unsigned*)(ws + WS_CTL), (volatile LAS unsigned*)(lds + MISC_OFF) + 8);
    const int lo = args.ph_lo, hi = args.ph_hi;
#ifndef PHASE_MASK
#define PHASE_MASK 0x7FF
#endif
#define IN(k) (lo <= (k) && (k) < hi)
#ifndef GATE_PA
#define GATE_PA 1
#endif
#ifndef GATE_PD
#define GATE_PD 1
#endif
#ifndef DUP_MASK
#define DUP_MASK 0x7FF
#endif
#define EN(j) (((PHASE_MASK >> (j)) & 1) && (rep_ > 0 || NREP_CUR == 1 || ((DUP_MASK >> (j)) & 1)))
#ifndef DUP_PHASE
#define DUP_PHASE (-1)
#endif
#define NREP(k) (((k) == DUP_PHASE) ? 2 : 1)
#define SEAM(k) do { if (IN(k) && IN((k) + 1)) xcd_barrier(bar); } while (0)
    const int gw = vcu * NWAVES + wave, NGW = G * NWAVES;

    for (int rep_ = 0, NREP_CUR = NREP(0); rep_ < NREP_CUR; ++rep_) { if (rep_) xcd_barrier(bar);
    if (EN(0) && IN(0)) {
        float* sl = (float*)ldsg;
        for (int i = tid; i < 9 * 1024; i += NWAVES * 64) { const float v = i < 8192 ? c_in[i] : cctx_in[i - 8192]; sl[i] = v / (1.0f + expf(-v)); }
        __syncthreads();
        for (int it = gw; it < 2 * 96 * 8; it += NGW) {
            const int l = it / 768, r = it - l * 768, cg = r >> 3, ks = r & 7;
            float acc[9];
#pragma unroll
            for (int b = 0; b < 9; ++b) acc[b] = 0.f;
            const float* wp = w_mod + ((size_t)l * 1024 + ks * 128) * 6144 + cg * 64 + lane;
#pragma unroll 8
            for (int kk = 0; kk < 128; ++kk) { const float w = wp[(size_t)kk * 6144];
#pragma unroll
                for (int b = 0; b < 9; ++b) acc[b] += sl[b * 1024 + ks * 128 + kk] * w; }
#pragma unroll
            for (int b = 0; b < 9; ++b) modpart[((size_t)(ks * 2 + l) * 9 + b) * 6144 + cg * 64 + lane] = acc[b];
        }
        __syncthreads();
        if (bx == 0) for (int i = tid; i < 512; i += NWAVES * 64) { const int pos = i >> 3, f = i & 7; const float fr = powf(10000.0f, -(float)f / 8.0f), ang = (float)pos * fr; rtab[i * 2] = cosf(ang); rtab[i * 2 + 1] = sinf(ang); }
        LAS float* scr = (LAS float*)(lds + wave * 16384);
        constexpr int I_IN = 768, I_UQ = 144, I_UKV = 128, I_OUT = 512, I_FF1 = 2048, I_FF2 = 2048, I_G = 32, I_P = 8, I_L = I_IN + I_UQ + I_UKV + I_OUT + I_FF1 + I_FF2 + I_G + I_P;
        for (int it = gw; it < 2 * I_L; it += NGW) {
            const int l = it / I_L; int r = it - l * I_L; bf16_t* wt = (bf16_t*)(ws + WS_WT + (size_t)l * WT_LAYER);
            if (r < I_IN) { const int pg = r >> 4, kb = r & 15; int src = 0; bool z0 = false, rp = false;
                if (pg < 16) src = 32 * pg; else if (pg < 24) src = 896 + 32 * (pg - 16); else if (pg < 32) src = 1184 + 32 * (pg - 24); else if (pg < 44) src = 512 + 32 * (pg - 32); else if (pg == 44) { src = 1152; rp = true; } else z0 = true;
                thin::transpose_tile(w_in + (size_t)l * 1024 * D_IN, D_IN, wt + WT_IN / 2, 1024, kb * 64, pg * 32, src, rp, nullptr, nullptr, z0, scr, lane); continue; } r -= I_IN;
            if (r < I_UQ) { const int pg = r / 6, kb = r - pg * 6;
                thin::transpose_tile(w_uq + (size_t)l * 384 * 768, 768, wt + WT_UQ / 2, 384, kb * 64, pg * 32, pg * 32, (pg % 3) == 2, g_q_lat + l * 384, nullptr, false, scr, lane); continue; } r -= I_UQ;
            if (r < I_UKV) { const int pg = r >> 2, kb = r & 3, pn = pg >> 3, bj = (pg >> 2) & 1, wc = pg & 3;
                const int src = pn < 2 ? (4 * pn + wc) * 128 + 32 * bj : (4 * (pn - 2) + wc) * 128 + 64 + 32 * bj;
                thin::transpose_tile(w_ukv + (size_t)l * 256 * 1024, 1024, wt + WT_UKV / 2, 256, kb * 64, pg * 32, src, false, g_kv_lat + l * 256, nullptr, false, scr, lane); continue; } r -= I_UKV;
            if (r < I_OUT) { const int pg = r >> 4, kb = r & 15;
                thin::transpose_tile(w_out + (size_t)l * 1024 * 1024, 1024, wt + WT_OUT / 2, 1024, kb * 64, pg * 32, pg * 32, false, nullptr, nullptr, false, scr, lane); continue; } r -= I_OUT;
            if (r < I_FF1) { const int pg = r >> 4, kb = r & 15;
                thin::transpose_tile(w_ff1 + (size_t)l * 1024 * 4096, 4096, wt + WT_FF1 / 2, 1024, kb * 64, pg * 32, pg * 32, false, nullptr, nullptr, false, scr, lane); continue; } r -= I_FF1;
            if (r < I_FF2) { const int pg = r >> 6, kb = r & 63;
                thin::transpose_tile(w_ff2 + (size_t)l * 4096 * 1024, 1024, wt + WT_FF2 / 2, 4096, kb * 64, pg * 32, pg * 32, false, nullptr, nullptr, false, scr, lane); continue; } r -= I_FF2;
            if (r < I_G) { const int mat = r >> 1, pg = r & 1, dir = mat >> 3, gate = (mat >> 2) & 1, hd = mat & 3;
                const float* src = (gate ? lru_w_x : lru_w_a) + ((size_t)((l * 2 + dir) * 4 + hd)) * 4096;
                thin::transpose_tile(src, 64, wt + WT_GATE / 2 + (size_t)mat * 4096, 64, 0, pg * 32, pg * 32, false, nullptr, nullptr, false, scr, lane); continue; } r -= I_G;
            { const int g = r >> 1, pg = r & 1;
                thin::transpose_tile(w_pool + (size_t)(l * 4 + g) * 4096, 64, wt + WT_POOL / 2 + (size_t)g * 4096, 64, 0, pg * 32, pg * 32, false, nullptr, pool_scale + l * 256 + g * 64 + pg * 32, false, scr, lane); }
        }
        __syncthreads();
    }
    } SEAM(0);
    for (int rep_ = 0, NREP_CUR = NREP(1); rep_ < NREP_CUR; ++rep_) { if (rep_) xcd_barrier(bar);
    if (EN(0) && IN(1)) {
        const int gt = vcu * (NWAVES * 64) + tid;
        if (gt < 2 * 9 * 1024) {
            const int l = gt / 9216, r = gt - l * 9216, b = r >> 10, j = r & 1023;
            float m[6];
#pragma unroll
            for (int s = 0; s < 6; ++s) { float a = b_mod[l * 6144 + s * 1024 + j];
#pragma unroll
                for (int ks = 0; ks < 8; ++ks) a += modpart[((size_t)(ks * 2 + l) * 9 + b) * 6144 + s * 1024 + j];
                m[s] = a; }
            float* v = vec + (size_t)(l * 9 + b) * 6144 + j;
            float gm1 = g_norm1[l * 1024 + j] * (1.0f + m[1]), gm2 = g_norm2[l * 1024 + j] * (1.0f + m[4]);
            gm1 = fabsf(gm1) < 1e-20f ? 1e-20f : gm1; gm2 = fabsf(gm2) < 1e-20f ? 1e-20f : gm2;
            v[VEC_GM1 * 1024] = gm1; v[VEC_G1 * 1024] = m[2];
            v[VEC_GM2 * 1024] = gm2; v[VEC_G2 * 1024] = m[5];
            rvec[(size_t)(l * 9 + b) * 2048 + j] = 1.0f / gm1; rvec[(size_t)(l * 9 + b) * 2048 + 1024 + j] = 1.0f / gm2;
            v[VEC_SH1 * 1024] = m[0]; v[VEC_SH2 * 1024] = m[3];
        }
    }
    } SEAM(1);
    for (int rep_ = 0, NREP_CUR = NREP(2); rep_ < NREP_CUR; ++rep_) { if (rep_) xcd_barrier(bar);
    if (EN(0) && IN(2)) {
        RELANE();
        float* sl = (float*)ldsg;
        for (int combo = 0; combo < 4; ++combo) {
            const int l = combo >> 1, mat = combo & 1, N = mat ? D_FF : ZW;
            __syncthreads();
            for (int i = tid; i < 9 * 1024; i += NWAVES * 64) sl[i] = vec[(size_t)(l * 9 + (i >> 10)) * 6144 + (mat ? VEC_SH2 : VEC_SH1) * 1024 + (i & 1023)];
            __syncthreads();
            const bf16_t* wt = (const bf16_t*)(ws + WS_WT + (size_t)l * WT_LAYER + (mat ? WT_FF1 : WT_IN));
            float* bo = (mat ? bias_ff : bias_in) + (size_t)l * 9 * N;
            for (int n = gw; n < N; n += NGW) {
                const u32x4 w0 = *(const u32x4*)(wt + (size_t)n * 1024 + 8 * lane), w1 = *(const u32x4*)(wt + (size_t)n * 1024 + 512 + 8 * lane);
                float wv[16] = {bflo(w0.x), bfhi(w0.x), bflo(w0.y), bfhi(w0.y), bflo(w0.z), bfhi(w0.z), bflo(w0.w), bfhi(w0.w), bflo(w1.x), bfhi(w1.x), bflo(w1.y), bfhi(w1.y), bflo(w1.z), bfhi(w1.z), bflo(w1.w), bfhi(w1.w)};
#pragma unroll
                for (int b = 0; b < 9; ++b) { float s = 0.f;
#pragma unroll
                    for (int i = 0; i < 8; ++i) s += wv[i] * sl[b * 1024 + 8 * lane + i] + wv[8 + i] * sl[b * 1024 + 512 + 8 * lane + i];
                    s = thin::wave_sum(s); if (lane == 0) bo[b * N + n] = s; }
            }
        }
        RELANE();
        for (int r0 = gw * 2; r0 < MROWS; r0 += NGW * 2) {
            f32x4 v[2][4]; const float* gmv[2];
#pragma unroll
            for (int q = 0; q < 2; ++q) { const int r = r0 + q, b = r / TPB, tt = r - b * TPB, bidx = tt < CTX ? 8 : b;
                const float* src = tt < CTX ? ctx_in + ((size_t)b * CTX + tt) * D_MODEL : x_in + ((size_t)b * SEQ + (tt - CTX)) * D_MODEL;
                gmv[q] = vec + (size_t)(0 * 9 + bidx) * 6144 + VEC_GM1 * 1024;
#pragma unroll
                for (int j = 0; j < 4; ++j) v[q][j] = *(const f32x4*)(src + 256 * j + 4 * lane); }
#pragma unroll
            for (int q = 0; q < 2; ++q) { const int r = r0 + q; float ss = 0.f;
#pragma unroll
                for (int j = 0; j < 4; ++j) { const f32x4 g4 = *(const f32x4*)(gmv[q] + 256 * j + 4 * lane); ss += epi::sq4(v[q][j]);
                    const f32x4 t = v[q][j] * g4; u32x2 w; w.x = cvt_pk_bf16(t[0], t[1]); w.y = cvt_pk_bf16(t[2], t[3]); *(u32x2*)(xg + (size_t)r * D_MODEL + 256 * j + 4 * lane) = w; }
                ss = thin::wave_sum(ss);
                if (lane < 16) ssqx[(size_t)r * 16 + lane] = lane == 0 ? ss : 0.f; }
        }
    }
    } SEAM(2);
    for (int l = 0; l < DEPTH; ++l) {
        const int p0 = 3 + 6 * l; const bool lastl = (l == DEPTH - 1);
        const unsigned char* wtl = ws + WS_WT + (size_t)l * WT_LAYER;
        const float* vl = vec + (size_t)l * 9 * 6144;
    for (int rep_ = 0, NREP_CUR = NREP(p0); rep_ < NREP_CUR; ++rep_) { if (rep_) xcd_barrier(bar);
        if (EN(1) && IN(p0)) {
            pg8::Gemm g{xg, (const bf16_t*)(wtl + WT_IN)}; pg8::StaticOrder S; S.init(GATE_PA ? 128 : NPAN, ZW / 256, G, bx, GATE_PA ? 1 : 0);
            epi::EpiIn E{zb, ssqx, bias_in + (size_t)l * 9 * ZW, ssqkv, g_kn + l * 96, rtab};
            pg8::gemm_phase<1024, 1024, 1024, false>(lds, g, S, E);
        }
        } SEAM(p0);
    for (int rep_ = 0, NREP_CUR = NREP(p0 + 1); rep_ < NREP_CUR; ++rep_) { if (rep_) xcd_barrier(bar);
        if (IN(p0 + 1)) {
            unsigned* gate1 = (unsigned*)(ws + WS_CTL) + 4096 + 1024 + 1024 * l; unsigned* tmo = (unsigned*)(ws + WS_CTL) + XB_TMO;
            const unsigned need = lastl ? 24u : 48u;
            if (GATE_PA && EN(3)) {
                pg8::Gemm ga{xg, (const bf16_t*)(wtl + WT_IN)}; pg8::CtxProdOrder SP;
                if (lastl) SP.init(bx, 192, 2, 3, 0x520u, gate1);
                else SP.init_unit((bx >= 192 && (bx & 7) >= 1 && (bx & 7) <= 6) ? ((bx - 192) >> 3) * 6 + (bx & 7) - 1 : -1, 6, 0x543210u, gate1);
                epi::EpiIn Ea{zb, ssqx, bias_in + (size_t)l * 9 * ZW, ssqkv, g_kn + l * 96, rtab}; pg8::gemm_phase<1024, 1024, 1024, false>(lds, ga, SP, Ea);
            }
            thin::LruP P{zb, conv_w + l * 1024, conv_b + l * 256, (const bf16_t*)(wtl + WT_GATE), lru_b_a + l * 512, lru_b_x + l * 512, lru_lambda + l * 512, agg, mix};
            if (GATE_PA) {
                if (EN(4)) for (int it = G - 1 - vcu; it < 128 * 4; it += G) { const int pl = it >> 2; thin::lru_item<1>(P, pl + pl / 16 + 1, it & 3, ldsg); }
                if (EN(5)) for (int it = vcu; it < 128 * 4; it += G) { const int pl = it >> 2; thin::pool_item(zb, (const bf16_t*)(wtl + WT_POOL), mix, pl + pl / 16 + 1, it & 3, ldsg); }
            }
            if (EN(2)) { pg8::Gemm g{zb + Z_QL, (const bf16_t*)(wtl + WT_UQ)}; epi::EpiQ E{Qb, ssqq, g_qn + l * 96, rtab};
              if (GATE_PA && !lastl) { pg8::GatedOrder SG; SG.init(3, G, bx, gate1, need, tmo); pg8::gemm_phase<384, ZW, 384, false>(lds, g, SG, E); }
              else { pg8::StaticOrder S; S.init(lastl ? 128 : NPAN, 3, G, bx, lastl ? 1 : 0); pg8::gemm_phase<384, ZW, 384, false>(lds, g, S, E); } }
            if (EN(3)) { pg8::Gemm g{zb + Z_KVL, (const bf16_t*)(wtl + WT_UKV)}; epi::EpiKV E{Kb, Vb, zb, ssqkv, g_kn + l * 96};
              if (GATE_PA) { pg8::GatedOrder SG; SG.init(4, G, (bx + 96) % G, gate1, need, tmo); pg8::gemm_phase<256, ZW, 256, false>(lds, g, SG, E); }
              else { pg8::StaticOrder S; S.init(NPAN, 4, G, (bx + 96) % G, 0); pg8::gemm_phase<256, ZW, 256, false>(lds, g, S, E); } }
            if (GATE_PA) {
                if (EN(4) && G - 1 - vcu < 32) { const int it = G - 1 - vcu; gate_wait(gate1 + 64 * (it >> 2), need, tmo); thin::lru_item<1>(P, (it >> 2) * 17, it & 3, ldsg); }
                if (EN(5) && !lastl && vcu < 32) { gate_wait(gate1 + 64 * (vcu >> 2), need, tmo); thin::pool_item(zb, (const bf16_t*)(wtl + WT_POOL), mix, (vcu >> 2) * 17, vcu & 3, ldsg); }
            } else {
                if (EN(4)) for (int it = G - 1 - vcu; it < NPAN * 4; it += G) thin::lru_item<1>(P, it >> 2, it & 3, ldsg);
                if (!EN(5)) {} else if (lastl) { for (int it = vcu; it < 128 * 4; it += G) { const int pl = it >> 2; thin::pool_item(zb, (const bf16_t*)(wtl + WT_POOL), mix, pl + pl / 16 + 1, it & 3, ldsg); } }
                else { for (int it = vcu; it < NPAN * 4; it += G) thin::pool_item(zb, (const bf16_t*)(wtl + WT_POOL), mix, it >> 2, it & 3, ldsg); }
            }
        }
        } SEAM(p0 + 1);
    for (int rep_ = 0, NREP_CUR = NREP(p0 + 2); rep_ < NREP_CUR; ++rep_) { if (rep_) xcd_barrier(bar);
        if (IN(p0 + 2)) {
#ifndef SHIFT_THRESH
#define SHIFT_THRESH 64.0f
#endif
            float negB2; bool shifted;
            {
                const float* gq = g_qn + l * 96; const float* gk = g_kn + l * 96;
                int ln = threadIdx.x; asm volatile("" : "+v"(ln)); ln &= 63;
                float mq = fmaxf(fabsf(gq[ln]), ln < 32 ? fabsf(gq[64 + ln]) : 0.f), mk = fmaxf(fabsf(gk[ln]), ln < 32 ? fabsf(gk[64 + ln]) : 0.f);
#pragma unroll
                for (int o = 1; o < 64; o <<= 1) { mq = fmaxf(mq, __shfl_xor(mq, o)); mk = fmaxf(mk, __shfl_xor(mk, o)); }
                negB2 = -(96.0f * 1.02f * QSCALE) * mq * mk;
                shifted = __builtin_amdgcn_readfirstlane(negB2 < -SHIFT_THRESH ? 1 : 0) != 0;
                if (!shifted) negB2 = 0.f;
            }
            thin::LruP P{zb, conv_w + l * 1024, conv_b + l * 256, (const bf16_t*)(wtl + WT_GATE), lru_b_a + l * 512, lru_b_x + l * 512, lru_lambda + l * 512, agg, mix};
            if (!EN(6)) {} else if (lastl) { for (int it = vcu; it < 128 * 4; it += G) { const int pl = it >> 2; thin::lru_item<2>(P, pl + pl / 16 + 1, it & 3, ldsg); } }
            else { for (int it = vcu; it < NPAN * 4; it += G) thin::lru_item<2>(P, it >> 2, it & 3, ldsg); }
            if (EN(7)) for (int it = vcu; it < 1024; it += G) {
                const int bh = it >> 4, qp = it & 15, b = bh >> 3, h = bh & 7;
                #ifdef ATT_VAR
                if (rep_ == 0 && NREP(p0 + 2) == 2) att::attn_unit<ATT_VAR>(Qb, Kb, Vb, mix, ssqkv, ssqq, negB2, b * TPB + CTX + qp * 256, b * TPB, TPB, h, ldsg); else
#endif
                if (shifted) att::attn_unit<9>(Qb, Kb, Vb, mix, ssqkv, ssqq, negB2, b * TPB + CTX + qp * 256, b * TPB, TPB, h, ldsg);
                else att::attn_unit<0>(Qb, Kb, Vb, mix, ssqkv, ssqq, negB2, b * TPB + CTX + qp * 256, b * TPB, TPB, h, ldsg);
            }
            if (EN(7) && !lastl) for (int it = G - 1 - vcu; it < 64; it += G) { const int b = it >> 3, h = it & 7;
                if (shifted) att::attn_unit<9>(Qb, Kb, Vb, mix, ssqkv, ssqq, negB2, b * TPB, b * TPB, CTX, h, ldsg); else att::attn_unit<0>(Qb, Kb, Vb, mix, ssqkv, ssqq, negB2, b * TPB, b * TPB, CTX, h, ldsg); }
        }
        } SEAM(p0 + 2);
    for (int rep_ = 0, NREP_CUR = NREP(p0 + 3); rep_ < NREP_CUR; ++rep_) { if (rep_) xcd_barrier(bar);
        if (EN(8) && IN(p0 + 3)) {
            pg8::Gemm g{mix, (const bf16_t*)(wtl + WT_OUT)}; pg8::StaticOrder S; S.init((lastl || GATE_PD) ? 128 : NPAN, 4, G, bx, (lastl || GATE_PD) ? 1 : 0);
            if (l == 0) { epi::EpiRes<true, false> E{x_in, ctx_in, nullptr, xg, ssqx, vl + VEC_G1 * 1024, nullptr, vl + VEC_GM2 * 1024}; pg8::gemm_phase<1024, 1024, 1024, false>(lds, g, S, E); }
            else { epi::EpiRes<false, false> E{nullptr, nullptr, nullptr, xg, ssqx, vl + VEC_G1 * 1024, rvec + (size_t)l * 9 * 2048, vl + VEC_GM2 * 1024}; pg8::gemm_phase<1024, 1024, 1024, false>(lds, g, S, E); }
        }
        } SEAM(p0 + 3);
    for (int rep_ = 0, NREP_CUR = NREP(p0 + 4); rep_ < NREP_CUR; ++rep_) { if (rep_) xcd_barrier(bar);
        if (EN(9) && IN(p0 + 4)) {
            unsigned* gate0 = (unsigned*)(ws + WS_CTL) + 4096;
            if (GATE_PD && !lastl) {
                pg8::Gemm gd{mix, (const bf16_t*)(wtl + WT_OUT)}; pg8::CtxProdOrder SP; SP.init(bx, 128, 3, 4, 0x3210u, gate0);
                epi::EpiRes<true, false> Ed{x_in, ctx_in, nullptr, xg, ssqx, vl + VEC_G1 * 1024, nullptr, vl + VEC_GM2 * 1024}; pg8::gemm_phase<1024, 1024, 1024, false>(lds, gd, SP, Ed);
            }
            pg8::Gemm g{xg, (const bf16_t*)(wtl + WT_FF1)}; pg8::StaticOrder S; S.init(lastl ? 128 : NPAN, 16, G, bx, lastl ? 1 : 0);
            epi::EpiFF1 E{U, ssqx, bias_ff + (size_t)l * 9 * D_FF};
            if (GATE_PD && !lastl) { pg8::GatedOrder SG; SG.init(16, G, bx, gate0, 32u, (unsigned*)(ws + WS_CTL) + XB_TMO); pg8::gemm_phase<1024, 1024, 1024, false>(lds, g, SG, E); } else
#ifdef NULL_DUP
            if (rep_ == 0 && NREP_CUR == 2) { epi::EpiSink E0{(float*)(ws + WS_CTL + 65536)}; pg8::gemm_phase<1024, 1024, 1024, false>(lds, g, S, E0); } else
#endif
            pg8::gemm_phase<1024, 1024, 1024, false>(lds, g, S, E);
        }
        } SEAM(p0 + 4);
    for (int rep_ = 0, NREP_CUR = NREP(p0 + 5); rep_ < NREP_CUR; ++rep_) { if (rep_) xcd_barrier(bar);
        if (EN(10) && IN(p0 + 5)) {
            pg8::Gemm g{U, (const bf16_t*)(wtl + WT_FF2)}; pg8::StaticOrder S; S.init(lastl ? 128 : NPAN, 4, G, bx, lastl ? 1 : 0);
#ifdef NULL_DUP
            if (rep_ == 0 && NREP_CUR == 2) { pg8::StaticOrder SL; SL.init(128, 4, G, bx, 1); epi::EpiSink E0{(float*)(ws + WS_CTL + 65536)}; pg8::gemm_phase<4096, 4096, 4096, true>(lds, g, SL, E0); } else
#endif
            if (lastl) { epi::EpiRes<false, true> E{nullptr, nullptr, out, xg, nullptr, vl + VEC_G2 * 1024, rvec + (size_t)l * 9 * 2048 + 1024, nullptr}; pg8::gemm_phase<4096, 4096, 4096, true>(lds, g, S, E); }
            else {
                { pg8::StaticOrder SL; SL.init(128, 4, G, bx, 1);
                  epi::EpiRes<false, false> E{nullptr, nullptr, nullptr, xg, ssqx, vl + VEC_G2 * 1024, rvec + (size_t)l * 9 * 2048 + 1024, vec + (size_t)(l + 1) * 9 * 6144 + VEC_GM1 * 1024}; pg8::gemm_phase<4096, 4096, 4096, true>(lds, g, SL, E); }
                float* slab = out + (size_t)18 * 1024 * 1024;
                { pg8::CtxSplitOrder SC{4, 4, 1024, G, bx, 1}; epi::EpiSlab E{slab, 1024}; pg8::gemm_phase<1024, 4096, 4096, true>(lds, g, SC, E); }
                xcd_barrier(bar);
                ctx_combine(ws, out, rvec + (size_t)(l * 9 + 8) * 2048 + 1024, vl + 8 * 6144 + VEC_G2 * 1024, vec + (size_t)(l + 1) * 9 * 6144 + 8 * 6144 + VEC_GM1 * 1024, gw, NGW, (int)threadIdx.x);
            }
        }
        } if (!lastl) SEAM(p0 + 5);
    }
#undef IN
#undef SEAM
}


#ifdef DBG_DUMP
__global__ void dbg_dump(const bf16_t* buf, int pitch, int coloff, int ncols, float* out) {
    for (size_t i = blockIdx.x * (size_t)blockDim.x + threadIdx.x; i < (size_t)BATCH * SEQ * D_MODEL; i += (size_t)gridDim.x * blockDim.x) {
        const int c = (int)(i & 1023); const size_t rt = i >> 10; const int b = (int)(rt / SEQ), t = (int)(rt - (size_t)b * SEQ);
        out[i] = c < ncols ? bf2f(buf[((size_t)b * TPB + CTX + t) * pitch + coloff + c]) : 0.f;
    }
}
#endif
#ifndef N_LAUNCH_MODE
#define N_LAUNCH_MODE 1
#endif
extern "C" void kernel_launch(void* const* d_in, const int* in_sizes, int n_in, void* d_out, int out_size, void* d_ws, size_t ws_size, hipStream_t stream) {
    static int grid = 0;
    if (grid == 0) {
        if (n_in != 27 || in_sizes[0] != BATCH * SEQ * D_MODEL || out_size != BATCH * SEQ * D_MODEL || ws_size < WS_END) { fprintf(stderr, "kernel_launch: unexpected shapes (n_in %d, in0 %d, out %d, ws %zu < %zu)\n", n_in, n_in > 0 ? in_sizes[0] : -1, out_size, ws_size, (size_t)WS_END); grid = -1; return; }
        int dev = 0, cus = 0, per_cu = 0;
        if (hipGetDevice(&dev) != hipSuccess || hipDeviceGetAttribute(&cus, hipDeviceAttributeMultiprocessorCount, dev) != hipSuccess) { grid = -1; return; }
        if (hipFuncSetAttribute((const void*)fwd_kernel, hipFuncAttributeMaxDynamicSharedMemorySize, LDS_BYTES) != hipSuccess) { fprintf(stderr, "kernel_launch: hipFuncSetAttribute failed\n"); grid = -1; return; }
        if (hipOccupancyMaxActiveBlocksPerMultiprocessor(&per_cu, (const void*)fwd_kernel, NWAVES * 64, LDS_BYTES) != hipSuccess || per_cu < 1) { fprintf(stderr, "kernel_launch: occupancy query says %d blocks per CU\n", per_cu); (void)hipGetLastError(); grid = -1; return; }
        grid = cus;
    }
    if (grid < 0) return;
    (void)hipMemsetAsync((char*)d_ws + WS_CTL, 0, CTL_ZERO_BYTES, stream);
    Args a{};
    for (int i = 0; i < 27; ++i) a.in[i] = (const float*)d_in[i];
    a.out = (float*)d_out; a.ws = (unsigned char*)d_ws;
#if N_LAUNCH_MODE
    a.ph_lo = 0; a.ph_hi = NPHASE;
    void* kargs[] = {&a};
    hipError_t e = hipLaunchCooperativeKernel((const void*)fwd_kernel, dim3(grid), dim3(NWAVES * 64), kargs, LDS_BYTES, stream);
    if (e != hipSuccess) fprintf(stderr, "kernel_launch: cooperative launch failed: %s\n", hipGetErrorString(e));
#else
#ifndef DBG_STOP_PHASE
#define DBG_STOP_PHASE NPHASE
#endif
    for (int p = 0; p < DBG_STOP_PHASE; ++p) { a.ph_lo = p; a.ph_hi = p + 1; hipLaunchKernelGGL(fwd_kernel, dim3(grid), dim3(NWAVES * 64), LDS_BYTES, stream, a); }
#ifdef DBG_DUMP
    hipLaunchKernelGGL(dbg_dump, dim3(2048), dim3(256), 0, stream, (const bf16_t*)((unsigned char*)d_ws + DBG_DUMP_OFF), DBG_DUMP_PITCH, DBG_DUMP_COL, DBG_DUMP_NCOLS, (float*)d_out);
#endif
#endif
}
```

```cpp
#include <hip/hip_runtime.h>
#include <cstdio>
#include <cstdint>

#define LAS __attribute__((address_space(3)))
#define GAS __attribute__((address_space(1)))
typedef unsigned short bf16_t;
typedef short bf16x8 __attribute__((ext_vector_type(8)));
typedef short s16x4 __attribute__((ext_vector_type(4)));
typedef float f32x4 __attribute__((ext_vector_type(4)));
typedef float f32x2 __attribute__((ext_vector_type(2)));
typedef float f32x16 __attribute__((ext_vector_type(16)));
typedef unsigned u32x4 __attribute__((ext_vector_type(4)));
typedef unsigned u32x2 __attribute__((ext_vector_type(2)));

constexpr int D_MODEL = 1024, BATCH = 8, SEQ = 4096, DEPTH = 2, CTX = 256, D_IN = 1440, D_FF = 4096;
constexpr int TPB = SEQ + CTX;
constexpr int MROWS = BATCH * TPB;
constexpr int PPB = TPB / 256;
constexpr int NPAN = MROWS / 256;
constexpr int ZW = 1536;
constexpr int Z_LX = 0, Z_LG = 256, Z_KVL = 512, Z_PU = 768, Z_QL = 1024, Z_KR = 1408;
constexpr float EPS = 1e-6f;
constexpr float QSCALE = 0.10206207261596575f * 1.4426950408889634f;

typedef __bf16 bf16x2_t __attribute__((ext_vector_type(2)));
__device__ __forceinline__ unsigned cvt_pk_bf16(float lo, float hi) { f32x2 v = {lo, hi}; bf16x2_t b = __builtin_convertvector(v, bf16x2_t); return __builtin_bit_cast(unsigned, b); }
__device__ __forceinline__ float bf2f(unsigned short h) { return __uint_as_float((unsigned)h << 16); }
__device__ __forceinline__ float bflo(unsigned w) { return __uint_as_float(w << 16); }
__device__ __forceinline__ float bfhi(unsigned w) { return __uint_as_float(w & 0xffff0000u); }
__device__ __forceinline__ unsigned short f2bf(float f) { unsigned u = __float_as_uint(f); return (unsigned short)((u + 0x7fffu + ((u >> 16) & 1u)) >> 16); }

namespace pg8 {
constexpr int BM = 256, BK = 64, HALF = 128, HTB = HALF * BK * 2, STAGE_BYTES = 8 * HTB, NXCD = 8, WGM = 8;
__host__ __device__ __forceinline__ int lds_byte(int r, int c) { const int st = (r >> 4) * 2 + (c >> 5), rr = r & 15, cc = c & 31, ob = rr * 64 + cc * 2; return st * 1024 + (ob ^ (((ob >> 9) & 1) << 5)); }
__host__ __device__ __forceinline__ void stage_rc(int b, int& R, int& C) { const int st = b / 1024, sb = b % 1024, swz = sb ^ (((sb >> 9) & 1) << 5); R = (st >> 1) * 16 + swz / 64; C = (st & 1) * 32 + (swz % 64) / 2; }
__host__ __device__ __forceinline__ int perm32(int rho) { const int n = rho >> 4, i = rho & 15; return 8 * (i >> 2) + 4 * n + (i & 3); }

struct Unit { int pm, pn; unsigned koffA, koffB; };
struct Gemm { const bf16_t* A; const bf16_t* Bt; };

struct StaticOrder {
    int nM, nN, nwg, G, c, latonly;
    __device__ void init(int nM_, int nN_, int G_, int c_, int latonly_) { nM = nM_; nN = nN_; nwg = nM * nN; G = G_; c = c_; latonly = latonly_; }
    __device__ bool next(int i, Unit& u) const {
        const long L = (long)i * G + c; if (L >= nwg) return false;
        int wgid = (int)L; { const int q = nwg / NXCD, r = nwg % NXCD, xcd = wgid % NXCD, off = wgid / NXCD; wgid = (xcd < r ? xcd * (q + 1) : r * (q + 1) + (xcd - r) * q) + off; }
        const int nig = WGM * nN, gid = wgid / nig, fm = gid * WGM, gsz = (nM - fm) < WGM ? (nM - fm) : WGM;
        int pm = fm + ((wgid % nig) % gsz); u.pn = (wgid % nig) / gsz;
        if (latonly) pm = pm + pm / 16 + 1;
        u.pm = pm; u.koffA = 0u; u.koffB = 0u; return true;
    }
    __device__ __forceinline__ void a_ready(const Unit&) const {}
    __device__ __forceinline__ void done(const Unit&) const {}
};
struct CtxSplitOrder {
    int nN, NS, KS, G, c, ablk;
    __device__ bool next(int i, Unit& u) const {
        const int L = i * G + c; if (L >= 8 * nN * NS) return false;
        const int ks = L % NS, t = L / NS; u.pn = t % nN; u.pm = (t / nN) * 17; u.koffB = (unsigned)(ks * KS * 2); u.koffA = ablk ? (unsigned)(ks * (KS / 32) * 16384) : u.koffB; return true;
    }
    __device__ __forceinline__ void a_ready(const Unit&) const {}
    __device__ __forceinline__ void done(const Unit&) const {}
};
struct CtxProdOrder {
    int unit, nsel; unsigned pnlist; unsigned* ready;
    __device__ __forceinline__ void init(int c, int c0, int cstride, int nsel_, unsigned pnlist_, unsigned* ready_) { const int d = c - c0; unit = (d >= 0 && d % cstride == 0 && d / cstride < 8 * nsel_) ? d / cstride : -1; nsel = nsel_; pnlist = pnlist_; ready = ready_; }
    __device__ __forceinline__ void init_unit(int unit_, int nsel_, unsigned pnlist_, unsigned* ready_) { unit = unit_ < 8 * nsel_ ? unit_ : -1; nsel = nsel_; pnlist = pnlist_; ready = ready_; }
    __device__ __forceinline__ bool next(int i, Unit& u) const { if (i != 0 || unit < 0) return false; u.pm = 17 * (unit / nsel); u.pn = (int)((pnlist >> (4 * (unit % nsel))) & 15u); u.koffA = 0u; u.koffB = 0u; return true; }
    __device__ __forceinline__ void a_ready(const Unit&) const {}
    __device__ __forceinline__ void done(const Unit& u) const {
        asm volatile("s_waitcnt vmcnt(0)" ::: "memory");
        __builtin_amdgcn_fence(__ATOMIC_RELEASE, "agent");
        asm volatile("s_waitcnt vmcnt(0)" ::: "memory");
        if ((threadIdx.x & 63) == 0) (void)__hip_atomic_fetch_add(ready + 64 * (u.pm / 17), 1u, __ATOMIC_RELAXED, __HIP_MEMORY_SCOPE_AGENT);
    }
};
struct GatedOrder {
    int nN, nwg, G, c, pn0; const unsigned* ready; unsigned need; unsigned* tmo;
    __device__ __forceinline__ void init(int nN_, int G_, int c_, const unsigned* ready_, unsigned need_, unsigned* tmo_, int pn0_ = 0) { nN = nN_; nwg = 136 * nN_; G = G_; c = c_; ready = ready_; need = need_; tmo = tmo_; pn0 = pn0_; }
    __device__ __forceinline__ bool next(int i, Unit& u) const {
        const long L = (long)i * G + c; if (L >= nwg) return false;
        int wgid = (int)L; { const int q = nwg / NXCD, r = nwg % NXCD, xcd = wgid % NXCD, off = wgid / NXCD; wgid = (xcd < r ? xcd * (q + 1) : r * (q + 1) + (xcd - r) * q) + off; }
        const int nig = WGM * nN, gid = wgid / nig, fm = gid * WGM;
        const int q = fm + ((wgid % nig) % WGM); u.pn = pn0 + (wgid % nig) / WGM;
        u.pm = q < 128 ? q + q / 16 + 1 : (q - 128) * 17; u.koffA = 0u; u.koffB = 0u; return true;
    }
    __device__ __forceinline__ void a_ready(const Unit& u) const {
        if (u.pm % 17 != 0) return;
        if (threadIdx.x < 64) {
            const unsigned* w = ready + 64 * (u.pm / 17); unsigned sp = 0u;
            while ((unsigned)__builtin_amdgcn_readfirstlane(__hip_atomic_load(w, __ATOMIC_RELAXED, __HIP_MEMORY_SCOPE_AGENT)) < need) {
                __builtin_amdgcn_s_sleep(2);
                if ((++sp & 255u) == 0u) { if (__hip_atomic_load(tmo, __ATOMIC_RELAXED, __HIP_MEMORY_SCOPE_AGENT)) break; if (sp > (1u << 20)) { if (threadIdx.x == 0) atomicAdd(tmo, 1u); break; } } }
            __builtin_amdgcn_fence(__ATOMIC_ACQUIRE, "agent");
            asm volatile("s_waitcnt vmcnt(0)" ::: "memory");
        }
        asm volatile("" ::: "memory"); __builtin_amdgcn_s_barrier(); asm volatile("" ::: "memory");
    }
    __device__ __forceinline__ void done(const Unit&) const {}
};

template <int K, int LDA, int LDB, bool ABLK, class Epi, class Sched>
__device__ __forceinline__ void gemm_phase(LAS unsigned char* lds, const Gemm g, const Sched& S, const Epi& E) {
    int tid = threadIdx.x; asm volatile("" : "+v"(tid));
    const int  wid = __builtin_amdgcn_readfirstlane(tid >> 6), lane = tid & 63, wr = wid >> 2, wc = wid & 3, fr = lane & 15, fq = lane >> 4;
    constexpr int nt = K / BK;
    unsigned voffA[2], voffB[2];
#pragma unroll
    for (int i = 0; i < 2; ++i) { int R, C; stage_rc(tid * 16 + i * 8192, R, C); const int Rb = Epi::PERM ? ((R & ~31) + perm32(R & 31)) : R;
        voffA[i] = ABLK ? (unsigned)((C >> 5) * 16384 + (R >> 4) * 1024 + ((R & 15) * 32 + (C & 31)) * 2) : (unsigned)(R * LDA + C) * 2u; voffB[i] = (unsigned)(Rb * LDB + C) * 2u; }
    const size_t kstep = (size_t)(BK * 2);
    const size_t kstepA = ABLK ? (size_t)32768 : kstep;
    const size_t hstepA = ABLK ? (size_t)8192 : (size_t)HALF * LDA * 2, tstepA = ABLK ? (size_t)(LDA / 32) * 16384 : 2 * hstepA;
    const size_t hstepB = (size_t)HALF * LDB * 2, tstepB = 2 * hstepB;
    const unsigned ldsw = (unsigned)wid * 1024u;
    const int aoff = lds_byte(wr * 64 + fr, fq * 8), boff = lds_byte(wc * 32 + fr, fq * 8);
#define PG8_SA(b, h) (((b) * 2 + (h)) * HTB)
#define PG8_SB(b, h) ((4 + (b) * 2 + (h)) * HTB)
#ifndef A_NT
#define A_NT 1
#endif
#define PG8_STAGE(bufoff, gbase, voff) do { _Pragma("unroll") for (int _i = 0; _i < 2; ++_i) \
        __builtin_amdgcn_global_load_lds((const unsigned*)((const char*)(gbase) + (voff)[_i]), (LAS unsigned*)(lds + (bufoff) + ldsw + _i * 8192), 16, 0, 0); } while (0)
#define PG8_STAGE_A(bufoff, gbase, voff) do { _Pragma("unroll") for (int _i = 0; _i < 2; ++_i) { \
        if (ABLK && A_NT) __builtin_amdgcn_global_load_lds((const unsigned*)((const char*)(gbase) + (voff)[_i]), (LAS unsigned*)(lds + (bufoff) + ldsw + _i * 8192), 16, 0, 2);   \
        else __builtin_amdgcn_global_load_lds((const unsigned*)((const char*)(gbase) + (voff)[_i]), (LAS unsigned*)(lds + (bufoff) + ldsw + _i * 8192), 16, 0, 0); } } while (0)
#define PG8_LDA(dst, b, h) do { _Pragma("unroll") for (int m = 0; m < 4; ++m) _Pragma("unroll") for (int k = 0; k < 2; ++k) dst[m][k] = *(const LAS bf16x8*)(lds + PG8_SA(b, h) + aoff + m * 2048 + k * 1024); } while (0)
#define PG8_LDB(dst, b, h) do { _Pragma("unroll") for (int n = 0; n < 2; ++n) _Pragma("unroll") for (int k = 0; k < 2; ++k) dst[n][k] = *(const LAS bf16x8*)(lds + PG8_SB(b, h) + boff + n * 2048 + k * 1024); } while (0)
#ifndef MMA_KOUTER
#define MMA_KOUTER 0
#endif
#if MMA_KOUTER
#define PG8_MMA(ai, bj, At, Bt) do { __builtin_amdgcn_s_setprio(1); _Pragma("unroll") for (int k = 0; k < 2; ++k) _Pragma("unroll") for (int m = 0; m < 4; ++m) _Pragma("unroll") for (int n = 0; n < 2; ++n) \
        acc[ai][bj][m][n] = __builtin_amdgcn_mfma_f32_16x16x32_bf16(Bt[n][k], At[m][k], acc[ai][bj][m][n], 0, 0, 0); __builtin_amdgcn_s_setprio(0); } while (0)
#else
#define PG8_MMA(ai, bj, At, Bt) do { __builtin_amdgcn_s_setprio(1); _Pragma("unroll") for (int m = 0; m < 4; ++m) _Pragma("unroll") for (int n = 0; n < 2; ++n) _Pragma("unroll") for (int k = 0; k < 2; ++k) \
        acc[ai][bj][m][n] = __builtin_amdgcn_mfma_f32_16x16x32_bf16(Bt[n][k], At[m][k], acc[ai][bj][m][n], 0, 0, 0); __builtin_amdgcn_s_setprio(0); } while (0)
#endif
#define PG8_WAIT_V(n) asm volatile("s_waitcnt vmcnt(" #n ")" ::: "memory")
#define PG8_WAIT_L(n) asm volatile("s_waitcnt lgkmcnt(" #n ")" ::: "memory")
#define PG8_BAR __builtin_amdgcn_s_barrier()
#define PG8_SCHED __builtin_amdgcn_sched_barrier(0)
    Unit cur, nxt; int ui = 0;
    if (!S.next(0, cur)) return;
    f32x4 acc[2][2][4][2];
#pragma unroll
    for (int a = 0; a < 2; ++a)
#pragma unroll
        for (int b = 0; b < 2; ++b)
#pragma unroll
            for (int m = 0; m < 4; ++m)
#pragma unroll
                for (int n = 0; n < 2; ++n) acc[a][b][m][n] = (f32x4){0.f, 0.f, 0.f, 0.f};
    bf16x8 At[4][2], B0[2][2], B1[2][2];
    const char* cA = (const char*)g.A + (size_t)cur.pm * tstepA + cur.koffA; const char* cB = (const char*)g.Bt + (size_t)cur.pn * tstepB + cur.koffB;
    S.a_ready(cur);
    PG8_STAGE(PG8_SB(0, 0), cB, voffB); PG8_STAGE(PG8_SB(0, 1), cB + hstepB, voffB); PG8_STAGE_A(PG8_SA(0, 0), cA, voffA); PG8_STAGE_A(PG8_SA(0, 1), cA + hstepA, voffA);
    if (wr == 1) PG8_BAR;
    PG8_WAIT_V(2); PG8_BAR;
    PG8_STAGE(PG8_SB(1, 0), cB + kstep, voffB); PG8_STAGE_A(PG8_SA(1, 0), cA + kstepA, voffA); PG8_STAGE(PG8_SB(1, 1), cB + hstepB + kstep, voffB);
    PG8_WAIT_V(6); PG8_BAR;
    for (;;) {
        const bool has_next = S.next(ui + 1, nxt);
        const char* nA = has_next ? (const char*)g.A + (size_t)nxt.pm * tstepA + nxt.koffA : cA; const char* nB = has_next ? (const char*)g.Bt + (size_t)nxt.pn * tstepB + nxt.koffB : cB;
#pragma unroll 1
        for (int t = 0; t < nt; t += 2) {
            const bool last = (t == nt - 2);
            const char* a1 = cA + (size_t)(t + 1) * kstepA;
            const char* a2 = last ? nA : cA + (size_t)(t + 2) * kstepA; const char* b2 = last ? nB : cB + (size_t)(t + 2) * kstep;
            const char* a3 = a2 + kstepA; const char* b3 = b2 + kstep;
            if (last && has_next) S.a_ready(nxt);
            PG8_LDB(B0, 0, 0); PG8_LDB(B1, 0, 1); PG8_SCHED; PG8_LDA(At, 0, 0); PG8_STAGE_A(PG8_SA(1, 1), a1 + hstepA, voffA);
            PG8_WAIT_V(8); PG8_WAIT_L(0); PG8_BAR; PG8_MMA(0, 0, At, B0); PG8_MMA(0, 1, At, B1); PG8_BAR; PG8_SCHED;
            PG8_LDA(At, 0, 1); PG8_STAGE(PG8_SB(0, 0), b2, voffB); PG8_STAGE(PG8_SB(0, 1), b2 + hstepB, voffB); PG8_STAGE_A(PG8_SA(0, 0), a2, voffA);
            PG8_WAIT_V(8); PG8_WAIT_L(0); PG8_BAR; PG8_MMA(1, 0, At, B0); PG8_MMA(1, 1, At, B1); PG8_BAR; PG8_SCHED;
            PG8_LDB(B0, 1, 0); PG8_LDB(B1, 1, 1); PG8_SCHED; PG8_LDA(At, 1, 0); PG8_STAGE_A(PG8_SA(0, 1), a2 + hstepA, voffA);
            PG8_WAIT_V(8); PG8_WAIT_L(0); PG8_BAR; PG8_MMA(0, 0, At, B0); PG8_MMA(0, 1, At, B1); PG8_BAR; PG8_SCHED;
            PG8_LDA(At, 1, 1); PG8_STAGE(PG8_SB(1, 0), b3, voffB); PG8_STAGE(PG8_SB(1, 1), b3 + hstepB, voffB); PG8_STAGE_A(PG8_SA(1, 0), a3, voffA);
            PG8_WAIT_V(8); PG8_WAIT_L(0); PG8_BAR; PG8_MMA(1, 0, At, B0); PG8_MMA(1, 1, At, B1); PG8_BAR; PG8_SCHED;
        }
        if (wr == 0) PG8_BAR;
        { int fr2 = fr, fq2 = fq; asm volatile("" : "+v"(fr2), "+v"(fq2));
          E(acc, cur, wr, wc, fr2, fq2); }
        S.done(cur);
        if (!has_next) break;
#pragma unroll
        for (int a = 0; a < 2; ++a)
#pragma unroll
            for (int b = 0; b < 2; ++b)
#pragma unroll
                for (int m = 0; m < 4; ++m)
#pragma unroll
                    for (int n = 0; n < 2; ++n) acc[a][b][m][n] = (f32x4){0.f, 0.f, 0.f, 0.f};
        cur = nxt; cA = nA; cB = nB; ++ui;
        if (wr == 1) PG8_BAR;
    }
    PG8_WAIT_V(0);
    PG8_BAR;
#undef PG8_SA
#undef PG8_SB
#undef PG8_STAGE
#undef PG8_STAGE_A
#undef PG8_LDA
#undef PG8_LDB
#undef PG8_MMA
#undef PG8_WAIT_V
#undef PG8_WAIT_L
#undef PG8_BAR
#undef PG8_SCHED
}
}
namespace epi {
using pg8::Unit;
typedef f32x4 Acc[2][2][4][2];
__device__ __forceinline__ float sum4(f32x4 v) { return (v[0] + v[1]) + (v[2] + v[3]); }
__device__ __forceinline__ float sq4(f32x4 v) { return (v[0] * v[0] + v[1] * v[1]) + (v[2] * v[2] + v[3] * v[3]); }
#ifndef RED_SWAP
#define RED_SWAP 1
#endif
#if RED_SWAP
__device__ __forceinline__ float red_fq(float s) {
    auto a = __builtin_amdgcn_permlane16_swap(__float_as_uint(s), __float_as_uint(s), false, false); s = __uint_as_float(a[0]) + __uint_as_float(a[1]);
    auto b = __builtin_amdgcn_permlane32_swap(__float_as_uint(s), __float_as_uint(s), false, false); return __uint_as_float(b[0]) + __uint_as_float(b[1]);
}
#else
__device__ __forceinline__ float red_fq(float s) { s += __shfl_xor(s, 16); s += __shfl_xor(s, 32); return s; }
#endif
__device__ __forceinline__ u32x4 pack8(f32x4 a, f32x4 b) { u32x4 w; w.x = cvt_pk_bf16(a[0], a[1]); w.y = cvt_pk_bf16(a[2], a[3]); w.z = cvt_pk_bf16(b[0], b[1]); w.w = cvt_pk_bf16(b[2], b[3]); return w; }
__device__ __forceinline__ void rope4(f32x4& x1, f32x4& x2, const float* rtab, int t, int fq) {
    const int idx = (fq >> 1) ? (t & 63) : (t >> 6);
    const f32x4 c0 = *(const f32x4*)(rtab + (idx * 8 + (fq & 1) * 4) * 2), c1 = *(const f32x4*)(rtab + (idx * 8 + (fq & 1) * 4) * 2 + 4);
    const f32x4 cs = (f32x4){c0[0], c0[2], c1[0], c1[2]}, sn = (f32x4){c0[1], c0[3], c1[1], c1[3]};
    const f32x4 y1 = x1 * cs - x2 * sn, y2 = x2 * cs + x1 * sn; x1 = y1; x2 = y2;
}
__device__ __forceinline__ float row_rstd16(const float* ssq, int row, int fq, float inv_n) {
    const f32x4 p = *(const f32x4*)(ssq + (size_t)row * 16 + 4 * fq); return rsqrtf(red_fq(sum4(p)) * inv_n + EPS);
}

struct EpiIn {
    static constexpr bool PERM = true;
    bf16_t* z; const float* ssqx; const float* bias; float* ssqkv; const float* gkn; const float* rtab;
    __device__ __forceinline__ void operator()(const Acc& acc, const Unit& u, int wr, int wc, int fr, int fq) const {
        const int pm = u.pm, pn = u.pn, b = pm / PPB, pp = pm - b * PPB, bidx = pp == 0 ? 8 : b;
        const float* bia = bias + bidx * ZW + pn * 256 + wc * 32 + 8 * fq;
        f32x4 bv[2][2];
#pragma unroll
        for (int bj = 0; bj < 2; ++bj)
#pragma unroll
            for (int n = 0; n < 2; ++n) bv[bj][n] = *(const f32x4*)(bia + bj * 128 + 4 * n);
        const int ax = fq >> 1, f0 = (fq & 1) * 4;
        const f32x4 gk1 = *(const f32x4*)(gkn + 64 + ax * 16 + f0), gk2 = *(const f32x4*)(gkn + 64 + ax * 16 + 8 + f0);
#pragma unroll
        for (int ai = 0; ai < 2; ++ai)
#pragma unroll
            for (int m = 0; m < 4; ++m) {
                const int rl = ai * 128 + wr * 64 + m * 16 + fr, row = pm * 256 + rl;
                const float rs = row_rstd16(ssqx, row, fq, 1.0f / 1024.0f);
                f32x4 v[2][2];
#pragma unroll
                for (int bj = 0; bj < 2; ++bj)
#pragma unroll
                    for (int n = 0; n < 2; ++n) v[bj][n] = acc[ai][bj][m][n] * rs + bv[bj][n];
                if (pn == 2 || pn == 4) {
                    const float s = red_fq((sq4(v[0][0]) + sq4(v[0][1])) + (sq4(v[1][0]) + sq4(v[1][1])));
                    if (fq == 0) ssqkv[(size_t)row * 16 + (pn == 2 ? wc : 4 + wc)] = s;
                }
                if (pn == 5) {
                    const float s = red_fq(sq4(v[0][0]) + sq4(v[0][1]));
                    if (fq == 0) ssqkv[(size_t)row * 16 + 8 + wc] = s;
                    if (wc == 0) {
                        const float s1 = red_fq(sq4(v[1][0]) + sq4(v[1][1]));
                        if (fq == 0) ssqkv[(size_t)row * 16 + 12] = s1;
                        v[1][0] = v[1][0] * gk1; v[1][1] = v[1][1] * gk2;
                        if (pp != 0) rope4(v[1][0], v[1][1], rtab, (pp - 1) * 256 + rl, fq);
                    }
                }
                bf16_t* zp = z + (size_t)row * ZW + pn * 256 + wc * 32 + 8 * fq;
#pragma unroll
                for (int bj = 0; bj < 2; ++bj) *(u32x4*)(zp + bj * 128) = pack8(v[bj][0], v[bj][1]);
                asm volatile("" ::: "memory");
            }
    }
};

struct EpiQ {
    static constexpr bool PERM = true;
    bf16_t* Q; float* ssqq; const float* gqn; const float* rtab;
    __device__ __forceinline__ void operator()(const Acc& acc, const Unit& u, int wr, int wc, int fr, int fq) const {
        const int pm = u.pm, pn = u.pn, b = pm / PPB, pp = pm - b * PPB;
        const int ax = fq >> 1, f0 = (fq & 1) * 4;
        f32x4 g0[2], g1[2]; int part[2], grp[2];
#pragma unroll
        for (int bj = 0; bj < 2; ++bj) {
            grp[bj] = pn * 8 + bj * 4 + wc; part[bj] = grp[bj] % 3;
            if (part[bj] < 2) { g0[bj] = *(const f32x4*)(gqn + 32 * part[bj] + 8 * fq); g1[bj] = *(const f32x4*)(gqn + 32 * part[bj] + 8 * fq + 4); }
            else { g0[bj] = *(const f32x4*)(gqn + 64 + ax * 16 + f0); g1[bj] = *(const f32x4*)(gqn + 64 + ax * 16 + 8 + f0); }
        }
#pragma unroll
        for (int ai = 0; ai < 2; ++ai)
#pragma unroll
            for (int m = 0; m < 4; ++m) {
                const int rl = ai * 128 + wr * 64 + m * 16 + fr, row = pm * 256 + rl;
                bf16_t* qp = Q + (size_t)row * 768 + pn * 256 + wc * 32 + 8 * fq;
#pragma unroll
                for (int bj = 0; bj < 2; ++bj) {
                    const f32x4 a0 = acc[ai][bj][m][0], a1 = acc[ai][bj][m][1];
                    const float s = red_fq(sq4(a0) + sq4(a1));
                    if (fq == 0) ssqq[(size_t)row * 24 + grp[bj]] = s;
                    f32x4 v0 = a0 * g0[bj], v1 = a1 * g1[bj];
                    if (part[bj] == 2 && pp != 0) rope4(v0, v1, rtab, (pp - 1) * 256 + rl, fq);
                    *(u32x4*)(qp + bj * 128) = pack8(v0, v1);
                }
                asm volatile("" ::: "memory");
            }
    }
};

template <bool ISK>
struct EpiKV {
    static constexpr bool PERM = true;
    bf16_t* Kb; bf16_t* Vb; const bf16_t* z; const float* ssqkv; const float* gkn;
    __device__ __forceinline__ void operator()(const Acc& acc, const Unit& u, int wr, int wc, int fr, int fq) const {
        const int pm = u.pm, pn = u.pn;
        f32x4 gk[2][2];
#pragma unroll
        for (int bj = 0; bj < 2; ++bj)
#pragma unroll
            for (int n = 0; n < 2; ++n) gk[bj][n] = *(const f32x4*)(gkn + 32 * bj + 8 * fq + 4 * n);
        const int row0 = pm * 256 + wr * 64 + fr;
        float sv[8], skr[8]; u32x4 krv[8];
#pragma unroll
        for (int g = 0; g < 8; ++g) { const int row = row0 + (g >> 2) * 128 + (g & 3) * 16;
            const f32x4 st = *(const f32x4*)(ssqkv + (size_t)row * 16); sv[g] = sum4(st);
            if (ISK) { skr[g] = ssqkv[(size_t)row * 16 + 12]; krv[g] = *(const u32x4*)(z + (size_t)row * ZW + Z_KR + 8 * fq); } }
#pragma unroll
        for (int g = 0; g < 8; ++g) {
            const int ai = g >> 2, m = g & 3, row = row0 + ai * 128 + m * 16;
            const float s = rsqrtf(sv[g] * (1.0f / 256.0f) + EPS);
            if (ISK) {
                const int head = 4 * pn + wc;
                const float ss = red_fq((sq4(acc[ai][0][m][0]) + sq4(acc[ai][0][m][1])) + (sq4(acc[ai][1][m][0]) + sq4(acc[ai][1][m][1])));
                const float rk = rsqrtf((s * s * ss + skr[g]) * (1.0f / 96.0f) + EPS);
                const float sk = s * rk;
                bf16_t* kp = Kb + (size_t)row * 768 + head * 96;
#pragma unroll
                for (int bj = 0; bj < 2; ++bj) *(u32x4*)(kp + 32 * bj + 8 * fq) = pack8(acc[ai][bj][m][0] * gk[bj][0] * sk, acc[ai][bj][m][1] * gk[bj][1] * sk);
                const u32x4 kr = krv[g]; u32x4 o;
                o.x = cvt_pk_bf16(bflo(kr.x) * rk, bfhi(kr.x) * rk); o.y = cvt_pk_bf16(bflo(kr.y) * rk, bfhi(kr.y) * rk);
                o.z = cvt_pk_bf16(bflo(kr.z) * rk, bfhi(kr.z) * rk); o.w = cvt_pk_bf16(bflo(kr.w) * rk, bfhi(kr.w) * rk);
                *(u32x4*)(kp + 64 + 8 * fq) = o;
            } else {
                const int head = 4 * (pn - 2) + wc;
                bf16_t* vp = Vb + (size_t)row * 512 + head * 64;
#pragma unroll
                for (int bj = 0; bj < 2; ++bj) *(u32x4*)(vp + 32 * bj + 8 * fq) = pack8(acc[ai][bj][m][0] * s, acc[ai][bj][m][1] * s);
            }
        }
    }
};

template <bool IN_F32, bool OUT_F32>
struct EpiRes {
    static constexpr bool PERM = true;
    const float* xin_lat; const float* xin_ctx; float* xout; bf16_t* xg; float* ssqx; const float* gate; const float* rgm_prev; const float* gm;
    __device__ __forceinline__ void operator()(const Acc& acc, const Unit& u, int wr, int wc, int fr, int fq) const {
        const int pm = u.pm, pn = u.pn, b = pm / PPB, pp = pm - b * PPB, bidx = pp == 0 ? 8 : b;
        const size_t rbase = pp == 0 ? (size_t)b * 256 : (size_t)b * SEQ + (size_t)(pp - 1) * 256;
        const float* xi = IN_F32 ? (pp == 0 ? xin_ctx : xin_lat) + rbase * D_MODEL : nullptr;
        float* xo = OUT_F32 ? xout + rbase * D_MODEL : nullptr;
        const int col0 = pn * 256 + wc * 32 + 8 * fq;
        f32x4 gv[2][2], mv[2][2], rv[2][2];
#pragma unroll
        for (int bj = 0; bj < 2; ++bj)
#pragma unroll
            for (int n = 0; n < 2; ++n) { gv[bj][n] = *(const f32x4*)(gate + bidx * 6144 + col0 + bj * 128 + n * 4);
                mv[bj][n] = OUT_F32 ? (f32x4){0.f, 0.f, 0.f, 0.f} : *(const f32x4*)(gm + bidx * 6144 + col0 + bj * 128 + n * 4);
                rv[bj][n] = IN_F32 ? (f32x4){0.f, 0.f, 0.f, 0.f} : *(const f32x4*)(rgm_prev + bidx * 2048 + col0 + bj * 128 + n * 4); }
#pragma unroll
        for (int ai = 0; ai < 2; ++ai)
#pragma unroll
            for (int m = 0; m < 4; ++m) {
                const int rl = ai * 128 + wr * 64 + m * 16 + fr; const size_t urow = (size_t)pm * 256 + rl, off = urow * D_MODEL + col0;
                float ss = 0.f;
#pragma unroll
                for (int bj = 0; bj < 2; ++bj) {
                    f32x4 x0, x1;
                    if (IN_F32) { x0 = *(const f32x4*)(xi + (size_t)rl * D_MODEL + col0 + bj * 128); x1 = *(const f32x4*)(xi + (size_t)rl * D_MODEL + col0 + bj * 128 + 4); }
                    else { const u32x4 w = *(const u32x4*)(xg + off + bj * 128); x0 = (f32x4){bflo(w.x), bfhi(w.x), bflo(w.y), bfhi(w.y)} * rv[bj][0]; x1 = (f32x4){bflo(w.z), bfhi(w.z), bflo(w.w), bfhi(w.w)} * rv[bj][1]; }
                    x0 += gv[bj][0] * acc[ai][bj][m][0]; x1 += gv[bj][1] * acc[ai][bj][m][1];
                    if (OUT_F32) {
#ifndef OUT_NT
#define OUT_NT 0
#endif
#if OUT_NT
                        __builtin_nontemporal_store(x0, (f32x4*)(xo + (size_t)rl * D_MODEL + col0 + bj * 128)); __builtin_nontemporal_store(x1, (f32x4*)(xo + (size_t)rl * D_MODEL + col0 + bj * 128 + 4));
#else
                        *(f32x4*)(xo + (size_t)rl * D_MODEL + col0 + bj * 128) = x0; *(f32x4*)(xo + (size_t)rl * D_MODEL + col0 + bj * 128 + 4) = x1;
#endif
                    }
                    else { ss += sq4(x0) + sq4(x1); *(u32x4*)(xg + off + bj * 128) = pack8(x0 * mv[bj][0], x1 * mv[bj][1]); }
                }
                if (!OUT_F32) { ss = red_fq(ss); if (fq == 0) ssqx[urow * 16 + pn * 4 + wc] = ss; }
                asm volatile("" ::: "memory");
            }
    }
};

struct EpiSlab {
    static constexpr bool PERM = true;
    float* slab; int KS;
    __device__ __forceinline__ void operator()(const Acc& acc, const Unit& u, int wr, int wc, int fr, int fq) const {
        const int cp = u.pm / PPB, ks = (int)(u.koffB / (unsigned)(2 * KS));
        float* sp = slab + ((size_t)(ks * (BATCH * CTX) + cp * 256)) * D_MODEL + u.pn * 256 + wc * 32 + 8 * fq;
#pragma unroll
        for (int ai = 0; ai < 2; ++ai)
#pragma unroll
            for (int m = 0; m < 4; ++m) { float* rp = sp + (size_t)(ai * 128 + wr * 64 + m * 16 + fr) * D_MODEL;
#pragma unroll
                for (int bj = 0; bj < 2; ++bj) { *(f32x4*)(rp + bj * 128) = acc[ai][bj][m][0]; *(f32x4*)(rp + bj * 128 + 4) = acc[ai][bj][m][1]; } }
    }
};

struct EpiFF1 {
    static constexpr bool PERM = true;
    bf16_t* U; const float* ssqx; const float* bias;
    __device__ __forceinline__ void operator()(const Acc& acc, const Unit& u, int wr, int wc, int fr, int fq) const {
        const int pm = u.pm, pn = u.pn, b = pm / PPB, pp = pm - b * PPB, bidx = pp == 0 ? 8 : b;
        const float* bia = bias + bidx * D_FF + pn * 256 + wc * 32 + 8 * fq;
        f32x4 bv[2][2];
#pragma unroll
        for (int bj = 0; bj < 2; ++bj)
#pragma unroll
            for (int n = 0; n < 2; ++n) bv[bj][n] = *(const f32x4*)(bia + bj * 128 + 4 * n);
#pragma unroll
        for (int ai = 0; ai < 2; ++ai)
#pragma unroll
            for (int m = 0; m < 4; ++m) {
                const int row = pm * 256 + ai * 128 + wr * 64 + m * 16 + fr;
                const float rs = row_rstd16(ssqx, row, fq, 1.0f / 1024.0f);
                bf16_t* up = U + (((size_t)pm * 128 + pn * 8 + wc) * 16 + (ai * 8 + wr * 4 + m)) * 512 + fr * 32 + 8 * fq;
#pragma unroll
                for (int bj = 0; bj < 2; ++bj) {
                    f32x4 v0 = acc[ai][bj][m][0] * rs + bv[bj][0], v1 = acc[ai][bj][m][1] * rs + bv[bj][1];
#pragma unroll
                    for (int e = 0; e < 4; ++e) { const float a = fmaxf(v0[e], 0.f), c = fmaxf(v1[e], 0.f); v0[e] = a * a; v1[e] = c * c; }
#ifndef U_NT
#define U_NT 1
#endif
#if U_NT
                    __builtin_nontemporal_store(pack8(v0, v1), (u32x4*)(up + (size_t)bj * 4 * 16 * 512));
#else
                    *(u32x4*)(up + (size_t)bj * 4 * 16 * 512) = pack8(v0, v1);
#endif
                }
                asm volatile("" ::: "memory");
            }
    }
};
struct EpiSink {
    static constexpr bool PERM = true;
    float* dummy;
    __device__ __forceinline__ void operator()(const Acc& acc, const Unit& u, int wr, int wc, int fr, int fq) const {
        f32x4 s = {0.f, 0.f, 0.f, 0.f};
#pragma unroll
        for (int ai = 0; ai < 2; ++ai)
#pragma unroll
            for (int bj = 0; bj < 2; ++bj)
#pragma unroll
                for (int m = 0; m < 4; ++m) s += acc[ai][bj][m][0] + acc[ai][bj][m][1];
        const float t = s[0] + s[1] + s[2] + s[3];
        if (t == 1.2345678e33f) dummy[u.pm] = t;
    }
};
}
namespace att {
constexpr int NW = 8, QBLK = 32, KVBLK = 64, DQK = 96, DV = 64;
constexpr int KROWB = 208;
constexpr int SHM_K = KVBLK * KROWB, SHM_V = KVBLK * DV * 2;
constexpr int NSLOT = 3;
constexpr int LDS_V = 0, LDS_K = NSLOT * SHM_V, LDS_WS = LDS_K + NSLOT * SHM_K, LDS_OST = LDS_WS + NW * 64 * 4, LDS_BYTES = LDS_OST + NW * 4096;
#define SBAR() __builtin_amdgcn_sched_barrier(0)
__device__ __forceinline__ int crow(int r, int hi) { return (r & 3) + 8 * (r >> 2) + 4 * hi; }

template <int VAR> __device__ __forceinline__ void partialSM(f32x16& p0, float shift) {
  if (VAR == 1) return;
  if (VAR == 9) {
#pragma unroll
    for (int r = 0; r < 16; ++r) p0[r] -= shift; }
#pragma unroll
  for (int r = 0; r < 16; ++r) p0[r] = __builtin_amdgcn_exp2f(p0[r]);
}
template <int VAR> __device__ __forceinline__ void finishSM(f32x16& p0, f32x16& p1, float shift, float& l_reg, bf16x8& pa0, bf16x8& pa1, bf16x8& pa2, bf16x8& pa3) {
  if (VAR == 9) {
#pragma unroll
    for (int r = 0; r < 16; ++r) p1[r] -= shift; }
  if (VAR != 1) {
#pragma unroll
  for (int r = 0; r < 16; ++r) p1[r] = __builtin_amdgcn_exp2f(p1[r]); }
  float ps = 0;
#pragma unroll
  for (int r = 0; r < 16; ++r) ps += p0[r];
#pragma unroll
  for (int r = 0; r < 16; ++r) ps += p1[r];
  l_reg += ps;
#define PK4(P, BASE, OUT) do { u32x4 w = {cvt_pk_bf16(P[BASE + 0], P[BASE + 1]), cvt_pk_bf16(P[BASE + 2], P[BASE + 3]), cvt_pk_bf16(P[BASE + 4], P[BASE + 5]), cvt_pk_bf16(P[BASE + 6], P[BASE + 7])}; \
    OUT = *reinterpret_cast<bf16x8*>(&w); } while (0)
  PK4(p0, 0, pa0); PK4(p0, 8, pa1); PK4(p1, 0, pa2); PK4(p1, 8, pa3);
#undef PK4
}
#define KFR(KS, d0, half) (*reinterpret_cast<const bf16x8*>((KS) + (r32 + 32 * (half)) * KROWB + ((d0) * 16 + hi * 8) * 2))
#ifndef QKSEQ
#define QKSEQ 0
#endif
#if QKSEQ
__device__ __forceinline__ void kread4(bf16x8* kf, const char* Ks, int r32, int hi) { kf[0] = KFR(Ks, 0, 0); kf[1] = KFR(Ks, 1, 0); kf[2] = KFR(Ks, 2, 0); kf[3] = KFR(Ks, 3, 0); }
#else
__device__ __forceinline__ void kread4(bf16x8* kf, const char* Ks, int r32, int hi) { kf[0] = KFR(Ks, 0, 0); kf[1] = KFR(Ks, 0, 1); kf[2] = KFR(Ks, 1, 0); kf[3] = KFR(Ks, 1, 1); }
#endif
#define MF(A_, B_, C_) (VAR == 32 ? nomf(A_, B_, C_) : __builtin_amdgcn_mfma_f32_32x32x16_bf16(A_, B_, C_, 0, 0, 0))
__device__ __forceinline__ f32x16 nomf(bf16x8 a, bf16x8 b, f32x16 c) { asm volatile("" :: "v"(a), "v"(b)); c[0] += 1.0f; return c; }
template <bool FIN, int VAR>
__device__ __forceinline__ void qkt_fin(f32x16& p0, f32x16& p1, const char* Ks, const bf16x8* qr, int r32, int hi,
                                        f32x16& f0, f32x16& f1, float shift, float& l_reg, bf16x8& pa0, bf16x8& pa1, bf16x8& pa2, bf16x8& pa3, bf16x8* kfa) {
#if QKSEQ
  bf16x8 kf[4] = {kfa[0], kfa[1], kfa[2], kfa[3]};
  SBAR();
  const bf16x8 b0 = KFR(Ks, 4, 0), b1 = KFR(Ks, 5, 0), b2 = KFR(Ks, 0, 1), b3 = KFR(Ks, 1, 1);
  p0 = MF(kf[0], qr[0], f32x16{}); p0 = MF(kf[1], qr[1], p0);
  p0 = MF(kf[2], qr[2], p0); p0 = MF(kf[3], qr[3], p0);
  if (FIN) {
    if (VAR == 9) {
#pragma unroll
      for (int r = 0; r < 16; ++r) f1[r] -= shift; }
    if (VAR != 1) {
#pragma unroll
      for (int r = 0; r < 16; ++r) f1[r] = __builtin_amdgcn_exp2f(f1[r]); }
  }
  SBAR();
  const bf16x8 c0 = KFR(Ks, 2, 1), c1 = KFR(Ks, 3, 1), c2 = KFR(Ks, 4, 1), c3 = KFR(Ks, 5, 1);
  p0 = MF(b0, qr[4], p0); p0 = MF(b1, qr[5], p0);
  p1 = MF(b2, qr[0], f32x16{}); p1 = MF(b3, qr[1], p1);
  if (FIN) {
    float ps = 0;
#pragma unroll
    for (int r = 0; r < 16; ++r) ps += f0[r];
#pragma unroll
    for (int r = 0; r < 16; ++r) ps += f1[r];
    l_reg += ps;
  }
  SBAR();
  p1 = MF(c0, qr[2], p1); p1 = MF(c1, qr[3], p1);
  p1 = MF(c2, qr[4], p1); p1 = MF(c3, qr[5], p1);
#else
  bf16x8 kf[4] = {kfa[0], kfa[1], kfa[2], kfa[3]};
  SBAR();
  const bf16x8 b0 = VAR == 8 ? qr[2] : KFR(Ks, 2, 0), b1 = VAR == 8 ? qr[2] : KFR(Ks, 2, 1), b2 = VAR == 8 ? qr[3] : KFR(Ks, 3, 0), b3 = VAR == 8 ? qr[3] : KFR(Ks, 3, 1);
  p0 = MF(kf[0], qr[0], f32x16{}); p1 = MF(kf[1], qr[0], f32x16{});
  p0 = MF(kf[2], qr[1], p0); p1 = MF(kf[3], qr[1], p1);
  if (FIN) {
    if (VAR == 9) {
#pragma unroll
      for (int r = 0; r < 16; ++r) f1[r] -= shift; }
    if (VAR != 1) {
#pragma unroll
      for (int r = 0; r < 16; ++r) f1[r] = __builtin_amdgcn_exp2f(f1[r]); }
  }
  SBAR();
  const bf16x8 c0 = VAR == 8 ? qr[4] : KFR(Ks, 4, 0), c1 = VAR == 8 ? qr[4] : KFR(Ks, 4, 1), c2 = VAR == 8 ? qr[5] : KFR(Ks, 5, 0), c3 = VAR == 8 ? qr[5] : KFR(Ks, 5, 1);
  p0 = MF(b0, qr[2], p0); p1 = MF(b1, qr[2], p1);
  p0 = MF(b2, qr[3], p0); p1 = MF(b3, qr[3], p1);
  if (FIN) {
    float ps = 0;
#pragma unroll
    for (int r = 0; r < 16; ++r) ps += f0[r];
#pragma unroll
    for (int r = 0; r < 16; ++r) ps += f1[r];
    l_reg += ps;
  }
  SBAR();
  p0 = MF(c0, qr[4], p0); p1 = MF(c1, qr[4], p1);
  p0 = MF(c2, qr[5], p0); p1 = MF(c3, qr[5], p1);
#endif
  if (FIN) {
#define PK4(P, BASE, OUT) do { u32x4 w = {cvt_pk_bf16(P[BASE + 0], P[BASE + 1]), cvt_pk_bf16(P[BASE + 2], P[BASE + 3]), cvt_pk_bf16(P[BASE + 4], P[BASE + 5]), cvt_pk_bf16(P[BASE + 6], P[BASE + 7])}; \
    OUT = *reinterpret_cast<bf16x8*>(&w); } while (0)
    PK4(f0, 0, pa0); PK4(f0, 8, pa1); PK4(f1, 0, pa2); PK4(f1, 8, pa3);
#undef PK4
  }
}
#undef MF
__device__ __forceinline__ int v_st(int k, int c) { return ((k >> 3) * 2 + (c >> 5)) * 512 + ((k & 7) * 32 + (c & 31)) * 2; }
__device__ __forceinline__ int v_rd_base(int lane) { return ((lane & 3) << 3) | (((lane >> 2) & 3) << 6) | (((lane >> 4) & 1) << 5) | (((lane >> 5) & 1) << 8); }
constexpr int v_rd_off(int d0, int ks, int half) { return d0 * 512 + ks * 2048 + half * 1024; }
template <int OFF> __device__ __forceinline__ s16x4 tr_read(int vb) {
  s16x4 r; asm volatile("ds_read_b64_tr_b16 %0, %1 offset:%2" : "=&v"(r) : "v"(vb), "i"(OFF) : "memory"); return r;
}
template <int D0> __device__ __forceinline__ void pv_one(f32x16& od, int vb, bf16x8 pa0, bf16x8 pa1, bf16x8 pa2, bf16x8 pa3) {
  const s16x4 l0 = tr_read<v_rd_off(D0, 0, 0)>(vb), h0 = tr_read<v_rd_off(D0, 0, 1)>(vb), l1 = tr_read<v_rd_off(D0, 1, 0)>(vb), h1 = tr_read<v_rd_off(D0, 1, 1)>(vb);
  const s16x4 l2 = tr_read<v_rd_off(D0, 2, 0)>(vb), h2 = tr_read<v_rd_off(D0, 2, 1)>(vb), l3 = tr_read<v_rd_off(D0, 3, 0)>(vb), h3 = tr_read<v_rd_off(D0, 3, 1)>(vb);
  asm volatile("s_waitcnt lgkmcnt(0)" ::: "memory"); SBAR();
#define PK(L, H) (bf16x8){L[0], L[1], L[2], L[3], H[0], H[1], H[2], H[3]}
  od = __builtin_amdgcn_mfma_f32_32x32x16_bf16(PK(l0, h0), pa0, od, 0, 0, 0);
  od = __builtin_amdgcn_mfma_f32_32x32x16_bf16(PK(l1, h1), pa1, od, 0, 0, 0);
  od = __builtin_amdgcn_mfma_f32_32x32x16_bf16(PK(l2, h2), pa2, od, 0, 0, 0);
  od = __builtin_amdgcn_mfma_f32_32x32x16_bf16(PK(l3, h3), pa3, od, 0, 0, 0);
#undef PK
}
__device__ __forceinline__ void pv_d0(f32x16* o, int vb, bf16x8 pa0, bf16x8 pa1, bf16x8 pa2, bf16x8 pa3) {
  pv_one<0>(o[0], vb, pa0, pa1, pa2, pa3); pv_one<1>(o[1], vb, pa0, pa1, pa2, pa3);
}
#ifndef PVMID
#define PVMID 0
#endif
#if PVMID
#define PVALT_MID if (VAR == 9) { _Pragma("unroll") for (int r = 0; r < 8; ++r) p0[r] -= shift; } _Pragma("unroll") for (int r = 0; r < 8; ++r) p0[r] = __builtin_amdgcn_exp2f(p0[r]);
#else
#define PVALT_MID
#endif
template <int VAR> __device__ __forceinline__ void pv_alt(f32x16* o, int vb, bf16x8 pa0, bf16x8 pa1, bf16x8 pa2, bf16x8 pa3, f32x16& p0, float shift) {
  const s16x4 al0 = tr_read<v_rd_off(0, 0, 0)>(vb), ah0 = tr_read<v_rd_off(0, 0, 1)>(vb), bl0 = tr_read<v_rd_off(1, 0, 0)>(vb), bh0 = tr_read<v_rd_off(1, 0, 1)>(vb);
  const s16x4 al1 = tr_read<v_rd_off(0, 1, 0)>(vb), ah1 = tr_read<v_rd_off(0, 1, 1)>(vb), bl1 = tr_read<v_rd_off(1, 1, 0)>(vb), bh1 = tr_read<v_rd_off(1, 1, 1)>(vb);
  asm volatile("s_waitcnt lgkmcnt(0)" ::: "memory"); SBAR();
#define PK(L, H) (bf16x8){L[0], L[1], L[2], L[3], H[0], H[1], H[2], H[3]}
  o[0] = __builtin_amdgcn_mfma_f32_32x32x16_bf16(PK(al0, ah0), pa0, o[0], 0, 0, 0);
  o[1] = __builtin_amdgcn_mfma_f32_32x32x16_bf16(PK(bl0, bh0), pa0, o[1], 0, 0, 0);
  const s16x4 al2 = tr_read<v_rd_off(0, 2, 0)>(vb), ah2 = tr_read<v_rd_off(0, 2, 1)>(vb), bl2 = tr_read<v_rd_off(1, 2, 0)>(vb), bh2 = tr_read<v_rd_off(1, 2, 1)>(vb);
  o[0] = __builtin_amdgcn_mfma_f32_32x32x16_bf16(PK(al1, ah1), pa1, o[0], 0, 0, 0);
  o[1] = __builtin_amdgcn_mfma_f32_32x32x16_bf16(PK(bl1, bh1), pa1, o[1], 0, 0, 0);
  const s16x4 al3 = tr_read<v_rd_off(0, 3, 0)>(vb), ah3 = tr_read<v_rd_off(0, 3, 1)>(vb), bl3 = tr_read<v_rd_off(1, 3, 0)>(vb), bh3 = tr_read<v_rd_off(1, 3, 1)>(vb);
  PVALT_MID
  asm volatile("s_waitcnt lgkmcnt(0)" ::: "memory"); SBAR();
  o[0] = __builtin_amdgcn_mfma_f32_32x32x16_bf16(PK(al2, ah2), pa2, o[0], 0, 0, 0);
  o[1] = __builtin_amdgcn_mfma_f32_32x32x16_bf16(PK(bl2, bh2), pa2, o[1], 0, 0, 0);
  o[0] = __builtin_amdgcn_mfma_f32_32x32x16_bf16(PK(al3, ah3), pa3, o[0], 0, 0, 0);
  o[1] = __builtin_amdgcn_mfma_f32_32x32x16_bf16(PK(bl3, bh3), pa3, o[1], 0, 0, 0);
#undef PK
}

template <int VAR> __device__ __forceinline__ void pv_psm(f32x16* o, int vb, bf16x8 pa0, bf16x8 pa1, bf16x8 pa2, bf16x8 pa3, f32x16& p0, float shift) {
#ifndef PVALT
#define PVALT 1
#endif
#if PVALT
  pv_alt<VAR>(o, vb, pa0, pa1, pa2, pa3, p0, shift);
  if (VAR == 9) {
#pragma unroll
    for (int r = PVMID ? 8 : 0; r < 16; ++r) p0[r] -= shift; }
#pragma unroll
  for (int r = PVMID ? 8 : 0; r < 16; ++r) p0[r] = __builtin_amdgcn_exp2f(p0[r]);
#else
  pv_one<0>(o[0], vb, pa0, pa1, pa2, pa3);
  if (VAR == 9) {
#pragma unroll
    for (int r = 0; r < 8; ++r) p0[r] -= shift; }
#pragma unroll
  for (int r = 0; r < 8; ++r) p0[r] = __builtin_amdgcn_exp2f(p0[r]);
  SBAR();
  pv_one<1>(o[1], vb, pa0, pa1, pa2, pa3);
  if (VAR == 9) {
#pragma unroll
    for (int r = 8; r < 16; ++r) p0[r] -= shift; }
#pragma unroll
  for (int r = 8; r < 16; ++r) p0[r] = __builtin_amdgcn_exp2f(p0[r]);
#endif
}

#define MF32(A_, B_, C_) __builtin_amdgcn_mfma_f32_32x32x16_bf16(A_, B_, C_, 0, 0, 0)
#define PKV(L, H) (bf16x8){L[0], L[1], L[2], L[3], H[0], H[1], H[2], H[3]}
template <int OFF> __device__ __forceinline__ bf16x8 k_read(int kb) {
  bf16x8 r; asm volatile("ds_read_b128 %0, %1 offset:%2" : "=&v"(r) : "v"(kb), "i"(OFF) : "memory"); return r;
}
constexpr int k_off(int d0, int half) { return half * 32 * KROWB + d0 * 32; }
#define LGKM(n) do { asm volatile("s_waitcnt lgkmcnt(" #n ")" ::: "memory"); SBAR(); } while (0)
template <bool WITH_PV, bool NOREAD = false>
__device__ __forceinline__ void mblock(f32x16& p0, f32x16& p1, f32x16* o, int kb, int vb, const bf16x8* qr, const bf16x8* kfa,
                                       bf16x8 pa0, bf16x8 pa1, bf16x8 pa2, bf16x8 pa3) {
  s16x4 al0, ah0, bl0, bh0, al1, ah1, bl1, bh1, al2, ah2, bl2, bh2, al3, ah3, bl3, bh3;
  if (WITH_PV) { al0 = (NOREAD ? (s16x4){(short)vb, 1, 2, 3} : tr_read<v_rd_off(0, 0, 0)>(vb)); ah0 = (NOREAD ? (s16x4){(short)vb, 1, 2, 3} : tr_read<v_rd_off(0, 0, 1)>(vb)); bl0 = (NOREAD ? (s16x4){(short)vb, 1, 2, 3} : tr_read<v_rd_off(1, 0, 0)>(vb)); bh0 = (NOREAD ? (s16x4){(short)vb, 1, 2, 3} : tr_read<v_rd_off(1, 0, 1)>(vb)); }
  const bf16x8 k20 = (NOREAD ? qr[0] : k_read<k_off(2, 0)>(kb)), k21 = (NOREAD ? qr[0] : k_read<k_off(2, 1)>(kb));
  if (WITH_PV) { al1 = (NOREAD ? (s16x4){(short)vb, 1, 2, 3} : tr_read<v_rd_off(0, 1, 0)>(vb)); ah1 = (NOREAD ? (s16x4){(short)vb, 1, 2, 3} : tr_read<v_rd_off(0, 1, 1)>(vb)); bl1 = (NOREAD ? (s16x4){(short)vb, 1, 2, 3} : tr_read<v_rd_off(1, 1, 0)>(vb)); bh1 = (NOREAD ? (s16x4){(short)vb, 1, 2, 3} : tr_read<v_rd_off(1, 1, 1)>(vb)); }
  const bf16x8 k30 = (NOREAD ? qr[0] : k_read<k_off(3, 0)>(kb)), k31 = (NOREAD ? qr[0] : k_read<k_off(3, 1)>(kb));
  SBAR();
  p0 = MF32(kfa[0], qr[0], f32x16{}); p1 = MF32(kfa[1], qr[0], f32x16{});
  p0 = MF32(kfa[2], qr[1], p0); p1 = MF32(kfa[3], qr[1], p1);
  if (WITH_PV) { LGKM(8); o[0] = MF32(PKV(al0, ah0), pa0, o[0]); o[1] = MF32(PKV(bl0, bh0), pa0, o[1]); }
  if (WITH_PV) LGKM(6); else LGKM(2);
  p0 = MF32(k20, qr[2], p0); p1 = MF32(k21, qr[2], p1);
  SBAR();
  if (WITH_PV) { al2 = (NOREAD ? (s16x4){(short)vb, 1, 2, 3} : tr_read<v_rd_off(0, 2, 0)>(vb)); ah2 = (NOREAD ? (s16x4){(short)vb, 1, 2, 3} : tr_read<v_rd_off(0, 2, 1)>(vb)); bl2 = (NOREAD ? (s16x4){(short)vb, 1, 2, 3} : tr_read<v_rd_off(1, 2, 0)>(vb)); bh2 = (NOREAD ? (s16x4){(short)vb, 1, 2, 3} : tr_read<v_rd_off(1, 2, 1)>(vb)); }
  const bf16x8 k40 = (NOREAD ? qr[0] : k_read<k_off(4, 0)>(kb)), k41 = (NOREAD ? qr[0] : k_read<k_off(4, 1)>(kb));
  if (WITH_PV) { al3 = (NOREAD ? (s16x4){(short)vb, 1, 2, 3} : tr_read<v_rd_off(0, 3, 0)>(vb)); ah3 = (NOREAD ? (s16x4){(short)vb, 1, 2, 3} : tr_read<v_rd_off(0, 3, 1)>(vb)); bl3 = (NOREAD ? (s16x4){(short)vb, 1, 2, 3} : tr_read<v_rd_off(1, 3, 0)>(vb)); bh3 = (NOREAD ? (s16x4){(short)vb, 1, 2, 3} : tr_read<v_rd_off(1, 3, 1)>(vb)); }
  const bf16x8 k50 = (NOREAD ? qr[0] : k_read<k_off(5, 0)>(kb)), k51 = (NOREAD ? qr[0] : k_read<k_off(5, 1)>(kb));
  SBAR();
  if (WITH_PV) { LGKM(14); o[0] = MF32(PKV(al1, ah1), pa1, o[0]); o[1] = MF32(PKV(bl1, bh1), pa1, o[1]); }
  if (WITH_PV) LGKM(12); else LGKM(4);
  p0 = MF32(k30, qr[3], p0); p1 = MF32(k31, qr[3], p1);
  if (WITH_PV) { LGKM(8); o[0] = MF32(PKV(al2, ah2), pa2, o[0]); o[1] = MF32(PKV(bl2, bh2), pa2, o[1]); }
  if (WITH_PV) LGKM(6); else LGKM(2);
  p0 = MF32(k40, qr[4], p0); p1 = MF32(k41, qr[4], p1);
  if (WITH_PV) { LGKM(2); o[0] = MF32(PKV(al3, ah3), pa3, o[0]); o[1] = MF32(PKV(bl3, bh3), pa3, o[1]); }
  LGKM(0);
  p0 = MF32(k50, qr[5], p0); p1 = MF32(k51, qr[5], p1);
}
template <int VAR> __device__ __forceinline__ void vsoftmax(f32x16& p0, f32x16& p1, float shift, float& l_reg, bf16x8& pa0, bf16x8& pa1, bf16x8& pa2, bf16x8& pa3) {
  if (VAR == 9) {
#pragma unroll
    for (int r = 0; r < 16; ++r) { p0[r] -= shift; p1[r] -= shift; } }
#pragma unroll
  for (int r = 0; r < 16; ++r) p0[r] = __builtin_amdgcn_exp2f(p0[r]);
#pragma unroll
  for (int r = 0; r < 16; ++r) p1[r] = __builtin_amdgcn_exp2f(p1[r]);
#ifndef PKSUM
#define PKSUM 0
#endif
#if PKSUM
  {
    typedef float f32x8_ __attribute__((ext_vector_type(8))); typedef float f32x2_ __attribute__((ext_vector_type(2)));
    const f32x16 s16 = p0 + p1;
    const f32x8_ s8 = __builtin_shufflevector(s16, s16, 0, 1, 2, 3, 4, 5, 6, 7) + __builtin_shufflevector(s16, s16, 8, 9, 10, 11, 12, 13, 14, 15);
    const f32x4 s4 = __builtin_shufflevector(s8, s8, 0, 1, 2, 3) + __builtin_shufflevector(s8, s8, 4, 5, 6, 7);
    const f32x2_ s2 = __builtin_shufflevector(s4, s4, 0, 1) + __builtin_shufflevector(s4, s4, 2, 3);
    l_reg += s2[0] + s2[1];
  }
#else
  float ps = 0;
#pragma unroll
  for (int r = 0; r < 16; ++r) ps += p0[r];
#pragma unroll
  for (int r = 0; r < 16; ++r) ps += p1[r];
  l_reg += ps;
#endif
#define PK4(P, BASE, OUT) do { u32x4 w = {cvt_pk_bf16(P[BASE + 0], P[BASE + 1]), cvt_pk_bf16(P[BASE + 2], P[BASE + 3]), cvt_pk_bf16(P[BASE + 4], P[BASE + 5]), cvt_pk_bf16(P[BASE + 6], P[BASE + 7])}; \
    OUT = *reinterpret_cast<bf16x8*>(&w); } while (0)
  PK4(p0, 0, pa0); PK4(p0, 8, pa1); PK4(p1, 0, pa2); PK4(p1, 8, pa3);
#undef PK4
}

template <int VAR>
__device__ __forceinline__ void attn_unit(const bf16_t* __restrict__ Qraw, const bf16_t* __restrict__ Kb, const bf16_t* __restrict__ Vb, bf16_t* mix,
                                          const float* ssqkv, const float* ssqq, float negB2, int qrow0, int krow0, int nkeys, int h, char* lds) {
  if (VAR == 10) return;
  int tid = threadIdx.x; asm volatile("" : "+v"(tid));
    const int  wid = __builtin_amdgcn_readfirstlane(tid >> 6), lane = tid & 63, r32 = lane & 31, hi = lane >> 5;
  char* V_lds = lds + LDS_V; char* K_lds = lds + LDS_K;
  float l_reg = 0; f32x16 o[2] = {}; bf16x8 qr[6];
  const float shift = -negB2;
  {
    const int row = qrow0 + wid * QBLK + r32;
    const f32x4 pa = *(const f32x4*)(ssqkv + (size_t)row * 16 + 4), pb = *(const f32x4*)(ssqkv + (size_t)row * 16 + 8);
    const float sql = rsqrtf(((pa[0] + pa[1]) + (pa[2] + pa[3]) + (pb[0] + pb[1]) + (pb[2] + pb[3])) * (1.0f / 384.0f) + EPS);
    const float ssh = ssqq[(size_t)row * 24 + 3 * h] + ssqq[(size_t)row * 24 + 3 * h + 1] + ssqq[(size_t)row * 24 + 3 * h + 2];
    const float sc = sql * rsqrtf(sql * sql * ssh * (1.0f / 96.0f) + EPS) * QSCALE;
    const bf16_t* Qw = Qraw + (size_t)row * 768 + h * 96 + hi * 8;
#pragma unroll
    for (int d0 = 0; d0 < 6; ++d0) { const u32x4 w = *(const u32x4*)(Qw + d0 * 16); u32x4 o4;
      o4.x = cvt_pk_bf16(bflo(w.x) * sc, bfhi(w.x) * sc); o4.y = cvt_pk_bf16(bflo(w.y) * sc, bfhi(w.y) * sc);
      o4.z = cvt_pk_bf16(bflo(w.z) * sc, bfhi(w.z) * sc); o4.w = cvt_pk_bf16(bflo(w.w) * sc, bfhi(w.w) * sc);
      qr[d0] = *reinterpret_cast<bf16x8*>(&o4); }
  }
  const int kk0 = tid / 12, kc0 = tid - kk0 * 12, kk1 = (tid + 512) / 12, kc1 = (tid + 512) - kk1 * 12, vk = tid >> 3, vc = tid & 7;
  const bf16_t* Kh = Kb + (size_t)krow0 * 768 + h * 96; const bf16_t* Vh = Vb + (size_t)krow0 * 512 + h * 64;
  const unsigned kof0 = (unsigned)(kk0 * 768 + kc0 * 8) * 2u, kof1 = (unsigned)(kk1 * 768 + kc1 * 8) * 2u, vof = (unsigned)(vk * 512 + vc * 8) * 2u;
  const int kst0 = kk0 * KROWB + kc0 * 16, kst1 = kk1 * KROWB + kc1 * 16, vst = v_st(vk, vc * 8);
  const __amdgpu_buffer_rsrc_t krs = __builtin_amdgcn_make_buffer_rsrc((void*)Kh, 0, nkeys * 768 * 2, 0x00020000);
  const __amdgpu_buffer_rsrc_t vrs = __builtin_amdgcn_make_buffer_rsrc((void*)Vh, 0, nkeys * 512 * 2, 0x00020000);
  const bool two = wid < 4;
  const int vb0 = (int)(uintptr_t)V_lds + v_rd_base(lane);
  bf16x8 sk0, sk1, sv;
#define LOADK(t) do { if (VAR == 4) break; const int so_ = (t) * (KVBLK * 768 * 2); sk0 = __builtin_bit_cast(bf16x8, __builtin_amdgcn_raw_buffer_load_b128(krs, kof0, so_, 0)); if (two) sk1 = __builtin_bit_cast(bf16x8, __builtin_amdgcn_raw_buffer_load_b128(krs, kof1, so_, 0)); } while (0)
#define LOADV(t) do { if (VAR == 4) break; sv = __builtin_bit_cast(bf16x8, __builtin_amdgcn_raw_buffer_load_b128(vrs, vof, (t) * (KVBLK * 512 * 2), 0)); } while (0)
#define WRITEK(slot) do { if (VAR == 4) break; *(bf16x8*)(K_lds + (slot) * SHM_K + kst0) = sk0; if (two) *(bf16x8*)(K_lds + (slot) * SHM_K + kst1) = sk1; } while (0)
#define WRITEV(slot) do { if (VAR == 4) break; *(bf16x8*)(V_lds + (slot) * SHM_V + vst) = sv; } while (0)
#define PV(slot) do { if (VAR != 2) pv_d0(o, vb0 + (slot) * SHM_V, pa0, pa1, pa2, pa3); else { asm volatile("" :: "v"(pa0), "v"(pa1), "v"(pa2), "v"(pa3)); } } while (0)
#define QFS(FIN, P0, P1, F0, F1, KQ) qkt_fin<FIN, VAR>(P0, P1, K_lds + (KQ) * SHM_K, qr, r32, hi, F0, F1, shift, l_reg, pa0, pa1, pa2, pa3, kfa)
#define KRD(slot) kread4(kfa, K_lds + (slot) * SHM_K, r32, hi)
#define QF(FIN, P0, P1, F0, F1) QFS(FIN, P0, P1, F0, F1, kq)
  f32x16 pA0, pA1, pB0, pB1; bf16x8 pa0, pa1, pa2, pa3; bf16x8 kfa[4]; const int NT = nkeys / KVBLK;
#ifndef PINGPONG
#define PINGPONG 2
#endif
#ifndef MPRIO
#define MPRIO 2
#endif
#if PINGPONG == 2
  const bool grpB = wid >= 4;
  const int kb0 = (int)(uintptr_t)K_lds + r32 * KROWB + hi * 16;
#ifndef PRO1
#define PRO1 1
#endif
#if PRO1
  {
    bf16x8 t00, t01 = {}, t10, t11 = {}, tv;
    t00 = __builtin_bit_cast(bf16x8, __builtin_amdgcn_raw_buffer_load_b128(krs, kof0, 0, 0)); if (two) t01 = __builtin_bit_cast(bf16x8, __builtin_amdgcn_raw_buffer_load_b128(krs, kof1, 0, 0));
    tv = __builtin_bit_cast(bf16x8, __builtin_amdgcn_raw_buffer_load_b128(vrs, vof, 0, 0));
    t10 = __builtin_bit_cast(bf16x8, __builtin_amdgcn_raw_buffer_load_b128(krs, kof0, KVBLK * 768 * 2, 0)); if (two) t11 = __builtin_bit_cast(bf16x8, __builtin_amdgcn_raw_buffer_load_b128(krs, kof1, KVBLK * 768 * 2, 0));
    LOADK(2); LOADV(1);
    *(bf16x8*)(K_lds + kst0) = t00; if (two) *(bf16x8*)(K_lds + kst1) = t01;
    *(bf16x8*)(V_lds + vst) = tv;
    *(bf16x8*)(K_lds + SHM_K + kst0) = t10; if (two) *(bf16x8*)(K_lds + SHM_K + kst1) = t11;
  }
#else
  LOADK(0); LOADV(0); WRITEK(0); WRITEV(0); LOADK(1); WRITEK(1); LOADK(2); LOADV(1);
#endif
  __syncthreads();
  KRD(0);
  int sk = 0, sv_ = 2;
#define STAGE_STEP() do { if (VAR == 5) break; if (j + 2 < NT) WRITEK(s2); if (j + 1 < NT) WRITEV(s1); if (j + 3 < NT) LOADK(j + 3); if (j + 2 < NT) LOADV(j + 2); } while (0)
  for (int j = 0; j < NT; ++j) {
    const int s1 = sk == 2 ? 0 : sk + 1, s2 = sv_;
    if (grpB) { if (j > 0) vsoftmax<VAR>(pA0, pA1, shift, l_reg, pa0, pa1, pa2, pa3); STAGE_STEP(); }
    SBAR();
    if (MPRIO) __builtin_amdgcn_s_setprio(MPRIO);
    if (j == 0) mblock<false>(pA0, pA1, o, kb0 + sk * SHM_K, vb0, qr, kfa, pa0, pa1, pa2, pa3);
    else        mblock<true>(pA0, pA1, o, kb0 + sk * SHM_K, vb0 + sv_ * SHM_V, qr, kfa, pa0, pa1, pa2, pa3);
    SBAR();
    if (MPRIO) __builtin_amdgcn_s_setprio(0);
    if (j + 1 < NT) KRD(s1);
    if (!grpB) { vsoftmax<VAR>(pA0, pA1, shift, l_reg, pa0, pa1, pa2, pa3); STAGE_STEP(); }
    if (VAR != 16) __syncthreads();
    sv_ = sk; sk = s1;
  }
#undef STAGE_STEP
  if (grpB) vsoftmax<VAR>(pA0, pA1, shift, l_reg, pa0, pa1, pa2, pa3);
  pv_alt<0>(o, vb0 + sv_ * SHM_V, pa0, pa1, pa2, pa3, pA0, 0.f);
#elif PINGPONG
  const bool grpB = wid >= 4;
  const int kb0 = (int)(uintptr_t)K_lds + r32 * KROWB + hi * 16;
  LOADK(0); LOADV(0); WRITEK(0); WRITEV(0); LOADK(1); WRITEK(1); LOADK(2); LOADV(1);
  __syncthreads();
  KRD(0);
  int sk = 0, sv_ = 2;
  if (grpB) __syncthreads();
  for (int j = 0; j < NT; ++j) {
    const int s1 = sk == 2 ? 0 : sk + 1, s2 = sv_;
    SBAR();
#ifndef MPRIO
#define MPRIO 2
#endif
    if (MPRIO) __builtin_amdgcn_s_setprio(MPRIO);
    if (VAR == 2) { asm volatile("" : "+v"(pA0), "+v"(pA1)); }
    else if (j == 0) mblock<false>(pA0, pA1, o, kb0 + sk * SHM_K, vb0, qr, kfa, pa0, pa1, pa2, pa3);
    else if (VAR == 8) mblock<true, true>(pA0, pA1, o, kb0 + sk * SHM_K, vb0 + sv_ * SHM_V, qr, kfa, pa0, pa1, pa2, pa3);
    else        mblock<true>(pA0, pA1, o, kb0 + sk * SHM_K, vb0 + sv_ * SHM_V, qr, kfa, pa0, pa1, pa2, pa3);
    SBAR();
    if (MPRIO) __builtin_amdgcn_s_setprio(0);
    if (VAR != 16) __syncthreads();
    if (VAR == 1) { asm volatile("" : "+v"(pa0), "+v"(pa1), "+v"(pa2), "+v"(pa3) : "v"(pA0), "v"(pA1)); }
    else vsoftmax<VAR>(pA0, pA1, shift, l_reg, pa0, pa1, pa2, pa3);
    if (j + 2 < NT) WRITEK(s2);
    if (j + 1 < NT) { WRITEV(s1); KRD(s1); }
    if (j + 3 < NT) LOADK(j + 3);
    if (j + 2 < NT) LOADV(j + 2);
    if (VAR != 16) __syncthreads();
    sv_ = sk; sk = s1;
  }
  pv_alt<0>(o, vb0 + sv_ * SHM_V, pa0, pa1, pa2, pa3, pA0, 0.f);
  if (!grpB) __syncthreads();
#else
#ifndef WEARLY
#define WEARLY 0
#endif
#if WEARLY
  LOADK(0); LOADV(0); WRITEK(0); WRITEV(0); LOADK(1); WRITEK(1); LOADK(2); LOADV(1); WRITEK(2); WRITEV(1); LOADK(3); LOADV(2);
  __syncthreads();
  KRD(0);
  int sa = 2, sb = 1, kq = 0;
#define ROT() do { sa = (sa == 2) ? 0 : sa + 1; sb = (sb == 2) ? 0 : sb + 1; kq = (kq == 2) ? 0 : kq + 1; } while (0)
  SBAR(); QF(false, pA0, pA1, pA0, pA1); SBAR(); KRD(sb); partialSM<VAR>(pA0, shift); __syncthreads();
  ROT();
  int j = 1;
  for (; j + 1 < NT; j += 2) {
    WRITEK(sa); WRITEV(sb); if (j + 3 < NT) LOADK(j + 3); LOADV(j + 2);
    SBAR(); QF(true, pB0, pB1, pA0, pA1); SBAR(); pv_psm<VAR>(o, vb0 + sa * SHM_V, pa0, pa1, pa2, pa3, pB0, shift); SBAR(); KRD(sb);
    if (VAR != 16) __syncthreads();
    ROT();
    const bool t3 = (j + 3 < NT);
    if (t3) WRITEK(sa); WRITEV(sb); if (j + 4 < NT) LOADK(j + 4); if (t3) LOADV(j + 3);
    SBAR(); QF(true, pA0, pA1, pB0, pB1); SBAR(); pv_psm<VAR>(o, vb0 + sa * SHM_V, pa0, pa1, pa2, pa3, pA0, shift); SBAR(); KRD(sb);
    if (VAR != 16) __syncthreads();
    ROT();
  }
#else
  LOADK(0); LOADV(0); WRITEK(0); WRITEV(0); LOADK(1); WRITEK(1); LOADK(2); LOADV(1);
  __syncthreads();
  KRD(0);
  int sa = 2, sb = 1, kq = 0;
#define ROT() do { sa = (sa == 2) ? 0 : sa + 1; sb = (sb == 2) ? 0 : sb + 1; kq = (kq == 2) ? 0 : kq + 1; } while (0)
  SBAR(); QF(false, pA0, pA1, pA0, pA1); SBAR(); KRD(sb); partialSM<VAR>(pA0, shift); WRITEK(sa); WRITEV(sb); LOADK(3); LOADV(2); __syncthreads();
  ROT();
  int j = 1;
  for (; j + 1 < NT; j += 2) {
    SBAR(); QF(true, pB0, pB1, pA0, pA1); SBAR(); pv_psm<VAR>(o, vb0 + sa * SHM_V, pa0, pa1, pa2, pa3, pB0, shift); SBAR(); KRD(sb);
    WRITEK(sa); WRITEV(sb); if (j + 3 < NT) LOADK(j + 3); LOADV(j + 2); if (VAR != 16) __syncthreads();
    ROT();
    const bool t3 = (j + 3 < NT);
    SBAR(); QF(true, pA0, pA1, pB0, pB1); SBAR(); pv_psm<VAR>(o, vb0 + sa * SHM_V, pa0, pa1, pa2, pa3, pA0, shift); SBAR(); KRD(sb);
    if (t3) WRITEK(sa); WRITEV(sb); if (j + 4 < NT) LOADK(j + 4); if (t3) LOADV(j + 3); if (VAR != 16) __syncthreads();
    ROT();
  }
#endif
  SBAR(); QF(true, pB0, pB1, pA0, pA1); SBAR(); PV(sa); partialSM<VAR>(pB0, shift);
  finishSM<VAR>(pB0, pB1, shift, l_reg, pa0, pa1, pa2, pa3); SBAR();
  ROT();
  PV(sa);
#endif
  { auto rr = __builtin_amdgcn_permlane32_swap(__float_as_uint(l_reg), __float_as_uint(l_reg), false, false); l_reg = __uint_as_float(rr[0]) + __uint_as_float(rr[1]); }
  const float rl = __builtin_amdgcn_rcpf(l_reg);
  { bf16_t* stg = (bf16_t*)(lds + LDS_OST) + wid * 2048;
#pragma unroll
    for (int d0 = 0; d0 < 2; ++d0)
#pragma unroll
      for (int g = 0; g < 4; ++g) { u32x2 w; w.x = cvt_pk_bf16(o[d0][4 * g] * rl, o[d0][4 * g + 1] * rl); w.y = cvt_pk_bf16(o[d0][4 * g + 2] * rl, o[d0][4 * g + 3] * rl);
        *(u32x2*)(stg + r32 * 64 + d0 * 32 + 8 * g + 4 * hi) = w; }
    asm volatile("s_waitcnt lgkmcnt(0)" ::: "memory");
    bf16_t* Ow = mix + (size_t)(qrow0 + wid * QBLK) * D_MODEL + 256 + h * 64;
#pragma unroll
    for (int i = 0; i < 4; ++i) { const int row = i * 8 + (lane >> 3), ch = lane & 7; const u32x4 v = *(const u32x4*)(stg + row * 64 + ch * 8); *(u32x4*)(Ow + (size_t)row * D_MODEL + ch * 8) = v; } }
  __syncthreads();
#undef LOADK
#undef LOADV
#undef WRITEK
#undef WRITEV
#undef ROT
#undef QF
#undef QFS
#undef KRD
#undef PV
}
#undef SBAR
}
namespace thin {
__device__ __forceinline__ float fexp(float x) { return __builtin_amdgcn_exp2f(x * 1.4426950408889634f); }
__device__ __forceinline__ float sigmoidf_(float x) { return __builtin_amdgcn_rcpf(1.0f + fexp(-x)); }
__device__ __forceinline__ float gelu_tanh(float x) { return x * __builtin_amdgcn_rcpf(1.0f + __builtin_amdgcn_exp2f(x * fmaf(x * x, -0.10294323f, -2.3022082f))); }
__device__ __forceinline__ float fexpm1_neg(float x) { const float p = x * (1.0f + x * (0.5f + x * (0.16666667f + x * (0.041666668f + x * 0.0083333338f)))); const float e = fexp(x) - 1.0f; return x > -0.25f ? p : e; }
__device__ __forceinline__ int rope_logical(int p) { const int q = p >> 3, i = p & 7; return (q >> 1) * 16 + (i >> 2) * 8 + (q & 1) * 4 + (i & 3); }

constexpr int XC_ROWB = 144;
constexpr int LRU_XC = 0, LRU_Y = 256 * XC_ROWB;
constexpr int NPOS = 34;

struct LruP { const bf16_t* z; const float* convw; const float* convb; const bf16_t* gw; const float* ba; const float* bx; const float* lam; float* agg; bf16_t* mix; };

template <int PASS>
__device__ __forceinline__ void lru_item(const LruP& P, int pm, int hd, char* lds) {
    int tid = threadIdx.x; asm volatile("" : "+v"(tid));
    const int  wid = __builtin_amdgcn_readfirstlane(tid >> 6), lane = tid & 63, r32 = lane & 31, hi = lane >> 5;
    const int b = pm / PPB, pp = pm - b * PPB;
    const int L = pp == 0 ? CTX : SEQ, seqbase = b * TPB + (pp == 0 ? 0 : CTX), t0 = pp == 0 ? 0 : (pp - 1) * 256;
    char* XC = lds + LRU_XC; float* Y = (float*)(lds + LRU_Y);
    {
        const int c8 = tid & 7, ch = hd * 64 + c8 * 8;
        f32x4 w[4][2];
#pragma unroll
        for (int k = 0; k < 4; ++k) { w[k][0] = *(const f32x4*)(P.convw + k * 256 + ch); w[k][1] = *(const f32x4*)(P.convw + k * 256 + ch + 4); }
        const f32x4 cb0 = *(const f32x4*)(P.convb + ch), cb1 = *(const f32x4*)(P.convb + ch + 4);
#pragma unroll
        for (int i = 0; i < 4; ++i) {
            const int tk = (tid >> 3) + 64 * i, ts = t0 + tk;
            f32x4 a0 = cb0, a1 = cb1;
#pragma unroll
            for (int k = 0; k < 4; ++k) { const int tsrc = ts + k - 1;
                if (tsrc >= 0 && tsrc < L) { const u32x4 v = *(const u32x4*)(P.z + (size_t)(seqbase + tsrc) * ZW + Z_LX + ch);
                    a0 += w[k][0] * (f32x4){bflo(v.x), bfhi(v.x), bflo(v.y), bfhi(v.y)}; a1 += w[k][1] * (f32x4){bflo(v.z), bfhi(v.z), bflo(v.w), bfhi(v.w)}; } }
            *(u32x4*)(XC + tk * XC_ROWB + c8 * 16) = epi::pack8(a0, a1);
        }
    }
    __syncthreads();
    const int dir = wid & 1, cb = (wid >> 1) & 1, half = wid >> 2;
    const int chl = cb * 32 + r32, ch = hd * 64 + chl;
    bf16x8 Ba[4], Bx[4];
#pragma unroll
    for (int ks = 0; ks < 4; ++ks) {
        Ba[ks] = *(const bf16x8*)(P.gw + ((size_t)((dir * 2 + 0) * 4 + hd) * 64 + chl) * 64 + ks * 16 + hi * 8);
        Bx[ks] = *(const bf16x8*)(P.gw + ((size_t)((dir * 2 + 1) * 4 + hd) * 64 + chl) * 64 + ks * 16 + hi * 8);
    }
    const float bav = P.ba[dir * 256 + ch], bxv = P.bx[dir * 256 + ch];
    const float sp8 = (8.0f * 0.6931471805599453f) * __builtin_amdgcn_logf(1.0f + __builtin_amdgcn_exp2f(-1.4426950408889634f * P.lam[dir * 256 + ch]));
    const float nsp8 = -sp8, ba2 = bav * -1.4426950408889634f, bx2 = bxv * -1.4426950408889634f;
    const bool small_la = __all(sp8 <= 0.125f);
    const int chunk = pp == 0 ? half : 2 * pp + half;
    const int pos = dir == 0 ? chunk : (chunk == 1 ? 0 : (chunk == 0 ? 1 : 35 - chunk));
    float Hrun = 0.f, Arun = 1.f;
    if (PASS == 2) {
        const float* ag = P.agg + ((size_t)(b * 2 + dir) * NPOS) * 512 + ch * 2;
#pragma unroll 1
        for (int p0 = 0; p0 < pos; p0 += 11) {
            f32x2 e[11];
#pragma unroll
            for (int q = 0; q < 11; ++q) e[q] = (p0 + q) < pos ? *(const f32x2*)(ag + (size_t)(p0 + q) * 512) : (f32x2){1.0f, 0.0f};
#pragma unroll
            for (int q = 0; q < 11; ++q) Hrun = e[q].x * Hrun + e[q].y;
        }
    }
    float yv[4][16];
    const int tau = ((r32 >> 2) & 1) * 16 + (r32 >> 3) * 4 + (r32 & 3);
    const int firsthi = dir;
#pragma unroll
    for (int ii = 0; ii < 4; ++ii) {
        const int tile = dir == 0 ? ii : 3 - ii, tb = half * 128 + tile * 32;
        f32x16 ra = {}, ix = {};
#pragma unroll
        for (int ks = 0; ks < 4; ++ks) {
            const bf16x8 af = *(const bf16x8*)(XC + (tb + tau) * XC_ROWB + (ks * 16 + hi * 8) * 2);
            ra = __builtin_amdgcn_mfma_f32_32x32x16_bf16(af, Ba[ks], ra, 0, 0, 0);
            ix = __builtin_amdgcn_mfma_f32_32x32x16_bf16(af, Bx[ks], ix, 0, 0, 0);
        }
        float av[16], bv[16];
        if (small_la) { asm volatile("; lru: series expm1" ::: "memory");
#pragma unroll
            for (int r = 0; r < 16; ++r) {
                const float xcv = bf2f(*(const bf16_t*)(XC + (tb + hi * 16 + r) * XC_ROWB + chl * 2));
                const float rr = __builtin_amdgcn_rcpf(1.0f + __builtin_amdgcn_exp2f(fmaf(ra[r], -1.4426950408889634f, ba2)));
                const float iv = __builtin_amdgcn_rcpf(1.0f + __builtin_amdgcn_exp2f(fmaf(ix[r], -1.4426950408889634f, bx2)));
                const float la = nsp8 * rr;
                const float em = la * fmaf(la, fmaf(la, fmaf(la, 0.041666668f, 0.16666667f), 0.5f), 1.0f);
                av[r] = 1.0f + em; bv[r] = __builtin_amdgcn_sqrtf(-fmaf(em, em, em + em)) * (iv * xcv);
            }
        } else {
#pragma unroll
            for (int r = 0; r < 16; ++r) {
                const float xcv = bf2f(*(const bf16_t*)(XC + (tb + hi * 16 + r) * XC_ROWB + chl * 2));
                const float rr = __builtin_amdgcn_rcpf(1.0f + __builtin_amdgcn_exp2f(fmaf(ra[r], -1.4426950408889634f, ba2)));
                const float iv = __builtin_amdgcn_rcpf(1.0f + __builtin_amdgcn_exp2f(fmaf(ix[r], -1.4426950408889634f, bx2)));
                const float em = fexpm1_neg(nsp8 * rr);
                av[r] = 1.0f + em; bv[r] = __builtin_amdgcn_sqrtf(-fmaf(em, em, em + em)) * (iv * xcv);
            }
        }
        float hl[16], cl[16]; float h = 0.f, c = 1.f;
        if (dir == 0) {
#pragma unroll
            for (int r = 0; r < 16; ++r) { h = av[r] * h + bv[r]; c *= av[r]; hl[r] = h; cl[r] = c; }
        } else {
#pragma unroll
            for (int r = 15; r >= 0; --r) { h = av[r] * h + bv[r]; c *= av[r]; hl[r] = h; cl[r] = c; }
        }
        const auto hs = __builtin_amdgcn_permlane32_swap(__float_as_uint(h), __float_as_uint(h), false, false), cs = __builtin_amdgcn_permlane32_swap(__float_as_uint(c), __float_as_uint(c), false, false);
        const float H1 = __uint_as_float(firsthi ? hs[1] : hs[0]), A1 = __uint_as_float(firsthi ? cs[1] : cs[0]);
        const float H2 = __uint_as_float(firsthi ? hs[0] : hs[1]), A2 = __uint_as_float(firsthi ? cs[0] : cs[1]);
        const float Hin1 = Hrun, Hin2 = A1 * Hrun + H1;
        const float Hmine = (hi == firsthi) ? Hin1 : Hin2;
        Hrun = A2 * Hin2 + H2; Arun = Arun * A1 * A2;
        if (PASS == 2) {
#pragma unroll
            for (int r = 0; r < 16; ++r) yv[ii][r] = hl[r] + cl[r] * Hmine;
        }
    }
    if (PASS == 1) {
        if (hi == 0) *(f32x2*)(P.agg + ((size_t)(b * 2 + dir) * NPOS + pos) * 512 + ch * 2) = (f32x2){Arun, Hrun};
        __syncthreads();
    } else {
        if (dir == 0) {
#pragma unroll
            for (int ii = 0; ii < 4; ++ii)
#pragma unroll
                for (int r = 0; r < 16; ++r) Y[(half * 128 + ii * 32 + hi * 16 + r) * 64 + chl] = yv[ii][r];
        }
        __syncthreads();
        if (dir == 1) {
            float t[4][16];
#pragma unroll
            for (int ii = 0; ii < 4; ++ii)
#pragma unroll
                for (int r = 0; r < 16; ++r) t[ii][r] = Y[(half * 128 + (3 - ii) * 32 + hi * 16 + r) * 64 + chl];
#pragma unroll
            for (int ii = 0; ii < 4; ++ii)
#pragma unroll
                for (int r = 0; r < 16; ++r) Y[(half * 128 + (3 - ii) * 32 + hi * 16 + r) * 64 + chl] = t[ii][r] + yv[ii][r];
        }
        __syncthreads();
        const int c8 = tid & 7;
#pragma unroll
        for (int i = 0; i < 4; ++i) {
            const int tk = (tid >> 3) + 64 * i; const size_t row = (size_t)pm * 256 + tk;
            const f32x4 y0 = *(const f32x4*)(Y + tk * 64 + c8 * 8), y1 = *(const f32x4*)(Y + tk * 64 + c8 * 8 + 4);
            const u32x4 g = *(const u32x4*)(P.z + row * ZW + Z_LG + hd * 64 + c8 * 8);
            const f32x4 o0 = y0 * (f32x4){gelu_tanh(bflo(g.x)), gelu_tanh(bfhi(g.x)), gelu_tanh(bflo(g.y)), gelu_tanh(bfhi(g.y))};
            const f32x4 o1 = y1 * (f32x4){gelu_tanh(bflo(g.z)), gelu_tanh(bfhi(g.z)), gelu_tanh(bflo(g.w)), gelu_tanh(bfhi(g.w))};
            *(u32x4*)(P.mix + row * D_MODEL + hd * 64 + c8 * 8) = epi::pack8(o0, o1);
        }
        __syncthreads();
    }
}

constexpr int PL_PU = 0, PL_MX = 272 * 128;
template <int GI>
__device__ __forceinline__ void pool_item_g(const bf16_t* z, const bf16_t* pw, bf16_t* mix, int pm, char* lds) {
    constexpr int g = GI, W = 2 << GI;
    int tid = threadIdx.x; asm volatile("" : "+v"(tid));
    const int  wid = __builtin_amdgcn_readfirstlane(tid >> 6), lane = tid & 63, r32 = lane & 31, hi = lane >> 5;
    const int b = pm / PPB, pp = pm - b * PPB;
    const int L = pp == 0 ? CTX : SEQ, seqbase = b * TPB + (pp == 0 ? 0 : CTX), t0 = pp == 0 ? 0 : (pp - 1) * 256;
    char* PU = lds + PL_PU; char* MX = lds + PL_MX;
    const int c8 = tid & 7;
#pragma unroll
    for (int i = 0; i < 5; ++i) { const int hr = (tid >> 3) + 64 * i, ts = t0 - 8 + hr;
        if (hr < 272 && ts >= 0 && ts < L) *(u32x4*)(PU + hr * 128 + c8 * 16) = *(const u32x4*)(z + (size_t)(seqbase + ts) * ZW + Z_PU + g * 64 + c8 * 8); }
    __syncthreads();
#pragma unroll
    for (int i = 0; i < 4; ++i) {
        const int tk = (tid >> 3) + 64 * i, ts = t0 + tk;
        f32x4 s0 = {0.f, 0.f, 0.f, 0.f}, s1 = {0.f, 0.f, 0.f, 0.f}; int cnt = 0;
#pragma unroll
        for (int k = 0; k < W; ++k) {
            const int tt = ts - W / 2 + k;
            if (tt >= 0 && tt < L) { const u32x4 v = *(const u32x4*)(PU + (tk + 8 - W / 2 + k) * 128 + c8 * 16); ++cnt;
                s0 += (f32x4){bflo(v.x), bfhi(v.x), bflo(v.y), bfhi(v.y)}; s1 += (f32x4){bflo(v.z), bfhi(v.z), bflo(v.w), bfhi(v.w)}; } }
        const float inv = __builtin_amdgcn_rcpf((float)cnt);
        const u32x4 v = *(const u32x4*)(PU + (tk + 8) * 128 + c8 * 16);
        s0 = s0 * inv - (f32x4){bflo(v.x), bfhi(v.x), bflo(v.y), bfhi(v.y)}; s1 = s1 * inv - (f32x4){bflo(v.z), bfhi(v.z), bflo(v.w), bfhi(v.w)};
        *(u32x4*)(MX + tk * XC_ROWB + c8 * 16) = epi::pack8(s0, s1);
    }
    __syncthreads();
    f32x16 c0 = {}, c1 = {};
#pragma unroll
    for (int ks = 0; ks < 4; ++ks) {
        const bf16x8 bf = *(const bf16x8*)(MX + (wid * 32 + r32) * XC_ROWB + (ks * 16 + hi * 8) * 2);
        const bf16x8 a0 = *(const bf16x8*)(pw + ((size_t)g * 64 + r32) * 64 + ks * 16 + hi * 8);
        const bf16x8 a1 = *(const bf16x8*)(pw + ((size_t)g * 64 + 32 + r32) * 64 + ks * 16 + hi * 8);
        c0 = __builtin_amdgcn_mfma_f32_32x32x16_bf16(a0, bf, c0, 0, 0, 0);
        c1 = __builtin_amdgcn_mfma_f32_32x32x16_bf16(a1, bf, c1, 0, 0, 0);
    }
    bf16_t* OT = (bf16_t*)PU;
#pragma unroll
    for (int q = 0; q < 4; ++q) {
        u32x2 w0, w1; w0.x = cvt_pk_bf16(c0[4 * q], c0[4 * q + 1]); w0.y = cvt_pk_bf16(c0[4 * q + 2], c0[4 * q + 3]);
        w1.x = cvt_pk_bf16(c1[4 * q], c1[4 * q + 1]); w1.y = cvt_pk_bf16(c1[4 * q + 2], c1[4 * q + 3]);
        *(u32x2*)(OT + (wid * 32 + r32) * 64 + 4 * hi + 8 * q) = w0; *(u32x2*)(OT + (wid * 32 + r32) * 64 + 32 + 4 * hi + 8 * q) = w1;
    }
    __syncthreads();
#pragma unroll
    for (int i = 0; i < 4; ++i) { const int tk = (tid >> 3) + 64 * i;
        *(u32x4*)(mix + ((size_t)pm * 256 + tk) * D_MODEL + 768 + g * 64 + c8 * 8) = *(const u32x4*)(OT + tk * 64 + c8 * 8); }
    __syncthreads();
}
__device__ __forceinline__ void pool_item(const bf16_t* z, const bf16_t* pw, bf16_t* mix, int pm, int g, char* lds) {
    if (g == 0) pool_item_g<0>(z, pw, mix, pm, lds); else if (g == 1) pool_item_g<1>(z, pw, mix, pm, lds); else if (g == 2) pool_item_g<2>(z, pw, mix, pm, lds); else pool_item_g<3>(z, pw, mix, pm, lds);
}

__device__ __forceinline__ void transpose_tile(const float* W, int N, bf16_t* WT, int Kp, int k0, int nphys, int srcbase, bool rperm, const float* kscale, const float* nscale, bool zero, LAS float* scr, int lane) {
    const int nl = lane & 31, sc = srcbase + (rperm ? rope_logical(nl) : nl);
    const float nsv = nscale ? nscale[nl] : 1.0f;
#pragma unroll 8
    for (int i = 0; i < 32; ++i) { const int kk = 2 * i + (lane >> 5);
        float v = zero ? 0.f : __builtin_nontemporal_load(W + (size_t)(k0 + kk) * N + sc) * nsv;     if (kscale) v *= kscale[k0 + kk];
        scr[kk * 33 + nl] = v; }
    asm volatile("s_waitcnt lgkmcnt(0)" ::: "memory");
    const int c = lane & 7;
#pragma unroll
    for (int j = 0; j < 4; ++j) { const int n = (lane >> 3) + 8 * j; const LAS float* s = scr + (8 * c) * 33 + n;
        u32x4 o; o.x = cvt_pk_bf16(s[0 * 33], s[1 * 33]); o.y = cvt_pk_bf16(s[2 * 33], s[3 * 33]); o.z = cvt_pk_bf16(s[4 * 33], s[5 * 33]); o.w = cvt_pk_bf16(s[6 * 33], s[7 * 33]);
        *(u32x4*)(WT + (size_t)(nphys + n) * Kp + k0 + 8 * c) = o; }
    asm volatile("s_waitcnt lgkmcnt(0)" ::: "memory");
}
#define WS_DPP(v, ctrl) __uint_as_float((unsigned)__builtin_amdgcn_update_dpp(0, (int)__float_as_uint(v), ctrl, 0xF, 0xF, true))
__device__ __forceinline__ float wave_sum(float v) {
    v += WS_DPP(v, 0xB1); v += WS_DPP(v, 0x4E); v += WS_DPP(v, 0x141); v += WS_DPP(v, 0x140);
    auto a = __builtin_amdgcn_permlane16_swap(__float_as_uint(v), __float_as_uint(v), false, false); v = __uint_as_float(a[0]) + __uint_as_float(a[1]);
    auto b = __builtin_amdgcn_permlane32_swap(__float_as_uint(v), __float_as_uint(v), false, false); return __uint_as_float(b[0]) + __uint_as_float(b[1]);
}
}
constexpr int NWAVES = 8;
constexpr size_t MiB = 1u << 20;
constexpr size_t WS_CTL = 0, CTL_ZERO_BYTES = 64 * 1024;
constexpr size_t WS_MODPART = 1 * MiB;
constexpr size_t WS_VEC = 5 * MiB;
constexpr size_t WS_BIASIN = WS_VEC + 512 * 1024;
constexpr size_t WS_BIASFF = WS_BIASIN + 128 * 1024;
constexpr size_t WS_RTAB = WS_BIASFF + 320 * 1024;
constexpr size_t WS_RVEC = 17 * MiB + 512 * 1024;
constexpr size_t WS_AGG = 6 * MiB;
constexpr size_t WS_SSQX = 8 * MiB;
constexpr size_t WS_SSQKV = 11 * MiB;
constexpr size_t WS_SSQQ = 14 * MiB;
constexpr size_t WS_WT = 18 * MiB, WT_LAYER = 23 * MiB;
constexpr size_t WT_IN = 0, WT_UQ = 3 * MiB, WT_UKV = WT_UQ + 640 * 1024, WT_OUT = WT_UKV + 512 * 1024, WT_FF1 = WT_OUT + 2 * MiB, WT_FF2 = WT_FF1 + 8 * MiB, WT_GATE = WT_FF2 + 8 * MiB, WT_POOL = WT_GATE + 128 * 1024;
static_assert(WT_POOL + 32 * 1024 <= WT_LAYER, "weights per layer");
constexpr size_t WS_XG = 72 * MiB;
constexpr size_t WS_U = 208 * MiB;
constexpr size_t WS_Z = WS_U, WS_Q = WS_Z + 102 * MiB, WS_K = WS_Q + 51 * MiB, WS_V = WS_K + 51 * MiB;
constexpr size_t WS_END = WS_U + 272 * MiB;
static_assert(WS_V + 34 * MiB <= WS_END && WS_END <= 512 * MiB, "d_ws map");
enum { VEC_GM1 = 0, VEC_G1 = 1, VEC_GM2 = 2, VEC_G2 = 3, VEC_SH1 = 4, VEC_SH2 = 5 };

constexpr int LDS_BYTES = 147456;
constexpr int LDSCTL_OFF = 131072, MISC_OFF = LDSCTL_OFF + 320;

typedef GAS unsigned gu32;
#define RLX_AGENT __ATOMIC_RELAXED, __HIP_MEMORY_SCOPE_AGENT
#define XB_TMO      128
#define XB_XCNT(j)  (256  + 64 * (j))
#define XB_XSUB(j)  (1280 + 64 * (j))
#define XB_XGEN(j)  (2304 + 64 * (j))
#define XB_TOP      3328
#define XB_TOPGEN   3392
#define XCD_BAR_WORDS 3456
#define XB_SPIN_CAP (1u << 20)
__device__ __forceinline__ unsigned xb_ld(unsigned* p)              { return __hip_atomic_load(p, __ATOMIC_RELAXED, __HIP_MEMORY_SCOPE_AGENT); }
__device__ __forceinline__ unsigned xb_add(unsigned* p, unsigned v) { return __hip_atomic_fetch_add(p, v, __ATOMIC_RELAXED, __HIP_MEMORY_SCOPE_AGENT); }
__device__ __forceinline__ unsigned xb_xcc_id() { return (unsigned)__builtin_amdgcn_s_getreg((3 << 11) | 20) & 0xFu; }
#define XB_SPIN(cond, bar) do { unsigned _sp = 0; while (cond) { __builtin_amdgcn_s_sleep(1); \
    if ((++_sp & 255u) == 0u) { if (xb_ld(&(bar)[XB_TMO])) break; if (_sp > XB_SPIN_CAP) { atomicAdd(&(bar)[XB_TMO], 1u); break; } } } } while (0)
struct XcdBarrier { unsigned* bar; unsigned x; volatile LAS unsigned* st; };
__device__ __forceinline__ XcdBarrier xcd_barrier_post(unsigned* bar, volatile LAS unsigned* st) {
    XcdBarrier b; b.bar = bar; b.x = xb_xcc_id(); b.st = st;
    if (threadIdx.x == 0) (void)xb_add(&bar[XB_XCNT(b.x)], 1u);
    return b;
}
__device__ __forceinline__ void xcd_barrier_complete(unsigned* bar, unsigned x, unsigned& nloc, unsigned& nx) {
    const unsigned G = gridDim.x * gridDim.y * gridDim.z;
    unsigned sum, cnt, mine, sp = 0u;
    for (;;) {
        sum = 0u; cnt = 0u; mine = 0u;
#pragma unroll
        for (unsigned j = 0; j < 16; ++j) { const unsigned c = xb_ld(&bar[XB_XCNT(j)]); sum += c; cnt += (c > 0u) ? 1u : 0u; mine = (j == x) ? c : mine; }
        if (sum == G) break;
        __builtin_amdgcn_s_sleep(1);
        if ((++sp & 255u) == 0u) { if (xb_ld(&bar[XB_TMO])) break; if (sp > XB_SPIN_CAP) { atomicAdd(&bar[XB_TMO], 1u); break; } }
    }
    nloc = mine > 0u ? mine : 1u; nx = cnt > 0u ? cnt : 1u;
}
#ifndef FASTBAR
#define FASTBAR 1
#endif
#if FASTBAR
__device__ __forceinline__ void xcd_barrier(const XcdBarrier& b) {
    asm volatile("s_waitcnt vmcnt(0)" ::: "memory");
    __syncthreads();
    if (threadIdx.x == 0) {
        unsigned* bar = b.bar;
        __builtin_amdgcn_s_waitcnt(0);
        unsigned nloc = b.st[0], nx = b.st[1];
        if (nloc == 0u) { xcd_barrier_complete(bar, b.x, nloc, nx); b.st[0] = nloc; b.st[1] = nx; }
        const unsigned k = b.st[2]; b.st[2] = k + 1u;
        const unsigned old = xb_add(&bar[XB_XSUB(b.x)], 1u);
        if ((old + 1u) % nloc == 0u) {
            __builtin_amdgcn_fence(__ATOMIC_RELEASE, "agent");
            asm volatile("s_waitcnt vmcnt(0)" ::: "memory");
            const unsigned og = xb_add(&bar[XB_TOP], 1u);
            if ((og + 1u) % nx == 0u) xb_add(&bar[XB_TOPGEN], 1u);
        }
        __builtin_amdgcn_fence(__ATOMIC_ACQUIRE, "agent");
        XB_SPIN(xb_ld(&bar[XB_TOPGEN]) == k, bar);
        asm volatile("s_waitcnt vmcnt(0)" ::: "memory");
    }
    __syncthreads();
}
#else
__device__ __forceinline__ void xcd_barrier(const XcdBarrier& b) {
    asm volatile("s_waitcnt vmcnt(0)" ::: "memory");
    __syncthreads();
    if (threadIdx.x == 0) {
        unsigned* bar = b.bar;
        __builtin_amdgcn_s_waitcnt(0);
        unsigned nloc = b.st[0], nx = b.st[1];
        if (nloc == 0u) { xcd_barrier_complete(bar, b.x, nloc, nx); b.st[0] = nloc; b.st[1] = nx; }
        const unsigned old = xb_add(&bar[XB_XSUB(b.x)], 1u);
        const unsigned gen = old / nloc;
        if (old + 1u == (gen + 1u) * nloc) {
            __builtin_amdgcn_fence(__ATOMIC_RELEASE, "agent");
            asm volatile("s_waitcnt vmcnt(0)" ::: "memory");
            const unsigned og = xb_add(&bar[XB_TOP], 1u);
            const unsigned tg = og / nx;
            if (og + 1u == (tg + 1u) * nx) xb_add(&bar[XB_TOPGEN], 1u);
            else XB_SPIN(xb_ld(&bar[XB_TOPGEN]) == tg, bar);
            __builtin_amdgcn_fence(__ATOMIC_ACQUIRE, "agent");
            xb_add(&bar[XB_XGEN(b.x)], 1u);
            asm volatile("s_waitcnt vmcnt(0)" ::: "memory");
        } else {
            XB_SPIN(xb_ld(&bar[XB_XGEN(b.x)]) == gen, bar);
            __builtin_amdgcn_fence(__ATOMIC_ACQUIRE, "agent");
            asm volatile("s_waitcnt vmcnt(0)" ::: "memory");
        }
    }
    __syncthreads();
}
#endif


__device__ __forceinline__ void gate_wait(const unsigned* w, unsigned need, unsigned* tmo) {
    if (threadIdx.x < 64) { unsigned sp = 0u;
        while ((unsigned)__builtin_amdgcn_readfirstlane(xb_ld((unsigned*)w)) < need) { __builtin_amdgcn_s_sleep(2);
            if ((++sp & 255u) == 0u) { if (xb_ld(tmo)) break; if (sp > XB_SPIN_CAP) { if (threadIdx.x == 0) atomicAdd(tmo, 1u); break; } } }
        __builtin_amdgcn_fence(__ATOMIC_ACQUIRE, "agent");
        asm volatile("s_waitcnt vmcnt(0)" ::: "memory"); }
    __syncthreads();
}

__device__ __forceinline__ void ctx_combine(unsigned char* ws, float* out, const float* rgmv, const float* gatev, const float* gmv, int gw, int NGW, int lane_in) {
    int lane = lane_in; asm volatile("" : "+v"(lane)); lane &= 63;
    const float* slab = out + (size_t)18 * 1024 * 1024;
    bf16_t* xg_ = (bf16_t*)(ws + WS_XG); float* ssq_ = (float*)(ws + WS_SSQX);
    for (int cr = gw; cr < BATCH * CTX; cr += NGW) {
        const size_t urow = (size_t)(cr >> 8) * TPB + (cr & 255); float ss = 0.f;
#pragma unroll
        for (int j = 0; j < 4; ++j) { const int col = 256 * j + 4 * lane;
            f32x4 a = *(const f32x4*)(slab + (size_t)cr * D_MODEL + col);
#pragma unroll
            for (int ks = 1; ks < 4; ++ks) a += *(const f32x4*)(slab + ((size_t)ks * (BATCH * CTX) + cr) * D_MODEL + col);
            const u32x2 w = *(const u32x2*)(xg_ + urow * D_MODEL + col);
            const f32x4 x = (f32x4){bflo(w.x), bfhi(w.x), bflo(w.y), bfhi(w.y)} * *(const f32x4*)(rgmv + col) + *(const f32x4*)(gatev + col) * a;
            ss += epi::sq4(x);
            const f32x4 t = x * *(const f32x4*)(gmv + col); u32x2 o; o.x = cvt_pk_bf16(t[0], t[1]); o.y = cvt_pk_bf16(t[2], t[3]); *(u32x2*)(xg_ + urow * D_MODEL + col) = o; }
        ss = thin::wave_sum(ss);
        if (lane < 16) ssq_[urow * 16 + lane] = lane == 0 ? ss : 0.f;
    }
}

struct Args { const float* in[27]; float* out; unsigned char* ws; int ph_lo, ph_hi; };
constexpr int NPHASE = 15;

#ifndef COMBINE_IN_PA
#define COMBINE_IN_PA 0
#endif
#ifndef LATE_L1
#define LATE_L1 0
#endif
#define DO_BIAS(C0_, C1_, GW_, NGW_) do { \
        float* sl = (float*)ldsg; \
        for (int combo = (C0_); combo < (C1_); ++combo) { \
            const int l = combo >> 1, mat = combo & 1, N = mat ? D_FF : ZW; \
            __syncthreads(); \
            for (int i = tid; i < 9 * 1024; i += NWAVES * 64) sl[i] = vec[(size_t)(l * 9 + (i >> 10)) * 6144 + (mat ? VEC_SH2 : VEC_SH1) * 1024 + (i & 1023)]; \
            __syncthreads(); \
            const bf16_t* wt = (const bf16_t*)(ws + WS_WT + (size_t)l * WT_LAYER + (mat ? WT_FF1 : WT_IN)); \
            float* bo = (mat ? bias_ff : bias_in) + (size_t)l * 9 * N; \
            for (int n = (GW_); n < N; n += (NGW_)) { \
                const u32x4 w0 = *(const u32x4*)(wt + (size_t)n * 1024 + 8 * lane), w1 = *(const u32x4*)(wt + (size_t)n * 1024 + 512 + 8 * lane); \
                float wv[16] = {bflo(w0.x), bfhi(w0.x), bflo(w0.y), bfhi(w0.y), bflo(w0.z), bfhi(w0.z), bflo(w0.w), bfhi(w0.w), bflo(w1.x), bfhi(w1.x), bflo(w1.y), bfhi(w1.y), bflo(w1.z), bfhi(w1.z), bflo(w1.w), bfhi(w1.w)}; \
_Pragma("unroll") \
                for (int b = 0; b < 9; ++b) { float s = 0.f; \
_Pragma("unroll") \
                    for (int i = 0; i < 8; ++i) s += wv[i] * sl[b * 1024 + 8 * lane + i] + wv[8 + i] * sl[b * 1024 + 512 + 8 * lane + i]; \
                    s = thin::wave_sum(s); if (lane == 0) bo[b * N + n] = s; } \
            } \
        } \
    } while (0)
#define DO_TRANSPOSES(L_, GW_, NGW_) do { \
        LAS float* scr = (LAS float*)(lds + wave * 16384); \
        constexpr int I_IN = 768, I_UQ = 144, I_UKV = 128, I_OUT = 512, I_FF1 = 2048, I_FF2 = 2048, I_G = 32, I_P = 8, I_L = I_IN + I_UQ + I_UKV + I_OUT + I_FF1 + I_FF2 + I_G + I_P; \
        for (int it = (GW_); it < I_L; it += (NGW_)) { \
            const int l = (L_); int r = it; bf16_t* wt = (bf16_t*)(ws + WS_WT + (size_t)l * WT_LAYER); \
            if (r < I_IN) { const int pg = r >> 4, kb = r & 15; int src = 0; bool z0 = false, rp = false; \
                if (pg < 16) src = 32 * pg; else if (pg < 24) src = 896 + 32 * (pg - 16); else if (pg < 32) src = 1184 + 32 * (pg - 24); else if (pg < 44) src = 512 + 32 * (pg - 32); else if (pg == 44) { src = 1152; rp = true; } else z0 = true; \
                thin::transpose_tile(w_in + (size_t)l * 1024 * D_IN, D_IN, wt + WT_IN / 2, 1024, kb * 64, pg * 32, src, rp, nullptr, nullptr, z0, scr, lane); continue; } r -= I_IN; \
            if (r < I_UQ) { const int pg = r / 6, kb = r - pg * 6; \
                thin::transpose_tile(w_uq + (size_t)l * 384 * 768, 768, wt + WT_UQ / 2, 384, kb * 64, pg * 32, pg * 32, (pg % 3) == 2, g_q_lat + l * 384, nullptr, false, scr, lane); continue; } r -= I_UQ; \
            if (r < I_UKV) { const int pg = r >> 2, kb = r & 3, pn = pg >> 3, bj = (pg >> 2) & 1, wc = pg & 3; \
                const int src = pn < 2 ? (4 * pn + wc) * 128 + 32 * bj : (4 * (pn - 2) + wc) * 128 + 64 + 32 * bj; \
                thin::transpose_tile(w_ukv + (size_t)l * 256 * 1024, 1024, wt + WT_UKV / 2, 256, kb * 64, pg * 32, src, false, g_kv_lat + l * 256, nullptr, false, scr, lane); continue; } r -= I_UKV; \
            if (r < I_OUT) { const int pg = r >> 4, kb = r & 15; \
                thin::transpose_tile(w_out + (size_t)l * 1024 * 1024, 1024, wt + WT_OUT / 2, 1024, kb * 64, pg * 32, pg * 32, false, nullptr, nullptr, false, scr, lane); continue; } r -= I_OUT; \
            if (r < I_FF1) { const int pg = r >> 4, kb = r & 15; \
                thin::transpose_tile(w_ff1 + (size_t)l * 1024 * 4096, 4096, wt + WT_FF1 / 2, 1024, kb * 64, pg * 32, pg * 32, false, nullptr, nullptr, false, scr, lane); continue; } r -= I_FF1; \
            if (r < I_FF2) { const int pg = r >> 6, kb = r & 63; \
                thin::transpose_tile(w_ff2 + (size_t)l * 4096 * 1024, 1024, wt + WT_FF2 / 2, 4096, kb * 64, pg * 32, pg * 32, false, nullptr, nullptr, false, scr, lane); continue; } r -= I_FF2; \
            if (r < I_G) { const int mat = r >> 1, pg = r & 1, dir = mat >> 3, gate = (mat >> 2) & 1, hd = mat & 3; \
                const float* src = (gate ? lru_w_x : lru_w_a) + ((size_t)((l * 2 + dir) * 4 + hd)) * 4096; \
                thin::transpose_tile(src, 64, wt + WT_GATE / 2 + (size_t)mat * 4096, 64, 0, pg * 32, pg * 32, false, nullptr, nullptr, false, scr, lane); continue; } r -= I_G; \
            { const int g = r >> 1, pg = r & 1; \
                thin::transpose_tile(w_pool + (size_t)(l * 4 + g) * 4096, 64, wt + WT_POOL / 2 + (size_t)g * 4096, 64, 0, pg * 32, pg * 32, false, nullptr, pool_scale + l * 256 + g * 64 + pg * 32, false, scr, lane); } \
        } \
    } while (0)
__global__ void __launch_bounds__(NWAVES * 64, 2) fwd_kernel(Args args) {
    extern __shared__ __attribute__((aligned(16))) unsigned char lds_raw[];
    LAS unsigned char* lds = (LAS unsigned char*)lds_raw;
    char* ldsg = (char*)lds_raw;
    const int tid = threadIdx.x, wave = __builtin_amdgcn_readfirstlane(tid >> 6); int lane = tid & 63;
#define RELANE() do { int t_ = threadIdx.x; asm volatile("" : "+v"(t_)); lane = t_ & 63; } while (0)
    const int G = gridDim.x; const int bx = blockIdx.x; const int vcu = (G % 8 == 0) ? (bx % 8) * (G / 8) + bx / 8 : bx;
    unsigned char* ws = args.ws;
    typedef __attribute__((address_space(4))) const Args* KArgs;
#define KA(i) (((KArgs)__builtin_amdgcn_kernarg_segment_ptr())->in[i])
#define x_in KA(0)
#define c_in KA(1)
#define ctx_in KA(2)
#define cctx_in KA(3)
#define w_mod KA(4)
#define b_mod KA(5)
#define g_norm1 KA(6)
#define g_norm2 KA(7)
#define w_in KA(8)
#define conv_w KA(9)
#define conv_b KA(10)
#define lru_w_a KA(11)
#define lru_b_a KA(12)
#define lru_w_x KA(13)
#define lru_b_x KA(14)
#define lru_lambda KA(15)
#define g_q_lat KA(16)
#define w_uq KA(17)
#define g_kv_lat KA(18)
#define w_ukv KA(19)
#define g_qn KA(20)
#define g_kn KA(21)
#define w_pool KA(22)
#define pool_scale KA(23)
#define w_out KA(24)
#define w_ff1 KA(25)
#define w_ff2 KA(26)
    float* out = args.out;
#define modpart ((float*)(ws + WS_MODPART))
#define vec ((float*)(ws + WS_VEC))
#define bias_in ((float*)(ws + WS_BIASIN))
#define bias_ff ((float*)(ws + WS_BIASFF))
#define rtab ((float*)(ws + WS_RTAB))
#define agg ((float*)(ws + WS_AGG))
#define ssqx ((float*)(ws + WS_SSQX))
#define ssqkv ((float*)(ws + WS_SSQKV))
#define ssqq ((float*)(ws + WS_SSQQ))
#define rvec ((float*)(ws + WS_RVEC))
#define xg ((bf16_t*)(ws + WS_XG))
#define mix ((bf16_t*)out)
#define U ((bf16_t*)(ws + WS_U))
#define zb ((bf16_t*)(ws + WS_Z))
#define Qb ((bf16_t*)(ws + WS_Q))
#define Kb ((bf16_t*)(ws + WS_K))
#define Vb ((bf16_t*)(ws + WS_V))

    for (int u = tid; u < (LDS_BYTES - LDSCTL_OFF) / 4; u += NWAVES * 64) ((LAS unsigned*)(lds + LDSCTL_OFF))[u] = 0u;
    __syncthreads();
    const bool single = (args.ph_hi - args.ph_lo) > 1;
    XcdBarrier bar; bar.bar = (unsigned*)(ws + WS_CTL); bar.x = 0; bar.st = nullptr;
    if (single) bar = xcd_barrier_post((unsigned*)(ws + WS_CTL), (volatile LAS unsigned*)(lds + MISC_OFF) + 8);
    const int lo = args.ph_lo, hi = args.ph_hi;
#ifndef PHASE_MASK
#define PHASE_MASK 0x7FF
#endif
#define IN(k) (lo <= (k) && (k) < hi)
#ifndef GATE_PA
#define GATE_PA 1
#endif
#ifndef GATE_PD
#define GATE_PD 1
#endif
#ifndef DUP_MASK
#define DUP_MASK 0x7FF
#endif
#define EN(j) (((PHASE_MASK >> (j)) & 1) && (rep_ > 0 || NREP_CUR == 1 || ((DUP_MASK >> (j)) & 1)))
#ifndef DUP_PHASE
#define DUP_PHASE (-1)
#endif
#define NREP(k) (((k) == DUP_PHASE) ? 2 : 1)
#define SEAM(k) do { if (IN(k) && IN((k) + 1)) xcd_barrier(bar); } while (0)
    const int gw = vcu * NWAVES + wave, NGW = G * NWAVES;

    for (int rep_ = 0, NREP_CUR = NREP(0); rep_ < NREP_CUR; ++rep_) { if (rep_) xcd_barrier(bar);
    if (EN(0) && IN(0)) {
        float* sl = (float*)ldsg;
        for (int i = tid; i < 9 * 1024; i += NWAVES * 64) { const float v = i < 8192 ? c_in[i] : cctx_in[i - 8192]; sl[i] = v / (1.0f + expf(-v)); }
        __syncthreads();
        for (int it = gw; it < 2 * 96 * 8; it += NGW) {
            const int l = it / 768, r = it - l * 768, cg = r >> 3, ks = r & 7;
            float acc[9];
#pragma unroll
            for (int b = 0; b < 9; ++b) acc[b] = 0.f;
            const float* wp = w_mod + ((size_t)l * 1024 + ks * 128) * 6144 + cg * 64 + lane;
#pragma unroll 8
            for (int kk = 0; kk < 128; ++kk) { const float w = __builtin_nontemporal_load(wp + (size_t)kk * 6144);
#pragma unroll
                for (int b = 0; b < 9; ++b) acc[b] += sl[b * 1024 + ks * 128 + kk] * w; }
#pragma unroll
            for (int b = 0; b < 9; ++b) modpart[((size_t)(ks * 2 + l) * 9 + b) * 6144 + cg * 64 + lane] = acc[b];
        }
        __syncthreads();
        if (bx == 0) for (int i = tid; i < 512; i += NWAVES * 64) { const int pos = i >> 3, f = i & 7; const float fr = powf(10000.0f, -(float)f / 8.0f), ang = (float)pos * fr; rtab[i * 2] = cosf(ang); rtab[i * 2 + 1] = sinf(ang); }
        if (LATE_L1) DO_TRANSPOSES(0, gw, NGW); else { DO_TRANSPOSES(0, gw, NGW); DO_TRANSPOSES(1, gw, NGW); }
        __syncthreads();
    }
    } SEAM(0);
    for (int rep_ = 0, NREP_CUR = NREP(1); rep_ < NREP_CUR; ++rep_) { if (rep_) xcd_barrier(bar);
    if (EN(0) && IN(1)) {
        const int gt = vcu * (NWAVES * 64) + tid;
        if (gt < 2 * 9 * 1024) {
            const int l = gt / 9216, r = gt - l * 9216, b = r >> 10, j = r & 1023;
            float m[6];
#pragma unroll
            for (int s = 0; s < 6; ++s) { float a = b_mod[l * 6144 + s * 1024 + j];
#pragma unroll
                for (int ks = 0; ks < 8; ++ks) a += modpart[((size_t)(ks * 2 + l) * 9 + b) * 6144 + s * 1024 + j];
                m[s] = a; }
            float* v = vec + (size_t)(l * 9 + b) * 6144 + j;
            float gm1 = g_norm1[l * 1024 + j] * (1.0f + m[1]), gm2 = g_norm2[l * 1024 + j] * (1.0f + m[4]);
            gm1 = fabsf(gm1) < 1e-20f ? 1e-20f : gm1; gm2 = fabsf(gm2) < 1e-20f ? 1e-20f : gm2;
            v[VEC_GM1 * 1024] = gm1; v[VEC_G1 * 1024] = m[2];
            v[VEC_GM2 * 1024] = gm2; v[VEC_G2 * 1024] = m[5];
            rvec[(size_t)(l * 9 + b) * 2048 + j] = 1.0f / gm1; rvec[(size_t)(l * 9 + b) * 2048 + 1024 + j] = 1.0f / gm2;
            v[VEC_SH1 * 1024] = m[0]; v[VEC_SH2 * 1024] = m[3];
        }
    }
    } SEAM(1);
    for (int rep_ = 0, NREP_CUR = NREP(2); rep_ < NREP_CUR; ++rep_) { if (rep_) xcd_barrier(bar);
    if (EN(0) && IN(2)) {
        RELANE();
        if (LATE_L1) DO_BIAS(0, 2, gw, NGW); else DO_BIAS(0, 4, gw, NGW);
        RELANE();
        for (int r0 = gw * 2; r0 < MROWS; r0 += NGW * 2) {
            f32x4 v[2][4]; const float* gmv[2];
#pragma unroll
            for (int q = 0; q < 2; ++q) { const int r = r0 + q, b = r / TPB, tt = r - b * TPB, bidx = tt < CTX ? 8 : b;
                const float* src = tt < CTX ? ctx_in + ((size_t)b * CTX + tt) * D_MODEL : x_in + ((size_t)b * SEQ + (tt - CTX)) * D_MODEL;
                gmv[q] = vec + (size_t)(0 * 9 + bidx) * 6144 + VEC_GM1 * 1024;
#pragma unroll
                for (int j = 0; j < 4; ++j) v[q][j] = __builtin_nontemporal_load((const f32x4*)(src + 256 * j + 4 * lane)); }
#pragma unroll
            for (int q = 0; q < 2; ++q) { const int r = r0 + q; float ss = 0.f;
#pragma unroll
                for (int j = 0; j < 4; ++j) { const f32x4 g4 = *(const f32x4*)(gmv[q] + 256 * j + 4 * lane); ss += epi::sq4(v[q][j]);
                    const f32x4 t = v[q][j] * g4; u32x2 w; w.x = cvt_pk_bf16(t[0], t[1]); w.y = cvt_pk_bf16(t[2], t[3]); *(u32x2*)(xg + (size_t)r * D_MODEL + 256 * j + 4 * lane) = w; }
                ss = thin::wave_sum(ss);
                if (lane < 16) ssqx[(size_t)r * 16 + lane] = lane == 0 ? ss : 0.f; }
        }
    }
    } SEAM(2);
    for (int l = 0; l < DEPTH; ++l) {
        const int p0 = 3 + 6 * l; const bool lastl = (l == DEPTH - 1);
        const unsigned char* wtl = ws + WS_WT + (size_t)l * WT_LAYER;
        const float* vl = vec + (size_t)l * 9 * 6144;
    for (int rep_ = 0, NREP_CUR = NREP(p0); rep_ < NREP_CUR; ++rep_) { if (rep_) xcd_barrier(bar);
        if (EN(1) && IN(p0)) {
            if (COMBINE_IN_PA && l > 0) { const float* vp = vec + (size_t)(l - 1) * 9 * 6144;
                ctx_combine(ws, out, rvec + (size_t)((l - 1) * 9 + 8) * 2048 + 1024, vp + 8 * 6144 + VEC_G2 * 1024, vec + (size_t)l * 9 * 6144 + 8 * 6144 + VEC_GM1 * 1024, gw, NGW, (int)threadIdx.x); }
            pg8::Gemm g{xg, (const bf16_t*)(wtl + WT_IN)}; pg8::StaticOrder S; S.init(GATE_PA ? 128 : NPAN, ZW / 256, G, bx, GATE_PA ? 1 : 0);
            epi::EpiIn E{zb, ssqx, bias_in + (size_t)l * 9 * ZW, ssqkv, g_kn + l * 96, rtab};
            pg8::gemm_phase<1024, 1024, 1024, false>(lds, g, S, E);
        }
        } SEAM(p0);
    for (int rep_ = 0, NREP_CUR = NREP(p0 + 1); rep_ < NREP_CUR; ++rep_) { if (rep_) xcd_barrier(bar);
        if (IN(p0 + 1)) {
            unsigned* gate1 = (unsigned*)(ws + WS_CTL) + 4096 + 1024 + 1024 * l; unsigned* tmo = (unsigned*)(ws + WS_CTL) + XB_TMO;
            const unsigned need = lastl ? 24u : 48u;
            if (GATE_PA && EN(3) && !(rep_ == 0 && NREP_CUR == 2)) {
                pg8::Gemm ga{xg, (const bf16_t*)(wtl + WT_IN)}; pg8::CtxProdOrder SP;
                if (lastl) SP.init(bx, 192, 2, 3, 0x520u, gate1);
                else SP.init_unit((bx >= 192 && (bx & 7) >= 1 && (bx & 7) <= 6) ? ((bx - 192) >> 3) * 6 + (bx & 7) - 1 : -1, 6, 0x543210u, gate1);
                epi::EpiIn Ea{zb, ssqx, bias_in + (size_t)l * 9 * ZW, ssqkv, g_kn + l * 96, rtab}; pg8::gemm_phase<1024, 1024, 1024, false>(lds, ga, SP, Ea);
            }
            thin::LruP P{zb, conv_w + l * 1024, conv_b + l * 256, (const bf16_t*)(wtl + WT_GATE), lru_b_a + l * 512, lru_b_x + l * 512, lru_lambda + l * 512, agg, mix};
            if (GATE_PA) {
                if (EN(4)) for (int it = G - 1 - vcu; it < 128 * 4; it += G) { const int pl = it >> 2; thin::lru_item<1>(P, pl + pl / 16 + 1, it & 3, ldsg); }
                if (EN(5)) for (int it = vcu; it < 128 * 4; it += G) { const int pl = it >> 2; thin::pool_item(zb, (const bf16_t*)(wtl + WT_POOL), mix, pl + pl / 16 + 1, it & 3, ldsg); }
            }
            if (EN(2)) { pg8::Gemm g{zb + Z_QL, (const bf16_t*)(wtl + WT_UQ)}; epi::EpiQ E{Qb, ssqq, g_qn + l * 96, rtab};
              if (GATE_PA && !lastl) { pg8::GatedOrder SG; SG.init(3, G, bx, gate1, need, tmo); pg8::gemm_phase<384, ZW, 384, false>(lds, g, SG, E); }
              else { pg8::StaticOrder S; S.init(lastl ? 128 : NPAN, 3, G, bx, lastl ? 1 : 0); pg8::gemm_phase<384, ZW, 384, false>(lds, g, S, E); } }
            if (EN(3)) { pg8::Gemm g{zb + Z_KVL, (const bf16_t*)(wtl + WT_UKV)};
              epi::EpiKV<true> EK{Kb, Vb, zb, ssqkv, g_kn + l * 96}; epi::EpiKV<false> EV{Kb, Vb, zb, ssqkv, g_kn + l * 96};
              pg8::GatedOrder SK; SK.init(2, G, (bx + 96) % G, gate1, need, tmo, 0); pg8::gemm_phase<256, ZW, 256, false>(lds, g, SK, EK);
              pg8::GatedOrder SV; SV.init(2, G, (bx + 96 + 128) % G, gate1, need, tmo, 2); pg8::gemm_phase<256, ZW, 256, false>(lds, g, SV, EV); }
            if (GATE_PA) {
                if (EN(4) && G - 1 - vcu < 32) { const int it = G - 1 - vcu; gate_wait(gate1 + 64 * (it >> 2), need, tmo); thin::lru_item<1>(P, (it >> 2) * 17, it & 3, ldsg); }
                if (EN(5) && !lastl && vcu < 32) { gate_wait(gate1 + 64 * (vcu >> 2), need, tmo); thin::pool_item(zb, (const bf16_t*)(wtl + WT_POOL), mix, (vcu >> 2) * 17, vcu & 3, ldsg); }
            } else {
                if (EN(4)) for (int it = G - 1 - vcu; it < NPAN * 4; it += G) thin::lru_item<1>(P, it >> 2, it & 3, ldsg);
                if (!EN(5)) {} else if (lastl) { for (int it = vcu; it < 128 * 4; it += G) { const int pl = it >> 2; thin::pool_item(zb, (const bf16_t*)(wtl + WT_POOL), mix, pl + pl / 16 + 1, it & 3, ldsg); } }
                else { for (int it = vcu; it < NPAN * 4; it += G) thin::pool_item(zb, (const bf16_t*)(wtl + WT_POOL), mix, it >> 2, it & 3, ldsg); }
            }
        }
        } SEAM(p0 + 1);
    for (int rep_ = 0, NREP_CUR = NREP(p0 + 2); rep_ < NREP_CUR; ++rep_) { if (rep_) xcd_barrier(bar);
        if (IN(p0 + 2)) {
#ifndef SHIFT_THRESH
#define SHIFT_THRESH 64.0f
#endif
            float negB2; bool shifted;
            {
                const float* gq = g_qn + l * 96; const float* gk = g_kn + l * 96;
                int ln = threadIdx.x; asm volatile("" : "+v"(ln)); ln &= 63;
                float mq = fmaxf(fabsf(gq[ln]), ln < 32 ? fabsf(gq[64 + ln]) : 0.f), mk = fmaxf(fabsf(gk[ln]), ln < 32 ? fabsf(gk[64 + ln]) : 0.f);
#pragma unroll
                for (int o = 1; o < 64; o <<= 1) { mq = fmaxf(mq, __shfl_xor(mq, o)); mk = fmaxf(mk, __shfl_xor(mk, o)); }
                negB2 = -(96.0f * 1.02f * QSCALE) * mq * mk;
                shifted = __builtin_amdgcn_readfirstlane(negB2 < -SHIFT_THRESH ? 1 : 0) != 0;
                if (!shifted) negB2 = 0.f;
            }
            thin::LruP P{zb, conv_w + l * 1024, conv_b + l * 256, (const bf16_t*)(wtl + WT_GATE), lru_b_a + l * 512, lru_b_x + l * 512, lru_lambda + l * 512, agg, mix};
            if (!EN(6)) {} else if (lastl) { for (int it = vcu; it < 128 * 4; it += G) { const int pl = it >> 2; thin::lru_item<2>(P, pl + pl / 16 + 1, it & 3, ldsg); } }
            else { for (int it = vcu; it < NPAN * 4; it += G) thin::lru_item<2>(P, it >> 2, it & 3, ldsg); }
            if (EN(7)) for (int it = vcu; it < 1024; it += G) {
                const int bh = it >> 4, qp = it & 15, b = bh >> 3, h = bh & 7;
                #ifdef ATT_VAR
                if (rep_ == 0 && NREP(p0 + 2) == 2) att::attn_unit<ATT_VAR>(Qb, Kb, Vb, mix, ssqkv, ssqq, negB2, b * TPB + CTX + qp * 256, b * TPB, TPB, h, ldsg); else
#endif
                if (shifted) att::attn_unit<9>(Qb, Kb, Vb, mix, ssqkv, ssqq, negB2, b * TPB + CTX + qp * 256, b * TPB, TPB, h, ldsg);
                else att::attn_unit<0>(Qb, Kb, Vb, mix, ssqkv, ssqq, negB2, b * TPB + CTX + qp * 256, b * TPB, TPB, h, ldsg);
            }
            if (EN(7) && !lastl) for (int it = G - 1 - vcu; it < 64; it += G) { const int b = it >> 3, h = it & 7;
                if (shifted) att::attn_unit<9>(Qb, Kb, Vb, mix, ssqkv, ssqq, negB2, b * TPB, b * TPB, CTX, h, ldsg); else att::attn_unit<0>(Qb, Kb, Vb, mix, ssqkv, ssqq, negB2, b * TPB, b * TPB, CTX, h, ldsg); }
        }
        } SEAM(p0 + 2);
    for (int rep_ = 0, NREP_CUR = NREP(p0 + 3); rep_ < NREP_CUR; ++rep_) { if (rep_) xcd_barrier(bar);
        if (EN(8) && IN(p0 + 3)) {
            pg8::Gemm g{mix, (const bf16_t*)(wtl + WT_OUT)}; pg8::StaticOrder S; S.init((lastl || GATE_PD) ? 128 : NPAN, 4, G, bx, (lastl || GATE_PD) ? 1 : 0);
            if (l == 0) { epi::EpiRes<true, false> E{x_in, ctx_in, nullptr, xg, ssqx, vl + VEC_G1 * 1024, nullptr, vl + VEC_GM2 * 1024}; pg8::gemm_phase<1024, 1024, 1024, false>(lds, g, S, E); }
            else { epi::EpiRes<false, false> E{nullptr, nullptr, nullptr, xg, ssqx, vl + VEC_G1 * 1024, rvec + (size_t)l * 9 * 2048, vl + VEC_GM2 * 1024}; pg8::gemm_phase<1024, 1024, 1024, false>(lds, g, S, E); }
        }
        } SEAM(p0 + 3);
    for (int rep_ = 0, NREP_CUR = NREP(p0 + 4); rep_ < NREP_CUR; ++rep_) { if (rep_) xcd_barrier(bar);
        if (EN(9) && IN(p0 + 4)) {
#ifndef PE_STAG_US
#define PE_STAG_US 0
#endif
            if (PE_STAG_US > 0 && bx >= 128 && (lastl || (bx - 128) % 3 != 0 || (bx - 128) / 3 >= 32)) {
                const unsigned long long t0_ = __builtin_amdgcn_s_memrealtime();
                while (__builtin_amdgcn_s_memrealtime() - t0_ < (unsigned long long)(PE_STAG_US * 100)) __builtin_amdgcn_s_sleep(16);
            }
            unsigned* gate0 = (unsigned*)(ws + WS_CTL) + 4096;
            if (GATE_PD && !lastl) {
                pg8::Gemm gd{mix, (const bf16_t*)(wtl + WT_OUT)}; pg8::CtxProdOrder SP; SP.init(bx, 128, 3, 4, 0x3210u, gate0);
                epi::EpiRes<true, false> Ed{x_in, ctx_in, nullptr, xg, ssqx, vl + VEC_G1 * 1024, nullptr, vl + VEC_GM2 * 1024}; pg8::gemm_phase<1024, 1024, 1024, false>(lds, gd, SP, Ed);
            }
            pg8::Gemm g{xg, (const bf16_t*)(wtl + WT_FF1)}; pg8::StaticOrder S; S.init(lastl ? 128 : NPAN, 16, G, bx, lastl ? 1 : 0);
            epi::EpiFF1 E{U, ssqx, bias_ff + (size_t)l * 9 * D_FF};
            if (GATE_PD && !lastl) { pg8::GatedOrder SG; SG.init(16, G, bx, gate0, 32u, (unsigned*)(ws + WS_CTL) + XB_TMO); pg8::gemm_phase<1024, 1024, 1024, false>(lds, g, SG, E); } else
#ifdef NULL_DUP
            if (rep_ == 0 && NREP_CUR == 2) { epi::EpiSink E0{(float*)(ws + WS_CTL + 65536)}; pg8::gemm_phase<1024, 1024, 1024, false>(lds, g, S, E0); } else
#endif
            pg8::gemm_phase<1024, 1024, 1024, false>(lds, g, S, E);
            if (LATE_L1 && GATE_PD && !lastl && bx >= 128) {
                const int d = bx - 128; const int hidx = d >= 96 ? d - 32 : (d % 3 != 0 ? d - (d / 3 + 1) : -1);
                if (hidx >= 0) { RELANE(); __syncthreads(); DO_TRANSPOSES(1, hidx * NWAVES + wave, 96 * NWAVES); __syncthreads(); }
            }
        }
        } SEAM(p0 + 4);
    for (int rep_ = 0, NREP_CUR = NREP(p0 + 5); rep_ < NREP_CUR; ++rep_) { if (rep_) xcd_barrier(bar);
        if (EN(10) && IN(p0 + 5)) {
            pg8::Gemm g{U, (const bf16_t*)(wtl + WT_FF2)}; pg8::StaticOrder S; S.init(lastl ? 128 : NPAN, 4, G, bx, lastl ? 1 : 0);
#ifdef NULL_DUP
            if (rep_ == 0 && NREP_CUR == 2) { pg8::StaticOrder SL; SL.init(128, 4, G, bx, 1); epi::EpiSink E0{(float*)(ws + WS_CTL + 65536)}; pg8::gemm_phase<4096, 4096, 4096, true>(lds, g, SL, E0); } else
#endif
            if (lastl) { epi::EpiRes<false, true> E{nullptr, nullptr, out, xg, nullptr, vl + VEC_G2 * 1024, rvec + (size_t)l * 9 * 2048 + 1024, nullptr}; pg8::gemm_phase<4096, 4096, 4096, true>(lds, g, S, E); }
            else {
                { pg8::StaticOrder SL; SL.init(128, 4, G, bx, 1);
                  epi::EpiRes<false, false> E{nullptr, nullptr, nullptr, xg, ssqx, vl + VEC_G2 * 1024, rvec + (size_t)l * 9 * 2048 + 1024, vec + (size_t)(l + 1) * 9 * 6144 + VEC_GM1 * 1024}; pg8::gemm_phase<4096, 4096, 4096, true>(lds, g, SL, E); }
                float* slab = out + (size_t)18 * 1024 * 1024;
                { pg8::CtxSplitOrder SC{4, 4, 1024, G, bx, 1}; epi::EpiSlab E{slab, 1024}; pg8::gemm_phase<1024, 4096, 4096, true>(lds, g, SC, E); }
                if (LATE_L1 && bx >= 128) { RELANE(); DO_BIAS(2, 4, (bx - 128) * NWAVES + wave, 128 * NWAVES); __syncthreads(); }
                if (!COMBINE_IN_PA) {
                xcd_barrier(bar);
                ctx_combine(ws, out, rvec + (size_t)(l * 9 + 8) * 2048 + 1024, vl + 8 * 6144 + VEC_G2 * 1024, vec + (size_t)(l + 1) * 9 * 6144 + 8 * 6144 + VEC_GM1 * 1024, gw, NGW, (int)threadIdx.x); }
            }
        }
        } if (!lastl) SEAM(p0 + 5);
    }
#undef IN
#undef SEAM
}


#ifdef DBG_DUMP
__global__ void dbg_dump(const bf16_t* buf, int pitch, int coloff, int ncols, float* out) {
    for (size_t i = blockIdx.x * (size_t)blockDim.x + threadIdx.x; i < (size_t)BATCH * SEQ * D_MODEL; i += (size_t)gridDim.x * blockDim.x) {
        const int c = (int)(i & 1023); const size_t rt = i >> 10; const int b = (int)(rt / SEQ), t = (int)(rt - (size_t)b * SEQ);
        out[i] = c < ncols ? bf2f(buf[((size_t)b * TPB + CTX + t) * pitch + coloff + c]) : 0.f;
    }
}
#endif
#ifndef N_LAUNCH_MODE
#define N_LAUNCH_MODE 1
#endif
extern "C" void kernel_launch(void* const* d_in, const int* in_sizes, int n_in, void* d_out, int out_size, void* d_ws, size_t ws_size, hipStream_t stream) {
    static int grid = 0;
    if (grid == 0) {
        if (n_in != 27 || in_sizes[0] != BATCH * SEQ * D_MODEL || out_size != BATCH * SEQ * D_MODEL || ws_size < WS_END) { fprintf(stderr, "kernel_launch: unexpected shapes (n_in %d, in0 %d, out %d, ws %zu < %zu)\n", n_in, n_in > 0 ? in_sizes[0] : -1, out_size, ws_size, (size_t)WS_END); grid = -1; return; }
        int dev = 0, cus = 0, per_cu = 0;
        if (hipGetDevice(&dev) != hipSuccess || hipDeviceGetAttribute(&cus, hipDeviceAttributeMultiprocessorCount, dev) != hipSuccess) { grid = -1; return; }
        if (hipFuncSetAttribute((const void*)fwd_kernel, hipFuncAttributeMaxDynamicSharedMemorySize, LDS_BYTES) != hipSuccess) { fprintf(stderr, "kernel_launch: hipFuncSetAttribute failed\n"); grid = -1; return; }
        if (hipOccupancyMaxActiveBlocksPerMultiprocessor(&per_cu, (const void*)fwd_kernel, NWAVES * 64, LDS_BYTES) != hipSuccess || per_cu < 1) { fprintf(stderr, "kernel_launch: occupancy query says %d blocks per CU\n", per_cu); (void)hipGetLastError(); grid = -1; return; }
        grid = cus;
    }
    if (grid < 0) return;
    (void)hipMemsetAsync((char*)d_ws + WS_CTL, 0, CTL_ZERO_BYTES, stream);
    Args a{};
    for (int i = 0; i < 27; ++i) a.in[i] = (const float*)d_in[i];
    a.out = (float*)d_out; a.ws = (unsigned char*)d_ws;
#if N_LAUNCH_MODE
    a.ph_lo = 0; a.ph_hi = NPHASE;
    void* kargs[] = {&a};
    hipError_t e = hipLaunchCooperativeKernel((const void*)fwd_kernel, dim3(grid), dim3(NWAVES * 64), kargs, LDS_BYTES, stream);
    if (e != hipSuccess) fprintf(stderr, "kernel_launch: cooperative launch failed: %s\n", hipGetErrorString(e));
#else
#ifndef DBG_STOP_PHASE
#define DBG_STOP_PHASE NPHASE
#endif
    for (int p = 0; p < DBG_STOP_PHASE; ++p) { a.ph_lo = p; a.ph_hi = p + 1; hipLaunchKernelGGL(fwd_kernel, dim3(grid), dim3(NWAVES * 64), LDS_BYTES, stream, a); }
#ifdef DBG_DUMP
    hipLaunchKernelGGL(dbg_dump, dim3(2048), dim3(256), 0, stream, (const bf16_t*)((unsigned char*)d_ws + DBG_DUMP_OFF), DBG_DUMP_PITCH, DBG_DUMP_COL, DBG_DUMP_NCOLS, (float*)d_out);
#endif
#endif
}
```
